# Optimizing an MI355X kernel written in HIP

```python
import jax, jax.numpy as jnp
from jax import lax
import numpy as np

D_MODEL = 1024
BATCH = 8
SEQ = 4096
DEPTH = 2

GRID_W = 64
CTX_LEN = 256
N_MIXERS = 2
N_HEADS = 8
N_KV_HEADS = 2
GROUP = N_HEADS // N_KV_HEADS
HEAD_DIM = 128
ATTN_DIM = N_HEADS * HEAD_DIM
QKV_DIM = (N_HEADS + 2 * N_KV_HEADS) * HEAD_DIM
WINDOW = 128
BLOCK = 128
AXIS_DIM = HEAD_DIM // 2
ROPE_BASE = 10000.0
LRU_WIDTH = D_MODEL
LRU_BLOCKS = 8
LRU_BLOCK_DIM = LRU_WIDTH // LRU_BLOCKS
CONV_WIDTH = 4
CONV_PAD_LEFT = 2
CONV_PAD_RIGHT = 1
LRU_C = 8.0
D_FF = 3584
N_EXPERTS = 8
TOP_K = 2
N_EVEN = (DEPTH + 1) // 2
N_ODD = DEPTH // 2
ALPHA = (2 * DEPTH) ** 0.25
BETA = (8 * DEPTH) ** -0.25
LN_EPS = 1e-5
NEG_INF = -1e30

kernel_name = "hybrid_swa_rglru_moe_diffusion_trunk"


def layer_norm(h, g, b):
    hf = h.astype(jnp.float32)
    mu = jnp.mean(hf, axis=-1, keepdims=True)
    var = jnp.mean(jnp.square(hf - mu), axis=-1, keepdims=True)
    return ((hf - mu) * lax.rsqrt(var + LN_EPS) * g + b).astype(h.dtype)


def modulate(h, shift, scale):
    return h * (1 + scale) + shift


def grid_rope_angles(L):
    rows = L // GRID_W
    t = jnp.arange(rows * GRID_W)
    row = (t // GRID_W).astype(jnp.float32)
    col = (t % GRID_W).astype(jnp.float32)
    freqs = ROPE_BASE ** (-jnp.arange(0, AXIS_DIM, 2, dtype=jnp.float32) / AXIS_DIM)
    return row[:, None] * freqs, col[:, None] * freqs


def rotate_axis(u, ang):
    half = AXIS_DIM // 2
    cos = jnp.cos(ang)[None, :, None, :].astype(u.dtype)
    sin = jnp.sin(ang)[None, :, None, :].astype(u.dtype)
    u1, u2 = u[..., :half], u[..., half:]
    return jnp.concatenate([u1 * cos - u2 * sin, u2 * cos + u1 * sin], axis=-1)


def apply_rope_2d(u, row_ang, col_ang):
    return jnp.concatenate([rotate_axis(u[..., :AXIS_DIM], row_ang),
                            rotate_axis(u[..., AXIS_DIM:], col_ang)], axis=-1)


def windowed_gqa(hx, hc, w_qkv, w_o, sink, row_ang, col_ang, need_ctx):
    B, L, _ = hx.shape
    Lc = hc.shape[1]
    scale = HEAD_DIM ** -0.5

    def split_heads(u, n):
        q, k, v = jnp.split(u, [ATTN_DIM, ATTN_DIM + N_KV_HEADS * HEAD_DIM], axis=-1)
        return (q.reshape(B, n, N_HEADS, HEAD_DIM), k.reshape(B, n, N_KV_HEADS, HEAD_DIM),
                v.reshape(B, n, N_KV_HEADS, HEAD_DIM))

    q, k, v = split_heads(hx @ w_qkv, L)
    q = apply_rope_2d(q, row_ang, col_ang) * scale
    k = apply_rope_2d(k, row_ang, col_ang)
    qc, kc, vc = split_heads(hc @ w_qkv, Lc)
    sink_g = sink.reshape(N_KV_HEADS, GROUP).astype(jnp.float32)

    nb = L // BLOCK
    qb = q.reshape(B, nb, BLOCK, N_KV_HEADS, GROUP, HEAD_DIM)
    pad = ((0, 0), (BLOCK, BLOCK), (0, 0), (0, 0))
    kp = jnp.pad(k, pad).reshape(B, nb + 2, BLOCK, N_KV_HEADS, HEAD_DIM)
    vp = jnp.pad(v, pad).reshape(B, nb + 2, BLOCK, N_KV_HEADS, HEAD_DIM)
    k_band = jnp.concatenate([kp[:, :-2], kp[:, 1:-1], kp[:, 2:]], axis=2)
    v_band = jnp.concatenate([vp[:, :-2], vp[:, 1:-1], vp[:, 2:]], axis=2)
    s_loc = jnp.einsum('bnqkgd,bnjkd->bnkgqj', qb, k_band).astype(jnp.float32)
    qi = jnp.arange(BLOCK)[:, None]
    kj = jnp.arange(3 * BLOCK)[None, :]
    rel = kj - BLOCK - qi
    key_pos = jnp.arange(nb)[:, None, None] * BLOCK - BLOCK + kj[None]
    valid = (jnp.abs(rel) <= WINDOW)[None] & (key_pos >= 0) & (key_pos < L)
    s_loc = jnp.where(valid[None, :, None, None], s_loc, NEG_INF)
    s_ctx = jnp.einsum('bnqkgd,bckd->bnkgqc', qb, kc).astype(jnp.float32)
    s_sink = jnp.broadcast_to(sink_g[None, None, :, :, None, None],
                              (B, nb, N_KV_HEADS, GROUP, BLOCK, 1))
    p = jax.nn.softmax(jnp.concatenate([s_loc, s_ctx, s_sink], axis=-1), axis=-1).astype(hx.dtype)
    o = (jnp.einsum('bnkgqj,bnjkd->bnqkgd', p[..., :3 * BLOCK], v_band)
         + jnp.einsum('bnkgqc,bckd->bnqkgd', p[..., 3 * BLOCK:3 * BLOCK + Lc], vc))
    out_x = o.reshape(B, L, ATTN_DIM) @ w_o

    if need_ctx:
        qcs = qc.reshape(B, Lc, N_KV_HEADS, GROUP, HEAD_DIM) * scale
        sc = jnp.einsum('bqkgd,bckd->bkgqc', qcs, kc).astype(jnp.float32)
        sc_sink = jnp.broadcast_to(sink_g[None, :, :, None, None], (B, N_KV_HEADS, GROUP, Lc, 1))
        pc = jax.nn.softmax(jnp.concatenate([sc, sc_sink], axis=-1), axis=-1).astype(hc.dtype)
        oc = jnp.einsum('bkgqc,bckd->bqkgd', pc[..., :Lc], vc).reshape(B, Lc, ATTN_DIM)
        out_c = oc @ w_o
    else:
        out_c = None
    return out_x, out_c


def centred_dwconv(u, w, b):
    y = lax.conv_general_dilated(u, w[:, None, :].astype(u.dtype), window_strides=(1,),
                                 padding=[(CONV_PAD_LEFT, CONV_PAD_RIGHT)],
                                 dimension_numbers=('NWC', 'WIO', 'NWC'),
                                 feature_group_count=u.shape[-1])
    return y + b


def block_diag(u, w):
    ub = u.reshape(u.shape[:-1] + (LRU_BLOCKS, LRU_BLOCK_DIM))
    return jnp.einsum('blnd,nde->blne', ub, w).reshape(u.shape)


def linear_scan(a, b, h0):
    b = b.at[:, 0].add(a[:, 0] * h0)

    def combine(e1, e2):
        a1, b1 = e1
        a2, b2 = e2
        return a1 * a2, a2 * b1 + b2

    _, h = lax.associative_scan(combine, (a, b), axis=1)
    return h


def reverse_scan(a, b, h0):
    return jnp.flip(linear_scan(jnp.flip(a, axis=1), jnp.flip(b, axis=1), h0), axis=1)


def bidir_rglru(hx, hc, w_in, conv_w, conv_b, lam, w_r, b_r, w_i, b_i, w_out, need_ctx):
    B = hx.shape[0]
    R = LRU_WIDTH
    gate_x, xb = jnp.split(hx @ w_in, 2, axis=-1)
    if need_ctx:
        gate_c, xb_c = jnp.split(hc @ w_in, 2, axis=-1)
    else:
        xb_c = hc @ w_in[:, R:]
    u_x = centred_dwconv(xb, conv_w, conv_b)
    u_c = centred_dwconv(xb_c, conv_w, conv_b)

    def rg_lru_coeffs(u, d):
        r = jax.nn.sigmoid(block_diag(u, w_r[d]) + b_r[d]).astype(jnp.float32)
        ig = jax.nn.sigmoid(block_diag(u, w_i[d]) + b_i[d])
        log_a = -LRU_C * r * jax.nn.softplus(-lam[d].astype(jnp.float32))
        a = jnp.exp(log_a)
        bterm = jnp.sqrt(-jnp.expm1(2.0 * log_a)) * (ig * u).astype(jnp.float32)
        return a, bterm

    h0 = jnp.zeros((B, R), jnp.float32)
    a_c, b_c = rg_lru_coeffs(u_c, 0)
    hc_f = linear_scan(a_c, b_c, h0)
    a_x, b_x = rg_lru_coeffs(u_x, 0)
    hx_f = linear_scan(a_x, b_x, hc_f[:, -1])
    a_c, b_c = rg_lru_coeffs(u_c, 1)
    hc_b = reverse_scan(a_c, b_c, h0)
    a_x, b_x = rg_lru_coeffs(u_x, 1)
    hx_b = reverse_scan(a_x, b_x, hc_b[:, 0])

    out_x = (jax.nn.gelu(gate_x) * (hx_f + hx_b).astype(hx.dtype)) @ w_out
    if need_ctx:
        out_c = (jax.nn.gelu(gate_c) * (hc_f + hc_b).astype(hc.dtype)) @ w_out
    else:
        out_c = None
    return out_x, out_c


def swiglu(h, w_gu, w_dn):
    g, u = jnp.split(h @ w_gu, 2, axis=-1)
    return (jax.nn.silu(g) * u) @ w_dn


def moe_swiglu(h, router, w_gu, w_dn):
    logits = (h @ router).astype(jnp.float32)
    top_v, top_i = lax.top_k(logits, TOP_K)
    top_w = jax.nn.softmax(top_v, axis=-1)
    gates = jnp.einsum('blk,blke->ble', top_w,
                       jax.nn.one_hot(top_i, N_EXPERTS, dtype=jnp.float32)).astype(h.dtype)
    y = jnp.zeros_like(h)
    for e in range(N_EXPERTS):
        y = y + gates[..., e:e + 1] * swiglu(h, w_gu[e], w_dn[e])
    return y


def setup_inputs(seed: int = 0) -> dict:
    key = jax.random.key(seed)
    ks = iter(jax.random.split(key, 32))

    def nrm(shape, s):
        return jax.random.normal(next(ks), shape, jnp.float32) * s

    D, R, F = D_MODEL, LRU_WIDTH, D_FF
    a8 = jax.random.uniform(next(ks), (N_ODD, 2, R), jnp.float32, 0.9, 0.999)
    sig = a8 ** (1.0 / LRU_C)
    lru_lambda = jnp.log(sig) - jnp.log1p(-sig)
    return {
        "x": nrm((BATCH, SEQ, D), 1.0),
        "c": nrm((BATCH, D), 1.0),
        "ctx": nrm((BATCH, CTX_LEN, D), 1.0),
        "c_ctx": nrm((D,), 1.0),
        "w_mod": nrm((DEPTH, D, 6 * D), D ** -0.5),
        "b_mod": nrm((DEPTH, 6 * D), 0.02),
        "ln_g": 1.0 + nrm((DEPTH, 2, D), 0.02),
        "ln_b": nrm((DEPTH, 2, D), 0.02),
        "attn_w_qkv": nrm((N_EVEN, D, QKV_DIM), D ** -0.5),
        "attn_w_o": nrm((N_EVEN, ATTN_DIM, D), ATTN_DIM ** -0.5 * BETA),
        "attn_sink": nrm((N_EVEN, N_HEADS), 0.5),
        "ffn_w_gu": nrm((N_EVEN, D, 2 * F), D ** -0.5),
        "ffn_w_dn": nrm((N_EVEN, F, D), F ** -0.5 * BETA),
        "lru_w_in": nrm((N_ODD, D, 2 * R), D ** -0.5),
        "lru_conv_w": nrm((N_ODD, CONV_WIDTH, R), CONV_WIDTH ** -0.5),
        "lru_conv_b": nrm((N_ODD, R), 0.02),
        "lru_lambda": lru_lambda,
        "lru_w_r": nrm((N_ODD, 2, LRU_BLOCKS, LRU_BLOCK_DIM, LRU_BLOCK_DIM), LRU_BLOCK_DIM ** -0.5),
        "lru_b_r": nrm((N_ODD, 2, R), 0.02),
        "lru_w_i": nrm((N_ODD, 2, LRU_BLOCKS, LRU_BLOCK_DIM, LRU_BLOCK_DIM), LRU_BLOCK_DIM ** -0.5),
        "lru_b_i": nrm((N_ODD, 2, R), 0.02),
        "lru_w_out": nrm((N_ODD, R, D), R ** -0.5 * BETA),
        "moe_router": nrm((N_ODD, D, N_EXPERTS), D ** -0.5),
        "moe_w_gu": nrm((N_ODD, N_EXPERTS, D, 2 * F), D ** -0.5),
        "moe_w_dn": nrm((N_ODD, N_EXPERTS, F, D), F ** -0.5 * BETA),
    }


def reference(x, c, ctx, c_ctx, w_mod, b_mod, ln_g, ln_b,
              attn_w_qkv, attn_w_o, attn_sink, ffn_w_gu, ffn_w_dn,
              lru_w_in, lru_conv_w, lru_conv_b, lru_lambda, lru_w_r, lru_b_r, lru_w_i, lru_b_i,
              lru_w_out, moe_router, moe_w_gu, moe_w_dn):
    L = x.shape[1]
    Lc = ctx.shape[1]
    row_ang, col_ang = grid_rope_angles(L)
    silu_c = jax.nn.silu(c)
    silu_cc = jax.nn.silu(c_ctx)
    for i in range(DEPTH):
        need_ctx = i < DEPTH - 1
        j = i // N_MIXERS
        mod_x = (silu_c @ w_mod[i] + b_mod[i])[:, None, :]
        mod_c = (silu_cc @ w_mod[i] + b_mod[i])[None, None, :]
        sh1, sc1, g1, sh2, sc2, g2 = jnp.split(mod_x, 6, axis=-1)
        csh1, csc1, cg1, csh2, csc2, cg2 = jnp.split(mod_c, 6, axis=-1)

        hx = modulate(x, sh1, sc1)
        hc = modulate(ctx, csh1, csc1)
        if i % N_MIXERS == 0:
            ox, oc = windowed_gqa(hx, hc, attn_w_qkv[j], attn_w_o[j], attn_sink[j],
                                  row_ang, col_ang, need_ctx)
        else:
            ox, oc = bidir_rglru(hx, hc, lru_w_in[j], lru_conv_w[j], lru_conv_b[j], lru_lambda[j],
                                 lru_w_r[j], lru_b_r[j], lru_w_i[j], lru_b_i[j], lru_w_out[j],
                                 need_ctx)
        x = layer_norm(ALPHA * x + g1 * ox, ln_g[i, 0], ln_b[i, 0])

        hx = modulate(x, sh2, sc2)
        if need_ctx:
            ctx = layer_norm(ALPHA * ctx + cg1 * oc, ln_g[i, 0], ln_b[i, 0])
            h = jnp.concatenate([modulate(ctx, csh2, csc2), hx], axis=1)
        else:
            h = hx
        if i % 2 == 0:
            f = swiglu(h, ffn_w_gu[j], ffn_w_dn[j])
        else:
            f = moe_swiglu(h, moe_router[j], moe_w_gu[j], moe_w_dn[j])
        if need_ctx:
            ctx = layer_norm(ALPHA * ctx + cg2 * f[:, :Lc], ln_g[i, 1], ln_b[i, 1])
            fx = f[:, Lc:]
        else:
            fx = f
        x = layer_norm(ALPHA * x + g2 * fx, ln_g[i, 1], ln_b[i, 1])
    return x
```

```cpp
#include <hip/hip_runtime.h>
#include <cstdio>
#include <cstdint>

#define GAS __attribute__((address_space(1)))
#define LAS __attribute__((address_space(3)))
typedef unsigned short bf16;
typedef short bf16x8 __attribute__((ext_vector_type(8)));
typedef short s16x4 __attribute__((ext_vector_type(4)));
typedef float f32x4 __attribute__((ext_vector_type(4)));
typedef float f32x2 __attribute__((ext_vector_type(2)));
typedef float f32x16 __attribute__((ext_vector_type(16)));
typedef unsigned u32x4 __attribute__((ext_vector_type(4)));
typedef unsigned u32x2 __attribute__((ext_vector_type(2)));
typedef GAS unsigned gu32;

constexpr int NB = 8, SEQ = 4096, DM = 1024, LCTX = 256;
constexpr int RL = NB * SEQ;
constexpr int RC = NB * LCTX;
constexpr int RT = RL + RC;
constexpr int NHEAD = 8, NKVH = 2, HDIM = 128, QKVD = 1536;
constexpr int DFF = 3584, NEXP = 8;
constexpr float ALPHA = 1.4142135623730951f;
constexpr float LN_EPS = 1e-5f;
constexpr float LOG2E = 1.4426950408889634f;
constexpr int NWAVES = 8;

__device__ __forceinline__ unsigned cvtpk(float lo, float hi) { unsigned r; asm volatile("v_cvt_pk_bf16_f32 %0, %1, %2" : "=v"(r) : "v"(lo), "v"(hi)); return r; }
__device__ __forceinline__ float bflo(unsigned w) { return __uint_as_float(w << 16); }
__device__ __forceinline__ float bfhi(unsigned w) { return __uint_as_float(w & 0xffff0000u); }
__device__ __forceinline__ float ex2(float x) { return __builtin_amdgcn_exp2f(x); }
__device__ __forceinline__ float rcpf_(float x) { return __builtin_amdgcn_rcpf(x); }
__device__ __forceinline__ float sigm(float x) { return rcpf_(1.0f + ex2(-LOG2E * x)); }
typedef int v8i __attribute__((ext_vector_type(8)));
typedef int v4i __attribute__((ext_vector_type(4)));
__device__ __forceinline__ float clamp8(float x) { return __builtin_amdgcn_fmed3f(x, -448.f, 448.f); }
__device__ __forceinline__ unsigned pk4_fp8(float a, float b, float c, float d) {
    int p = __builtin_amdgcn_cvt_pk_fp8_f32(clamp8(a), clamp8(b), 0, false); p = __builtin_amdgcn_cvt_pk_fp8_f32(clamp8(c), clamp8(d), p, true); return (unsigned)p; }
__device__ __forceinline__ int lane_id() { int l; asm volatile("v_mbcnt_lo_u32_b32 %0, -1, 0\n\tv_mbcnt_hi_u32_b32 %0, -1, %0" : "=v"(l)); return l; }
#define REFRESH_F(F) do { (F).lane = lane_id(); (F).tid = (F).wave * 64 + (F).lane; } while (0)
__device__ __forceinline__ float dpp_add(float v, const int ctrl_sel) {
    int r;
    switch (ctrl_sel) { case 0: r = __builtin_amdgcn_update_dpp(0, __float_as_int(v), 0xB1, 0xf, 0xf, true); break;
                        case 1: r = __builtin_amdgcn_update_dpp(0, __float_as_int(v), 0x4E, 0xf, 0xf, true); break;
                        case 2: r = __builtin_amdgcn_update_dpp(0, __float_as_int(v), 0x141, 0xf, 0xf, true); break;
                        default: r = __builtin_amdgcn_update_dpp(0, __float_as_int(v), 0x140, 0xf, 0xf, true); break; }
    return v + __int_as_float(r);
}
__device__ __forceinline__ float wave_sum(float v) {
    v = dpp_add(v, 0); v = dpp_add(v, 1); v = dpp_add(v, 2); v = dpp_add(v, 3);
    const float r0 = __int_as_float(__builtin_amdgcn_readlane(__float_as_int(v), 0)), r1 = __int_as_float(__builtin_amdgcn_readlane(__float_as_int(v), 16)),
                r2 = __int_as_float(__builtin_amdgcn_readlane(__float_as_int(v), 32)), r3 = __int_as_float(__builtin_amdgcn_readlane(__float_as_int(v), 48));
    return (r0 + r1) + (r2 + r3);
}

namespace pg8 {
#define PG8_LAS __attribute__((address_space(3)))
typedef unsigned short bf16_t;
constexpr int BM = 256, BK = 64, HALF = 128, HTB = HALF * BK * 2, STAGE_BYTES = 8 * HTB, NXCD = 8, WGM = 8;
__host__ __device__ __forceinline__ int lds_byte(int r, int c) { const int st = (r >> 4) * 2 + (c >> 5), rr = r & 15, cc = c & 31, ob = rr * 64 + cc * 2; return st * 1024 + (ob ^ (((ob >> 9) & 1) << 5)); }
__host__ __device__ __forceinline__ void stage_rc(int b, int& R, int& C) { const int st = b / 1024, sb = b % 1024, swz = sb ^ (((sb >> 9) & 1) << 5); R = (st >> 1) * 16 + swz / 64; C = (st & 1) * 32 + (swz % 64) / 2; }
__host__ __device__ __forceinline__ int perm32(int rho) { const int n = rho >> 4, i = rho & 15; return 8 * (i >> 2) + 4 * n + (i & 3); }
struct Unit { int pm, pn; };
struct Gemm { const bf16_t* A; const bf16_t* Bt; int M, N, K; };
struct StaticOrder {
    int nM, nN, nwg, G, c;
    __host__ __device__ void init(int M, int N, int G_, int c_) { nM = M / BM; nN = N / BM; nwg = nM * nN; G = G_; c = c_; }
    __host__ __device__ bool next(int i, Unit& u) const {
        const long L = (long)i * G + c; if (L >= nwg) return false;
        int wgid = (int)L; { const int q = nwg / NXCD, r = nwg % NXCD, xcd = wgid % NXCD, off = wgid / NXCD; wgid = (xcd < r ? xcd * (q + 1) : r * (q + 1) + (xcd - r) * q) + off; }
        const int nig = WGM * nN, gid = wgid / nig, fm = gid * WGM, gsz = (nM - fm) < WGM ? (nM - fm) : WGM;
        u.pm = fm + ((wgid % nig) % gsz); u.pn = (wgid % nig) / gsz; return true;
    }
    __device__ __forceinline__ void a_ready(const Unit&) const {}
    __device__ __forceinline__ void done(const Unit&) const {}
};
struct MoeOrder {
    int nM, nN, nwg, G, c, npe; int t1, t2, t3, t4, t5, t6, t7;
    __device__ bool next(int i, Unit& u) const {
        const long L = (long)i * G + c; if (L >= nwg) return false;
        int wgid = (int)L; { const int q = nwg / NXCD, r = nwg % NXCD, xcd = wgid % NXCD, off = wgid / NXCD; wgid = (xcd < r ? xcd * (q + 1) : r * (q + 1) + (xcd - r) * q) + off; }
        const int nig = WGM * nN, gid = wgid / nig, fm = gid * WGM, gsz = (nM - fm) < WGM ? (nM - fm) : WGM;
        const int pm = fm + ((wgid % nig) % gsz), pnl = (wgid % nig) / gsz;
        const int e = (pm >= t1) + (pm >= t2) + (pm >= t3) + (pm >= t4) + (pm >= t5) + (pm >= t6) + (pm >= t7);
        u.pm = pm; u.pn = e * npe + pnl; return true;
    }
    __device__ __forceinline__ void a_ready(const Unit&) const {}
    __device__ __forceinline__ void done(const Unit&) const {}
};


struct EpiQKV {
    static constexpr bool PERM = true, AFTER_DRAIN = false;
    bf16_t* O; const float* rope; float ascale;
    __device__ __forceinline__ void operator()(const f32x4 (&acc)[2][2][4][2], const Unit& u, int wr, int wc, int fr, int fq) const {
        const int row0 = u.pm * BM + wr * 64 + fr;
        const bool rope_on = (u.pm < (RL / BM)) && (u.pn < 5);
        const int axis = wc & 1;
        const int colb = u.pn * 256 + (wc >> 1) * 128 + axis * 64 + 8 * fq;
#pragma unroll
        for (int ai = 0; ai < 2; ++ai)
#pragma unroll
            for (int m = 0; m < 4; ++m) {
                const int r = row0 + ai * HALF + m * 16;
                f32x4 a0 = acc[ai][0][m][0] * ascale, a1 = acc[ai][0][m][1] * ascale, b0 = acc[ai][1][m][0] * ascale, b1 = acc[ai][1][m][1] * ascale;
                if (rope_on) {
                    const int t = r & (SEQ - 1); const int pos = axis ? (t & 63) : (t >> 6);
                    const float* cp = rope + pos * 32 + 8 * fq;
                    const f32x4 c0 = *(const f32x4*)cp, c1 = *(const f32x4*)(cp + 4), s0 = *(const f32x4*)(cp + 2048), s1 = *(const f32x4*)(cp + 2052);
                    const f32x4 o0 = a0 * c0 - b0 * s0, o1 = a1 * c1 - b1 * s1, q0 = b0 * c0 + a0 * s0, q1 = b1 * c1 + a1 * s1;
                    a0 = o0; a1 = o1; b0 = q0; b1 = q1;
                }
                bf16_t* rowp = O + (size_t)r * QKVD + colb;
                u32x4 w; w.x = cvtpk(a0[0], a0[1]); w.y = cvtpk(a0[2], a0[3]); w.z = cvtpk(a1[0], a1[1]); w.w = cvtpk(a1[2], a1[3]);
                *(u32x4*)rowp = w;
                u32x4 v; v.x = cvtpk(b0[0], b0[1]); v.y = cvtpk(b0[2], b0[3]); v.z = cvtpk(b1[0], b1[1]); v.w = cvtpk(b1[2], b1[3]);
                *(u32x4*)(rowp + 32) = v;
            }
    }
};
template <bool LN> struct EpiResid {
    static constexpr bool PERM = true, AFTER_DRAIN = false;
    const float* xin_lat; const float* xin_ctx; bf16_t* y; const float* gate; float ascale; const f32x2* st; const float* lng; const float* lnb;
    __device__ __forceinline__ void operator()(const f32x4 (&acc)[2][2][4][2], const Unit& u, int wr, int wc, int fr, int fq) const {
        const bool lat = u.pm < (RL / BM);
        const int b = lat ? (u.pm >> 4) : 8;
        const int row0 = u.pm * BM + wr * 64 + fr, col0 = u.pn * BM + wc * 32 + 8 * fq;
        const float* xin = lat ? xin_lat + (size_t)row0 * DM : xin_ctx + (size_t)(row0 - RL) * DM;
        f32x2 sv[2][4];
        if constexpr (LN) {
#pragma unroll
            for (int ai = 0; ai < 2; ++ai)
#pragma unroll
                for (int m = 0; m < 4; ++m) sv[ai][m] = st[row0 + ai * HALF + m * 16];
        }
#pragma unroll
        for (int bj = 0; bj < 2; ++bj) { const int cc = col0 + bj * HALF;
            const f32x4 g0 = *(const f32x4*)(gate + (size_t)b * 6144 + cc) * ascale, g1 = *(const f32x4*)(gate + (size_t)b * 6144 + cc + 4) * ascale;
            f32x4 lg0, lg1, lb0, lb1; if constexpr (LN) { lg0 = *(const f32x4*)(lng + cc) * ALPHA; lg1 = *(const f32x4*)(lng + cc + 4) * ALPHA; lb0 = *(const f32x4*)(lnb + cc) * ALPHA; lb1 = *(const f32x4*)(lnb + cc + 4) * ALPHA; }
#pragma unroll
            for (int ai = 0; ai < 2; ++ai)
#pragma unroll
                for (int m = 0; m < 4; ++m) { const int rr = ai * HALF + m * 16; f32x4 x0, x1;
                    if constexpr (LN) { const u32x4 w = *(const u32x4*)(y + (size_t)(row0 + rr) * DM + cc);
                        x0 = (f32x4){bflo(w.x), bfhi(w.x), bflo(w.y), bfhi(w.y)}; x1 = (f32x4){bflo(w.z), bfhi(w.z), bflo(w.w), bfhi(w.w)};
                        x0 = (x0 - sv[ai][m].x) * sv[ai][m].y * lg0 + lb0; x1 = (x1 - sv[ai][m].x) * sv[ai][m].y * lg1 + lb1; }
                    else { x0 = *(const f32x4*)(xin + (size_t)rr * DM + cc) * ALPHA; x1 = *(const f32x4*)(xin + (size_t)rr * DM + cc + 4) * ALPHA; }
                    const f32x4 o0 = x0 + g0 * acc[ai][bj][m][0], o1 = x1 + g1 * acc[ai][bj][m][1];
                    u32x4 w; w.x = cvtpk(o0[0], o0[1]); w.y = cvtpk(o0[2], o0[3]); w.z = cvtpk(o1[0], o1[1]); w.w = cvtpk(o1[2], o1[3]);
                    *(u32x4*)(y + (size_t)(row0 + rr) * DM + cc) = w; }
            asm volatile("" ::: "memory"); }
    }
};
struct EpiSwiGLU {
    static constexpr bool PERM = true, AFTER_DRAIN = false;
    bf16_t* O; int npe;
    __device__ __forceinline__ void operator()(const f32x4 (&acc)[2][2][4][2], const Unit& u, int wr, int wc, int fr, int fq) const {
        const int row0 = u.pm * BM + wr * 64 + fr, pnl = u.pn % npe, col0 = pnl * 128 + wc * 32 + 8 * fq;
#pragma unroll
        for (int ai = 0; ai < 2; ++ai)
#pragma unroll
            for (int m = 0; m < 4; ++m) {
                unsigned w[4];
#pragma unroll
                for (int n = 0; n < 2; ++n) { const f32x4 g = acc[ai][0][m][n], uu = acc[ai][1][m][n]; float o[4];
#pragma unroll
                    for (int j = 0; j < 4; ++j) o[j] = g[j] * sigm(g[j]) * uu[j];
                    w[2 * n] = cvtpk(o[0], o[1]); w[2 * n + 1] = cvtpk(o[2], o[3]); }
                u32x4 ww; ww.x = w[0]; ww.y = w[1]; ww.z = w[2]; ww.w = w[3];
                *(u32x4*)(O + (size_t)(row0 + ai * HALF + m * 16) * DFF + col0) = ww;
            }
    }
};
struct EpiLruIn {
    static constexpr bool PERM = true, AFTER_DRAIN = false;
    bf16_t* G; bf16_t* XB;
    __device__ __forceinline__ void operator()(const f32x4 (&acc)[2][2][4][2], const Unit& u, int wr, int wc, int fr, int fq) const {
        const int row0 = u.pm * BM + wr * 64 + fr; const bool isg = u.pn < 4;
        bf16_t* base = isg ? G : XB; const int col0 = (u.pn & 3) * BM + wc * 32 + 8 * fq;
#pragma unroll
        for (int ai = 0; ai < 2; ++ai)
#pragma unroll
            for (int m = 0; m < 4; ++m)
#pragma unroll
                for (int bj = 0; bj < 2; ++bj) {
                    f32x4 v0 = acc[ai][bj][m][0], v1 = acc[ai][bj][m][1];
                    if (isg) {
#pragma unroll
                        for (int j = 0; j < 4; ++j) { float x = v0[j]; float z = 0.7978845608028654f * (x + 0.044715f * x * x * x); v0[j] = x * sigm(2.0f * z);
                            x = v1[j]; z = 0.7978845608028654f * (x + 0.044715f * x * x * x); v1[j] = x * sigm(2.0f * z); }
                    }
                    u32x4 w; w.x = cvtpk(v0[0], v0[1]); w.y = cvtpk(v0[2], v0[3]); w.z = cvtpk(v1[0], v1[1]); w.w = cvtpk(v1[2], v1[3]);
                    *(u32x4*)(base + (size_t)(row0 + ai * HALF + m * 16) * DM + col0 + bj * HALF) = w;
                }
    }
};
struct EpiMoeOut {
    static constexpr bool PERM = true, AFTER_DRAIN = false;
    bf16_t* O; const float* wrow;
    __device__ __forceinline__ void operator()(const f32x4 (&acc)[2][2][4][2], const Unit& u, int wr, int wc, int fr, int fq) const {
        const int row0 = u.pm * BM + wr * 64 + fr, col0 = (u.pn & 3) * BM + wc * 32 + 8 * fq;
#pragma unroll
        for (int ai = 0; ai < 2; ++ai)
#pragma unroll
            for (int m = 0; m < 4; ++m) { const int r = row0 + ai * HALF + m * 16; const float g = wrow[r];
#pragma unroll
                for (int bj = 0; bj < 2; ++bj) { const f32x4 v0 = acc[ai][bj][m][0] * g, v1 = acc[ai][bj][m][1] * g;
                    u32x4 w; w.x = cvtpk(v0[0], v0[1]); w.y = cvtpk(v0[2], v0[3]); w.z = cvtpk(v1[0], v1[1]); w.w = cvtpk(v1[2], v1[3]);
                    *(u32x4*)(O + (size_t)r * DM + col0 + bj * HALF) = w; } }
    }
};

struct EpiSwiGLU8 {
    static constexpr bool PERM = true, AFTER_DRAIN = false;
    unsigned char* O; int npe;
    __device__ __forceinline__ void operator()(const f32x4 (&acc)[2][2][4][2], const Unit& u, int wr, int wc, int fr, int fq) const {
        const int row0 = u.pm * BM + wr * 64 + fr, pnl = u.pn % npe, col0 = pnl * 128 + wc * 32 + 8 * fq;
        constexpr float DS = 1.0f / 512.0f;
#pragma unroll
        for (int ai = 0; ai < 2; ++ai)
#pragma unroll
            for (int m = 0; m < 4; ++m) {
                u32x2 w;
#pragma unroll
                for (int n = 0; n < 2; ++n) { const f32x4 g = acc[ai][0][m][n] * DS, uu = acc[ai][1][m][n] * (DS * 8.0f); float o[4];
#pragma unroll
                    for (int j = 0; j < 4; ++j) o[j] = g[j] * sigm(g[j]) * uu[j];
                    w[n] = pk4_fp8(o[0], o[1], o[2], o[3]); }
                *(u32x2*)(O + (size_t)(row0 + ai * HALF + m * 16) * DFF + col0) = w;
            }
    }
};
struct EpiMoeOut8 {
    static constexpr bool PERM = true, AFTER_DRAIN = false;
    bf16_t* O; const float* wrow;
    __device__ __forceinline__ void operator()(const f32x4 (&acc)[2][2][4][2], const Unit& u, int wr, int wc, int fr, int fq) const {
        const int row0 = u.pm * BM + wr * 64 + fr, col0 = (u.pn & 3) * BM + wc * 32 + 8 * fq;
#pragma unroll
        for (int ai = 0; ai < 2; ++ai)
#pragma unroll
            for (int m = 0; m < 4; ++m) { const int r = row0 + ai * HALF + m * 16; const float g = wrow[r] * (1.0f / 4096.0f);
#pragma unroll
                for (int bj = 0; bj < 2; ++bj) { const f32x4 v0 = acc[ai][bj][m][0] * g, v1 = acc[ai][bj][m][1] * g;
                    u32x4 w; w.x = cvtpk(v0[0], v0[1]); w.y = cvtpk(v0[2], v0[3]); w.z = cvtpk(v1[0], v1[1]); w.w = cvtpk(v1[2], v1[3]);
                    *(u32x4*)(O + (size_t)r * DM + col0 + bj * HALF) = w; } }
    }
};

template <class Epi, class Sched, bool ALIGN_EPI = false, bool SP2 = false, bool FP8 = false>
__device__ __forceinline__ void gemm_phase(PG8_LAS unsigned char* lds, const Gemm g, const Sched& S, const Epi& E, const int wid) {
    const int lane = lane_id(), tid = wid * 64 + lane, wr = wid >> 2, wc = wid & 3, fr = lane & 15, fq = lane >> 4;
    const int K = g.K, nt = K / BK;
    unsigned voffA[2], voffB[2];
#pragma unroll
    for (int i = 0; i < 2; ++i) { int R, C; stage_rc(tid * 16 + i * 8192, R, C); const int Rb = Epi::PERM ? ((R & ~31) + perm32(R & 31)) : R;
        voffA[i] = (unsigned)(R * K + C) * 2u; voffB[i] = (unsigned)(Rb * K + C) * 2u; }
    const unsigned kstep = (unsigned)(BK * 2);
    const unsigned hstep = (unsigned)HALF * K * 2;
    const unsigned tstep = 2 * hstep;
    const __amdgpu_buffer_rsrc_t rs_voffA = __builtin_amdgcn_make_buffer_rsrc((void*)g.A, 0, -1, 0x00020000), rs_voffB = __builtin_amdgcn_make_buffer_rsrc((void*)g.Bt, 0, -1, 0x00020000);
    const unsigned ldsw = (unsigned)wid * 1024u;
    const int aoff = lds_byte(wr * 64 + fr, fq * 8), boff = lds_byte(wc * 32 + fr, fq * 8);
#define PG8_SA(b, h) (((b) * 2 + (h)) * HTB)
#define PG8_SB(b, h) ((4 + (b) * 2 + (h)) * HTB)
#define PG8_STAGE(bufoff, gbase, voff) do { _Pragma("unroll") for (int _i = 0; _i < 2; ++_i) \
        __builtin_amdgcn_raw_ptr_buffer_load_lds(rs_##voff, (PG8_LAS void*)(lds + (bufoff) + ldsw + _i * 8192), 16, (voff)[_i], (gbase), 0, 0); } while (0)
#define PG8_LDA(dst, b, h) do { if constexpr (FP8) { _Pragma("unroll") for (int m = 0; m < 4; ++m) { const v4i _l = *(const PG8_LAS v4i*)(lds + PG8_SA(b, h) + aoff + m * 2048), _h = *(const PG8_LAS v4i*)(lds + PG8_SA(b, h) + aoff + m * 2048 + 1024); \
            dst##8[m] = __builtin_shufflevector(_l, _h, 0, 1, 2, 3, 4, 5, 6, 7); } } \
        else { _Pragma("unroll") for (int m = 0; m < 4; ++m) _Pragma("unroll") for (int k = 0; k < 2; ++k) dst[m][k] = *(const PG8_LAS bf16x8*)(lds + PG8_SA(b, h) + aoff + m * 2048 + k * 1024); } } while (0)
#define PG8_LDB(dst, b, h) do { if constexpr (FP8) { _Pragma("unroll") for (int n = 0; n < 2; ++n) { const v4i _l = *(const PG8_LAS v4i*)(lds + PG8_SB(b, h) + boff + n * 2048), _h = *(const PG8_LAS v4i*)(lds + PG8_SB(b, h) + boff + n * 2048 + 1024); \
            dst##8[n] = __builtin_shufflevector(_l, _h, 0, 1, 2, 3, 4, 5, 6, 7); } } \
        else { _Pragma("unroll") for (int n = 0; n < 2; ++n) _Pragma("unroll") for (int k = 0; k < 2; ++k) dst[n][k] = *(const PG8_LAS bf16x8*)(lds + PG8_SB(b, h) + boff + n * 2048 + k * 1024); } } while (0)
#define PG8_MMA(ai, bj, At, Bt) do { if constexpr (FP8) __builtin_amdgcn_sched_barrier(0); __builtin_amdgcn_s_setprio(1); \
        if constexpr (FP8) { _Pragma("unroll") for (int m = 0; m < 4; ++m) _Pragma("unroll") for (int n = 0; n < 2; ++n) \
            acc[ai][bj][m][n] = __builtin_amdgcn_mfma_scale_f32_16x16x128_f8f6f4(Bt##8[n], At##8[m], acc[ai][bj][m][n], 0, 0, 0, 0, 0, 0); } \
        else { _Pragma("unroll") for (int m = 0; m < 4; ++m) _Pragma("unroll") for (int n = 0; n < 2; ++n) _Pragma("unroll") for (int k = 0; k < 2; ++k) \
            acc[ai][bj][m][n] = __builtin_amdgcn_mfma_f32_16x16x32_bf16(Bt[n][k], At[m][k], acc[ai][bj][m][n], 0, 0, 0); } \
        __builtin_amdgcn_s_setprio(0); if constexpr (FP8) __builtin_amdgcn_sched_barrier(0); } while (0)
#define PG8_WAIT_V(n) asm volatile("s_waitcnt vmcnt(" #n ")" ::: "memory")
#define PG8_WAIT_L(n) asm volatile("s_waitcnt lgkmcnt(" #n ")" ::: "memory")
#define PG8_BAR __builtin_amdgcn_s_barrier()
#define PG8_SCHED __builtin_amdgcn_sched_barrier(0)
    Unit cur, nxt; int ui = 0;
    if (!S.next(0, cur)) return;
    f32x4 acc[2][2][4][2];
#pragma unroll
    for (int a = 0; a < 2; ++a)
#pragma unroll
        for (int b = 0; b < 2; ++b)
#pragma unroll
            for (int m = 0; m < 4; ++m)
#pragma unroll
                for (int n = 0; n < 2; ++n) acc[a][b][m][n] = (f32x4){0.f, 0.f, 0.f, 0.f};
    bf16x8 At[4][2], B0[2][2], B1[2][2]; v8i At8[4], B08[2], B18[2];
    unsigned cA = (unsigned)cur.pm * tstep, cB = (unsigned)cur.pn * tstep;
    S.a_ready(cur);
    if constexpr (SP2) {
        PG8_STAGE(PG8_SB(0, 0), cB, voffB); PG8_STAGE(PG8_SB(0, 1), cB + hstep, voffB); PG8_STAGE(PG8_SA(0, 0), cA, voffA); PG8_STAGE(PG8_SA(0, 1), cA + hstep, voffA);
        if (wr == 1) PG8_BAR;
        PG8_WAIT_V(2); PG8_BAR;
        PG8_STAGE(PG8_SB(1, 0), cB + kstep, voffB); PG8_STAGE(PG8_SA(1, 0), cA + kstep, voffA); PG8_STAGE(PG8_SB(1, 1), cB + hstep + kstep, voffB);
        PG8_WAIT_V(6); PG8_BAR;
    } else {
        PG8_STAGE(PG8_SB(0, 0), cB, voffB); PG8_STAGE(PG8_SA(0, 0), cA, voffA); PG8_STAGE(PG8_SB(0, 1), cB + hstep, voffB); PG8_STAGE(PG8_SA(0, 1), cA + hstep, voffA);
        if (wr == 1) PG8_BAR;
        PG8_WAIT_V(4); PG8_BAR;
        PG8_STAGE(PG8_SB(1, 0), cB + kstep, voffB); PG8_STAGE(PG8_SA(1, 0), cA + kstep, voffA); PG8_STAGE(PG8_SB(1, 1), cB + hstep + kstep, voffB);
        PG8_WAIT_V(6); PG8_BAR;
    }
    for (;;) {
        const bool has_next = S.next(ui + 1, nxt);
        const unsigned nA = has_next ? (unsigned)nxt.pm * tstep : cA, nB = has_next ? (unsigned)nxt.pn * tstep : cB;
        _Pragma("clang loop unroll(disable)") for (int t = 0; t < nt; t += 2) {
            const bool last = (t == nt - 2);
            const unsigned a1 = cA + (unsigned)(t + 1) * kstep;
            const unsigned a2 = last ? nA : cA + (unsigned)(t + 2) * kstep, b2 = last ? nB : cB + (unsigned)(t + 2) * kstep;
            const unsigned a3 = a2 + kstep, b3 = b2 + kstep;
            if (last && has_next) S.a_ready(nxt);
            if constexpr (SP2) {
            PG8_LDB(B0, 0, 0); PG8_LDB(B1, 0, 1); PG8_SCHED; PG8_LDA(At, 0, 0); PG8_STAGE(PG8_SA(1, 1), a1 + hstep, voffA);
            PG8_WAIT_V(8); PG8_WAIT_L(0); PG8_BAR; PG8_MMA(0, 0, At, B0); PG8_MMA(0, 1, At, B1); PG8_BAR; PG8_SCHED;
            PG8_LDA(At, 0, 1); PG8_STAGE(PG8_SB(0, 0), b2, voffB); PG8_STAGE(PG8_SB(0, 1), b2 + hstep, voffB); PG8_STAGE(PG8_SA(0, 0), a2, voffA);
            PG8_WAIT_V(8); PG8_WAIT_L(0); PG8_BAR; PG8_MMA(1, 0, At, B0); PG8_MMA(1, 1, At, B1); PG8_BAR; PG8_SCHED;
            PG8_LDB(B0, 1, 0); PG8_LDB(B1, 1, 1); PG8_SCHED; PG8_LDA(At, 1, 0); PG8_STAGE(PG8_SA(0, 1), a2 + hstep, voffA);
            PG8_WAIT_V(8); PG8_WAIT_L(0); PG8_BAR; PG8_MMA(0, 0, At, B0); PG8_MMA(0, 1, At, B1); PG8_BAR; PG8_SCHED;
            PG8_LDA(At, 1, 1); PG8_STAGE(PG8_SB(1, 0), b3, voffB); PG8_STAGE(PG8_SB(1, 1), b3 + hstep, voffB); PG8_STAGE(PG8_SA(1, 0), a3, voffA);
            PG8_WAIT_V(8); PG8_WAIT_L(0); PG8_BAR; PG8_MMA(1, 0, At, B0); PG8_MMA(1, 1, At, B1); PG8_BAR; PG8_SCHED;
            } else {
            PG8_LDB(B0, 0, 0); PG8_SCHED; PG8_LDA(At, 0, 0); PG8_STAGE(PG8_SA(1, 1), a1 + hstep, voffA);
            PG8_WAIT_L(8); PG8_BAR; PG8_WAIT_L(0); PG8_MMA(0, 0, At, B0); PG8_BAR; PG8_SCHED;
            PG8_LDB(B1, 0, 1); PG8_STAGE(PG8_SB(0, 0), b2, voffB);
            PG8_BAR; PG8_WAIT_L(0); PG8_MMA(0, 1, At, B1); PG8_BAR;
            PG8_LDA(At, 0, 1); PG8_STAGE(PG8_SA(0, 0), a2, voffA);
            PG8_BAR; PG8_WAIT_L(0); PG8_MMA(1, 0, At, B0); PG8_BAR; PG8_SCHED;
            PG8_STAGE(PG8_SB(0, 1), b2 + hstep, voffB);
            PG8_WAIT_V(6); PG8_BAR; PG8_MMA(1, 1, At, B1); PG8_BAR;
            PG8_LDB(B0, 1, 0); PG8_SCHED; PG8_LDA(At, 1, 0); PG8_STAGE(PG8_SA(0, 1), a2 + hstep, voffA);
            PG8_WAIT_L(8); PG8_BAR; PG8_WAIT_L(0); PG8_MMA(0, 0, At, B0); PG8_BAR; PG8_SCHED;
            PG8_LDB(B1, 1, 1); PG8_STAGE(PG8_SB(1, 0), b3, voffB);
            PG8_BAR; PG8_WAIT_L(0); PG8_MMA(0, 1, At, B1); PG8_BAR;
            PG8_LDA(At, 1, 1); PG8_STAGE(PG8_SA(1, 0), a3, voffA);
            PG8_BAR; PG8_WAIT_L(0); PG8_MMA(1, 0, At, B0); PG8_BAR; PG8_SCHED;
            PG8_STAGE(PG8_SB(1, 1), b3 + hstep, voffB);
            PG8_WAIT_V(6); PG8_BAR; PG8_MMA(1, 1, At, B1); PG8_BAR;
            }
        }
        if constexpr (ALIGN_EPI) { if (wr == 0) PG8_BAR; }
        if constexpr (!Epi::AFTER_DRAIN) { int le = lane_id();
            E(acc, cur, wr, wc, le & 15, le >> 4); S.done(cur); }
        if (!has_next) break;
#pragma unroll
        for (int a = 0; a < 2; ++a)
#pragma unroll
            for (int b = 0; b < 2; ++b)
#pragma unroll
                for (int m = 0; m < 4; ++m)
#pragma unroll
                    for (int n = 0; n < 2; ++n) acc[a][b][m][n] = (f32x4){0.f, 0.f, 0.f, 0.f};
        cur = nxt; cA = nA; cB = nB; ++ui;
        if constexpr (ALIGN_EPI) { if (wr == 1) PG8_BAR; }
    }
    PG8_WAIT_V(0);
    if constexpr (!ALIGN_EPI) { if (wr == 0) PG8_BAR; }
    PG8_BAR;
    if constexpr (Epi::AFTER_DRAIN) { E.fused(acc, cur, wr, wc, fr, fq, lds, wid, lane); S.done(cur); }
#undef PG8_SA
#undef PG8_SB
#undef PG8_STAGE
#undef PG8_LDA
#undef PG8_LDB
#undef PG8_MMA
#undef PG8_WAIT_V
#undef PG8_WAIT_L
#undef PG8_BAR
#undef PG8_SCHED
}
}

constexpr size_t MiB = 1u << 20;
constexpr size_t WS_CTL = 0, CTL_ZERO_BYTES = 65536;
constexpr size_t WS_MOD = 65536;
constexpr size_t WS_ROPE = 65536 + 458752;
constexpr size_t WS_WQKV = 1 * MiB, WS_WO = 4 * MiB, WS_WGU = 6 * MiB, WS_WDN = 20 * MiB, WS_WIN = 27 * MiB, WS_WOUT = 31 * MiB, WS_WLG = 33 * MiB;
constexpr size_t WS_WMGU = 34 * MiB, WS_WMDN = 146 * MiB;
constexpr size_t WS_YB = 760 * MiB;
constexpr size_t WS_H = 210 * MiB;
constexpr size_t WS_ACTV = 278 * MiB;
constexpr size_t WS_QKV = WS_ACTV, WS_O = WS_ACTV + 102 * MiB, WS_ACT = WS_ACTV + 170 * MiB;
constexpr size_t WS_G = WS_ACTV, WS_XB = WS_ACTV + 68 * MiB, WS_HF = WS_ACTV + 136 * MiB, WS_HH = WS_ACTV + 200 * MiB;
constexpr size_t WS_U = WS_ACTV + 264 * MiB;
constexpr size_t WS_HS = WS_ACTV, WS_FO = WS_ACTV + 68 * MiB, WS_MACT = WS_ACTV + 200 * MiB;
constexpr size_t WS_ROUTE = 872 * MiB;
constexpr size_t WS_LRUS = 874 * MiB;
constexpr size_t WS_END = 875 * MiB;
constexpr int MOE_MAXT = 264;
constexpr size_t RT_EIDX = 0, RT_WGT = 262144, RT_SLOT = 524288, RT_WS = 786432, RT_CNT = 786432 + 270336 + 0;
constexpr size_t LS_SUM = 0, LS_CTX = 524288;
constexpr size_t WS_STATS = WS_LRUS + 655360;

constexpr int RING_OFF = 0, RING_BYTES = 135168;
constexpr int LDSCTL_OFF = RING_BYTES, MISC_OFF = LDSCTL_OFF + 320;
constexpr int LDS_BYTES = 136192;

#define RLX_AGENT __ATOMIC_RELAXED, __HIP_MEMORY_SCOPE_AGENT
#define LDS_WAIT() asm volatile("s_waitcnt lgkmcnt(0)" ::: "memory")
#define VM_WAIT() asm volatile("s_waitcnt vmcnt(0)" ::: "memory")
#define XB_TMO      128
#define XB_XCNT(j)  (256  + 64 * (j))
#define XB_XSUB(j)  (1280 + 64 * (j))
#define XB_XGEN(j)  (2304 + 64 * (j))
#define XB_TOP      3328
#define XB_TOPGEN   3392
#define XCD_BAR_WORDS 3456
#define XB_SPIN_CAP (1u << 18)

__device__ __forceinline__ unsigned xb_ld(unsigned* p)              { return __hip_atomic_load(p, __ATOMIC_RELAXED, __HIP_MEMORY_SCOPE_AGENT); }
__device__ __forceinline__ unsigned xb_add(unsigned* p, unsigned v) { return __hip_atomic_fetch_add(p, v, __ATOMIC_RELAXED, __HIP_MEMORY_SCOPE_AGENT); }
__device__ __forceinline__ unsigned xb_xcc_id() { return (unsigned)__builtin_amdgcn_s_getreg((3 << 11) | 20) & 0xFu; }
#define XB_SPIN(cond, bar) do { unsigned _sp = 0; while (cond) { __builtin_amdgcn_s_sleep(1); \
    if ((++_sp & 255u) == 0u) { if (xb_ld(&(bar)[XB_TMO])) break; if (_sp > XB_SPIN_CAP) { atomicAdd(&(bar)[XB_TMO], 1u); break; } } } } while (0)

struct XcdBarrier {
    unsigned* bar; unsigned x;
    volatile LAS unsigned* st;
};

__device__ __forceinline__ XcdBarrier xcd_barrier_post(unsigned* bar, volatile LAS unsigned* st) {
    XcdBarrier b; b.bar = bar; b.x = xb_xcc_id(); b.st = st;
    if (threadIdx.x == 0) (void)xb_add(&bar[XB_XCNT(b.x)], 1u);
    return b;
}
__device__ __forceinline__ void xcd_barrier_complete(unsigned* bar, unsigned x, unsigned& nloc, unsigned& nx) {
    const unsigned G = gridDim.x * gridDim.y * gridDim.z;
    unsigned sum, cnt, mine, sp = 0u;
    for (;;) {
        sum = 0u; cnt = 0u; mine = 0u;
#pragma unroll
        for (unsigned j = 0; j < 16; ++j) { const unsigned c = xb_ld(&bar[XB_XCNT(j)]); sum += c; cnt += (c > 0u) ? 1u : 0u; mine = (j == x) ? c : mine; }
        if (sum == G) break;
        __builtin_amdgcn_s_sleep(1);
        if ((++sp & 255u) == 0u) { if (xb_ld(&bar[XB_TMO])) break; if (sp > XB_SPIN_CAP) { atomicAdd(&bar[XB_TMO], 1u); break; } }
    }
    nloc = mine > 0u ? mine : 1u; nx = cnt > 0u ? cnt : 1u;
}

__device__ __forceinline__ void xcd_barrier(const XcdBarrier& b) {
    asm volatile("s_waitcnt vmcnt(0)" ::: "memory");
    __syncthreads();
    if (threadIdx.x == 0) {
        unsigned* bar = b.bar;
        __builtin_amdgcn_s_waitcnt(0);
        unsigned nloc = b.st[0], nx = b.st[1];
        if (nloc == 0u) { xcd_barrier_complete(bar, b.x, nloc, nx); b.st[0] = nloc; b.st[1] = nx; }
        const unsigned old = xb_add(&bar[XB_XSUB(b.x)], 1u);
        const unsigned gen = old / nloc;
        if (old + 1u == (gen + 1u) * nloc) {
            __builtin_amdgcn_fence(__ATOMIC_RELEASE, "agent");
            asm volatile("s_waitcnt vmcnt(0)" ::: "memory");
            const unsigned og = xb_add(&bar[XB_TOP], 1u);
            const unsigned tg = og / nx;
            if (og + 1u == (tg + 1u) * nx) xb_add(&bar[XB_TOPGEN], 1u);
            else XB_SPIN(xb_ld(&bar[XB_TOPGEN]) == tg, bar);
            __builtin_amdgcn_fence(__ATOMIC_ACQUIRE, "agent");
            xb_add(&bar[XB_XGEN(b.x)], 1u);
            asm volatile("s_waitcnt vmcnt(0)" ::: "memory");
        } else {
            XB_SPIN(xb_ld(&bar[XB_XGEN(b.x)]) == gen, bar);
            __builtin_amdgcn_fence(__ATOMIC_ACQUIRE, "agent");
            asm volatile("s_waitcnt vmcnt(0)" ::: "memory");
        }
    }
    __syncthreads();
}


struct Frame {
    LAS unsigned char* lds;
    volatile LAS unsigned* MISC;
    int tid, lane, wave, vcu, G;
    const float *x, *c, *ctx, *cctx, *w_mod, *b_mod, *ln_g, *ln_b, *w_qkv, *w_o, *sink, *w_gu, *w_dn, *w_in, *conv_w, *conv_b, *lam, *w_r, *b_r, *w_i, *b_i, *w_out, *router, *mw_gu, *mw_dn;
    float* out; unsigned char* ws;
};
#define WSP(T, off) ((T*)(F.ws + (off)))

__device__ __forceinline__ void p0_mod_task(Frame& F, int task) {
    const int li = task / 96, cb = task % 96;
    LAS float* S = (LAS float*)F.lds;
    LAS float* red = (LAS float*)(F.lds + 36864);
    for (int idx = F.tid; idx < 9 * 1024; idx += NWAVES * 64) { const int b = idx >> 10, k = idx & 1023; const float v = (b < 8) ? F.c[b * 1024 + k] : F.cctx[k]; S[idx] = v * sigm(v); }
    __syncthreads();
    const float* W = F.w_mod + (size_t)li * 1024 * 6144 + cb * 64;
    const int cl = F.lane & 15, kr = F.lane >> 4;
    f32x4 acc[9];
#pragma unroll
    for (int b = 0; b < 9; ++b) acc[b] = (f32x4){0.f, 0.f, 0.f, 0.f};
#pragma unroll 4
    for (int kk = 0; kk < 32; ++kk) { const int k = 128 * F.wave + 4 * kk + kr; const f32x4 wv = *(const f32x4*)(W + (size_t)k * 6144 + 4 * cl);
#pragma unroll
        for (int b = 0; b < 9; ++b) acc[b] += wv * S[b * 1024 + k]; }
#pragma unroll
    for (int b = 0; b < 9; ++b)
#pragma unroll
        for (int j = 0; j < 4; ++j) { float v = acc[b][j]; v += __shfl_xor(v, 16); v += __shfl_xor(v, 32); acc[b][j] = v; }
    if (kr == 0) {
#pragma unroll
        for (int b = 0; b < 9; ++b) *(LAS f32x4*)(red + (F.wave * 9 + b) * 64 + 4 * cl) = acc[b]; }
    __syncthreads();
    float* mod = WSP(float, WS_MOD);
    for (int idx = F.tid; idx < 9 * 64; idx += NWAVES * 64) { const int b = idx >> 6, col = idx & 63; float s = 0.f;
#pragma unroll
        for (int w = 0; w < 8; ++w) s += red[(w * 9 + b) * 64 + col];
        mod[(size_t)(li * 9 + b) * 6144 + cb * 64 + col] = s + F.b_mod[li * 6144 + cb * 64 + col]; }
    __syncthreads();
}
__device__ __forceinline__ void p0_transpose_item(const float* W, int K, int N, bf16* WT, int kb, int n0, int drow0, LAS float* scr, int lane) {
    const int k0 = 64 * kb;
#pragma unroll
    for (int i = 0; i < 8; ++i) { const int kk = 8 * i + (lane >> 3); const f32x4 wv = *(const f32x4*)(W + (size_t)(k0 + kk) * N + n0 + 4 * (lane & 7));
        LAS float* d = scr + kk * 33 + 4 * (lane & 7); d[0] = wv[0]; d[1] = wv[1]; d[2] = wv[2]; d[3] = wv[3]; }
    LDS_WAIT(); asm volatile("" ::: "memory");
    const int c = lane & 7;
#pragma unroll
    for (int j = 0; j < 4; ++j) { const int n = (lane >> 3) + 8 * j; const LAS float* s = scr + (8 * c) * 33 + n;
        u32x4 o; o.x = cvtpk(s[0 * 33], s[1 * 33]); o.y = cvtpk(s[2 * 33], s[3 * 33]); o.z = cvtpk(s[4 * 33], s[5 * 33]); o.w = cvtpk(s[6 * 33], s[7 * 33]);
        *(GAS u32x4*)(WT + (size_t)(drow0 + n) * K + k0 + 8 * c) = o; }
    LDS_WAIT(); asm volatile("" ::: "memory");
}
template <int QS> __device__ __forceinline__ void p0_transpose_item8(const float* W, int K, int N, unsigned char* WT, int kb, int n0, int drow0, LAS float* scr, int lane) {
    const int k0 = 64 * kb; constexpr float qs = (float)(1 << QS);
#pragma unroll
    for (int i = 0; i < 8; ++i) { const int kk = 8 * i + (lane >> 3); const f32x4 wv = *(const f32x4*)(W + (size_t)(k0 + kk) * N + n0 + 4 * (lane & 7)) * qs;
        LAS float* d = scr + kk * 33 + 4 * (lane & 7); d[0] = wv[0]; d[1] = wv[1]; d[2] = wv[2]; d[3] = wv[3]; }
    LDS_WAIT(); asm volatile("" ::: "memory");
    const int c = lane & 7;
#pragma unroll
    for (int j = 0; j < 4; ++j) { const int n = (lane >> 3) + 8 * j; const LAS float* s = scr + (8 * c) * 33 + n;
        u32x2 o; o.x = pk4_fp8(s[0 * 33], s[1 * 33], s[2 * 33], s[3 * 33]); o.y = pk4_fp8(s[4 * 33], s[5 * 33], s[6 * 33], s[7 * 33]);
        *(GAS u32x2*)(WT + (size_t)(drow0 + n) * K + k0 + 8 * c) = o; }
    LDS_WAIT(); asm volatile("" ::: "memory");
}
__device__ __forceinline__ int gu_row(int j) { const int isu = j >= DFF, jj = isu ? j - DFF : j; return (jj >> 7) * 256 + isu * 128 + (jj & 127); }
__device__ __forceinline__ int qkv_row(int L) { const int pn = L >> 8, rem = L & 255, hsel = rem >> 7, axis = (rem >> 6) & 1, half = (rem >> 5) & 1, x = rem & 31; return pn * 256 + 128 * half + 32 * (2 * hsel + axis) + x; }

__device__ __forceinline__ void p0_prologue(Frame& F) {
    for (int task = F.vcu; task < 192; task += F.G) p0_mod_task(F, task);
    if (F.vcu == F.G - 1) {
        float* rope = WSP(float, WS_ROPE);
        for (int idx = F.tid; idx < 2048; idx += NWAVES * 64) { const int pos = idx >> 5, i = idx & 31;
            const double freq = exp2(-(double)i * (13.287712379549449 / 32.0));
            const float ang = (float)pos * (float)freq;
            double rev = (double)ang * 0.15915494309189535; rev -= floor(rev);
            rope[idx] = __builtin_amdgcn_cosf((float)rev); rope[2048 + idx] = __builtin_amdgcn_sinf((float)rev); }
    }
    LAS float* scr = (LAS float*)(F.lds + F.wave * 8704);
    const int gw = F.vcu * NWAVES + F.wave, NGW = F.G * NWAVES;
    constexpr int I_QKV = 16 * 48;
    for (int r = gw; r < I_QKV; r += NGW) { const int kb = r / 48, n0 = (r % 48) * 32; p0_transpose_item8<7>(F.w_qkv, 1024, 1536, WSP(unsigned char, WS_WQKV), kb, n0, qkv_row(n0), scr, F.lane); }
}

constexpr int MOE_I_GU = 16 * 224, MOE_I_DN = 56 * 32, MOE_ITEMS = 8 * (MOE_I_GU + MOE_I_DN);
constexpr int DR_O = 16 * 32, DR_GU = 16 * 224, DR_DN = 56 * 32, DR_IN = 16 * 64, DR_OUT = 16 * 32, DR_LG = 32 * 8, DR_ITEMS = DR_O + DR_GU + DR_DN + DR_IN + DR_OUT + DR_LG;
constexpr int CV_ITEMS = DR_ITEMS + MOE_ITEMS;
__device__ __forceinline__ void moe_convert_items(Frame& F, int lo, int hi, int rank, int nranks) {
    LAS float* scr = (LAS float*)(F.lds + F.wave * 8704);
    for (int it0 = lo + rank * NWAVES + F.wave; it0 < hi; it0 += nranks * NWAVES) {
        int r = it0;
        if (r < DR_O) { const int kb = r / 32, n0 = (r % 32) * 32; p0_transpose_item8<7>(F.w_o, 1024, 1024, WSP(unsigned char, WS_WO), kb, n0, n0, scr, F.lane); continue; } r -= DR_O;
        if (r < DR_GU) { const int kb = r / 224, n0 = (r % 224) * 32; p0_transpose_item8<7>(F.w_gu, 1024, 7168, WSP(unsigned char, WS_WGU), kb, n0, gu_row(n0), scr, F.lane); continue; } r -= DR_GU;
        if (r < DR_DN) { const int kb = r / 32, n0 = (r % 32) * 32; p0_transpose_item8<9>(F.w_dn, 3584, 1024, WSP(unsigned char, WS_WDN), kb, n0, n0, scr, F.lane); continue; } r -= DR_DN;
        if (r < DR_IN) { const int kb = r / 64, n0 = (r % 64) * 32; p0_transpose_item(F.w_in, 1024, 2048, WSP(bf16, WS_WIN), kb, n0, n0, scr, F.lane); continue; } r -= DR_IN;
        if (r < DR_OUT) { const int kb = r / 32, n0 = (r % 32) * 32; p0_transpose_item(F.w_out, 1024, 1024, WSP(bf16, WS_WOUT), kb, n0, n0, scr, F.lane); continue; } r -= DR_OUT;
        if (r < DR_LG) { const int mi = r >> 3, sub = r & 7, which = mi >> 4, d = (mi >> 3) & 1, n = mi & 7, kb = sub >> 2, n0 = (sub & 3) * 32;
            p0_transpose_item((which ? F.w_i : F.w_r) + (size_t)(d * 8 + n) * 16384, 128, 128, WSP(bf16, WS_WLG) + (size_t)(n * 4 + 2 * d + which) * 16384, kb, n0, n0, scr, F.lane); continue; } r -= DR_LG;
        if (r < 8 * MOE_I_GU) { const int e = r / MOE_I_GU, q = r % MOE_I_GU, kb = q / 224, n0 = (q % 224) * 32;
            p0_transpose_item8<7>(F.mw_gu + (size_t)e * 1024 * 7168, 1024, 7168, WSP(unsigned char, WS_WMGU) + (size_t)e * 7168 * 1024, kb, n0, gu_row(n0), scr, F.lane); }
        else { r -= 8 * MOE_I_GU; const int e = r / MOE_I_DN, q = r % MOE_I_DN, kb = q / 32, n0 = (q % 32) * 32;
            p0_transpose_item8<9>(F.mw_dn + (size_t)e * 3584 * 1024, 3584, 1024, WSP(unsigned char, WS_WMDN) + (size_t)e * 1024 * 3584, kb, n0, n0, scr, F.lane); }
    }
}
__device__ __forceinline__ void moe_convert_filler(Frame& F, int nwg, int c, int lo, int hi) {
    const int R = (nwg + F.G - 1) / F.G, rem = nwg - (R - 1) * F.G;
    if (rem >= F.G) { moe_convert_items(F, lo, hi, c, F.G); return; }
    if (c >= rem) { REFRESH_F(F); moe_convert_items(F, lo, hi, c - rem, F.G - rem); }
}
__device__ __forceinline__ void row_load(f32x4 (&v)[4], const float* p, int lane) {
#pragma unroll
    for (int j = 0; j < 4; ++j) v[j] = *(const f32x4*)(p + 4 * lane + 256 * j);
}
__device__ __forceinline__ void row_load_bf(f32x4 (&v)[4], const bf16* p, int lane) {
#pragma unroll
    for (int j = 0; j < 4; ++j) { const u32x2 w = *(const u32x2*)(p + 4 * lane + 256 * j); v[j] = (f32x4){bflo(w.x), bfhi(w.x), bflo(w.y), bfhi(w.y)}; }
}
__device__ __forceinline__ void row_store(const f32x4 (&v)[4], float* p, int lane) {
#pragma unroll
    for (int j = 0; j < 4; ++j) *(f32x4*)(p + 4 * lane + 256 * j) = v[j];
}
struct Vec16 { f32x4 q[4]; };
__device__ __forceinline__ Vec16 vec_load(const float* p, int lane) { Vec16 r;
#pragma unroll
    for (int j = 0; j < 4; ++j) r.q[j] = *(const f32x4*)(p + 4 * lane + 256 * j);
    return r; }
__device__ __forceinline__ f32x2 row_ln_v(f32x4 (&v)[4], const Vec16& g, const Vec16& bt) {
    float s = 0.f;
#pragma unroll
    for (int j = 0; j < 4; ++j) s += (v[j].x + v[j].y) + (v[j].z + v[j].w);
    const float mean = wave_sum(s) * (1.f / DM); float s2 = 0.f;
#pragma unroll
    for (int j = 0; j < 4; ++j) { v[j] = v[j] - mean; s2 += (v[j].x * v[j].x + v[j].y * v[j].y) + (v[j].z * v[j].z + v[j].w * v[j].w); }
    const float rstd = 1.f / sqrtf(wave_sum(s2) * (1.f / DM) + LN_EPS);
#pragma unroll
    for (int j = 0; j < 4; ++j) v[j] = v[j] * rstd * g.q[j] + bt.q[j];
    return (f32x2){mean, rstd};
}
template <bool H8> __device__ __forceinline__ void row_mod_store_v(const f32x4 (&v)[4], const Vec16& sh, const Vec16& sc, void* hbase, size_t r, int lane) {
#pragma unroll
    for (int j = 0; j < 4; ++j) { const f32x4 h = v[j] * (sc.q[j] + 1.0f) + sh.q[j];
        if constexpr (H8) *(unsigned*)((unsigned char*)hbase + r * DM + 4 * lane + 256 * j) = pk4_fp8(h[0] * 4.f, h[1] * 4.f, h[2] * 4.f, h[3] * 4.f);
        else { u32x2 w; w.x = cvtpk(h[0], h[1]); w.y = cvtpk(h[2], h[3]); *(u32x2*)((bf16*)hbase + r * DM + 4 * lane + 256 * j) = w; } }
}
#define ROWS_LAT(...) do { const int nwb_ = NGW / 8; if (nwb_ > 0 && gw < 8 * nwb_) { const int b = gw / nwb_, nwin_ = (SEQ + nwb_ - 1) / nwb_; \
    for (int i_ = 0; i_ < nwin_; ++i_) { const int r = b * SEQ + ((i_ + 2 * b) % nwin_) * nwb_ + gw % nwb_;     \
        if (r < (b + 1) * SEQ) { __VA_ARGS__ } } } } while (0)
#define ROWS_CTX(...) do { const int b = 8; for (int r = RL + gw; r < RT; r += NGW) { __VA_ARGS__ } } while (0)
__device__ __forceinline__ void p1_modulate(Frame& F) {
    const int gw = F.vcu * NWAVES + F.wave, NGW = F.G * NWAVES; const float* mod = WSP(float, WS_MOD); bf16* H = WSP(bf16, WS_H);
    { const int bb = gw / (NGW / 8) < 8 ? gw / (NGW / 8) : 7; const Vec16 sh = vec_load(mod + (size_t)bb * 6144, F.lane), sc = vec_load(mod + (size_t)bb * 6144 + 1024, F.lane);
      ROWS_LAT( (void)b; f32x4 v[4]; row_load(v, F.x + (size_t)r * DM, F.lane); row_mod_store_v<true>(v, sh, sc, H, (size_t)r, F.lane); ); }
    { const Vec16 sh = vec_load(mod + (size_t)8 * 6144, F.lane), sc = vec_load(mod + (size_t)8 * 6144 + 1024, F.lane);
      ROWS_CTX( (void)b; f32x4 v[4]; row_load(v, F.ctx + (size_t)(r - RL) * DM, F.lane); row_mod_store_v<true>(v, sh, sc, H, (size_t)r, F.lane); ); }
}
template <bool H8> __device__ __forceinline__ void ln_mod_pass(Frame& F, bool with_ctx, const float* g, const float* bt, int ml, int cs) {
    const int gw = F.vcu * NWAVES + F.wave, NGW = F.G * NWAVES; const float* mod = WSP(float, WS_MOD) + (size_t)ml * 9 * 6144; bf16* H = WSP(bf16, WS_H); const bf16* YB = WSP(bf16, WS_YB);
    const Vec16 gv = vec_load(g, F.lane), bv = vec_load(bt, F.lane);
    { const int bb = gw / (NGW / 8) < 8 ? gw / (NGW / 8) : 7; const Vec16 sh = vec_load(mod + (size_t)bb * 6144 + cs, F.lane), sc = vec_load(mod + (size_t)bb * 6144 + cs + 1024, F.lane);
      ROWS_LAT( (void)b; f32x4 v[4]; row_load_bf(v, YB + (size_t)r * DM, F.lane); const f32x2 sv = row_ln_v(v, gv, bv); if (F.lane == 0) ((f32x2*)(F.ws + WS_STATS))[r] = sv;
                row_mod_store_v<H8>(v, sh, sc, H, (size_t)r, F.lane); ); }
    if (with_ctx) { const Vec16 sh = vec_load(mod + (size_t)8 * 6144 + cs, F.lane), sc = vec_load(mod + (size_t)8 * 6144 + cs + 1024, F.lane);
      ROWS_CTX( (void)b; f32x4 v[4]; row_load_bf(v, YB + (size_t)r * DM, F.lane); const f32x2 sv = row_ln_v(v, gv, bv); if (F.lane == 0) ((f32x2*)(F.ws + WS_STATS))[r] = sv;
                row_mod_store_v<H8>(v, sh, sc, H, (size_t)r, F.lane); ); }
}

namespace att {
constexpr float SCALE = 0.08838834764831845f, THR = 8.f;
constexpr int SHM_V = 64 * 128 * 2, SHM_K = 64 * 128 * 2;
#define KSWZ(row, colB) ((row) * 256 + ((colB) ^ (((row) & 7) << 4)))
#define SBAR() __builtin_amdgcn_sched_barrier(0)
__device__ __forceinline__ int crow(int r, int hi) { return (r & 3) + 8 * (r >> 2) + 4 * hi; }
__device__ __forceinline__ void partialSM(f32x16& p0, f32x16& p1, float& m_reg, float& mn, float& alpha, bool domask, int d0) {
    constexpr float C = SCALE * 1.4426950408889634f;
    {
        const int dd = domask ? d0 : -32;
#pragma unroll
        for (int r = 0; r < 16; ++r) { const int rel = dd + (r & 3) + 8 * (r >> 2);
            p0[r] = ((unsigned)(rel + 128) <= 256u) ? p0[r] : -1e30f; p1[r] = ((unsigned)(rel + 160) <= 256u) ? p1[r] : -1e30f; }
    }
    float pmax = p0[0];
#pragma unroll
    for (int r = 1; r < 16; ++r) pmax = fmaxf(pmax, p0[r]);
#pragma unroll
    for (int r = 0; r < 16; ++r) pmax = fmaxf(pmax, p1[r]);
    { auto rr = __builtin_amdgcn_permlane32_swap(__float_as_uint(pmax), __float_as_uint(pmax), false, false);
      pmax = fmaxf(__uint_as_float(rr[0]), __uint_as_float(rr[1])); }
    if (__builtin_expect(__all(pmax - m_reg <= THR / SCALE), 1)) { mn = m_reg; alpha = 1.f; }
    else { mn = fmaxf(m_reg, pmax); alpha = ex2((m_reg - mn) * C); m_reg = mn; }
    const float mnC = -mn * C;
#pragma unroll
    for (int r = 0; r < 16; ++r) p0[r] = fmaf(p0[r], C, mnC);
#pragma unroll
    for (int r = 0; r < 16; ++r) p1[r] = fmaf(p1[r], C, mnC);
#pragma unroll
    for (int r = 0; r < 16; ++r) p0[r] = ex2(p0[r]);
}
__device__ __forceinline__ void finishSM(f32x16& p0, f32x16& p1, float alpha, float& l_reg, bf16x8& pa0, bf16x8& pa1, bf16x8& pa2, bf16x8& pa3) {
#pragma unroll
    for (int r = 0; r < 16; ++r) p1[r] = ex2(p1[r]);
    float ps = 0;
#pragma unroll
    for (int r = 0; r < 16; ++r) ps += p0[r];
#pragma unroll
    for (int r = 0; r < 16; ++r) ps += p1[r];
    { auto rr = __builtin_amdgcn_permlane32_swap(__float_as_uint(ps), __float_as_uint(ps), false, false);
      ps = __uint_as_float(rr[0]) + __uint_as_float(rr[1]); }
    l_reg = l_reg * alpha + ps;
#define PK4(P, BASE, OUT) do { unsigned a0 = cvtpk(P[BASE + 0], P[BASE + 1]), a1 = cvtpk(P[BASE + 2], P[BASE + 3]);   \
    unsigned b0 = cvtpk(P[BASE + 4], P[BASE + 5]), b1 = cvtpk(P[BASE + 6], P[BASE + 7]);                              \
    auto r0 = __builtin_amdgcn_permlane32_swap(a0, b0, false, false); auto r1 = __builtin_amdgcn_permlane32_swap(a1, b1, false, false); \
    u32x4 w = {r0[0], r1[0], r0[1], r1[1]}; OUT = __builtin_bit_cast(bf16x8, w); } while (0)
    PK4(p0, 0, pa0); PK4(p0, 8, pa1); PK4(p1, 0, pa2); PK4(p1, 8, pa3);
#undef PK4
}
__device__ __forceinline__ void qkt(f32x16& p0, f32x16& p1, LAS const unsigned char* Ks, const bf16x8* qr, int r32, int hi) {
    p0 = f32x16{}; p1 = f32x16{};
#pragma unroll
    for (int d0 = 0; d0 < 8; ++d0) { const int cb = (d0 * 16 + hi * 8) * 2;
        const bf16x8 b0 = *(LAS const bf16x8*)(Ks + KSWZ(r32, cb));
        const bf16x8 b1 = *(LAS const bf16x8*)(Ks + KSWZ(32 + r32, cb));
        p0 = __builtin_amdgcn_mfma_f32_32x32x16_bf16(b0, qr[d0], p0, 0, 0, 0);
        p1 = __builtin_amdgcn_mfma_f32_32x32x16_bf16(b1, qr[d0], p1, 0, 0, 0); }
}
__device__ __forceinline__ int v_st(int k, int c) { const int kk = (k & ~0xC) | ((k & 4) << 1) | ((k & 8) >> 1); return ((kk >> 3) * 4 + (c >> 5)) * 512 + ((kk & 7) * 32 + (c & 31)) * 2; }
__device__ __forceinline__ int v_rd_base(int lane) { return ((lane & 3) << 3) | (((lane >> 2) & 3) << 6) | (((lane >> 4) & 1) << 5) | (((lane >> 5) & 1) << 8); }
constexpr int v_rd_off(int d0, int ks, int half) { return d0 * 512 + ks * 4096 + half * 2048; }
template <int OFF> __device__ __forceinline__ s16x4 tr_read(int vb) {
    s16x4 r; asm volatile("ds_read_b64_tr_b16 %0, %1 offset:%2" : "=&v"(r) : "v"(vb), "i"(OFF) : "memory"); return r;
}
template <int D0> __device__ __forceinline__ void pv_one(f32x16& od, int vb, bf16x8 pa0, bf16x8 pa1, bf16x8 pa2, bf16x8 pa3) {
    const s16x4 l0 = tr_read<v_rd_off(D0, 0, 0)>(vb), h0 = tr_read<v_rd_off(D0, 0, 1)>(vb), l1 = tr_read<v_rd_off(D0, 1, 0)>(vb), h1 = tr_read<v_rd_off(D0, 1, 1)>(vb);
    const s16x4 l2 = tr_read<v_rd_off(D0, 2, 0)>(vb), h2 = tr_read<v_rd_off(D0, 2, 1)>(vb), l3 = tr_read<v_rd_off(D0, 3, 0)>(vb), h3 = tr_read<v_rd_off(D0, 3, 1)>(vb);
    asm volatile("s_waitcnt lgkmcnt(0)" ::: "memory"); SBAR();
#define PKV(L, H) (bf16x8){L[0], L[1], L[2], L[3], H[0], H[1], H[2], H[3]}
    od = __builtin_amdgcn_mfma_f32_32x32x16_bf16(pa0, PKV(l0, h0), od, 0, 0, 0);
    od = __builtin_amdgcn_mfma_f32_32x32x16_bf16(pa1, PKV(l1, h1), od, 0, 0, 0);
    od = __builtin_amdgcn_mfma_f32_32x32x16_bf16(pa2, PKV(l2, h2), od, 0, 0, 0);
    od = __builtin_amdgcn_mfma_f32_32x32x16_bf16(pa3, PKV(l3, h3), od, 0, 0, 0);
#undef PKV
}
__device__ __forceinline__ void pv_d0(f32x16* o, int vb, bf16x8 pa0, bf16x8 pa1, bf16x8 pa2, bf16x8 pa3) {
    pv_one<0>(o[0], vb, pa0, pa1, pa2, pa3); pv_one<1>(o[1], vb, pa0, pa1, pa2, pa3); pv_one<2>(o[2], vb, pa0, pa1, pa2, pa3); pv_one<3>(o[3], vb, pa0, pa1, pa2, pa3);
}
__device__ __forceinline__ void attn_unit(const bf16* __restrict__ QKV, bf16* __restrict__ O, const float* __restrict__ sink, int qrow0, int head0, int kvh, int krow_band, int nband, int krow_ctx, int dpos0, LAS unsigned char* lds) {
    const int tid = threadIdx.x, wid = __builtin_amdgcn_readfirstlane(tid >> 6), lane = tid & 63, r32 = lane & 31, hi = lane >> 5;
    LAS unsigned char* V_lds = lds; LAS unsigned char* K_lds = lds + 2 * SHM_V;
    LAS float* wsf = (LAS float*)(lds + 2 * SHM_V + 2 * SHM_K) + wid * 64; LAS float* li_l = wsf; LAS float* al_l = wsf + 32;
    const int head = head0 + (wid >> 2), qoff = 32 * (wid & 3);
    float m_reg = sink[head] * (1.0f / SCALE), l_reg = 1.0f; f32x16 o[4] = {}; bf16x8 qr[8];
    const bf16* Qw = QKV + (size_t)(qrow0 + qoff + r32) * QKVD + head * HDIM + hi * 8;
#pragma unroll
    for (int d0 = 0; d0 < 8; ++d0) qr[d0] = *(const bf16x8*)(Qw + d0 * 16);
    const bf16* Kg = QKV + 1024 + kvh * HDIM; const bf16* Vg = QKV + 1280 + kvh * HDIM;
    const int sr = tid >> 4, sc = (tid & 15) * 8, vst0 = v_st(sr, sc), vst1 = v_st(32 + sr, sc);
    const int vb0 = (int)(unsigned)(uintptr_t)V_lds + v_rd_base(lane);
    const int NT = nband + 4;
    struct { bf16x8 vs0, vs1, ks0, ks1; } sr_[2];
#define TROW(j) ((j) < nband ? krow_band + 64 * (j) : krow_ctx + 64 * ((j) - nband))
#define SLOAD(i, j) do { const size_t _r0 = (size_t)(TROW(j) + sr) * QKVD + sc, _r1 = _r0 + (size_t)32 * QKVD; \
    sr_[i].vs0 = *(const bf16x8*)(Vg + _r0); sr_[i].vs1 = *(const bf16x8*)(Vg + _r1); sr_[i].ks0 = *(const bf16x8*)(Kg + _r0); sr_[i].ks1 = *(const bf16x8*)(Kg + _r1); } while (0)
#define SWRITE(b, i) do { *(LAS bf16x8*)(V_lds + (b) * SHM_V + vst0) = sr_[i].vs0; *(LAS bf16x8*)(V_lds + (b) * SHM_V + vst1) = sr_[i].vs1; const int kc = sc * 2; \
    *(LAS bf16x8*)(K_lds + (b) * SHM_K + KSWZ(sr, kc)) = sr_[i].ks0; *(LAS bf16x8*)(K_lds + (b) * SHM_K + KSWZ(32 + sr, kc)) = sr_[i].ks1; } while (0)
#define SWAIT() asm volatile("s_waitcnt vmcnt(4)" ::: "memory")
#define RESC(a) do { if (__any((a) < 1.f)) { if (hi == 0) al_l[r32] = (a); asm volatile("s_waitcnt lgkmcnt(0)" ::: "memory"); \
    _Pragma("unroll") for (int d = 0; d < 4; ++d) _Pragma("unroll") for (int r = 0; r < 16; ++r) o[d][r] *= al_l[crow(r, hi)]; } } while (0)
#define TMASK(j, dm, dd) const int _dl##j = dpos0 + 64 * (j) - qoff; const bool dm = ((j) < nband) && !(_dl##j >= -97 && _dl##j <= 65); const int dd = _dl##j - r32 + 4 * hi
    f32x16 pA0, pA1, pB0, pB1; float mnA, mnB, alA, alB; bf16x8 pa0, pa1, pa2, pa3;
    constexpr int SE = 0, SO = 1;
    SLOAD(SE, 0); asm volatile("s_waitcnt vmcnt(0)" ::: "memory"); SWRITE(0, SE); __syncthreads();
    qkt(pA0, pA1, K_lds, qr, r32, hi); { TMASK(0, dm, dd); partialSM(pA0, pA1, m_reg, mnA, alA, dm, dd); }
    SLOAD(SO, 1); if (2 < NT) SLOAD(SE, 2);
    SWAIT(); SWRITE(1, SO); __syncthreads();
    for (int j = 1; j + 1 < NT; j += 2) {
        SBAR(); qkt(pB0, pB1, K_lds + SHM_K, qr, r32, hi);
        finishSM(pA0, pA1, alA, l_reg, pa0, pa1, pa2, pa3); SBAR();
        SLOAD(SO, (j + 2 < NT ? j + 2 : j)); SBAR();
        pv_d0(o, vb0, pa0, pa1, pa2, pa3); { const int jj = j; const int dl = dpos0 + 64 * jj - qoff; const bool dm = (jj < nband) && !(dl >= -97 && dl <= 65); partialSM(pB0, pB1, m_reg, mnB, alB, dm, dl - r32 + 4 * hi); }
        __syncthreads(); SWAIT(); SWRITE(0, SE);
        RESC(alB); __syncthreads();
        SBAR(); qkt(pA0, pA1, K_lds, qr, r32, hi);
        finishSM(pB0, pB1, alB, l_reg, pa0, pa1, pa2, pa3); SBAR();
        SLOAD(SE, (j + 3 < NT ? j + 3 : j)); SBAR();
        pv_d0(o, vb0 + SHM_V, pa0, pa1, pa2, pa3); { const int jj = j + 1; const int dl = dpos0 + 64 * jj - qoff; const bool dm = (jj < nband) && !(dl >= -97 && dl <= 65); partialSM(pA0, pA1, m_reg, mnA, alA, dm, dl - r32 + 4 * hi); }
        __syncthreads(); SWAIT(); SWRITE(1, SO);
        RESC(alA); __syncthreads();
    }
    SBAR(); qkt(pB0, pB1, K_lds + SHM_K, qr, r32, hi);
    finishSM(pA0, pA1, alA, l_reg, pa0, pa1, pa2, pa3); SBAR();
    pv_d0(o, vb0, pa0, pa1, pa2, pa3); { const int jj = NT - 1; const int dl = dpos0 + 64 * jj - qoff; const bool dm = (jj < nband) && !(dl >= -97 && dl <= 65); partialSM(pB0, pB1, m_reg, mnB, alB, dm, dl - r32 + 4 * hi); }
    asm volatile("s_waitcnt vmcnt(0)" ::: "memory");
    __syncthreads(); RESC(alB);
    finishSM(pB0, pB1, alB, l_reg, pa0, pa1, pa2, pa3); SBAR();
    pv_d0(o, vb0 + SHM_V, pa0, pa1, pa2, pa3);
    if (hi == 0) li_l[r32] = l_reg; asm volatile("s_waitcnt lgkmcnt(0)" ::: "memory");
    float rli[16];
#pragma unroll
    for (int r = 0; r < 16; ++r) rli[r] = rcpf_(li_l[crow(r, hi)]);
    { LAS unsigned char* ot = lds + 2 * SHM_V + 2 * SHM_K + 4096 + wid * 4096;
#pragma unroll
      for (int r = 0; r < 16; ++r) { const int orow = crow(r, hi);
#pragma unroll
          for (int d0 = 0; d0 < 4; ++d0) { const float x = clamp8(o[d0][r] * rli[r] * 16.0f); ot[orow * 128 + d0 * 32 + r32] = (unsigned char)(__builtin_amdgcn_cvt_pk_fp8_f32(x, x, 0, false) & 0xff); } }
      asm volatile("s_waitcnt lgkmcnt(0)" ::: "memory");
      unsigned char* Ob = (unsigned char*)O + (size_t)(qrow0 + qoff) * DM + head * HDIM;
#pragma unroll
      for (int i = 0; i < 4; ++i) { const int row = (lane >> 3) + 8 * i, ch = lane & 7; *(u32x4*)(Ob + (size_t)row * DM + ch * 16) = *(LAS const u32x4*)(ot + row * 128 + ch * 16); } }
    __syncthreads();
#undef TROW
#undef SLOAD
#undef SWRITE
#undef SWAIT
#undef RESC
#undef TMASK
}
constexpr int N_LAT_UNITS = NB * 32 * NKVH * 2, N_CTX_UNITS = NB * 2 * NKVH * 2, N_UNITS = N_LAT_UNITS + N_CTX_UNITS;
__device__ __forceinline__ void attn_phase(const bf16* QKV, bf16* O, const float* sink, int G, int c, LAS unsigned char* lds) {
    for (int L = c; L < N_UNITS; L += G) {
        if (L < N_LAT_UNITS) { const int hp = L & 1, kh = (L >> 1) & 1, n = (L >> 2) & 31, b = L >> 7;
            const int nlo = n > 0 ? n - 1 : 0, nhi = n < 31 ? n + 1 : 31, nband = 2 * (nhi - nlo + 1);
            attn_unit(QKV, O, sink, b * SEQ + n * 128, kh * 4 + hp * 2, kh, b * SEQ + nlo * 128, nband, RL + b * LCTX, (nlo - n) * 128, lds);
        } else { const int u = L - N_LAT_UNITS, hp = u & 1, kh = (u >> 1) & 1, qh = (u >> 2) & 1, b = u >> 3;
            attn_unit(QKV, O, sink, RL + b * LCTX + qh * 128, kh * 4 + hp * 2, kh, 0, 0, RL + b * LCTX, 0, lds);
        }
    }
}
#undef KSWZ
#undef SBAR
}

__device__ __forceinline__ void p10_conv(Frame& F) {
    const int gw = F.vcu * NWAVES + F.wave, NGW = F.G * NWAVES; const bf16* XB = WSP(bf16, WS_XB); bf16* U = WSP(bf16, WS_U);
    float cw[4][16], cb[16];
#pragma unroll
    for (int j = 0; j < 4; ++j)
#pragma unroll
        for (int q = 0; q < 4; ++q) { const f32x4 w = *(const f32x4*)(F.conv_w + j * 1024 + 16 * F.lane + 4 * q); cw[j][4 * q] = w[0]; cw[j][4 * q + 1] = w[1]; cw[j][4 * q + 2] = w[2]; cw[j][4 * q + 3] = w[3]; }
#pragma unroll
    for (int q = 0; q < 4; ++q) { const f32x4 w = *(const f32x4*)(F.conv_b + 16 * F.lane + 4 * q); cb[4 * q] = w[0]; cb[4 * q + 1] = w[1]; cb[4 * q + 2] = w[2]; cb[4 * q + 3] = w[3]; }
    const int per = (RT + NGW - 1) / NGW, r0 = gw * per, r1 = (r0 + per < RT) ? r0 + per : RT;
    if (r0 >= RT) return;
    u32x4 w0[4], w1[4];
#pragma unroll
    for (int j = 0; j < 4; ++j) { int rr = r0 + j - 2; rr = rr < 0 ? 0 : (rr >= RT ? RT - 1 : rr); const u32x4* p = (const u32x4*)(XB + (size_t)rr * DM + 16 * F.lane); w0[j] = p[0]; w1[j] = p[1]; }
    for (int r = r0; r < r1; ++r) { const bool lat = r < RL; const int t = lat ? (r & (SEQ - 1)) : ((r - RL) & (LCTX - 1)); const int Ls = lat ? SEQ : LCTX;
        u32x4 n0, n1; { int rn = r + 2; rn = rn >= RT ? RT - 1 : rn; const u32x4* p = (const u32x4*)(XB + (size_t)rn * DM + 16 * F.lane); n0 = p[0]; n1 = p[1]; }
        float acc[16];
#pragma unroll
        for (int i = 0; i < 16; ++i) acc[i] = cb[i];
#pragma unroll
        for (int j = 0; j < 4; ++j) { const int tj = t + j - 2;
            if (tj >= 0 && tj < Ls) { const u32x4 x0 = w0[j], x1 = w1[j];
#pragma unroll
                for (int q = 0; q < 4; ++q) { acc[2 * q] += cw[j][2 * q] * bflo(x0[q]); acc[2 * q + 1] += cw[j][2 * q + 1] * bfhi(x0[q]); acc[8 + 2 * q] += cw[j][8 + 2 * q] * bflo(x1[q]); acc[8 + 2 * q + 1] += cw[j][8 + 2 * q + 1] * bfhi(x1[q]); } } }
        u32x4 o0, o1;
#pragma unroll
        for (int q = 0; q < 4; ++q) { o0[q] = cvtpk(acc[2 * q], acc[2 * q + 1]); o1[q] = cvtpk(acc[8 + 2 * q], acc[8 + 2 * q + 1]); }
        u32x4* op = (u32x4*)(U + (size_t)r * DM + 16 * F.lane); op[0] = o0; op[1] = o1;
        w0[0] = w0[1]; w0[1] = w0[2]; w0[2] = w0[3]; w0[3] = n0; w1[0] = w1[1]; w1[1] = w1[2]; w1[2] = w1[3]; w1[3] = n1; }
}
namespace lru {
constexpr int AIMG_BYTES = 65536;
constexpr int EX_OFF = 2 * AIMG_BYTES;
struct Ctx { const bf16* U; const bf16* G; bf16* HH; u32x4* HF; const bf16* WLG; const float *lam, *b_r, *b_i; };

__device__ __forceinline__ void issue_u(const Ctx& C, LAS unsigned char* buf, int n, size_t row0, int wid, int lane) {
#pragma unroll
    for (int ii = 0; ii < 8; ++ii) { const int i = wid + 8 * ii; const int row = 4 * i + (lane >> 4), q = (lane & 15) ^ (row & 15);
        __builtin_amdgcn_global_load_lds((const unsigned*)(C.U + (row0 + row) * DM + n * 128 + q * 8), (LAS unsigned*)(buf + i * 1024), 16, 0, 0); }
}
__device__ __forceinline__ void chunk_geom(int DIR, int k, int b, size_t& row0, int& lc) {
    if (k == 0) { row0 = (size_t)RL + b * LCTX; lc = -1; } else { lc = DIR ? 16 - k : k - 1; row0 = (size_t)b * SEQ + 256 * lc; }
}
#define LRU_BAR() do { asm volatile("s_waitcnt lgkmcnt(0)" ::: "memory"); __builtin_amdgcn_s_barrier(); asm volatile("" ::: "memory"); } while (0)
template <int DIR>
__device__ __forceinline__ void walk(const Ctx& C, LAS unsigned char* lds, int task) {
    const int cq = task & 3, n = (task >> 2) & 7, b = task >> 5;
    const int tid = threadIdx.x, wid = __builtin_amdgcn_readfirstlane(tid >> 6), lane = tid & 63, c = lane & 15, g = lane >> 4;
    const int chalf = wid & 1, tq = wid >> 1;
    const int chl = 32 * cq + 16 * chalf + c;
    const int ch = n * 128 + chl;
    bf16x8 Br[4], Bi[4];
    { const bf16* wr = C.WLG + ((size_t)(n * 4 + 2 * DIR) * 128 + chl) * 128 + 8 * g; const bf16* wi = wr + 16384;
#pragma unroll
      for (int ks = 0; ks < 4; ++ks) { Br[ks] = *(const bf16x8*)(wr + ks * 32); Bi[ks] = *(const bf16x8*)(wi + ks * 32); } }
    const float br = C.b_r[DIR * 1024 + ch], bi = C.b_i[DIR * 1024 + ch];
    const float sp8 = 8.0f * log1pf(expf(-C.lam[DIR * 1024 + ch]));
    const float kbr = -LOG2E * br, kbi = -LOG2E * bi, ka = -sp8 * LOG2E;
    float H = 0.f;
    { size_t r0; int lc; chunk_geom(DIR, 0, b, r0, lc); issue_u(C, lds, n, r0, wid, lane); }
    for (int k = 0; k < 17; ++k) {
        size_t row0; int lc; chunk_geom(DIR, k, b, row0, lc);
        LAS unsigned char* img = lds + (k & 1) * AIMG_BYTES;
        asm volatile("s_waitcnt vmcnt(0)" ::: "memory");
        LRU_BAR();
        if (k + 1 < 17) { size_t r1; int l1; chunk_geom(DIR, k + 1, b, r1, l1); issue_u(C, lds + ((k + 1) & 1) * AIMG_BYTES, n, r1, wid, lane); }
        u32x4 hf0, hf1;
        u32x4 gp0, gp1;
        if (DIR == 1 && lc >= 0) { const u32x4* hp = C.HF + ((((size_t)task * 16 + lc) * 8 + wid) * 2) * 64 + lane; hf0 = hp[0]; hf1 = hp[64];
            const size_t grow = (row0 + (tid >> 1)) * DM + n * 128 + 32 * cq + 16 * (tid & 1); gp0 = *(const u32x4*)(C.G + grow); gp1 = *(const u32x4*)(C.G + grow + 8); }
        f32x4 ar[4], ai[4];
#pragma unroll
        for (int mt = 0; mt < 4; ++mt) { ar[mt] = (f32x4){0.f, 0.f, 0.f, 0.f}; ai[mt] = (f32x4){0.f, 0.f, 0.f, 0.f};
#pragma unroll
            for (int ks = 0; ks < 4; ++ks) { const bf16x8 af = *(LAS const bf16x8*)(img + (64 * tq + mt * 16 + c) * 256 + ((ks * 64 + 16 * g) ^ (c << 4)));
                ar[mt] = __builtin_amdgcn_mfma_f32_16x16x32_bf16(af, Br[ks], ar[mt], 0, 0, 0);
                ai[mt] = __builtin_amdgcn_mfma_f32_16x16x32_bf16(af, Bi[ks], ai[mt], 0, 0, 0); } }
        float y0[4][4], P[4][4]; float TA = 1.f, TB = 0.f;
#pragma unroll
        for (int mm = 0; mm < 4; ++mm) { const int mt = DIR ? 3 - mm : mm;
            float a[4], bb[4];
#pragma unroll
            for (int r = 0; r < 4; ++r) { const int tt = 64 * tq + mt * 16 + 4 * g + r;
                const float rg = rcpf_(1.0f + ex2(fmaf(ar[mt][r], -LOG2E, kbr))), ig = rcpf_(1.0f + ex2(fmaf(ai[mt][r], -LOG2E, kbi)));
                a[r] = ex2(rg * ka);
                const float em = fmaf(-a[r], a[r], 1.0f);
                const float uu = __uint_as_float((unsigned)*(LAS const bf16*)(img + tt * 256 + ((2 * chl) ^ ((tt & 15) << 4))) << 16);
                bb[r] = __builtin_amdgcn_sqrtf(em) * (ig * uu); }
            float p[4], yl[4];
            if (DIR == 0) { p[0] = a[0]; yl[0] = bb[0];
#pragma unroll
                for (int r = 1; r < 4; ++r) { p[r] = a[r] * p[r - 1]; yl[r] = a[r] * yl[r - 1] + bb[r]; } }
            else { p[3] = a[3]; yl[3] = bb[3];
#pragma unroll
                for (int r = 2; r >= 0; --r) { p[r] = a[r] * p[r + 1]; yl[r] = a[r] * yl[r + 1] + bb[r]; } }
            const float Al = DIR ? p[0] : p[3], Bl = DIR ? yl[0] : yl[3];
            const float A0 = __shfl(Al, c), A1 = __shfl(Al, 16 + c), A2 = __shfl(Al, 32 + c), A3 = __shfl(Al, 48 + c);
            const float B0 = __shfl(Bl, c), B1 = __shfl(Bl, 16 + c), B2 = __shfl(Bl, 32 + c), B3 = __shfl(Bl, 48 + c);
            float EA, EB, At, Bt;
            if (DIR == 0) { const float e1a = A0, e1b = B0, e2a = A1 * e1a, e2b = A1 * e1b + B1, e3a = A2 * e2a, e3b = A2 * e2b + B2;
                EA = g == 0 ? 1.f : (g == 1 ? e1a : (g == 2 ? e2a : e3a)); EB = g == 0 ? 0.f : (g == 1 ? e1b : (g == 2 ? e2b : e3b)); At = A3 * e3a; Bt = A3 * e3b + B3; }
            else { const float e2a = A3, e2b = B3, e1a = A2 * e2a, e1b = A2 * e2b + B2, e0a = A1 * e1a, e0b = A1 * e1b + B1;
                EA = g == 3 ? 1.f : (g == 2 ? e2a : (g == 1 ? e1a : e0a)); EB = g == 3 ? 0.f : (g == 2 ? e2b : (g == 1 ? e1b : e0b)); At = A0 * e0a; Bt = A0 * e0b + B0; }
            const float QA = EA * TA, QB = EA * TB + EB;
#pragma unroll
            for (int r = 0; r < 4; ++r) { P[mt][r] = p[r] * QA; y0[mt][r] = p[r] * QB + yl[r]; }
            TB = At * TB + Bt; TA = At * TA;
        }
        if (g == 0) *(LAS f32x2*)(lds + EX_OFF + ((tq * 2 + chalf) * 16 + c) * 8) = (f32x2){TA, TB};
        LRU_BAR();
        float Hw;
        { const f32x2 e0 = *(LAS const f32x2*)(lds + EX_OFF + ((0 * 2 + chalf) * 16 + c) * 8), e1 = *(LAS const f32x2*)(lds + EX_OFF + ((1 * 2 + chalf) * 16 + c) * 8),
                      e2 = *(LAS const f32x2*)(lds + EX_OFF + ((2 * 2 + chalf) * 16 + c) * 8), e3 = *(LAS const f32x2*)(lds + EX_OFF + ((3 * 2 + chalf) * 16 + c) * 8);
          if (DIR == 0) { const float h1 = e0.x * H + e0.y, h2 = e1.x * h1 + e1.y, h3 = e2.x * h2 + e2.y; Hw = tq == 0 ? H : (tq == 1 ? h1 : (tq == 2 ? h2 : h3)); H = e3.x * h3 + e3.y; }
          else { const float h2 = e3.x * H + e3.y, h1 = e2.x * h2 + e2.y, h0 = e1.x * h1 + e1.y; Hw = tq == 3 ? H : (tq == 2 ? h2 : (tq == 1 ? h1 : h0)); H = e0.x * h0 + e0.y; } }
        if (lc >= 0) {
#pragma unroll
            for (int mt = 0; mt < 4; ++mt)
#pragma unroll
                for (int r = 0; r < 4; ++r) y0[mt][r] += P[mt][r] * Hw;
            if (DIR == 0) {
                u32x4* hp = C.HF + ((((size_t)task * 16 + lc) * 8 + wid) * 2) * 64 + lane;
                u32x4 w0, w1; w0.x = cvtpk(y0[0][0], y0[0][1]); w0.y = cvtpk(y0[0][2], y0[0][3]); w0.z = cvtpk(y0[1][0], y0[1][1]); w0.w = cvtpk(y0[1][2], y0[1][3]);
                w1.x = cvtpk(y0[2][0], y0[2][1]); w1.y = cvtpk(y0[2][2], y0[2][3]); w1.z = cvtpk(y0[3][0], y0[3][1]); w1.w = cvtpk(y0[3][2], y0[3][3]);
                hp[0] = w0; hp[64] = w1;
            } else {
                const unsigned hw[8] = {hf0.x, hf0.y, hf0.z, hf0.w, hf1.x, hf1.y, hf1.z, hf1.w};
#pragma unroll
                for (int mt = 0; mt < 4; ++mt)
#pragma unroll
                    for (int r = 0; r < 4; ++r) { const unsigned w = hw[mt * 2 + (r >> 1)]; const float hfv = (r & 1) ? bfhi(w) : bflo(w); const float s = y0[mt][r] + hfv;
                        *(LAS bf16*)(img + (64 * tq + mt * 16 + 4 * g + r) * 64 + (16 * chalf + c) * 2) = (bf16)(cvtpk(s, 0.f) & 0xffffu); }
                LRU_BAR();
                { const int tt = tid >> 1, hh = tid & 1; const size_t grow = (row0 + tt) * DM + n * 128 + 32 * cq + 16 * hh;
                  const u32x4 s0 = *(LAS const u32x4*)(img + tt * 64 + hh * 32), s1 = *(LAS const u32x4*)(img + tt * 64 + hh * 32 + 16);
                  const u32x4 g0 = gp0, g1 = gp1;
                  u32x4 o0, o1;
#pragma unroll
                  for (int j = 0; j < 4; ++j) { o0[j] = cvtpk(bflo(s0[j]) * bflo(g0[j]), bfhi(s0[j]) * bfhi(g0[j])); o1[j] = cvtpk(bflo(s1[j]) * bflo(g1[j]), bfhi(s1[j]) * bfhi(g1[j])); }
                  *(u32x4*)(C.HH + grow) = o0; *(u32x4*)(C.HH + grow + 8) = o1; }
            }
        }
    }
    asm volatile("s_waitcnt vmcnt(0)" ::: "memory");
    LRU_BAR();
}
#undef LRU_BAR
}
__device__ __forceinline__ void p11_lru(Frame& F, const lru::Ctx& C) {
    for (int task = F.vcu; task < 256; task += F.G) { lru::walk<0>(C, F.lds, task); lru::walk<1>(C, F.lds, task); }
}

__device__ __forceinline__ void p13_ln_router(Frame& F) {
    LAS float* RTR = (LAS float*)F.lds;
    LAS int* lcnt = (LAS int*)(F.lds + 32768);
    for (int idx = F.tid; idx < 8192; idx += NWAVES * 64) RTR[(idx & 7) * 1024 + (idx >> 3)] = F.router[idx];
    const float* mod = WSP(float, WS_MOD) + (size_t)1 * 9 * 6144; unsigned char* H8 = WSP(unsigned char, WS_H);
    int* eidx = (int*)(F.ws + WS_ROUTE + RT_EIDX); float* wgt = (float*)(F.ws + WS_ROUTE + RT_WGT); int* cnt = (int*)(F.ws + WS_ROUTE + RT_CNT);
    const Vec16 gv = vec_load(F.ln_g + 2 * 1024, F.lane), bv = vec_load(F.ln_b + 2 * 1024, F.lane);
    for (int batch = F.vcu; batch < RL / 128; batch += F.G) {
        const float* mb0 = mod + (size_t)((batch * 128) >> 12) * 6144 + 3072; const Vec16 sh = vec_load(mb0, F.lane), sc = vec_load(mb0 + 1024, F.lane);
        if (F.tid < 8) lcnt[F.tid] = 0;
        __syncthreads();
        u32x2 nx[4]; { const bf16* yp = WSP(bf16, WS_YB) + (size_t)(batch * 128 + F.wave * 16) * DM;
#pragma unroll
            for (int j = 0; j < 4; ++j) nx[j] = *(const u32x2*)(yp + 4 * F.lane + 256 * j); }
        for (int i = 0; i < 16; ++i) { const int r = batch * 128 + F.wave * 16 + i;
            f32x4 v[4];
#pragma unroll
            for (int j = 0; j < 4; ++j) v[j] = (f32x4){bflo(nx[j].x), bfhi(nx[j].x), bflo(nx[j].y), bfhi(nx[j].y)};
            if (i + 1 < 16) { const bf16* yp = WSP(bf16, WS_YB) + (size_t)(r + 1) * DM;
#pragma unroll
                for (int j = 0; j < 4; ++j) nx[j] = *(const u32x2*)(yp + 4 * F.lane + 256 * j); }
            row_ln_v(v, gv, bv);
            float lg[8];
#pragma unroll
            for (int e = 0; e < 8; ++e) lg[e] = 0.f;
#pragma unroll
            for (int j = 0; j < 4; ++j) { const f32x4 hm = v[j] * (sc.q[j] + 1.0f) + sh.q[j];
                *(unsigned*)(H8 + (size_t)r * DM + 4 * F.lane + 256 * j) = pk4_fp8(hm[0] * 4.f, hm[1] * 4.f, hm[2] * 4.f, hm[3] * 4.f);
#pragma unroll
                for (int e = 0; e < 8; ++e) { const f32x4 rt = *(LAS const f32x4*)(RTR + e * 1024 + 4 * F.lane + 256 * j); lg[e] += (hm[0] * rt[0] + hm[1] * rt[1]) + (hm[2] * rt[2] + hm[3] * rt[3]); } }
#pragma unroll
            for (int e = 0; e < 8; ++e) lg[e] = wave_sum(lg[e]);
            int ea = 0; float la = lg[0];
#pragma unroll
            for (int e = 1; e < 8; ++e) if (lg[e] > la) { la = lg[e]; ea = e; }
            int eb = -1; float lb = -3.0e38f;
#pragma unroll
            for (int e = 0; e < 8; ++e) if (e != ea && lg[e] > lb) { lb = lg[e]; eb = e; }
            const float wa = 1.0f / (1.0f + __expf(lb - la)), wb = 1.0f - wa;
            if (F.lane == 0) { *(int2*)(eidx + 2 * r) = make_int2(ea, eb); *(float2*)(wgt + 2 * r) = make_float2(wa, wb); atomicAdd((int*)(lcnt + ea), 1); atomicAdd((int*)(lcnt + eb), 1); }
        }
        __syncthreads();
        if (F.tid < 8) cnt[batch * 8 + F.tid] = lcnt[F.tid];
        __syncthreads();
    }
}
__device__ __forceinline__ void moe_totals(Frame& F, int upto_batch, int (&tot)[8], int (&before)[8]) {
    const int* cnt = (const int*)(F.ws + WS_ROUTE + RT_CNT);
#pragma unroll
    for (int e = 0; e < 8; ++e) { tot[e] = 0; before[e] = 0; }
#pragma unroll
    for (int k = 0; k < 4; ++k) { const int bb = 4 * F.lane + k; const int4 c0 = *(const int4*)(cnt + bb * 8), c1 = *(const int4*)(cnt + bb * 8 + 4); const int m = bb < upto_batch ? 1 : 0;
        tot[0] += c0.x; tot[1] += c0.y; tot[2] += c0.z; tot[3] += c0.w; tot[4] += c1.x; tot[5] += c1.y; tot[6] += c1.z; tot[7] += c1.w;
        before[0] += m * c0.x; before[1] += m * c0.y; before[2] += m * c0.z; before[3] += m * c0.w; before[4] += m * c1.x; before[5] += m * c1.y; before[6] += m * c1.z; before[7] += m * c1.w; }
#pragma unroll
    for (int e = 0; e < 8; ++e) {
#pragma unroll
        for (int o = 1; o < 64; o <<= 1) { tot[e] += __shfl_xor(tot[e], o); before[e] += __shfl_xor(before[e], o); } }
}
__device__ __forceinline__ void p14_gather(Frame& F) {
    const int* eidx = (const int*)(F.ws + WS_ROUTE + RT_EIDX); const float* wgt = (const float*)(F.ws + WS_ROUTE + RT_WGT);
    int* slot = (int*)(F.ws + WS_ROUTE + RT_SLOT); float* wsort = (float*)(F.ws + WS_ROUTE + RT_WS);
    const unsigned char* H8 = WSP(unsigned char, WS_H); unsigned char* HS8 = WSP(unsigned char, WS_HS);
    LAS int* wcnt = (LAS int*)F.lds;
    LAS int* dsts = (LAS int*)(F.lds + 256);
    for (int batch = F.vcu; batch < RL / 128; batch += F.G) {
        int tot[8], before[8]; moe_totals(F, batch, tot, before);
        int base[8]; { int tp = 0;
#pragma unroll
            for (int e = 0; e < 8; ++e) { base[e] = tp * 256 + before[e]; tp += (tot[e] + 255) >> 8; } }
        int my_e = 0, rank_in_wave = 0;
        if (F.tid < 256) { my_e = eidx[batch * 256 + F.tid];
#pragma unroll
            for (int e = 0; e < 8; ++e) { const unsigned long long m = __ballot(my_e == e); if (my_e == e) rank_in_wave = __popcll(m & ((1ull << F.lane) - 1ull)); if (F.lane == 0) wcnt[F.wave * 8 + e] = __popcll(m); } }
        __syncthreads();
        if (F.tid < 256) { int off = 0;
#pragma unroll
            for (int w = 0; w < 4; ++w) if (w < F.wave) off += wcnt[w * 8 + my_e];
            int bs = 0;
#pragma unroll
            for (int e = 0; e < 8; ++e) bs = (my_e == e) ? base[e] : bs;
            const int d = bs + off + rank_in_wave; dsts[F.tid] = d; slot[batch * 256 + F.tid] = d; wsort[d] = wgt[batch * 256 + F.tid]; }
        __syncthreads();
        for (int i = 0; i < 32; ++i) { const int a = F.wave * 32 + i; const int d = dsts[a]; const int r = batch * 128 + (a >> 1);
            const u32x4* src = (const u32x4*)(H8 + (size_t)r * DM); u32x4* dp = (u32x4*)(HS8 + (size_t)d * DM);
            dp[F.lane] = src[F.lane]; }
        __syncthreads();
    }
}
__device__ __forceinline__ void p17_final(Frame& F) {
    const int gw = F.vcu * NWAVES + F.wave, NGW = F.G * NWAVES; const float* mod = WSP(float, WS_MOD) + (size_t)1 * 9 * 6144; const bf16* FO = WSP(bf16, WS_FO);
    const int* slot = (const int*)(F.ws + WS_ROUTE + RT_SLOT);
    const Vec16 g0 = vec_load(F.ln_g + 2 * 1024, F.lane), b0 = vec_load(F.ln_b + 2 * 1024, F.lane), g1 = vec_load(F.ln_g + 3 * 1024, F.lane), b1 = vec_load(F.ln_b + 3 * 1024, F.lane);
    const int bb = gw / (NGW / 8) < 8 ? gw / (NGW / 8) : 7; const Vec16 g2 = vec_load(mod + (size_t)bb * 6144 + 5120, F.lane);
    ROWS_LAT( (void)b; float* yp = F.out + (size_t)r * DM; const int2 s = *(const int2*)(slot + 2 * r);
        const bf16* fa = FO + (size_t)s.x * DM, * fb = FO + (size_t)s.y * DM;
        f32x4 v[4]; row_load_bf(v, WSP(bf16, WS_YB) + (size_t)r * DM, F.lane); row_ln_v(v, g0, b0);
        _Pragma("unroll") for (int j = 0; j < 4; ++j) { const u32x2 a = *(const u32x2*)(fa + 4 * F.lane + 256 * j), c = *(const u32x2*)(fb + 4 * F.lane + 256 * j);
            const f32x4 f = {bflo(a.x) + bflo(c.x), bfhi(a.x) + bfhi(c.x), bflo(a.y) + bflo(c.y), bfhi(a.y) + bfhi(c.y)};
            v[j] = v[j] * ALPHA + g2.q[j] * f; }
        row_ln_v(v, g1, b1); row_store(v, yp, F.lane); );
}

constexpr int N_PHASES = 18;
#ifndef REP_PHASE
#define REP_PHASE -1
#endif
struct Args { const float* in[25]; float* out; unsigned char* ws; int ph_lo, ph_hi; };
__global__ void __launch_bounds__(NWAVES * 64, 2) fwd_kernel(Args args) {
    extern __shared__ __attribute__((aligned(16))) unsigned char lds[];
    Frame F;
    F.lds = (LAS unsigned char*)lds;
    F.MISC = (volatile LAS unsigned*)(F.lds + MISC_OFF);
    F.wave = __builtin_amdgcn_readfirstlane((int)(threadIdx.x >> 6)); F.lane = lane_id(); F.tid = F.wave * 64 + F.lane;
    F.G = gridDim.x; { const int bx = blockIdx.x; F.vcu = (F.G % 8 == 0) ? (bx % 8) * (F.G / 8) + bx / 8 : bx; }
    F.x = args.in[0]; F.c = args.in[1]; F.ctx = args.in[2]; F.cctx = args.in[3]; F.w_mod = args.in[4]; F.b_mod = args.in[5]; F.ln_g = args.in[6]; F.ln_b = args.in[7];
    F.w_qkv = args.in[8]; F.w_o = args.in[9]; F.sink = args.in[10]; F.w_gu = args.in[11]; F.w_dn = args.in[12]; F.w_in = args.in[13]; F.conv_w = args.in[14]; F.conv_b = args.in[15];
    F.lam = args.in[16]; F.w_r = args.in[17]; F.b_r = args.in[18]; F.w_i = args.in[19]; F.b_i = args.in[20]; F.w_out = args.in[21]; F.router = args.in[22]; F.mw_gu = args.in[23]; F.mw_dn = args.in[24];
    F.out = args.out; F.ws = args.ws;
    for (int u = F.tid; u < (LDS_BYTES - LDSCTL_OFF) / 4; u += NWAVES * 64) ((LAS unsigned*)(F.lds + LDSCTL_OFF))[u] = 0u;
    __syncthreads();
    const int lo = args.ph_lo, hi = args.ph_hi;
    const bool multi = (hi - lo) > 1;
    XcdBarrier bar; bar.bar = (unsigned*)(F.ws + WS_CTL) + 1024; bar.x = 0; bar.st = nullptr;
    if (multi) bar = xcd_barrier_post((unsigned*)(F.ws + WS_CTL) + 1024, F.MISC + 8);
#define IN(k) (lo <= (k) && (k) < hi)
#define REFRESH() do { F.lane = lane_id(); F.tid = F.wave * 64 + F.lane; } while (0)
#define SEAM(k) do { if (IN(k) && IN((k) + 1)) xcd_barrier(bar); } while (0)
    const float* MOD = WSP(float, WS_MOD);
    bf16* H = WSP(bf16, WS_H); bf16* YB = WSP(bf16, WS_YB); const f32x2* ST = (const f32x2*)(F.ws + WS_STATS);

    if (IN(0)) { REFRESH(); p0_prologue(F); if (REP_PHASE == 0) { xcd_barrier(bar); p0_prologue(F); } } SEAM(0);
    if (IN(1)) { REFRESH(); p1_modulate(F); if (REP_PHASE == 1) { xcd_barrier(bar); p1_modulate(F); } } SEAM(1);
    if (IN(2)) {
        pg8::Gemm g{H, WSP(bf16, WS_WQKV), RT, QKVD, DM / 2}; pg8::StaticOrder S; S.init(RT, QKVD, F.G, (int)blockIdx.x);
        pg8::EpiQKV E{WSP(bf16, WS_QKV), WSP(float, WS_ROPE), 1.0f / 512.0f};
        pg8::gemm_phase<pg8::EpiQKV, pg8::StaticOrder, true, true, true>(F.lds + RING_OFF, g, S, E, F.wave);
        moe_convert_filler(F, (RT / 256) * (QKVD / 256), (int)blockIdx.x, 0, 6400);
    } SEAM(2);
    if (IN(3)) { att::attn_phase(WSP(bf16, WS_QKV), WSP(bf16, WS_O), F.sink, F.G, F.vcu, F.lds + RING_OFF); if (REP_PHASE == 3) { xcd_barrier(bar); att::attn_phase(WSP(bf16, WS_QKV), WSP(bf16, WS_O), F.sink, F.G, F.vcu, F.lds + RING_OFF); } } SEAM(3);
    if (IN(4)) {
        pg8::Gemm g{WSP(bf16, WS_O), WSP(bf16, WS_WO), RT, DM, DM / 2}; pg8::StaticOrder S; S.init(RT, DM, F.G, (int)blockIdx.x);
        pg8::EpiResid<false> E{F.x, F.ctx, YB, MOD + 2048, 1.0f / 2048.0f, nullptr, nullptr, nullptr};
        pg8::gemm_phase<pg8::EpiResid<false>, pg8::StaticOrder, true, true, true>(F.lds + RING_OFF, g, S, E, F.wave);
        moe_convert_filler(F, (RT / 256) * (DM / 256), (int)blockIdx.x, 6400, 17408);
    } SEAM(4);
    if (IN(5)) { REFRESH(); ln_mod_pass<true>(F, true, F.ln_g, F.ln_b, 0, 3072); } SEAM(5);
    if (IN(6)) {
        pg8::Gemm g{H, WSP(bf16, WS_WGU), RT, 2 * DFF, DM / 2}; pg8::StaticOrder S; S.init(RT, 2 * DFF, F.G, (int)blockIdx.x);
        pg8::EpiSwiGLU8 E{WSP(unsigned char, WS_ACT), 28};
        pg8::gemm_phase<pg8::EpiSwiGLU8, pg8::StaticOrder, true, true, true>(F.lds + RING_OFF, g, S, E, F.wave);
    } SEAM(6);
    if (IN(7)) {
        pg8::Gemm g{WSP(bf16, WS_ACT), WSP(bf16, WS_WDN), RT, DM, DFF / 2}; pg8::StaticOrder S; S.init(RT, DM, F.G, (int)blockIdx.x);
        pg8::EpiResid<true> E{nullptr, nullptr, YB, MOD + 5120, 1.0f / 4096.0f, ST, F.ln_g, F.ln_b};
        pg8::gemm_phase<pg8::EpiResid<true>, pg8::StaticOrder, true, true, true>(F.lds + RING_OFF, g, S, E, F.wave);
        moe_convert_filler(F, (RT / 256) * (DM / 256), (int)blockIdx.x, 17408, 37888);
    } SEAM(7);
    if (IN(8)) { REFRESH(); ln_mod_pass<false>(F, true, F.ln_g + 1024, F.ln_b + 1024, 1, 0); } SEAM(8);
    if (IN(9)) {
        pg8::Gemm g{H, WSP(bf16, WS_WIN), RT, 2048, DM}; pg8::StaticOrder S; S.init(RT, 2048, F.G, (int)blockIdx.x);
        pg8::EpiLruIn E{WSP(bf16, WS_G), WSP(bf16, WS_XB)};
        pg8::gemm_phase<pg8::EpiLruIn, pg8::StaticOrder, true, true>(F.lds + RING_OFF, g, S, E, F.wave);
        moe_convert_filler(F, (RT / 256) * (2048 / 256), (int)blockIdx.x, 37888, CV_ITEMS);
    } SEAM(9);
    {
        const lru::Ctx LC{WSP(bf16, WS_U), WSP(bf16, WS_G), WSP(bf16, WS_HH), WSP(u32x4, WS_HF), WSP(bf16, WS_WLG), F.lam, F.b_r, F.b_i};
        if (IN(10)) { REFRESH(); p10_conv(F); } SEAM(10);
        if (IN(11)) { REFRESH(); p11_lru(F, LC); if (REP_PHASE == 11) { xcd_barrier(bar); p11_lru(F, LC); } } SEAM(11);
    }
    if (IN(12)) {
        pg8::Gemm g{WSP(bf16, WS_HH), WSP(bf16, WS_WOUT), RL, DM, DM}; pg8::StaticOrder S; S.init(RL, DM, F.G, (int)blockIdx.x);
        pg8::EpiResid<true> E{nullptr, nullptr, YB, MOD + 9 * 6144 + 2048, 1.0f, ST, F.ln_g + 1024, F.ln_b + 1024};
        pg8::gemm_phase<pg8::EpiResid<true>, pg8::StaticOrder, true, true>(F.lds + RING_OFF, g, S, E, F.wave);
    } SEAM(12);
    if (IN(13)) { REFRESH(); p13_ln_router(F); } SEAM(13);
    if (IN(14)) { REFRESH(); p14_gather(F); if (REP_PHASE == 14) { xcd_barrier(bar); p14_gather(F); } } SEAM(14);
    if (IN(15) || IN(16)) {
        REFRESH();
        int tot[8], before[8]; moe_totals(F, 0, tot, before);
        int tp[9]; tp[0] = 0;
#pragma unroll
        for (int e = 0; e < 8; ++e) tp[e + 1] = __builtin_amdgcn_readfirstlane(tp[e] + ((tot[e] + 255) >> 8));
        const int ntiles = tp[8];
        if (IN(15)) {
            pg8::Gemm g{WSP(bf16, WS_HS), WSP(bf16, WS_WMGU), ntiles * 256, 2 * DFF, DM / 2};
            pg8::MoeOrder S{ntiles, 28, ntiles * 28, F.G, (int)blockIdx.x, 28, tp[1], tp[2], tp[3], tp[4], tp[5], tp[6], tp[7]};
            pg8::EpiSwiGLU8 E{WSP(unsigned char, WS_MACT), 28};
            pg8::gemm_phase<pg8::EpiSwiGLU8, pg8::MoeOrder, true, true, true>(F.lds + RING_OFF, g, S, E, F.wave);
        } SEAM(15);
        if (IN(16)) {
            pg8::Gemm g{WSP(bf16, WS_MACT), WSP(bf16, WS_WMDN), ntiles * 256, DM, DFF / 2};
            pg8::MoeOrder S{ntiles, 4, ntiles * 4, F.G, (int)blockIdx.x, 4, tp[1], tp[2], tp[3], tp[4], tp[5], tp[6], tp[7]};
            pg8::EpiMoeOut8 E{WSP(bf16, WS_FO), (const float*)(F.ws + WS_ROUTE + RT_WS)};
            pg8::gemm_phase<pg8::EpiMoeOut8, pg8::MoeOrder, true, true, true>(F.lds + RING_OFF, g, S, E, F.wave);
        } SEAM(16);
    }
    if (IN(17)) { REFRESH(); p17_final(F); }
#undef IN
#undef SEAM
}

#ifndef N_LAUNCH_MODE
#define N_LAUNCH_MODE 1
#endif
extern "C" void kernel_launch(void* const* d_in, const int* in_sizes, int n_in, void* d_out, int out_size, void* d_ws, size_t ws_size, hipStream_t stream) {
    static int grid = 0;
    if (grid == 0) {
        if (n_in != 25 || out_size != RL * DM || ws_size < WS_END) { fprintf(stderr, "kernel_launch: unexpected shapes (n_in %d out %d ws %zu)\n", n_in, out_size, ws_size); grid = -1; return; }
        int dev = 0, cus = 0, per_cu = 0;
        if (hipGetDevice(&dev) != hipSuccess || hipDeviceGetAttribute(&cus, hipDeviceAttributeMultiprocessorCount, dev) != hipSuccess) { grid = -1; return; }
        if (hipFuncSetAttribute((const void*)fwd_kernel, hipFuncAttributeMaxDynamicSharedMemorySize, LDS_BYTES) != hipSuccess) { fprintf(stderr, "kernel_launch: hipFuncSetAttribute failed\n"); grid = -1; return; }
        if (hipOccupancyMaxActiveBlocksPerMultiprocessor(&per_cu, (const void*)fwd_kernel, NWAVES * 64, LDS_BYTES) != hipSuccess || per_cu < 1) { fprintf(stderr, "kernel_launch: occupancy query says %d\n", per_cu); per_cu = 1; }
        (void)hipGetLastError();
        grid = cus;
    }
    if (grid < 0) return;
    (void)hipMemsetAsync((char*)d_ws + WS_CTL, 0, CTL_ZERO_BYTES, stream);
    Args a{};
    for (int i = 0; i < 25; ++i) a.in[i] = (const float*)d_in[i];
    a.out = (float*)d_out; a.ws = (unsigned char*)d_ws;
#if N_LAUNCH_MODE == 1
    a.ph_lo = 0; a.ph_hi = N_PHASES;
    hipLaunchKernelGGL(fwd_kernel, dim3(grid), dim3(NWAVES * 64), LDS_BYTES, stream, a);
#else
    for (int p = 0; p < N_PHASES; ++p) { a.ph_lo = p; a.ph_hi = p + 1; hipLaunchKernelGGL(fwd_kernel, dim3(grid), dim3(NWAVES * 64), LDS_BYTES, stream, a); }
#endif
    const hipError_t le = hipPeekAtLastError();
    if (le != hipSuccess) fprintf(stderr, "kernel_launch: launch failed: %s\n", hipGetErrorName(le));
}
```

```cpp
#include <hip/hip_runtime.h>
#include <cstdio>
#include <cstdint>

#define GAS __attribute__((address_space(1)))
#define LAS __attribute__((address_space(3)))
typedef unsigned short bf16;
typedef short bf16x8 __attribute__((ext_vector_type(8)));
typedef short s16x4 __attribute__((ext_vector_type(4)));
typedef float f32x4 __attribute__((ext_vector_type(4)));
typedef float f32x2 __attribute__((ext_vector_type(2)));
typedef float f32x16 __attribute__((ext_vector_type(16)));
typedef unsigned u32x4 __attribute__((ext_vector_type(4)));
typedef unsigned u32x2 __attribute__((ext_vector_type(2)));
typedef GAS unsigned gu32;

constexpr int NB = 8, SEQ = 4096, DM = 1024, LCTX = 256;
constexpr int RL = NB * SEQ;
constexpr int RC = NB * LCTX;
constexpr int RT = RL + RC;
constexpr int NHEAD = 8, NKVH = 2, HDIM = 128, QKVD = 1536;
constexpr int DFF = 3584, NEXP = 8;
constexpr float ALPHA = 1.4142135623730951f;
constexpr float LN_EPS = 1e-5f;
constexpr float LOG2E = 1.4426950408889634f;
constexpr int NWAVES = 8;

__device__ __forceinline__ unsigned cvtpk(float lo, float hi) { unsigned r; asm volatile("v_cvt_pk_bf16_f32 %0, %1, %2" : "=v"(r) : "v"(lo), "v"(hi)); return r; }
__device__ __forceinline__ float bflo(unsigned w) { return __uint_as_float(w << 16); }
__device__ __forceinline__ float bfhi(unsigned w) { return __uint_as_float(w & 0xffff0000u); }
__device__ __forceinline__ float ex2(float x) { return __builtin_amdgcn_exp2f(x); }
__device__ __forceinline__ float rcpf_(float x) { return __builtin_amdgcn_rcpf(x); }
__device__ __forceinline__ float sigm(float x) { return rcpf_(1.0f + ex2(-LOG2E * x)); }
typedef int v8i __attribute__((ext_vector_type(8)));
typedef int v4i __attribute__((ext_vector_type(4)));
__device__ __forceinline__ float clamp8(float x) { return __builtin_amdgcn_fmed3f(x, -448.f, 448.f); }
__device__ __forceinline__ unsigned pk4_fp8(float a, float b, float c, float d) {
    int p = __builtin_amdgcn_cvt_pk_fp8_f32(clamp8(a), clamp8(b), 0, false); p = __builtin_amdgcn_cvt_pk_fp8_f32(clamp8(c), clamp8(d), p, true); return (unsigned)p; }
__device__ __forceinline__ int lane_id() { int l; asm volatile("v_mbcnt_lo_u32_b32 %0, -1, 0\n\tv_mbcnt_hi_u32_b32 %0, -1, %0" : "=v"(l)); return l; }
#define REFRESH_F(F) do { (F).lane = lane_id(); (F).tid = (F).wave * 64 + (F).lane; } while (0)
__device__ __forceinline__ float dpp_add(float v, const int ctrl_sel) {
    int r;
    switch (ctrl_sel) { case 0: r = __builtin_amdgcn_update_dpp(0, __float_as_int(v), 0xB1, 0xf, 0xf, true); break;
                        case 1: r = __builtin_amdgcn_update_dpp(0, __float_as_int(v), 0x4E, 0xf, 0xf, true); break;
                        case 2: r = __builtin_amdgcn_update_dpp(0, __float_as_int(v), 0x141, 0xf, 0xf, true); break;
                        default: r = __builtin_amdgcn_update_dpp(0, __float_as_int(v), 0x140, 0xf, 0xf, true); break; }
    return v + __int_as_float(r);
}
__device__ __forceinline__ float wave_sum(float v) {
    v = dpp_add(v, 0); v = dpp_add(v, 1); v = dpp_add(v, 2); v = dpp_add(v, 3);
    const float r0 = __int_as_float(__builtin_amdgcn_readlane(__float_as_int(v), 0)), r1 = __int_as_float(__builtin_amdgcn_readlane(__float_as_int(v), 16)),
                r2 = __int_as_float(__builtin_amdgcn_readlane(__float_as_int(v), 32)), r3 = __int_as_float(__builtin_amdgcn_readlane(__float_as_int(v), 48));
    return (r0 + r1) + (r2 + r3);
}

namespace pg8 {
#define PG8_LAS __attribute__((address_space(3)))
typedef unsigned short bf16_t;
constexpr int BM = 256, BK = 64, HALF = 128, HTB = HALF * BK * 2, STAGE_BYTES = 8 * HTB, NXCD = 8, WGM = 8;
__host__ __device__ __forceinline__ int lds_byte(int r, int c) { const int st = (r >> 4) * 2 + (c >> 5), rr = r & 15, cc = c & 31, ob = rr * 64 + cc * 2; return st * 1024 + (ob ^ (((ob >> 9) & 1) << 5)); }
__host__ __device__ __forceinline__ void stage_rc(int b, int& R, int& C) { const int st = b / 1024, sb = b % 1024, swz = sb ^ (((sb >> 9) & 1) << 5); R = (st >> 1) * 16 + swz / 64; C = (st & 1) * 32 + (swz % 64) / 2; }
__host__ __device__ __forceinline__ int perm32(int rho) { const int n = rho >> 4, i = rho & 15; return 8 * (i >> 2) + 4 * n + (i & 3); }
struct Unit { int pm, pn; };
struct Gemm { const bf16_t* A; const bf16_t* Bt; int M, N, K; };
struct StaticOrder {
    int nM, nN, nwg, G, c;
    __host__ __device__ void init(int M, int N, int G_, int c_) { nM = M / BM; nN = N / BM; nwg = nM * nN; G = G_; c = c_; }
    __host__ __device__ bool next(int i, Unit& u) const {
        const long L = (long)i * G + c; if (L >= nwg) return false;
        int wgid = (int)L; { const int q = nwg / NXCD, r = nwg % NXCD, xcd = wgid % NXCD, off = wgid / NXCD; wgid = (xcd < r ? xcd * (q + 1) : r * (q + 1) + (xcd - r) * q) + off; }
        const int nig = WGM * nN, gid = wgid / nig, fm = gid * WGM, gsz = (nM - fm) < WGM ? (nM - fm) : WGM;
        u.pm = fm + ((wgid % nig) % gsz); u.pn = (wgid % nig) / gsz; return true;
    }
    __device__ __forceinline__ void a_ready(const Unit&) const {}
    __device__ __forceinline__ void done(const Unit&) const {}
};
struct MoeOrder {
    int nM, nN, nwg, G, c, npe; int t1, t2, t3, t4, t5, t6, t7;
    __device__ bool next(int i, Unit& u) const {
        const long L = (long)i * G + c; if (L >= nwg) return false;
        int wgid = (int)L; { const int q = nwg / NXCD, r = nwg % NXCD, xcd = wgid % NXCD, off = wgid / NXCD; wgid = (xcd < r ? xcd * (q + 1) : r * (q + 1) + (xcd - r) * q) + off; }
        const int nig = WGM * nN, gid = wgid / nig, fm = gid * WGM, gsz = (nM - fm) < WGM ? (nM - fm) : WGM;
        const int pm = fm + ((wgid % nig) % gsz), pnl = (wgid % nig) / gsz;
        const int e = (pm >= t1) + (pm >= t2) + (pm >= t3) + (pm >= t4) + (pm >= t5) + (pm >= t6) + (pm >= t7);
        u.pm = pm; u.pn = e * npe + pnl; return true;
    }
    __device__ __forceinline__ void a_ready(const Unit&) const {}
    __device__ __forceinline__ void done(const Unit&) const {}
};


struct EpiQKV {
    static constexpr bool PERM = true, AFTER_DRAIN = false;
    bf16_t* O; const float* rope; float ascale;
    __device__ __forceinline__ void operator()(const f32x4 (&acc)[2][2][4][2], const Unit& u, int wr, int wc, int fr, int fq) const {
        const int row0 = u.pm * BM + wr * 64 + fr;
        const bool rope_on = (u.pm < (RL / BM)) && (u.pn < 5);
        const int axis = wc & 1;
        const int colb = u.pn * 256 + (wc >> 1) * 128 + axis * 64 + 8 * fq;
#pragma unroll
        for (int ai = 0; ai < 2; ++ai)
#pragma unroll
            for (int m = 0; m < 4; ++m) {
                const int r = row0 + ai * HALF + m * 16;
                f32x4 a0 = acc[ai][0][m][0] * ascale, a1 = acc[ai][0][m][1] * ascale, b0 = acc[ai][1][m][0] * ascale, b1 = acc[ai][1][m][1] * ascale;
                if (rope_on) {
                    const int t = r & (SEQ - 1); const int pos = axis ? (t & 63) : (t >> 6);
                    const float* cp = rope + pos * 32 + 8 * fq;
                    const f32x4 c0 = *(const f32x4*)cp, c1 = *(const f32x4*)(cp + 4), s0 = *(const f32x4*)(cp + 2048), s1 = *(const f32x4*)(cp + 2052);
                    const f32x4 o0 = a0 * c0 - b0 * s0, o1 = a1 * c1 - b1 * s1, q0 = b0 * c0 + a0 * s0, q1 = b1 * c1 + a1 * s1;
                    a0 = o0; a1 = o1; b0 = q0; b1 = q1;
                }
                bf16_t* rowp = O + (size_t)r * QKVD + colb;
                u32x4 w; w.x = cvtpk(a0[0], a0[1]); w.y = cvtpk(a0[2], a0[3]); w.z = cvtpk(a1[0], a1[1]); w.w = cvtpk(a1[2], a1[3]);
                *(u32x4*)rowp = w;
                u32x4 v; v.x = cvtpk(b0[0], b0[1]); v.y = cvtpk(b0[2], b0[3]); v.z = cvtpk(b1[0], b1[1]); v.w = cvtpk(b1[2], b1[3]);
                *(u32x4*)(rowp + 32) = v;
            }
    }
};
template <bool LN> struct EpiResid {
    static constexpr bool PERM = true, AFTER_DRAIN = false;
    const float* xin_lat; const float* xin_ctx; bf16_t* y; const float* gate; float ascale; const f32x2* st; const float* lng; const float* lnb;
    __device__ __forceinline__ void operator()(const f32x4 (&acc)[2][2][4][2], const Unit& u, int wr, int wc, int fr, int fq) const {
        const bool lat = u.pm < (RL / BM);
        const int b = lat ? (u.pm >> 4) : 8;
        const int row0 = u.pm * BM + wr * 64 + fr, col0 = u.pn * BM + wc * 32 + 8 * fq;
        const float* xin = lat ? xin_lat + (size_t)row0 * DM : xin_ctx + (size_t)(row0 - RL) * DM;
        f32x2 sv[2][4];
        if constexpr (LN) {
#pragma unroll
            for (int ai = 0; ai < 2; ++ai)
#pragma unroll
                for (int m = 0; m < 4; ++m) sv[ai][m] = st[row0 + ai * HALF + m * 16];
        }
#pragma unroll
        for (int bj = 0; bj < 2; ++bj) { const int cc = col0 + bj * HALF;
            const f32x4 g0 = *(const f32x4*)(gate + (size_t)b * 6144 + cc) * ascale, g1 = *(const f32x4*)(gate + (size_t)b * 6144 + cc + 4) * ascale;
            f32x4 lg0, lg1, lb0, lb1; if constexpr (LN) { lg0 = *(const f32x4*)(lng + cc) * ALPHA; lg1 = *(const f32x4*)(lng + cc + 4) * ALPHA; lb0 = *(const f32x4*)(lnb + cc) * ALPHA; lb1 = *(const f32x4*)(lnb + cc + 4) * ALPHA; }
#pragma unroll
            for (int ai = 0; ai < 2; ++ai)
#pragma unroll
                for (int m = 0; m < 4; ++m) { const int rr = ai * HALF + m * 16; f32x4 x0, x1;
                    if constexpr (LN) { const u32x4 w = *(const u32x4*)(y + (size_t)(row0 + rr) * DM + cc);
                        x0 = (f32x4){bflo(w.x), bfhi(w.x), bflo(w.y), bfhi(w.y)}; x1 = (f32x4){bflo(w.z), bfhi(w.z), bflo(w.w), bfhi(w.w)};
                        x0 = (x0 - sv[ai][m].x) * sv[ai][m].y * lg0 + lb0; x1 = (x1 - sv[ai][m].x) * sv[ai][m].y * lg1 + lb1; }
                    else { x0 = *(const f32x4*)(xin + (size_t)rr * DM + cc) * ALPHA; x1 = *(const f32x4*)(xin + (size_t)rr * DM + cc + 4) * ALPHA; }
                    const f32x4 o0 = x0 + g0 * acc[ai][bj][m][0], o1 = x1 + g1 * acc[ai][bj][m][1];
                    u32x4 w; w.x = cvtpk(o0[0], o0[1]); w.y = cvtpk(o0[2], o0[3]); w.z = cvtpk(o1[0], o1[1]); w.w = cvtpk(o1[2], o1[3]);
                    *(u32x4*)(y + (size_t)(row0 + rr) * DM + cc) = w; }
            asm volatile("" ::: "memory"); }
    }
};
struct EpiSwiGLU {
    static constexpr bool PERM = true, AFTER_DRAIN = false;
    bf16_t* O; int npe;
    __device__ __forceinline__ void operator()(const f32x4 (&acc)[2][2][4][2], const Unit& u, int wr, int wc, int fr, int fq) const {
        const int row0 = u.pm * BM + wr * 64 + fr, pnl = u.pn % npe, col0 = pnl * 128 + wc * 32 + 8 * fq;
#pragma unroll
        for (int ai = 0; ai < 2; ++ai)
#pragma unroll
            for (int m = 0; m < 4; ++m) {
                unsigned w[4];
#pragma unroll
                for (int n = 0; n < 2; ++n) { const f32x4 g = acc[ai][0][m][n], uu = acc[ai][1][m][n]; float o[4];
#pragma unroll
                    for (int j = 0; j < 4; ++j) o[j] = g[j] * sigm(g[j]) * uu[j];
                    w[2 * n] = cvtpk(o[0], o[1]); w[2 * n + 1] = cvtpk(o[2], o[3]); }
                u32x4 ww; ww.x = w[0]; ww.y = w[1]; ww.z = w[2]; ww.w = w[3];
                *(u32x4*)(O + (size_t)(row0 + ai * HALF + m * 16) * DFF + col0) = ww;
            }
    }
};
struct EpiLruIn {
    static constexpr bool PERM = true, AFTER_DRAIN = false;
    bf16_t* G; bf16_t* XB;
    __device__ __forceinline__ void operator()(const f32x4 (&acc)[2][2][4][2], const Unit& u, int wr, int wc, int fr, int fq) const {
        const int row0 = u.pm * BM + wr * 64 + fr; const bool isg = u.pn < 4;
        bf16_t* base = isg ? G : XB; const int col0 = (u.pn & 3) * BM + wc * 32 + 8 * fq;
#pragma unroll
        for (int ai = 0; ai < 2; ++ai)
#pragma unroll
            for (int m = 0; m < 4; ++m)
#pragma unroll
                for (int bj = 0; bj < 2; ++bj) {
                    f32x4 v0 = acc[ai][bj][m][0], v1 = acc[ai][bj][m][1];
                    if (isg) {
#pragma unroll
                        for (int j = 0; j < 4; ++j) { float x = v0[j]; float z = 0.7978845608028654f * (x + 0.044715f * x * x * x); v0[j] = x * sigm(2.0f * z);
                            x = v1[j]; z = 0.7978845608028654f * (x + 0.044715f * x * x * x); v1[j] = x * sigm(2.0f * z); }
                    }
                    u32x4 w; w.x = cvtpk(v0[0], v0[1]); w.y = cvtpk(v0[2], v0[3]); w.z = cvtpk(v1[0], v1[1]); w.w = cvtpk(v1[2], v1[3]);
                    *(u32x4*)(base + (size_t)(row0 + ai * HALF + m * 16) * DM + col0 + bj * HALF) = w;
                }
    }
};
struct EpiMoeOut {
    static constexpr bool PERM = true, AFTER_DRAIN = false;
    bf16_t* O; const float* wrow;
    __device__ __forceinline__ void operator()(const f32x4 (&acc)[2][2][4][2], const Unit& u, int wr, int wc, int fr, int fq) const {
        const int row0 = u.pm * BM + wr * 64 + fr, col0 = (u.pn & 3) * BM + wc * 32 + 8 * fq;
#pragma unroll
        for (int ai = 0; ai < 2; ++ai)
#pragma unroll
            for (int m = 0; m < 4; ++m) { const int r = row0 + ai * HALF + m * 16; const float g = wrow[r];
#pragma unroll
                for (int bj = 0; bj < 2; ++bj) { const f32x4 v0 = acc[ai][bj][m][0] * g, v1 = acc[ai][bj][m][1] * g;
                    u32x4 w; w.x = cvtpk(v0[0], v0[1]); w.y = cvtpk(v0[2], v0[3]); w.z = cvtpk(v1[0], v1[1]); w.w = cvtpk(v1[2], v1[3]);
                    *(u32x4*)(O + (size_t)r * DM + col0 + bj * HALF) = w; } }
    }
};

struct EpiSwiGLU8 {
    static constexpr bool PERM = true, AFTER_DRAIN = false;
    unsigned char* O; int npe;
    __device__ __forceinline__ void operator()(const f32x4 (&acc)[2][2][4][2], const Unit& u, int wr, int wc, int fr, int fq) const {
        const int row0 = u.pm * BM + wr * 64 + fr, pnl = u.pn % npe, col0 = pnl * 128 + wc * 32 + 8 * fq;
        constexpr float DS = 1.0f / 512.0f;
#pragma unroll
        for (int ai = 0; ai < 2; ++ai)
#pragma unroll
            for (int m = 0; m < 4; ++m) {
                u32x2 w;
#pragma unroll
                for (int n = 0; n < 2; ++n) { const f32x4 g = acc[ai][0][m][n] * DS, uu = acc[ai][1][m][n] * (DS * 8.0f); float o[4];
#pragma unroll
                    for (int j = 0; j < 4; ++j) o[j] = g[j] * sigm(g[j]) * uu[j];
                    w[n] = pk4_fp8(o[0], o[1], o[2], o[3]); }
                *(u32x2*)(O + (size_t)(row0 + ai * HALF + m * 16) * DFF + col0) = w;
            }
    }
};
struct EpiMoeOut8 {
    static constexpr bool PERM = true, AFTER_DRAIN = false;
    bf16_t* O; const float* wrow;
    __device__ __forceinline__ void operator()(const f32x4 (&acc)[2][2][4][2], const Unit& u, int wr, int wc, int fr, int fq) const {
        const int row0 = u.pm * BM + wr * 64 + fr, col0 = (u.pn & 3) * BM + wc * 32 + 8 * fq;
#pragma unroll
        for (int ai = 0; ai < 2; ++ai)
#pragma unroll
            for (int m = 0; m < 4; ++m) { const int r = row0 + ai * HALF + m * 16; const float g = wrow[r] * (1.0f / 4096.0f);
#pragma unroll
                for (int bj = 0; bj < 2; ++bj) { const f32x4 v0 = acc[ai][bj][m][0] * g, v1 = acc[ai][bj][m][1] * g;
                    u32x4 w; w.x = cvtpk(v0[0], v0[1]); w.y = cvtpk(v0[2], v0[3]); w.z = cvtpk(v1[0], v1[1]); w.w = cvtpk(v1[2], v1[3]);
                    *(u32x4*)(O + (size_t)r * DM + col0 + bj * HALF) = w; } }
    }
};

template <class Epi, class Sched, bool ALIGN_EPI = false, bool SP2 = false, bool FP8 = false>
__device__ __forceinline__ void gemm_phase(PG8_LAS unsigned char* lds, const Gemm g, const Sched& S, const Epi& E, const int wid) {
    const int lane = lane_id(), tid = wid * 64 + lane, wr = wid >> 2, wc = wid & 3, fr = lane & 15, fq = lane >> 4;
    const int K = g.K, nt = K / BK;
    unsigned voffA[2], voffB[2];
#pragma unroll
    for (int i = 0; i < 2; ++i) { int R, C; stage_rc(tid * 16 + i * 8192, R, C); const int Rb = Epi::PERM ? ((R & ~31) + perm32(R & 31)) : R;
        voffA[i] = (unsigned)(R * K + C) * 2u; voffB[i] = (unsigned)(Rb * K + C) * 2u; }
    const unsigned kstep = (unsigned)(BK * 2);
    const unsigned hstep = (unsigned)HALF * K * 2;
    const unsigned tstep = 2 * hstep;
    const __amdgpu_buffer_rsrc_t rs_voffA = __builtin_amdgcn_make_buffer_rsrc((void*)g.A, 0, -1, 0x00020000), rs_voffB = __builtin_amdgcn_make_buffer_rsrc((void*)g.Bt, 0, -1, 0x00020000);
    const unsigned ldsw = (unsigned)wid * 1024u;
    const int aoff = lds_byte(wr * 64 + fr, fq * 8), boff = lds_byte(wc * 32 + fr, fq * 8);
#define PG8_SA(b, h) (((b) * 2 + (h)) * HTB)
#define PG8_SB(b, h) ((4 + (b) * 2 + (h)) * HTB)
#define PG8_STAGE(bufoff, gbase, voff) do { _Pragma("unroll") for (int _i = 0; _i < 2; ++_i) \
        __builtin_amdgcn_raw_ptr_buffer_load_lds(rs_##voff, (PG8_LAS void*)(lds + (bufoff) + ldsw + _i * 8192), 16, (voff)[_i], (gbase), 0, 0); } while (0)
#define PG8_LDA(dst, b, h) do { if constexpr (FP8) { _Pragma("unroll") for (int m = 0; m < 4; ++m) { const v4i _l = *(const PG8_LAS v4i*)(lds + PG8_SA(b, h) + aoff + m * 2048), _h = *(const PG8_LAS v4i*)(lds + PG8_SA(b, h) + aoff + m * 2048 + 1024); \
            dst##8[m] = __builtin_shufflevector(_l, _h, 0, 1, 2, 3, 4, 5, 6, 7); } } \
        else { _Pragma("unroll") for (int m = 0; m < 4; ++m) _Pragma("unroll") for (int k = 0; k < 2; ++k) dst[m][k] = *(const PG8_LAS bf16x8*)(lds + PG8_SA(b, h) + aoff + m * 2048 + k * 1024); } } while (0)
#define PG8_LDB(dst, b, h) do { if constexpr (FP8) { _Pragma("unroll") for (int n = 0; n < 2; ++n) { const v4i _l = *(const PG8_LAS v4i*)(lds + PG8_SB(b, h) + boff + n * 2048), _h = *(const PG8_LAS v4i*)(lds + PG8_SB(b, h) + boff + n * 2048 + 1024); \
            dst##8[n] = __builtin_shufflevector(_l, _h, 0, 1, 2, 3, 4, 5, 6, 7); } } \
        else { _Pragma("unroll") for (int n = 0; n < 2; ++n) _Pragma("unroll") for (int k = 0; k < 2; ++k) dst[n][k] = *(const PG8_LAS bf16x8*)(lds + PG8_SB(b, h) + boff + n * 2048 + k * 1024); } } while (0)
#define PG8_MMA(ai, bj, At, Bt) do { if constexpr (FP8) __builtin_amdgcn_sched_barrier(0); __builtin_amdgcn_s_setprio(1); \
        if constexpr (FP8) { _Pragma("unroll") for (int m = 0; m < 4; ++m) _Pragma("unroll") for (int n = 0; n < 2; ++n) \
            acc[ai][bj][m][n] = __builtin_amdgcn_mfma_scale_f32_16x16x128_f8f6f4(Bt##8[n], At##8[m], acc[ai][bj][m][n], 0, 0, 0, 0, 0, 0); } \
        else { _Pragma("unroll") for (int m = 0; m < 4; ++m) _Pragma("unroll") for (int n = 0; n < 2; ++n) _Pragma("unroll") for (int k = 0; k < 2; ++k) \
            acc[ai][bj][m][n] = __builtin_amdgcn_mfma_f32_16x16x32_bf16(Bt[n][k], At[m][k], acc[ai][bj][m][n], 0, 0, 0); } \
        __builtin_amdgcn_s_setprio(0); if constexpr (FP8) __builtin_amdgcn_sched_barrier(0); } while (0)
#define PG8_WAIT_V(n) asm volatile("s_waitcnt vmcnt(" #n ")" ::: "memory")
#define PG8_WAIT_L(n) asm volatile("s_waitcnt lgkmcnt(" #n ")" ::: "memory")
#define PG8_BAR __builtin_amdgcn_s_barrier()
#define PG8_SCHED __builtin_amdgcn_sched_barrier(0)
    Unit cur, nxt; int ui = 0;
    if (!S.next(0, cur)) return;
    f32x4 acc[2][2][4][2];
#pragma unroll
    for (int a = 0; a < 2; ++a)
#pragma unroll
        for (int b = 0; b < 2; ++b)
#pragma unroll
            for (int m = 0; m < 4; ++m)
#pragma unroll
                for (int n = 0; n < 2; ++n) acc[a][b][m][n] = (f32x4){0.f, 0.f, 0.f, 0.f};
    bf16x8 At[4][2], B0[2][2], B1[2][2]; v8i At8[4], B08[2], B18[2];
    unsigned cA = (unsigned)cur.pm * tstep, cB = (unsigned)cur.pn * tstep;
    S.a_ready(cur);
    if constexpr (SP2) {
        PG8_STAGE(PG8_SB(0, 0), cB, voffB); PG8_STAGE(PG8_SB(0, 1), cB + hstep, voffB); PG8_STAGE(PG8_SA(0, 0), cA, voffA); PG8_STAGE(PG8_SA(0, 1), cA + hstep, voffA);
        if (wr == 1) PG8_BAR;
        PG8_WAIT_V(2); PG8_BAR;
        PG8_STAGE(PG8_SB(1, 0), cB + kstep, voffB); PG8_STAGE(PG8_SA(1, 0), cA + kstep, voffA); PG8_STAGE(PG8_SB(1, 1), cB + hstep + kstep, voffB);
        PG8_WAIT_V(6); PG8_BAR;
    } else {
        PG8_STAGE(PG8_SB(0, 0), cB, voffB); PG8_STAGE(PG8_SA(0, 0), cA, voffA); PG8_STAGE(PG8_SB(0, 1), cB + hstep, voffB); PG8_STAGE(PG8_SA(0, 1), cA + hstep, voffA);
        if (wr == 1) PG8_BAR;
        PG8_WAIT_V(4); PG8_BAR;
        PG8_STAGE(PG8_SB(1, 0), cB + kstep, voffB); PG8_STAGE(PG8_SA(1, 0), cA + kstep, voffA); PG8_STAGE(PG8_SB(1, 1), cB + hstep + kstep, voffB);
        PG8_WAIT_V(6); PG8_BAR;
    }
    for (;;) {
        const bool has_next = S.next(ui + 1, nxt);
        const unsigned nA = has_next ? (unsigned)nxt.pm * tstep : cA, nB = has_next ? (unsigned)nxt.pn * tstep : cB;
        _Pragma("clang loop unroll(disable)") for (int t = 0; t < nt; t += 2) {
            const bool last = (t == nt - 2);
            const unsigned a1 = cA + (unsigned)(t + 1) * kstep;
            const unsigned a2 = last ? nA : cA + (unsigned)(t + 2) * kstep, b2 = last ? nB : cB + (unsigned)(t + 2) * kstep;
            const unsigned a3 = a2 + kstep, b3 = b2 + kstep;
            if (last && has_next) S.a_ready(nxt);
            if constexpr (SP2) {
            PG8_LDB(B0, 0, 0); PG8_LDB(B1, 0, 1); PG8_SCHED; PG8_LDA(At, 0, 0); PG8_STAGE(PG8_SA(1, 1), a1 + hstep, voffA);
            PG8_WAIT_V(8); PG8_WAIT_L(0); PG8_BAR; PG8_MMA(0, 0, At, B0); PG8_MMA(0, 1, At, B1); PG8_BAR; PG8_SCHED;
            PG8_LDA(At, 0, 1); PG8_STAGE(PG8_SB(0, 0), b2, voffB); PG8_STAGE(PG8_SB(0, 1), b2 + hstep, voffB); PG8_STAGE(PG8_SA(0, 0), a2, voffA);
            PG8_WAIT_V(8); PG8_WAIT_L(0); PG8_BAR; PG8_MMA(1, 0, At, B0); PG8_MMA(1, 1, At, B1); PG8_BAR; PG8_SCHED;
            PG8_LDB(B0, 1, 0); PG8_LDB(B1, 1, 1); PG8_SCHED; PG8_LDA(At, 1, 0); PG8_STAGE(PG8_SA(0, 1), a2 + hstep, voffA);
            PG8_WAIT_V(8); PG8_WAIT_L(0); PG8_BAR; PG8_MMA(0, 0, At, B0); PG8_MMA(0, 1, At, B1); PG8_BAR; PG8_SCHED;
            PG8_LDA(At, 1, 1); PG8_STAGE(PG8_SB(1, 0), b3, voffB); PG8_STAGE(PG8_SB(1, 1), b3 + hstep, voffB); PG8_STAGE(PG8_SA(1, 0), a3, voffA);
            PG8_WAIT_V(8); PG8_WAIT_L(0); PG8_BAR; PG8_MMA(1, 0, At, B0); PG8_MMA(1, 1, At, B1); PG8_BAR; PG8_SCHED;
            } else {
            PG8_LDB(B0, 0, 0); PG8_SCHED; PG8_LDA(At, 0, 0); PG8_STAGE(PG8_SA(1, 1), a1 + hstep, voffA);
            PG8_WAIT_L(8); PG8_BAR; PG8_WAIT_L(0); PG8_MMA(0, 0, At, B0); PG8_BAR; PG8_SCHED;
            PG8_LDB(B1, 0, 1); PG8_STAGE(PG8_SB(0, 0), b2, voffB);
            PG8_BAR; PG8_WAIT_L(0); PG8_MMA(0, 1, At, B1); PG8_BAR;
            PG8_LDA(At, 0, 1); PG8_STAGE(PG8_SA(0, 0), a2, voffA);
            PG8_BAR; PG8_WAIT_L(0); PG8_MMA(1, 0, At, B0); PG8_BAR; PG8_SCHED;
            PG8_STAGE(PG8_SB(0, 1), b2 + hstep, voffB);
            PG8_WAIT_V(6); PG8_BAR; PG8_MMA(1, 1, At, B1); PG8_BAR;
            PG8_LDB(B0, 1, 0); PG8_SCHED; PG8_LDA(At, 1, 0); PG8_STAGE(PG8_SA(0, 1), a2 + hstep, voffA);
            PG8_WAIT_L(8); PG8_BAR; PG8_WAIT_L(0); PG8_MMA(0, 0, At, B0); PG8_BAR; PG8_SCHED;
            PG8_LDB(B1, 1, 1); PG8_STAGE(PG8_SB(1, 0), b3, voffB);
            PG8_BAR; PG8_WAIT_L(0); PG8_MMA(0, 1, At, B1); PG8_BAR;
            PG8_LDA(At, 1, 1); PG8_STAGE(PG8_SA(1, 0), a3, voffA);
            PG8_BAR; PG8_WAIT_L(0); PG8_MMA(1, 0, At, B0); PG8_BAR; PG8_SCHED;
            PG8_STAGE(PG8_SB(1, 1), b3 + hstep, voffB);
            PG8_WAIT_V(6); PG8_BAR; PG8_MMA(1, 1, At, B1); PG8_BAR;
            }
        }
        if constexpr (ALIGN_EPI) { if (wr == 0) PG8_BAR; }
        if constexpr (!Epi::AFTER_DRAIN) { int le = lane_id();
            E(acc, cur, wr, wc, le & 15, le >> 4); S.done(cur); }
        if (!has_next) break;
#pragma unroll
        for (int a = 0; a < 2; ++a)
#pragma unroll
            for (int b = 0; b < 2; ++b)
#pragma unroll
                for (int m = 0; m < 4; ++m)
#pragma unroll
                    for (int n = 0; n < 2; ++n) acc[a][b][m][n] = (f32x4){0.f, 0.f, 0.f, 0.f};
        cur = nxt; cA = nA; cB = nB; ++ui;
        if constexpr (ALIGN_EPI) { if (wr == 1) PG8_BAR; }
    }
    PG8_WAIT_V(0);
    if constexpr (!ALIGN_EPI) { if (wr == 0) PG8_BAR; }
    PG8_BAR;
    if constexpr (Epi::AFTER_DRAIN) { E.fused(acc, cur, wr, wc, fr, fq, lds, wid, lane); S.done(cur); }
#undef PG8_SA
#undef PG8_SB
#undef PG8_STAGE
#undef PG8_LDA
#undef PG8_LDB
#undef PG8_MMA
#undef PG8_WAIT_V
#undef PG8_WAIT_L
#undef PG8_BAR
#undef PG8_SCHED
}
}

constexpr size_t MiB = 1u << 20;
constexpr size_t WS_CTL = 0, CTL_ZERO_BYTES = 65536;
constexpr size_t WS_MOD = 65536;
constexpr size_t WS_ROPE = 65536 + 458752;
constexpr size_t WS_WQKV = 1 * MiB, WS_WO = 4 * MiB, WS_WGU = 6 * MiB, WS_WDN = 20 * MiB, WS_WIN = 27 * MiB, WS_WOUT = 31 * MiB, WS_WLG = 33 * MiB;
constexpr size_t WS_WMGU = 34 * MiB, WS_WMDN = 146 * MiB;
constexpr size_t WS_YB = 760 * MiB;
constexpr size_t WS_H = 210 * MiB;
constexpr size_t WS_ACTV = 278 * MiB;
constexpr size_t WS_QKV = WS_ACTV, WS_O = WS_ACTV + 102 * MiB, WS_ACT = WS_ACTV + 170 * MiB;
constexpr size_t WS_G = WS_ACTV, WS_XB = WS_ACTV + 68 * MiB, WS_HF = WS_ACTV + 136 * MiB, WS_HH = WS_ACTV + 200 * MiB;
constexpr size_t WS_U = WS_ACTV + 264 * MiB;
constexpr size_t WS_HS = WS_ACTV, WS_FO = WS_ACTV + 68 * MiB, WS_MACT = WS_ACTV + 200 * MiB;
constexpr size_t WS_ROUTE = 872 * MiB;
constexpr size_t WS_LRUS = 874 * MiB;
constexpr size_t WS_END = 875 * MiB;
constexpr int MOE_MAXT = 264;
constexpr size_t RT_EIDX = 0, RT_WGT = 262144, RT_SLOT = 524288, RT_WS = 786432, RT_CNT = 786432 + 270336 + 0;
constexpr size_t LS_SUM = 0, LS_CTX = 524288;
constexpr size_t WS_STATS = WS_LRUS + 655360;

constexpr int RING_OFF = 0, RING_BYTES = 135168;
constexpr int LDSCTL_OFF = RING_BYTES, MISC_OFF = LDSCTL_OFF + 320;
constexpr int LDS_BYTES = 136192;

#define RLX_AGENT __ATOMIC_RELAXED, __HIP_MEMORY_SCOPE_AGENT
#define LDS_WAIT() asm volatile("s_waitcnt lgkmcnt(0)" ::: "memory")
#define VM_WAIT() asm volatile("s_waitcnt vmcnt(0)" ::: "memory")
#define XB_TMO      128
#define XB_XCNT(j)  (256  + 64 * (j))
#define XB_XSUB(j)  (1280 + 64 * (j))
#define XB_XGEN(j)  (2304 + 64 * (j))
#define XB_TOP      3328
#define XB_TOPGEN   3392
#define XCD_BAR_WORDS 3456
#define XB_SPIN_CAP (1u << 18)

__device__ __forceinline__ unsigned xb_ld(unsigned* p)              { return __hip_atomic_load(p, __ATOMIC_RELAXED, __HIP_MEMORY_SCOPE_AGENT); }
__device__ __forceinline__ unsigned xb_add(unsigned* p, unsigned v) { return __hip_atomic_fetch_add(p, v, __ATOMIC_RELAXED, __HIP_MEMORY_SCOPE_AGENT); }
__device__ __forceinline__ unsigned xb_xcc_id() { return (unsigned)__builtin_amdgcn_s_getreg((3 << 11) | 20) & 0xFu; }
#define XB_SPIN(cond, bar) do { unsigned _sp = 0; while (cond) { __builtin_amdgcn_s_sleep(1); \
    if ((++_sp & 255u) == 0u) { if (xb_ld(&(bar)[XB_TMO])) break; if (_sp > XB_SPIN_CAP) { atomicAdd(&(bar)[XB_TMO], 1u); break; } } } } while (0)

struct XcdBarrier {
    unsigned* bar; unsigned x;
    volatile LAS unsigned* st;
};

__device__ __forceinline__ XcdBarrier xcd_barrier_post(unsigned* bar, volatile LAS unsigned* st, const bool t0  ) {
    XcdBarrier b; b.bar = bar; b.x = xb_xcc_id(); b.st = st;
    if (t0) (void)xb_add(&bar[XB_XCNT(b.x)], 1u);
    return b;
}
__device__ __forceinline__ void xcd_barrier_complete(unsigned* bar, unsigned x, unsigned& nloc, unsigned& nx) {
    const unsigned G = gridDim.x * gridDim.y * gridDim.z;
    unsigned sum, cnt, mine, sp = 0u;
    for (;;) {
        sum = 0u; cnt = 0u; mine = 0u;
#pragma unroll
        for (unsigned j = 0; j < 16; ++j) { const unsigned c = xb_ld(&bar[XB_XCNT(j)]); sum += c; cnt += (c > 0u) ? 1u : 0u; mine = (j == x) ? c : mine; }
        if (sum == G) break;
        __builtin_amdgcn_s_sleep(1);
        if ((++sp & 255u) == 0u) { if (xb_ld(&bar[XB_TMO])) break; if (sp > XB_SPIN_CAP) { atomicAdd(&bar[XB_TMO], 1u); break; } }
    }
    nloc = mine > 0u ? mine : 1u; nx = cnt > 0u ? cnt : 1u;
}

__device__ __forceinline__ void xcd_barrier(const XcdBarrier& b, const bool t0  ) {
    asm volatile("s_waitcnt vmcnt(0)" ::: "memory");
    __syncthreads();
    if (t0) {
        unsigned* bar = b.bar;
        __builtin_amdgcn_s_waitcnt(0);
        unsigned nloc = b.st[0], nx = b.st[1];
        if (nloc == 0u) { xcd_barrier_complete(bar, b.x, nloc, nx); b.st[0] = nloc; b.st[1] = nx; }
        const unsigned old = xb_add(&bar[XB_XSUB(b.x)], 1u);
        const unsigned gen = old / nloc;
        if (old + 1u == (gen + 1u) * nloc) {
            __builtin_amdgcn_fence(__ATOMIC_RELEASE, "agent");
            asm volatile("s_waitcnt vmcnt(0)" ::: "memory");
            const unsigned og = xb_add(&bar[XB_TOP], 1u);
            const unsigned tg = og / nx;
            if (og + 1u == (tg + 1u) * nx) xb_add(&bar[XB_TOPGEN], 1u);
            else XB_SPIN(xb_ld(&bar[XB_TOPGEN]) == tg, bar);
            __builtin_amdgcn_fence(__ATOMIC_ACQUIRE, "agent");
            xb_add(&bar[XB_XGEN(b.x)], 1u);
            asm volatile("s_waitcnt vmcnt(0)" ::: "memory");
        } else {
            XB_SPIN(xb_ld(&bar[XB_XGEN(b.x)]) == gen, bar);
            __builtin_amdgcn_fence(__ATOMIC_ACQUIRE, "agent");
            asm volatile("s_waitcnt vmcnt(0)" ::: "memory");
        }
    }
    __syncthreads();
}


struct Frame {
    LAS unsigned char* lds;
    volatile LAS unsigned* MISC;
    int tid, lane, wave, vcu, G;
    const float *x, *c, *ctx, *cctx, *w_mod, *b_mod, *ln_g, *ln_b, *w_qkv, *w_o, *sink, *w_gu, *w_dn, *w_in, *conv_w, *conv_b, *lam, *w_r, *b_r, *w_i, *b_i, *w_out, *router, *mw_gu, *mw_dn;
    float* out; unsigned char* ws;
};
#define WSP(T, off) ((T*)(F.ws + (off)))

__device__ __forceinline__ void p0_mod_task(Frame& F, int task) {
    const int li = task / 96, cb = task % 96;
    LAS float* S = (LAS float*)F.lds;
    LAS float* red = (LAS float*)(F.lds + 36864);
    for (int idx = F.tid; idx < 9 * 1024; idx += NWAVES * 64) { const int b = idx >> 10, k = idx & 1023; const float v = (b < 8) ? F.c[b * 1024 + k] : F.cctx[k]; S[idx] = v * sigm(v); }
    __syncthreads();
    const float* W = F.w_mod + (size_t)li * 1024 * 6144 + cb * 64;
    const int cl = F.lane & 15, kr = F.lane >> 4;
    f32x4 acc[9];
#pragma unroll
    for (int b = 0; b < 9; ++b) acc[b] = (f32x4){0.f, 0.f, 0.f, 0.f};
#pragma unroll 4
    for (int kk = 0; kk < 32; ++kk) { const int k = 128 * F.wave + 4 * kk + kr; const f32x4 wv = *(const f32x4*)(W + (size_t)k * 6144 + 4 * cl);
#pragma unroll
        for (int b = 0; b < 9; ++b) acc[b] += wv * S[b * 1024 + k]; }
#pragma unroll
    for (int b = 0; b < 9; ++b)
#pragma unroll
        for (int j = 0; j < 4; ++j) { float v = acc[b][j]; v += __shfl_xor(v, 16); v += __shfl_xor(v, 32); acc[b][j] = v; }
    if (kr == 0) {
#pragma unroll
        for (int b = 0; b < 9; ++b) *(LAS f32x4*)(red + (F.wave * 9 + b) * 64 + 4 * cl) = acc[b]; }
    __syncthreads();
    float* mod = WSP(float, WS_MOD);
    for (int idx = F.tid; idx < 9 * 64; idx += NWAVES * 64) { const int b = idx >> 6, col = idx & 63; float s = 0.f;
#pragma unroll
        for (int w = 0; w < 8; ++w) s += red[(w * 9 + b) * 64 + col];
        mod[(size_t)(li * 9 + b) * 6144 + cb * 64 + col] = s + F.b_mod[li * 6144 + cb * 64 + col]; }
    __syncthreads();
}
__device__ __forceinline__ void p0_transpose_item(const float* W, int K, int N, bf16* WT, int kb, int n0, int drow0, LAS float* scr, int lane) {
    const int k0 = 64 * kb;
#pragma unroll
    for (int i = 0; i < 8; ++i) { const int kk = 8 * i + (lane >> 3); const f32x4 wv = *(const f32x4*)(W + (size_t)(k0 + kk) * N + n0 + 4 * (lane & 7));
        LAS float* d = scr + kk * 33 + 4 * (lane & 7); d[0] = wv[0]; d[1] = wv[1]; d[2] = wv[2]; d[3] = wv[3]; }
    LDS_WAIT(); asm volatile("" ::: "memory");
    const int c = lane & 7;
#pragma unroll
    for (int j = 0; j < 4; ++j) { const int n = (lane >> 3) + 8 * j; const LAS float* s = scr + (8 * c) * 33 + n;
        u32x4 o; o.x = cvtpk(s[0 * 33], s[1 * 33]); o.y = cvtpk(s[2 * 33], s[3 * 33]); o.z = cvtpk(s[4 * 33], s[5 * 33]); o.w = cvtpk(s[6 * 33], s[7 * 33]);
        *(GAS u32x4*)(WT + (size_t)(drow0 + n) * K + k0 + 8 * c) = o; }
    LDS_WAIT(); asm volatile("" ::: "memory");
}
template <int QS> __device__ __forceinline__ void p0_transpose_item8(const float* W, int K, int N, unsigned char* WT, int kb, int n0, int drow0, LAS float* scr, int lane) {
    const int k0 = 64 * kb; constexpr float qs = (float)(1 << QS);
#pragma unroll
    for (int i = 0; i < 8; ++i) { const int kk = 8 * i + (lane >> 3); const f32x4 wv = *(const f32x4*)(W + (size_t)(k0 + kk) * N + n0 + 4 * (lane & 7)) * qs;
        LAS float* d = scr + kk * 33 + 4 * (lane & 7); d[0] = wv[0]; d[1] = wv[1]; d[2] = wv[2]; d[3] = wv[3]; }
    LDS_WAIT(); asm volatile("" ::: "memory");
    const int c = lane & 7;
#pragma unroll
    for (int j = 0; j < 4; ++j) { const int n = (lane >> 3) + 8 * j; const LAS float* s = scr + (8 * c) * 33 + n;
        u32x2 o; o.x = pk4_fp8(s[0 * 33], s[1 * 33], s[2 * 33], s[3 * 33]); o.y = pk4_fp8(s[4 * 33], s[5 * 33], s[6 * 33], s[7 * 33]);
        *(GAS u32x2*)(WT + (size_t)(drow0 + n) * K + k0 + 8 * c) = o; }
    LDS_WAIT(); asm volatile("" ::: "memory");
}
__device__ __forceinline__ int gu_row(int j) { const int isu = j >= DFF, jj = isu ? j - DFF : j; return (jj >> 7) * 256 + isu * 128 + (jj & 127); }
__device__ __forceinline__ int qkv_row(int L) { const int pn = L >> 8, rem = L & 255, hsel = rem >> 7, axis = (rem >> 6) & 1, half = (rem >> 5) & 1, x = rem & 31; return pn * 256 + 128 * half + 32 * (2 * hsel + axis) + x; }

__device__ __forceinline__ void p0_prologue(Frame& F) {
    for (int task = F.vcu; task < 192; task += F.G) p0_mod_task(F, task);
    if (F.vcu == F.G - 1) {
        float* rope = WSP(float, WS_ROPE);
        for (int idx = F.tid; idx < 2048; idx += NWAVES * 64) { const int pos = idx >> 5, i = idx & 31;
            const double freq = exp2(-(double)i * (13.287712379549449 / 32.0));
            const float ang = (float)pos * (float)freq;
            double rev = (double)ang * 0.15915494309189535; rev -= floor(rev);
            rope[idx] = __builtin_amdgcn_cosf((float)rev); rope[2048 + idx] = __builtin_amdgcn_sinf((float)rev); }
    }
    LAS float* scr = (LAS float*)(F.lds + F.wave * 8704);
    const int gw = F.vcu * NWAVES + F.wave, NGW = F.G * NWAVES;
    constexpr int I_QKV = 16 * 48;
    for (int r = gw; r < I_QKV; r += NGW) { const int kb = r / 48, n0 = (r % 48) * 32; p0_transpose_item8<7>(F.w_qkv, 1024, 1536, WSP(unsigned char, WS_WQKV), kb, n0, qkv_row(n0), scr, F.lane); }
}

constexpr int MOE_I_GU = 16 * 224, MOE_I_DN = 56 * 32, MOE_ITEMS = 8 * (MOE_I_GU + MOE_I_DN);
constexpr int DR_O = 16 * 32, DR_GU = 16 * 224, DR_DN = 56 * 32, DR_IN = 16 * 64, DR_OUT = 16 * 32, DR_LG = 32 * 8, DR_ITEMS = DR_O + DR_GU + DR_DN + DR_IN + DR_OUT + DR_LG;
constexpr int CV_ITEMS = DR_ITEMS + MOE_ITEMS;
__device__ __forceinline__ void moe_convert_items(Frame& F, int lo, int hi, int rank, int nranks) {
    LAS float* scr = (LAS float*)(F.lds + F.wave * 8704);
    for (int it0 = lo + rank * NWAVES + F.wave; it0 < hi; it0 += nranks * NWAVES) {
        int r = it0;
        if (r < DR_O) { const int kb = r / 32, n0 = (r % 32) * 32; p0_transpose_item8<7>(F.w_o, 1024, 1024, WSP(unsigned char, WS_WO), kb, n0, n0, scr, F.lane); continue; } r -= DR_O;
        if (r < DR_GU) { const int kb = r / 224, n0 = (r % 224) * 32; p0_transpose_item8<7>(F.w_gu, 1024, 7168, WSP(unsigned char, WS_WGU), kb, n0, gu_row(n0), scr, F.lane); continue; } r -= DR_GU;
        if (r < DR_DN) { const int kb = r / 32, n0 = (r % 32) * 32; p0_transpose_item8<9>(F.w_dn, 3584, 1024, WSP(unsigned char, WS_WDN), kb, n0, n0, scr, F.lane); continue; } r -= DR_DN;
        if (r < DR_IN) { const int kb = r / 64, n0 = (r % 64) * 32; p0_transpose_item(F.w_in, 1024, 2048, WSP(bf16, WS_WIN), kb, n0, n0, scr, F.lane); continue; } r -= DR_IN;
        if (r < DR_OUT) { const int kb = r / 32, n0 = (r % 32) * 32; p0_transpose_item(F.w_out, 1024, 1024, WSP(bf16, WS_WOUT), kb, n0, n0, scr, F.lane); continue; } r -= DR_OUT;
        if (r < DR_LG) { const int mi = r >> 3, sub = r & 7, which = mi >> 4, d = (mi >> 3) & 1, n = mi & 7, kb = sub >> 2, n0 = (sub & 3) * 32;
            p0_transpose_item((which ? F.w_i : F.w_r) + (size_t)(d * 8 + n) * 16384, 128, 128, WSP(bf16, WS_WLG) + (size_t)(n * 4 + 2 * d + which) * 16384, kb, n0, n0, scr, F.lane); continue; } r -= DR_LG;
        if (r < 8 * MOE_I_GU) { const int e = r / MOE_I_GU, q = r % MOE_I_GU, kb = q / 224, n0 = (q % 224) * 32;
            p0_transpose_item8<7>(F.mw_gu + (size_t)e * 1024 * 7168, 1024, 7168, WSP(unsigned char, WS_WMGU) + (size_t)e * 7168 * 1024, kb, n0, gu_row(n0), scr, F.lane); }
        else { r -= 8 * MOE_I_GU; const int e = r / MOE_I_DN, q = r % MOE_I_DN, kb = q / 32, n0 = (q % 32) * 32;
            p0_transpose_item8<9>(F.mw_dn + (size_t)e * 3584 * 1024, 3584, 1024, WSP(unsigned char, WS_WMDN) + (size_t)e * 1024 * 3584, kb, n0, n0, scr, F.lane); }
    }
}
__device__ __forceinline__ void moe_convert_filler(Frame& F, int nwg, int c, int lo, int hi) {
    const int R = (nwg + F.G - 1) / F.G, rem = nwg - (R - 1) * F.G;
    if (rem >= F.G) { moe_convert_items(F, lo, hi, c, F.G); return; }
    if (c >= rem) { REFRESH_F(F); moe_convert_items(F, lo, hi, c - rem, F.G - rem); }
}
__device__ __forceinline__ void row_load(f32x4 (&v)[4], const float* p, int lane) {
#pragma unroll
    for (int j = 0; j < 4; ++j) v[j] = *(const f32x4*)(p + 4 * lane + 256 * j);
}
__device__ __forceinline__ void row_load_bf(f32x4 (&v)[4], const bf16* p, int lane) {
#pragma unroll
    for (int j = 0; j < 4; ++j) { const u32x2 w = *(const u32x2*)(p + 4 * lane + 256 * j); v[j] = (f32x4){bflo(w.x), bfhi(w.x), bflo(w.y), bfhi(w.y)}; }
}
__device__ __forceinline__ void row_store(const f32x4 (&v)[4], float* p, int lane) {
#pragma unroll
    for (int j = 0; j < 4; ++j) *(f32x4*)(p + 4 * lane + 256 * j) = v[j];
}
struct Vec16 { f32x4 q[4]; };
__device__ __forceinline__ Vec16 vec_load(const float* p, int lane) { Vec16 r;
#pragma unroll
    for (int j = 0; j < 4; ++j) r.q[j] = *(const f32x4*)(p + 4 * lane + 256 * j);
    return r; }
__device__ __forceinline__ f32x2 row_ln_v(f32x4 (&v)[4], const Vec16& g, const Vec16& bt) {
    float s = 0.f;
#pragma unroll
    for (int j = 0; j < 4; ++j) s += (v[j].x + v[j].y) + (v[j].z + v[j].w);
    const float mean = wave_sum(s) * (1.f / DM); float s2 = 0.f;
#pragma unroll
    for (int j = 0; j < 4; ++j) { v[j] = v[j] - mean; s2 += (v[j].x * v[j].x + v[j].y * v[j].y) + (v[j].z * v[j].z + v[j].w * v[j].w); }
    const float rstd = 1.f / sqrtf(wave_sum(s2) * (1.f / DM) + LN_EPS);
#pragma unroll
    for (int j = 0; j < 4; ++j) v[j] = v[j] * rstd * g.q[j] + bt.q[j];
    return (f32x2){mean, rstd};
}
template <bool H8> __device__ __forceinline__ void row_mod_store_v(const f32x4 (&v)[4], const Vec16& sh, const Vec16& sc, void* hbase, size_t r, int lane) {
#pragma unroll
    for (int j = 0; j < 4; ++j) { const f32x4 h = v[j] * (sc.q[j] + 1.0f) + sh.q[j];
        if constexpr (H8) *(unsigned*)((unsigned char*)hbase + r * DM + 4 * lane + 256 * j) = pk4_fp8(h[0] * 4.f, h[1] * 4.f, h[2] * 4.f, h[3] * 4.f);
        else { u32x2 w; w.x = cvtpk(h[0], h[1]); w.y = cvtpk(h[2], h[3]); *(u32x2*)((bf16*)hbase + r * DM + 4 * lane + 256 * j) = w; } }
}
#define ROWS_LAT(...) do { const int nwb_ = NGW / 8; if (nwb_ > 0 && gw < 8 * nwb_) { const int b = gw / nwb_, nwin_ = (SEQ + nwb_ - 1) / nwb_; \
    for (int i_ = 0; i_ < nwin_; ++i_) { const int r = b * SEQ + ((i_ + 2 * b) % nwin_) * nwb_ + gw % nwb_;     \
        if (r < (b + 1) * SEQ) { __VA_ARGS__ } } } } while (0)
#define ROWS_CTX(...) do { const int b = 8; for (int r = RL + gw; r < RT; r += NGW) { __VA_ARGS__ } } while (0)
__device__ __forceinline__ void p1_modulate(Frame& F) {
    const int gw = F.vcu * NWAVES + F.wave, NGW = F.G * NWAVES; const float* mod = WSP(float, WS_MOD); bf16* H = WSP(bf16, WS_H);
    { const int bb = gw / (NGW / 8) < 8 ? gw / (NGW / 8) : 7; const Vec16 sh = vec_load(mod + (size_t)bb * 6144, F.lane), sc = vec_load(mod + (size_t)bb * 6144 + 1024, F.lane);
      ROWS_LAT( (void)b; f32x4 v[4]; row_load(v, F.x + (size_t)r * DM, F.lane); row_mod_store_v<true>(v, sh, sc, H, (size_t)r, F.lane); ); }
    { const Vec16 sh = vec_load(mod + (size_t)8 * 6144, F.lane), sc = vec_load(mod + (size_t)8 * 6144 + 1024, F.lane);
      ROWS_CTX( (void)b; f32x4 v[4]; row_load(v, F.ctx + (size_t)(r - RL) * DM, F.lane); row_mod_store_v<true>(v, sh, sc, H, (size_t)r, F.lane); ); }
}
template <bool H8> __device__ __forceinline__ void ln_mod_pass(Frame& F, bool with_ctx, const float* g, const float* bt, int ml, int cs) {
    const int gw = F.vcu * NWAVES + F.wave, NGW = F.G * NWAVES; const float* mod = WSP(float, WS_MOD) + (size_t)ml * 9 * 6144; bf16* H = WSP(bf16, WS_H); const bf16* YB = WSP(bf16, WS_YB);
    const Vec16 gv = vec_load(g, F.lane), bv = vec_load(bt, F.lane);
    { const int bb = gw / (NGW / 8) < 8 ? gw / (NGW / 8) : 7; const Vec16 sh = vec_load(mod + (size_t)bb * 6144 + cs, F.lane), sc = vec_load(mod + (size_t)bb * 6144 + cs + 1024, F.lane);
      ROWS_LAT( (void)b; f32x4 v[4]; row_load_bf(v, YB + (size_t)r * DM, F.lane); const f32x2 sv = row_ln_v(v, gv, bv); if (F.lane == 0) ((f32x2*)(F.ws + WS_STATS))[r] = sv;
                row_mod_store_v<H8>(v, sh, sc, H, (size_t)r, F.lane); ); }
    if (with_ctx) { const Vec16 sh = vec_load(mod + (size_t)8 * 6144 + cs, F.lane), sc = vec_load(mod + (size_t)8 * 6144 + cs + 1024, F.lane);
      ROWS_CTX( (void)b; f32x4 v[4]; row_load_bf(v, YB + (size_t)r * DM, F.lane); const f32x2 sv = row_ln_v(v, gv, bv); if (F.lane == 0) ((f32x2*)(F.ws + WS_STATS))[r] = sv;
                row_mod_store_v<H8>(v, sh, sc, H, (size_t)r, F.lane); ); }
}

namespace att {
constexpr float SCALE = 0.08838834764831845f, THR = 8.f;
constexpr int SHM_V = 64 * 128 * 2, SHM_K = 64 * 128 * 2;
#define KSWZ(row, colB) ((row) * 256 + ((colB) ^ (((row) & 7) << 4)))
#define SBAR() __builtin_amdgcn_sched_barrier(0)
__device__ __forceinline__ int crow(int r, int hi) { return (r & 3) + 8 * (r >> 2) + 4 * hi; }
__device__ __forceinline__ void partialSM(f32x16& p0, f32x16& p1, float& m_reg, float& mn, float& alpha, bool domask, int d0) {
    constexpr float C = SCALE * 1.4426950408889634f;
    if (domask) {
#pragma unroll
        for (int r = 0; r < 16; ++r) { const int rel = d0 + (r & 3) + 8 * (r >> 2);
            p0[r] = ((unsigned)(rel + 128) <= 256u) ? p0[r] : -1e30f; p1[r] = ((unsigned)(rel + 160) <= 256u) ? p1[r] : -1e30f; }
    }
    float pmax = p0[0];
#pragma unroll
    for (int r = 1; r < 16; ++r) pmax = fmaxf(pmax, p0[r]);
#pragma unroll
    for (int r = 0; r < 16; ++r) pmax = fmaxf(pmax, p1[r]);
    { auto rr = __builtin_amdgcn_permlane32_swap(__float_as_uint(pmax), __float_as_uint(pmax), false, false);
      pmax = fmaxf(__uint_as_float(rr[0]), __uint_as_float(rr[1])); }
    if (__builtin_expect(__all(pmax - m_reg <= THR / SCALE), 1)) { mn = m_reg; alpha = 1.f; }
    else { mn = fmaxf(m_reg, pmax); alpha = ex2((m_reg - mn) * C); m_reg = mn; }
    const float mnC = -mn * C;
#pragma unroll
    for (int r = 0; r < 16; ++r) p0[r] = fmaf(p0[r], C, mnC);
#pragma unroll
    for (int r = 0; r < 16; ++r) p1[r] = fmaf(p1[r], C, mnC);
#pragma unroll
    for (int r = 0; r < 16; ++r) p0[r] = ex2(p0[r]);
}
__device__ __forceinline__ void finishSM(f32x16& p0, f32x16& p1, float alpha, float& l_reg, bf16x8& pa0, bf16x8& pa1, bf16x8& pa2, bf16x8& pa3) {
#pragma unroll
    for (int r = 0; r < 16; ++r) p1[r] = ex2(p1[r]);
    float ps = 0;
#pragma unroll
    for (int r = 0; r < 16; ++r) ps += p0[r];
#pragma unroll
    for (int r = 0; r < 16; ++r) ps += p1[r];
    { auto rr = __builtin_amdgcn_permlane32_swap(__float_as_uint(ps), __float_as_uint(ps), false, false);
      ps = __uint_as_float(rr[0]) + __uint_as_float(rr[1]); }
    l_reg = l_reg * alpha + ps;
#define PK4(P, BASE, OUT) do { unsigned a0 = cvtpk(P[BASE + 0], P[BASE + 1]), a1 = cvtpk(P[BASE + 2], P[BASE + 3]);   \
    unsigned b0 = cvtpk(P[BASE + 4], P[BASE + 5]), b1 = cvtpk(P[BASE + 6], P[BASE + 7]);                              \
    auto r0 = __builtin_amdgcn_permlane32_swap(a0, b0, false, false); auto r1 = __builtin_amdgcn_permlane32_swap(a1, b1, false, false); \
    u32x4 w = {r0[0], r1[0], r0[1], r1[1]}; OUT = __builtin_bit_cast(bf16x8, w); } while (0)
    PK4(p0, 0, pa0); PK4(p0, 8, pa1); PK4(p1, 0, pa2); PK4(p1, 8, pa3);
#undef PK4
}
__device__ __forceinline__ void qkt(f32x16& p0, f32x16& p1, LAS const unsigned char* Ks, const bf16x8* qr, int r32, int hi) {
    p0 = f32x16{}; p1 = f32x16{};
#pragma unroll
    for (int d0 = 0; d0 < 8; ++d0) { const int cb = (d0 * 16 + hi * 8) * 2;
        const bf16x8 b0 = *(LAS const bf16x8*)(Ks + KSWZ(r32, cb));
        const bf16x8 b1 = *(LAS const bf16x8*)(Ks + KSWZ(32 + r32, cb));
        p0 = __builtin_amdgcn_mfma_f32_32x32x16_bf16(b0, qr[d0], p0, 0, 0, 0);
        p1 = __builtin_amdgcn_mfma_f32_32x32x16_bf16(b1, qr[d0], p1, 0, 0, 0); }
}
__device__ __forceinline__ int v_st(int k, int c) { const int kk = (k & ~0xC) | ((k & 4) << 1) | ((k & 8) >> 1); return ((kk >> 3) * 4 + (c >> 5)) * 512 + ((kk & 7) * 32 + (c & 31)) * 2; }
__device__ __forceinline__ int v_rd_base(int lane) { return ((lane & 3) << 3) | (((lane >> 2) & 3) << 6) | (((lane >> 4) & 1) << 5) | (((lane >> 5) & 1) << 8); }
constexpr int v_rd_off(int d0, int ks, int half) { return d0 * 512 + ks * 4096 + half * 2048; }
template <int OFF> __device__ __forceinline__ s16x4 tr_read(int vb) {
    s16x4 r; asm volatile("ds_read_b64_tr_b16 %0, %1 offset:%2" : "=&v"(r) : "v"(vb), "i"(OFF) : "memory"); return r;
}
template <int D0> __device__ __forceinline__ void pv_one(f32x16& od, int vb, bf16x8 pa0, bf16x8 pa1, bf16x8 pa2, bf16x8 pa3) {
    const s16x4 l0 = tr_read<v_rd_off(D0, 0, 0)>(vb), h0 = tr_read<v_rd_off(D0, 0, 1)>(vb), l1 = tr_read<v_rd_off(D0, 1, 0)>(vb), h1 = tr_read<v_rd_off(D0, 1, 1)>(vb);
    const s16x4 l2 = tr_read<v_rd_off(D0, 2, 0)>(vb), h2 = tr_read<v_rd_off(D0, 2, 1)>(vb), l3 = tr_read<v_rd_off(D0, 3, 0)>(vb), h3 = tr_read<v_rd_off(D0, 3, 1)>(vb);
    asm volatile("s_waitcnt lgkmcnt(0)" ::: "memory"); SBAR();
#define PKV(L, H) (bf16x8){L[0], L[1], L[2], L[3], H[0], H[1], H[2], H[3]}
    od = __builtin_amdgcn_mfma_f32_32x32x16_bf16(pa0, PKV(l0, h0), od, 0, 0, 0);
    od = __builtin_amdgcn_mfma_f32_32x32x16_bf16(pa1, PKV(l1, h1), od, 0, 0, 0);
    od = __builtin_amdgcn_mfma_f32_32x32x16_bf16(pa2, PKV(l2, h2), od, 0, 0, 0);
    od = __builtin_amdgcn_mfma_f32_32x32x16_bf16(pa3, PKV(l3, h3), od, 0, 0, 0);
#undef PKV
}
__device__ __forceinline__ void pv_d0(f32x16* o, int vb, bf16x8 pa0, bf16x8 pa1, bf16x8 pa2, bf16x8 pa3) {
    pv_one<0>(o[0], vb, pa0, pa1, pa2, pa3); pv_one<1>(o[1], vb, pa0, pa1, pa2, pa3); pv_one<2>(o[2], vb, pa0, pa1, pa2, pa3); pv_one<3>(o[3], vb, pa0, pa1, pa2, pa3);
}
__device__ __forceinline__ void attn_unit(const bf16* __restrict__ QKV, bf16* __restrict__ O, const float* __restrict__ sink, int qrow0, int head0, int kvh, int krow_band, int nband, int krow_ctx, int dpos0, LAS unsigned char* lds, const int wid) {
    const int lane = lane_id(), tid = wid * 64 + lane, r32 = lane & 31, hi = lane >> 5;
    LAS unsigned char* V_lds = lds; LAS unsigned char* K_lds = lds + 2 * SHM_V;
    LAS float* wsf = (LAS float*)(lds + 2 * SHM_V + 2 * SHM_K) + wid * 64; LAS float* li_l = wsf; LAS float* al_l = wsf + 32;
    const int head = head0 + (wid >> 2), qoff = 32 * (wid & 3);
    float m_reg = sink[head] * (1.0f / SCALE), l_reg = 1.0f; f32x16 o[4] = {}; bf16x8 qr[8];
    const bf16* Qw = QKV + (size_t)(qrow0 + qoff + r32) * QKVD + head * HDIM + hi * 8;
#pragma unroll
    for (int d0 = 0; d0 < 8; ++d0) qr[d0] = *(const bf16x8*)(Qw + d0 * 16);
    const bf16* Kg = QKV + 1024 + kvh * HDIM; const bf16* Vg = QKV + 1280 + kvh * HDIM;
    const int sr = tid >> 4, sc = (tid & 15) * 8, vst0 = v_st(sr, sc), vst1 = v_st(32 + sr, sc);
    const int vb0 = (int)(unsigned)(uintptr_t)V_lds + v_rd_base(lane);
    const int NT = nband + 4;
    struct { bf16x8 vs0, vs1, ks0, ks1; } sr_[2];
#define TROW(j) ((j) < nband ? krow_band + 64 * (j) : krow_ctx + 64 * ((j) - nband))
#define SLOAD(i, j) do { const size_t _r0 = (size_t)(TROW(j) + sr) * QKVD + sc, _r1 = _r0 + (size_t)32 * QKVD; \
    sr_[i].vs0 = *(const bf16x8*)(Vg + _r0); sr_[i].vs1 = *(const bf16x8*)(Vg + _r1); sr_[i].ks0 = *(const bf16x8*)(Kg + _r0); sr_[i].ks1 = *(const bf16x8*)(Kg + _r1); } while (0)
#define SWRITE(b, i) do { *(LAS bf16x8*)(V_lds + (b) * SHM_V + vst0) = sr_[i].vs0; *(LAS bf16x8*)(V_lds + (b) * SHM_V + vst1) = sr_[i].vs1; const int kc = sc * 2; \
    *(LAS bf16x8*)(K_lds + (b) * SHM_K + KSWZ(sr, kc)) = sr_[i].ks0; *(LAS bf16x8*)(K_lds + (b) * SHM_K + KSWZ(32 + sr, kc)) = sr_[i].ks1; } while (0)
#define SWAIT() asm volatile("s_waitcnt vmcnt(4)" ::: "memory")
#define RESC(a) do { if (__any((a) < 1.f)) { if (hi == 0) al_l[r32] = (a); asm volatile("s_waitcnt lgkmcnt(0)" ::: "memory"); \
    _Pragma("unroll") for (int d = 0; d < 4; ++d) _Pragma("unroll") for (int r = 0; r < 16; ++r) o[d][r] *= al_l[crow(r, hi)]; } } while (0)
#define TMASK(j, dm, dd) const int _dl##j = dpos0 + 64 * (j) - qoff; const bool dm = ((j) < nband) && !(_dl##j >= -97 && _dl##j <= 65); const int dd = _dl##j - r32 + 4 * hi
    f32x16 pA0, pA1, pB0, pB1; float mnA, mnB, alA, alB; bf16x8 pa0, pa1, pa2, pa3;
    constexpr int SE = 0, SO = 1;
    SLOAD(SE, 0); asm volatile("s_waitcnt vmcnt(0)" ::: "memory"); SWRITE(0, SE); __syncthreads();
    qkt(pA0, pA1, K_lds, qr, r32, hi); { TMASK(0, dm, dd); partialSM(pA0, pA1, m_reg, mnA, alA, dm, dd); }
    SLOAD(SO, 1); if (2 < NT) SLOAD(SE, 2);
    SWAIT(); SWRITE(1, SO); __syncthreads();
    for (int j = 1; j + 1 < NT; j += 2) {
        SBAR(); qkt(pB0, pB1, K_lds + SHM_K, qr, r32, hi);
        finishSM(pA0, pA1, alA, l_reg, pa0, pa1, pa2, pa3); SBAR();
        SLOAD(SO, (j + 2 < NT ? j + 2 : j)); SBAR();
        pv_d0(o, vb0, pa0, pa1, pa2, pa3); { const int jj = j; const int dl = dpos0 + 64 * jj - qoff; const bool dm = (jj < nband) && !(dl >= -97 && dl <= 65); partialSM(pB0, pB1, m_reg, mnB, alB, dm, dl - r32 + 4 * hi); }
        __syncthreads(); SWAIT(); SWRITE(0, SE);
        RESC(alB); __syncthreads();
        SBAR(); qkt(pA0, pA1, K_lds, qr, r32, hi);
        finishSM(pB0, pB1, alB, l_reg, pa0, pa1, pa2, pa3); SBAR();
        SLOAD(SE, (j + 3 < NT ? j + 3 : j)); SBAR();
        pv_d0(o, vb0 + SHM_V, pa0, pa1, pa2, pa3); { const int jj = j + 1; const int dl = dpos0 + 64 * jj - qoff; const bool dm = (jj < nband) && !(dl >= -97 && dl <= 65); partialSM(pA0, pA1, m_reg, mnA, alA, dm, dl - r32 + 4 * hi); }
        __syncthreads(); SWAIT(); SWRITE(1, SO);
        RESC(alA); __syncthreads();
    }
    SBAR(); qkt(pB0, pB1, K_lds + SHM_K, qr, r32, hi);
    finishSM(pA0, pA1, alA, l_reg, pa0, pa1, pa2, pa3); SBAR();
    pv_d0(o, vb0, pa0, pa1, pa2, pa3); { const int jj = NT - 1; const int dl = dpos0 + 64 * jj - qoff; const bool dm = (jj < nband) && !(dl >= -97 && dl <= 65); partialSM(pB0, pB1, m_reg, mnB, alB, dm, dl - r32 + 4 * hi); }
    asm volatile("s_waitcnt vmcnt(0)" ::: "memory");
    __syncthreads(); RESC(alB);
    finishSM(pB0, pB1, alB, l_reg, pa0, pa1, pa2, pa3); SBAR();
    pv_d0(o, vb0 + SHM_V, pa0, pa1, pa2, pa3);
    if (hi == 0) li_l[r32] = l_reg; asm volatile("s_waitcnt lgkmcnt(0)" ::: "memory");
    float rli[16];
#pragma unroll
    for (int r = 0; r < 16; ++r) rli[r] = rcpf_(li_l[crow(r, hi)]);
    { LAS unsigned char* ot = lds + 2 * SHM_V + 2 * SHM_K + 4096 + wid * 4096;
#pragma unroll
      for (int r = 0; r < 16; ++r) { const int orow = crow(r, hi);
#pragma unroll
          for (int d0 = 0; d0 < 4; ++d0) { const float x = clamp8(o[d0][r] * rli[r] * 16.0f); ot[orow * 128 + d0 * 32 + r32] = (unsigned char)(__builtin_amdgcn_cvt_pk_fp8_f32(x, x, 0, false) & 0xff); } }
      asm volatile("s_waitcnt lgkmcnt(0)" ::: "memory");
      unsigned char* Ob = (unsigned char*)O + (size_t)(qrow0 + qoff) * DM + head * HDIM;
#pragma unroll
      for (int i = 0; i < 4; ++i) { const int row = (lane >> 3) + 8 * i, ch = lane & 7; *(u32x4*)(Ob + (size_t)row * DM + ch * 16) = *(LAS const u32x4*)(ot + row * 128 + ch * 16); } }
    __syncthreads();
#undef TROW
#undef SLOAD
#undef SWRITE
#undef SWAIT
#undef RESC
#undef TMASK
}
constexpr int N_LAT_UNITS = NB * 32 * NKVH * 2, N_CTX_UNITS = NB * 2 * NKVH * 2, N_UNITS = N_LAT_UNITS + N_CTX_UNITS;
__device__ __forceinline__ void attn_phase(const bf16* QKV, bf16* O, const float* sink, int G, int c, LAS unsigned char* lds, const int wid) {
    for (int L = c; L < N_UNITS; L += G) {
        if (L < N_LAT_UNITS) { const int hp = L & 1, kh = (L >> 1) & 1, n = (L >> 2) & 31, b = L >> 7;
            const int nlo = n > 0 ? n - 1 : 0, nhi = n < 31 ? n + 1 : 31, nband = 2 * (nhi - nlo + 1);
            attn_unit(QKV, O, sink, b * SEQ + n * 128, kh * 4 + hp * 2, kh, b * SEQ + nlo * 128, nband, RL + b * LCTX, (nlo - n) * 128, lds, wid);
        } else { const int u = L - N_LAT_UNITS, hp = u & 1, kh = (u >> 1) & 1, qh = (u >> 2) & 1, b = u >> 3;
            attn_unit(QKV, O, sink, RL + b * LCTX + qh * 128, kh * 4 + hp * 2, kh, 0, 0, RL + b * LCTX, 0, lds, wid);
        }
    }
}
#undef KSWZ
#undef SBAR
}

__device__ __forceinline__ void p10_conv(Frame& F) {
    const int gw = F.vcu * NWAVES + F.wave, NGW = F.G * NWAVES; const bf16* XB = WSP(bf16, WS_XB); bf16* U = WSP(bf16, WS_U);
    float cw[4][16], cb[16];
#pragma unroll
    for (int j = 0; j < 4; ++j)
#pragma unroll
        for (int q = 0; q < 4; ++q) { const f32x4 w = *(const f32x4*)(F.conv_w + j * 1024 + 16 * F.lane + 4 * q); cw[j][4 * q] = w[0]; cw[j][4 * q + 1] = w[1]; cw[j][4 * q + 2] = w[2]; cw[j][4 * q + 3] = w[3]; }
#pragma unroll
    for (int q = 0; q < 4; ++q) { const f32x4 w = *(const f32x4*)(F.conv_b + 16 * F.lane + 4 * q); cb[4 * q] = w[0]; cb[4 * q + 1] = w[1]; cb[4 * q + 2] = w[2]; cb[4 * q + 3] = w[3]; }
    const int per = (RT + NGW - 1) / NGW, r0 = gw * per, r1 = (r0 + per < RT) ? r0 + per : RT;
    if (r0 >= RT) return;
    u32x4 w0[4], w1[4];
#pragma unroll
    for (int j = 0; j < 4; ++j) { int rr = r0 + j - 2; rr = rr < 0 ? 0 : (rr >= RT ? RT - 1 : rr); const u32x4* p = (const u32x4*)(XB + (size_t)rr * DM + 16 * F.lane); w0[j] = p[0]; w1[j] = p[1]; }
    for (int r = r0; r < r1; ++r) { const bool lat = r < RL; const int t = lat ? (r & (SEQ - 1)) : ((r - RL) & (LCTX - 1)); const int Ls = lat ? SEQ : LCTX;
        u32x4 n0, n1; { int rn = r + 2; rn = rn >= RT ? RT - 1 : rn; const u32x4* p = (const u32x4*)(XB + (size_t)rn * DM + 16 * F.lane); n0 = p[0]; n1 = p[1]; }
        float acc[16];
#pragma unroll
        for (int i = 0; i < 16; ++i) acc[i] = cb[i];
#pragma unroll
        for (int j = 0; j < 4; ++j) { const int tj = t + j - 2;
            if (tj >= 0 && tj < Ls) { const u32x4 x0 = w0[j], x1 = w1[j];
#pragma unroll
                for (int q = 0; q < 4; ++q) { acc[2 * q] += cw[j][2 * q] * bflo(x0[q]); acc[2 * q + 1] += cw[j][2 * q + 1] * bfhi(x0[q]); acc[8 + 2 * q] += cw[j][8 + 2 * q] * bflo(x1[q]); acc[8 + 2 * q + 1] += cw[j][8 + 2 * q + 1] * bfhi(x1[q]); } } }
        u32x4 o0, o1;
#pragma unroll
        for (int q = 0; q < 4; ++q) { o0[q] = cvtpk(acc[2 * q], acc[2 * q + 1]); o1[q] = cvtpk(acc[8 + 2 * q], acc[8 + 2 * q + 1]); }
        u32x4* op = (u32x4*)(U + (size_t)r * DM + 16 * F.lane); op[0] = o0; op[1] = o1;
        w0[0] = w0[1]; w0[1] = w0[2]; w0[2] = w0[3]; w0[3] = n0; w1[0] = w1[1]; w1[1] = w1[2]; w1[2] = w1[3]; w1[3] = n1; }
}
namespace lru {
constexpr int AIMG_BYTES = 65536;
constexpr int EX_OFF = 2 * AIMG_BYTES;
struct Ctx { const bf16* U; const bf16* G; bf16* HH; u32x4* HF; const bf16* WLG; const float *lam, *b_r, *b_i; };

__device__ __forceinline__ void issue_u(const __amdgpu_buffer_rsrc_t rs, LAS unsigned char* buf, int n, size_t row0, int wid, unsigned voff) {
#pragma unroll
    for (int ii = 0; ii < 8; ++ii) { const int i = wid + 8 * ii;
        __builtin_amdgcn_raw_ptr_buffer_load_lds(rs, (LAS void*)(buf + i * 1024), 16, voff, (unsigned)((row0 + 32 * ii) * DM * 2 + n * 256), 0, 0); }
}
__device__ __forceinline__ void chunk_geom(int DIR, int k, int b, size_t& row0, int& lc) {
    if (k == 0) { row0 = (size_t)RL + b * LCTX; lc = -1; } else { lc = DIR ? 16 - k : k - 1; row0 = (size_t)b * SEQ + 256 * lc; }
}
#define LRU_BAR() do { asm volatile("s_waitcnt lgkmcnt(0)" ::: "memory"); __builtin_amdgcn_s_barrier(); asm volatile("" ::: "memory"); } while (0)
template <int DIR>
__device__ __forceinline__ void walk(const Ctx& C, LAS unsigned char* lds, int task, const int wid) {
    const int cq = task & 3, n = (task >> 2) & 7, b = task >> 5;
    const int lane = lane_id(), tid = wid * 64 + lane, c = lane & 15, g = lane >> 4;
    const int chalf = wid & 1, tq = wid >> 1;
    const int chl = 32 * cq + 16 * chalf + c;
    const int ch = n * 128 + chl;
    bf16x8 Br[4], Bi[4];
    { const bf16* wr = C.WLG + ((size_t)(n * 4 + 2 * DIR) * 128 + chl) * 128 + 8 * g; const bf16* wi = wr + 16384;
#pragma unroll
      for (int ks = 0; ks < 4; ++ks) { Br[ks] = *(const bf16x8*)(wr + ks * 32); Bi[ks] = *(const bf16x8*)(wi + ks * 32); } }
    const float br = C.b_r[DIR * 1024 + ch], bi = C.b_i[DIR * 1024 + ch];
    const float sp8 = 8.0f * log1pf(expf(-C.lam[DIR * 1024 + ch]));
    const float kbr = -LOG2E * br, kbi = -LOG2E * bi, ka = -sp8 * LOG2E;
    float H = 0.f;
    unsigned fb[4], ub[4];
#pragma unroll
    for (int ks = 0; ks < 4; ++ks) fb[ks] = (unsigned)((64 * tq + c) * 256 + ((ks * 64 + 16 * g) ^ (c << 4)));
#pragma unroll
    for (int r = 0; r < 4; ++r) ub[r] = (unsigned)((64 * tq + 4 * g + r) * 256 + ((2 * chl) ^ ((4 * g + r) << 4)));
    const __amdgpu_buffer_rsrc_t urs = __builtin_amdgcn_make_buffer_rsrc((void*)C.U, 0, -1, 0x00020000);
    const unsigned uvoff = (unsigned)((4 * wid + (lane >> 4)) * DM * 2 + (((lane & 15) ^ ((4 * wid + (lane >> 4)) & 15)) * 16));
    { size_t r0; int lc; chunk_geom(DIR, 0, b, r0, lc); issue_u(urs, lds, n, r0, wid, uvoff); }
    for (int k = 0; k < 17; ++k) {
        size_t row0; int lc; chunk_geom(DIR, k, b, row0, lc);
        LAS unsigned char* img = lds + (k & 1) * AIMG_BYTES;
        asm volatile("s_waitcnt vmcnt(0)" ::: "memory");
        LRU_BAR();
        if (k + 1 < 17) { size_t r1; int l1; chunk_geom(DIR, k + 1, b, r1, l1); issue_u(urs, lds + ((k + 1) & 1) * AIMG_BYTES, n, r1, wid, uvoff); }
        u32x4 hf0, hf1;
        u32x4 gp0, gp1;
        if (DIR == 1 && lc >= 0) { const u32x4* hp = C.HF + ((((size_t)task * 16 + lc) * 8 + wid) * 2) * 64 + lane; hf0 = hp[0]; hf1 = hp[64];
            const size_t grow = (row0 + (tid >> 1)) * DM + n * 128 + 32 * cq + 16 * (tid & 1); gp0 = *(const u32x4*)(C.G + grow); gp1 = *(const u32x4*)(C.G + grow + 8); }
        f32x4 ar[4], ai[4];
#pragma unroll
        for (int mt = 0; mt < 4; ++mt) { ar[mt] = (f32x4){0.f, 0.f, 0.f, 0.f}; ai[mt] = (f32x4){0.f, 0.f, 0.f, 0.f};
#pragma unroll
            for (int ks = 0; ks < 4; ++ks) { const bf16x8 af = *(LAS const bf16x8*)(img + fb[ks] + mt * 4096);
                ar[mt] = __builtin_amdgcn_mfma_f32_16x16x32_bf16(af, Br[ks], ar[mt], 0, 0, 0);
                ai[mt] = __builtin_amdgcn_mfma_f32_16x16x32_bf16(af, Bi[ks], ai[mt], 0, 0, 0); } }
        float y0[4][4], P[4][4]; float TA = 1.f, TB = 0.f;
#pragma unroll
        for (int mm = 0; mm < 4; ++mm) { const int mt = DIR ? 3 - mm : mm;
            float a[4], bb[4];
#pragma unroll
            for (int r = 0; r < 4; ++r) {
                const float rg = rcpf_(1.0f + ex2(fmaf(ar[mt][r], -LOG2E, kbr))), ig = rcpf_(1.0f + ex2(fmaf(ai[mt][r], -LOG2E, kbi)));
                a[r] = ex2(rg * ka);
                const float em = fmaf(-a[r], a[r], 1.0f);
                const float uu = __uint_as_float((unsigned)*(LAS const bf16*)(img + ub[r] + mt * 4096) << 16);
                bb[r] = __builtin_amdgcn_sqrtf(em) * (ig * uu); }
            float p[4], yl[4];
            if (DIR == 0) { p[0] = a[0]; yl[0] = bb[0];
#pragma unroll
                for (int r = 1; r < 4; ++r) { p[r] = a[r] * p[r - 1]; yl[r] = a[r] * yl[r - 1] + bb[r]; } }
            else { p[3] = a[3]; yl[3] = bb[3];
#pragma unroll
                for (int r = 2; r >= 0; --r) { p[r] = a[r] * p[r + 1]; yl[r] = a[r] * yl[r + 1] + bb[r]; } }
            const float Al = DIR ? p[0] : p[3], Bl = DIR ? yl[0] : yl[3];
            const float A0 = __shfl(Al, c), A1 = __shfl(Al, 16 + c), A2 = __shfl(Al, 32 + c), A3 = __shfl(Al, 48 + c);
            const float B0 = __shfl(Bl, c), B1 = __shfl(Bl, 16 + c), B2 = __shfl(Bl, 32 + c), B3 = __shfl(Bl, 48 + c);
            float EA, EB, At, Bt;
            if (DIR == 0) { const float e1a = A0, e1b = B0, e2a = A1 * e1a, e2b = A1 * e1b + B1, e3a = A2 * e2a, e3b = A2 * e2b + B2;
                EA = g == 0 ? 1.f : (g == 1 ? e1a : (g == 2 ? e2a : e3a)); EB = g == 0 ? 0.f : (g == 1 ? e1b : (g == 2 ? e2b : e3b)); At = A3 * e3a; Bt = A3 * e3b + B3; }
            else { const float e2a = A3, e2b = B3, e1a = A2 * e2a, e1b = A2 * e2b + B2, e0a = A1 * e1a, e0b = A1 * e1b + B1;
                EA = g == 3 ? 1.f : (g == 2 ? e2a : (g == 1 ? e1a : e0a)); EB = g == 3 ? 0.f : (g == 2 ? e2b : (g == 1 ? e1b : e0b)); At = A0 * e0a; Bt = A0 * e0b + B0; }
            const float QA = EA * TA, QB = EA * TB + EB;
#pragma unroll
            for (int r = 0; r < 4; ++r) { P[mt][r] = p[r] * QA; y0[mt][r] = p[r] * QB + yl[r]; }
            TB = At * TB + Bt; TA = At * TA;
        }
        if (g == 0) *(LAS f32x2*)(lds + EX_OFF + ((tq * 2 + chalf) * 16 + c) * 8) = (f32x2){TA, TB};
        LRU_BAR();
        float Hw;
        { const f32x2 e0 = *(LAS const f32x2*)(lds + EX_OFF + ((0 * 2 + chalf) * 16 + c) * 8), e1 = *(LAS const f32x2*)(lds + EX_OFF + ((1 * 2 + chalf) * 16 + c) * 8),
                      e2 = *(LAS const f32x2*)(lds + EX_OFF + ((2 * 2 + chalf) * 16 + c) * 8), e3 = *(LAS const f32x2*)(lds + EX_OFF + ((3 * 2 + chalf) * 16 + c) * 8);
          if (DIR == 0) { const float h1 = e0.x * H + e0.y, h2 = e1.x * h1 + e1.y, h3 = e2.x * h2 + e2.y; Hw = tq == 0 ? H : (tq == 1 ? h1 : (tq == 2 ? h2 : h3)); H = e3.x * h3 + e3.y; }
          else { const float h2 = e3.x * H + e3.y, h1 = e2.x * h2 + e2.y, h0 = e1.x * h1 + e1.y; Hw = tq == 3 ? H : (tq == 2 ? h2 : (tq == 1 ? h1 : h0)); H = e0.x * h0 + e0.y; } }
        if (lc >= 0) {
#pragma unroll
            for (int mt = 0; mt < 4; ++mt)
#pragma unroll
                for (int r = 0; r < 4; ++r) y0[mt][r] += P[mt][r] * Hw;
            if (DIR == 0) {
                u32x4* hp = C.HF + ((((size_t)task * 16 + lc) * 8 + wid) * 2) * 64 + lane;
                u32x4 w0, w1; w0.x = cvtpk(y0[0][0], y0[0][1]); w0.y = cvtpk(y0[0][2], y0[0][3]); w0.z = cvtpk(y0[1][0], y0[1][1]); w0.w = cvtpk(y0[1][2], y0[1][3]);
                w1.x = cvtpk(y0[2][0], y0[2][1]); w1.y = cvtpk(y0[2][2], y0[2][3]); w1.z = cvtpk(y0[3][0], y0[3][1]); w1.w = cvtpk(y0[3][2], y0[3][3]);
                hp[0] = w0; hp[64] = w1;
            } else {
                const unsigned hw[8] = {hf0.x, hf0.y, hf0.z, hf0.w, hf1.x, hf1.y, hf1.z, hf1.w};
#pragma unroll
                for (int mt = 0; mt < 4; ++mt)
#pragma unroll
                    for (int r = 0; r < 4; ++r) { const unsigned w = hw[mt * 2 + (r >> 1)]; const float hfv = (r & 1) ? bfhi(w) : bflo(w); const float s = y0[mt][r] + hfv;
                        *(LAS bf16*)(img + (64 * tq + mt * 16 + 4 * g + r) * 64 + (16 * chalf + c) * 2) = (bf16)(cvtpk(s, 0.f) & 0xffffu); }
                LRU_BAR();
                { const int tt = tid >> 1, hh = tid & 1; const size_t grow = (row0 + tt) * DM + n * 128 + 32 * cq + 16 * hh;
                  const u32x4 s0 = *(LAS const u32x4*)(img + tt * 64 + hh * 32), s1 = *(LAS const u32x4*)(img + tt * 64 + hh * 32 + 16);
                  const u32x4 g0 = gp0, g1 = gp1;
                  u32x4 o0, o1;
#pragma unroll
                  for (int j = 0; j < 4; ++j) { o0[j] = cvtpk(bflo(s0[j]) * bflo(g0[j]), bfhi(s0[j]) * bfhi(g0[j])); o1[j] = cvtpk(bflo(s1[j]) * bflo(g1[j]), bfhi(s1[j]) * bfhi(g1[j])); }
                  *(u32x4*)(C.HH + grow) = o0; *(u32x4*)(C.HH + grow + 8) = o1; }
            }
        }
    }
    asm volatile("s_waitcnt vmcnt(0)" ::: "memory");
    LRU_BAR();
}
#undef LRU_BAR
}
__device__ __forceinline__ void p11_lru(Frame& F, const lru::Ctx& C) {
    for (int task = F.vcu; task < 256; task += F.G) { lru::walk<0>(C, F.lds, task, F.wave); lru::walk<1>(C, F.lds, task, F.wave); }
}

__device__ __forceinline__ void p13_ln_router(Frame& F) {
    LAS float* RTR = (LAS float*)F.lds;
    LAS int* lcnt = (LAS int*)(F.lds + 32768);
    for (int idx = F.tid; idx < 8192; idx += NWAVES * 64) RTR[(idx & 7) * 1024 + (idx >> 3)] = F.router[idx];
    const float* mod = WSP(float, WS_MOD) + (size_t)1 * 9 * 6144; unsigned char* H8 = WSP(unsigned char, WS_H);
    int* eidx = (int*)(F.ws + WS_ROUTE + RT_EIDX); float* wgt = (float*)(F.ws + WS_ROUTE + RT_WGT); int* cnt = (int*)(F.ws + WS_ROUTE + RT_CNT);
    const Vec16 gv = vec_load(F.ln_g + 2 * 1024, F.lane), bv = vec_load(F.ln_b + 2 * 1024, F.lane);
    for (int batch = F.vcu; batch < RL / 128; batch += F.G) {
        const float* mb0 = mod + (size_t)((batch * 128) >> 12) * 6144 + 3072; const Vec16 sh = vec_load(mb0, F.lane), sc = vec_load(mb0 + 1024, F.lane);
        if (F.tid < 8) lcnt[F.tid] = 0;
        __syncthreads();
        u32x2 nx[4]; { const bf16* yp = WSP(bf16, WS_YB) + (size_t)(batch * 128 + F.wave * 16) * DM;
#pragma unroll
            for (int j = 0; j < 4; ++j) nx[j] = *(const u32x2*)(yp + 4 * F.lane + 256 * j); }
        for (int i = 0; i < 16; ++i) { const int r = batch * 128 + F.wave * 16 + i;
            f32x4 v[4];
#pragma unroll
            for (int j = 0; j < 4; ++j) v[j] = (f32x4){bflo(nx[j].x), bfhi(nx[j].x), bflo(nx[j].y), bfhi(nx[j].y)};
            if (i + 1 < 16) { const bf16* yp = WSP(bf16, WS_YB) + (size_t)(r + 1) * DM;
#pragma unroll
                for (int j = 0; j < 4; ++j) nx[j] = *(const u32x2*)(yp + 4 * F.lane + 256 * j); }
            row_ln_v(v, gv, bv);
            float lg[8];
#pragma unroll
            for (int e = 0; e < 8; ++e) lg[e] = 0.f;
#pragma unroll
            for (int j = 0; j < 4; ++j) { const f32x4 hm = v[j] * (sc.q[j] + 1.0f) + sh.q[j];
                *(unsigned*)(H8 + (size_t)r * DM + 4 * F.lane + 256 * j) = pk4_fp8(hm[0] * 4.f, hm[1] * 4.f, hm[2] * 4.f, hm[3] * 4.f);
#pragma unroll
                for (int e = 0; e < 8; ++e) { const f32x4 rt = *(LAS const f32x4*)(RTR + e * 1024 + 4 * F.lane + 256 * j); lg[e] += (hm[0] * rt[0] + hm[1] * rt[1]) + (hm[2] * rt[2] + hm[3] * rt[3]); } }
#pragma unroll
            for (int e = 0; e < 8; ++e) lg[e] = wave_sum(lg[e]);
            int ea = 0; float la = lg[0];
#pragma unroll
            for (int e = 1; e < 8; ++e) if (lg[e] > la) { la = lg[e]; ea = e; }
            int eb = -1; float lb = -3.0e38f;
#pragma unroll
            for (int e = 0; e < 8; ++e) if (e != ea && lg[e] > lb) { lb = lg[e]; eb = e; }
            const float wa = 1.0f / (1.0f + __expf(lb - la)), wb = 1.0f - wa;
            if (F.lane == 0) { *(int2*)(eidx + 2 * r) = make_int2(ea, eb); *(float2*)(wgt + 2 * r) = make_float2(wa, wb); atomicAdd((int*)(lcnt + ea), 1); atomicAdd((int*)(lcnt + eb), 1); }
        }
        __syncthreads();
        if (F.tid < 8) cnt[batch * 8 + F.tid] = lcnt[F.tid];
        __syncthreads();
    }
}
__device__ __forceinline__ void moe_totals(Frame& F, int upto_batch, int (&tot)[8], int (&before)[8]) {
    const int* cnt = (const int*)(F.ws + WS_ROUTE + RT_CNT);
#pragma unroll
    for (int e = 0; e < 8; ++e) { tot[e] = 0; before[e] = 0; }
#pragma unroll
    for (int k = 0; k < 4; ++k) { const int bb = 4 * F.lane + k; const int4 c0 = *(const int4*)(cnt + bb * 8), c1 = *(const int4*)(cnt + bb * 8 + 4); const int m = bb < upto_batch ? 1 : 0;
        tot[0] += c0.x; tot[1] += c0.y; tot[2] += c0.z; tot[3] += c0.w; tot[4] += c1.x; tot[5] += c1.y; tot[6] += c1.z; tot[7] += c1.w;
        before[0] += m * c0.x; before[1] += m * c0.y; before[2] += m * c0.z; before[3] += m * c0.w; before[4] += m * c1.x; before[5] += m * c1.y; before[6] += m * c1.z; before[7] += m * c1.w; }
#pragma unroll
    for (int e = 0; e < 8; ++e) {
#pragma unroll
        for (int o = 1; o < 64; o <<= 1) { tot[e] += __shfl_xor(tot[e], o); before[e] += __shfl_xor(before[e], o); } }
}
__device__ __forceinline__ void p14_gather(Frame& F) {
    const int* eidx = (const int*)(F.ws + WS_ROUTE + RT_EIDX); const float* wgt = (const float*)(F.ws + WS_ROUTE + RT_WGT);
    int* slot = (int*)(F.ws + WS_ROUTE + RT_SLOT); float* wsort = (float*)(F.ws + WS_ROUTE + RT_WS);
    const unsigned char* H8 = WSP(unsigned char, WS_H); unsigned char* HS8 = WSP(unsigned char, WS_HS);
    LAS int* wcnt = (LAS int*)F.lds;
    LAS int* dsts = (LAS int*)(F.lds + 256);
    for (int batch = F.vcu; batch < RL / 128; batch += F.G) {
        int tot[8], before[8]; moe_totals(F, batch, tot, before);
        int base[8]; { int tp = 0;
#pragma unroll
            for (int e = 0; e < 8; ++e) { base[e] = tp * 256 + before[e]; tp += (tot[e] + 255) >> 8; } }
        int my_e = 0, rank_in_wave = 0;
        if (F.tid < 256) { my_e = eidx[batch * 256 + F.tid];
#pragma unroll
            for (int e = 0; e < 8; ++e) { const unsigned long long m = __ballot(my_e == e); if (my_e == e) rank_in_wave = __popcll(m & ((1ull << F.lane) - 1ull)); if (F.lane == 0) wcnt[F.wave * 8 + e] = __popcll(m); } }
        __syncthreads();
        if (F.tid < 256) { int off = 0;
#pragma unroll
            for (int w = 0; w < 4; ++w) if (w < F.wave) off += wcnt[w * 8 + my_e];
            int bs = 0;
#pragma unroll
            for (int e = 0; e < 8; ++e) bs = (my_e == e) ? base[e] : bs;
            const int d = bs + off + rank_in_wave; dsts[F.tid] = d; slot[batch * 256 + F.tid] = d; wsort[d] = wgt[batch * 256 + F.tid]; }
        __syncthreads();
        for (int i = 0; i < 32; ++i) { const int a = F.wave * 32 + i; const int d = dsts[a]; const int r = batch * 128 + (a >> 1);
            const u32x4* src = (const u32x4*)(H8 + (size_t)r * DM); u32x4* dp = (u32x4*)(HS8 + (size_t)d * DM);
            dp[F.lane] = src[F.lane]; }
        __syncthreads();
    }
}
__device__ __forceinline__ void p17_final(Frame& F) {
    const int gw = F.vcu * NWAVES + F.wave, NGW = F.G * NWAVES; const float* mod = WSP(float, WS_MOD) + (size_t)1 * 9 * 6144; const bf16* FO = WSP(bf16, WS_FO);
    const int* slot = (const int*)(F.ws + WS_ROUTE + RT_SLOT);
    const Vec16 g0 = vec_load(F.ln_g + 2 * 1024, F.lane), b0 = vec_load(F.ln_b + 2 * 1024, F.lane), g1 = vec_load(F.ln_g + 3 * 1024, F.lane), b1 = vec_load(F.ln_b + 3 * 1024, F.lane);
    const int bb = gw / (NGW / 8) < 8 ? gw / (NGW / 8) : 7; const Vec16 g2 = vec_load(mod + (size_t)bb * 6144 + 5120, F.lane);
    ROWS_LAT( (void)b; float* yp = F.out + (size_t)r * DM; const int2 s = *(const int2*)(slot + 2 * r);
        const bf16* fa = FO + (size_t)s.x * DM, * fb = FO + (size_t)s.y * DM;
        f32x4 v[4]; row_load_bf(v, WSP(bf16, WS_YB) + (size_t)r * DM, F.lane); row_ln_v(v, g0, b0);
        _Pragma("unroll") for (int j = 0; j < 4; ++j) { const u32x2 a = *(const u32x2*)(fa + 4 * F.lane + 256 * j), c = *(const u32x2*)(fb + 4 * F.lane + 256 * j);
            const f32x4 f = {bflo(a.x) + bflo(c.x), bfhi(a.x) + bfhi(c.x), bflo(a.y) + bflo(c.y), bfhi(a.y) + bfhi(c.y)};
            v[j] = v[j] * ALPHA + g2.q[j] * f; }
        row_ln_v(v, g1, b1); row_store(v, yp, F.lane); );
}

constexpr int N_PHASES = 18;
#ifndef REP_PHASE
#define REP_PHASE -1
#endif
struct Args { const float* in[25]; float* out; unsigned char* ws; int ph_lo, ph_hi; };
__global__ void __launch_bounds__(NWAVES * 64, 2) fwd_kernel(Args args) {
    extern __shared__ __attribute__((aligned(16))) unsigned char lds[];
    Frame F;
    F.lds = (LAS unsigned char*)lds;
    F.MISC = (volatile LAS unsigned*)(F.lds + MISC_OFF);
    F.wave = __builtin_amdgcn_readfirstlane((int)(threadIdx.x >> 6)); F.lane = lane_id(); F.tid = F.wave * 64 + F.lane;
    F.G = gridDim.x; { const int bx = blockIdx.x; F.vcu = (F.G % 8 == 0) ? (bx % 8) * (F.G / 8) + bx / 8 : bx; }
    F.x = args.in[0]; F.c = args.in[1]; F.ctx = args.in[2]; F.cctx = args.in[3]; F.w_mod = args.in[4]; F.b_mod = args.in[5]; F.ln_g = args.in[6]; F.ln_b = args.in[7];
    F.w_qkv = args.in[8]; F.w_o = args.in[9]; F.sink = args.in[10]; F.w_gu = args.in[11]; F.w_dn = args.in[12]; F.w_in = args.in[13]; F.conv_w = args.in[14]; F.conv_b = args.in[15];
    F.lam = args.in[16]; F.w_r = args.in[17]; F.b_r = args.in[18]; F.w_i = args.in[19]; F.b_i = args.in[20]; F.w_out = args.in[21]; F.router = args.in[22]; F.mw_gu = args.in[23]; F.mw_dn = args.in[24];
    F.out = args.out; F.ws = args.ws;
    for (int u = F.tid; u < (LDS_BYTES - LDSCTL_OFF) / 4; u += NWAVES * 64) ((LAS unsigned*)(F.lds + LDSCTL_OFF))[u] = 0u;
    __syncthreads();
    const int lo = args.ph_lo, hi = args.ph_hi;
    const bool multi = (hi - lo) > 1;
    XcdBarrier bar; bar.bar = (unsigned*)(F.ws + WS_CTL) + 1024; bar.x = 0; bar.st = nullptr;
    if (multi) bar = xcd_barrier_post((unsigned*)(F.ws + WS_CTL) + 1024, F.MISC + 8, F.wave == 0 && lane_id() == 0);
#define IN(k) (lo <= (k) && (k) < hi)
#define REFRESH() do { F.lane = lane_id(); F.tid = F.wave * 64 + F.lane; } while (0)
#define SEAM(k) do { if (IN(k) && IN((k) + 1)) xcd_barrier(bar, F.wave == 0 && lane_id() == 0); } while (0)
    const float* MOD = WSP(float, WS_MOD);
    bf16* H = WSP(bf16, WS_H); bf16* YB = WSP(bf16, WS_YB); const f32x2* ST = (const f32x2*)(F.ws + WS_STATS);

    if (IN(0)) { REFRESH(); p0_prologue(F); if (REP_PHASE == 0) { xcd_barrier(bar, F.wave == 0 && lane_id() == 0); p0_prologue(F); } } SEAM(0);
    if (IN(1)) { REFRESH(); p1_modulate(F); if (REP_PHASE == 1) { xcd_barrier(bar, F.wave == 0 && lane_id() == 0); p1_modulate(F); } } SEAM(1);
    if (IN(2)) {
        pg8::Gemm g{H, WSP(bf16, WS_WQKV), RT, QKVD, DM / 2}; pg8::StaticOrder S; S.init(RT, QKVD, F.G, (int)blockIdx.x);
        pg8::EpiQKV E{WSP(bf16, WS_QKV), WSP(float, WS_ROPE), 1.0f / 512.0f};
        pg8::gemm_phase<pg8::EpiQKV, pg8::StaticOrder, true, true, true>(F.lds + RING_OFF, g, S, E, F.wave);
        moe_convert_filler(F, (RT / 256) * (QKVD / 256), (int)blockIdx.x, 0, 6400);
    } SEAM(2);
    if (IN(3)) { att::attn_phase(WSP(bf16, WS_QKV), WSP(bf16, WS_O), F.sink, F.G, F.vcu, F.lds + RING_OFF, F.wave); if (REP_PHASE == 3) { xcd_barrier(bar, F.wave == 0 && lane_id() == 0); att::attn_phase(WSP(bf16, WS_QKV), WSP(bf16, WS_O), F.sink, F.G, F.vcu, F.lds + RING_OFF, F.wave); } } SEAM(3);
    if (IN(4)) {
        pg8::Gemm g{WSP(bf16, WS_O), WSP(bf16, WS_WO), RT, DM, DM / 2}; pg8::StaticOrder S; S.init(RT, DM, F.G, (int)blockIdx.x);
        pg8::EpiResid<false> E{F.x, F.ctx, YB, MOD + 2048, 1.0f / 2048.0f, nullptr, nullptr, nullptr};
        pg8::gemm_phase<pg8::EpiResid<false>, pg8::StaticOrder, true, true, true>(F.lds + RING_OFF, g, S, E, F.wave);
        moe_convert_filler(F, (RT / 256) * (DM / 256), (int)blockIdx.x, 6400, 17408);
    } SEAM(4);
    if (IN(5)) { REFRESH(); ln_mod_pass<true>(F, true, F.ln_g, F.ln_b, 0, 3072); } SEAM(5);
    if (IN(6)) {
        pg8::Gemm g{H, WSP(bf16, WS_WGU), RT, 2 * DFF, DM / 2}; pg8::StaticOrder S; S.init(RT, 2 * DFF, F.G, (int)blockIdx.x);
        pg8::EpiSwiGLU8 E{WSP(unsigned char, WS_ACT), 28};
        pg8::gemm_phase<pg8::EpiSwiGLU8, pg8::StaticOrder, true, true, true>(F.lds + RING_OFF, g, S, E, F.wave);
    } SEAM(6);
    if (IN(7)) {
        pg8::Gemm g{WSP(bf16, WS_ACT), WSP(bf16, WS_WDN), RT, DM, DFF / 2}; pg8::StaticOrder S; S.init(RT, DM, F.G, (int)blockIdx.x);
        pg8::EpiResid<true> E{nullptr, nullptr, YB, MOD + 5120, 1.0f / 4096.0f, ST, F.ln_g, F.ln_b};
        pg8::gemm_phase<pg8::EpiResid<true>, pg8::StaticOrder, true, true, true>(F.lds + RING_OFF, g, S, E, F.wave);
        moe_convert_filler(F, (RT / 256) * (DM / 256), (int)blockIdx.x, 17408, 37888);
    } SEAM(7);
    if (IN(8)) { REFRESH(); ln_mod_pass<false>(F, true, F.ln_g + 1024, F.ln_b + 1024, 1, 0); } SEAM(8);
    if (IN(9)) {
        pg8::Gemm g{H, WSP(bf16, WS_WIN), RT, 2048, DM}; pg8::StaticOrder S; S.init(RT, 2048, F.G, (int)blockIdx.x);
        pg8::EpiLruIn E{WSP(bf16, WS_G), WSP(bf16, WS_XB)};
        pg8::gemm_phase<pg8::EpiLruIn, pg8::StaticOrder, true, true>(F.lds + RING_OFF, g, S, E, F.wave);
        moe_convert_filler(F, (RT / 256) * (2048 / 256), (int)blockIdx.x, 37888, CV_ITEMS);
    } SEAM(9);
    {
        const lru::Ctx LC{WSP(bf16, WS_U), WSP(bf16, WS_G), WSP(bf16, WS_HH), WSP(u32x4, WS_HF), WSP(bf16, WS_WLG), F.lam, F.b_r, F.b_i};
        if (IN(10)) { REFRESH(); p10_conv(F); } SEAM(10);
        if (IN(11)) { REFRESH(); p11_lru(F, LC); if (REP_PHASE == 11) { xcd_barrier(bar, F.wave == 0 && lane_id() == 0); p11_lru(F, LC); } } SEAM(11);
    }
    if (IN(12)) {
        pg8::Gemm g{WSP(bf16, WS_HH), WSP(bf16, WS_WOUT), RL, DM, DM}; pg8::StaticOrder S; S.init(RL, DM, F.G, (int)blockIdx.x);
        pg8::EpiResid<true> E{nullptr, nullptr, YB, MOD + 9 * 6144 + 2048, 1.0f, ST, F.ln_g + 1024, F.ln_b + 1024};
        pg8::gemm_phase<pg8::EpiResid<true>, pg8::StaticOrder, true, true>(F.lds + RING_OFF, g, S, E, F.wave);
    } SEAM(12);
    if (IN(13)) { REFRESH(); p13_ln_router(F); } SEAM(13);
    if (IN(14)) { REFRESH(); p14_gather(F); if (REP_PHASE == 14) { xcd_barrier(bar, F.wave == 0 && lane_id() == 0); p14_gather(F); } } SEAM(14);
    if (IN(15) || IN(16)) {
        REFRESH();
        int tot[8], before[8]; moe_totals(F, 0, tot, before);
        int tp[9]; tp[0] = 0;
#pragma unroll
        for (int e = 0; e < 8; ++e) tp[e + 1] = __builtin_amdgcn_readfirstlane(tp[e] + ((tot[e] + 255) >> 8));
        const int ntiles = tp[8];
        if (IN(15)) {
            pg8::Gemm g{WSP(bf16, WS_HS), WSP(bf16, WS_WMGU), ntiles * 256, 2 * DFF, DM / 2};
            pg8::MoeOrder S{ntiles, 28, ntiles * 28, F.G, (int)blockIdx.x, 28, tp[1], tp[2], tp[3], tp[4], tp[5], tp[6], tp[7]};
            pg8::EpiSwiGLU8 E{WSP(unsigned char, WS_MACT), 28};
            pg8::gemm_phase<pg8::EpiSwiGLU8, pg8::MoeOrder, true, true, true>(F.lds + RING_OFF, g, S, E, F.wave);
        } SEAM(15);
        if (IN(16)) {
            pg8::Gemm g{WSP(bf16, WS_MACT), WSP(bf16, WS_WMDN), ntiles * 256, DM, DFF / 2};
            pg8::MoeOrder S{ntiles, 4, ntiles * 4, F.G, (int)blockIdx.x, 4, tp[1], tp[2], tp[3], tp[4], tp[5], tp[6], tp[7]};
            pg8::EpiMoeOut8 E{WSP(bf16, WS_FO), (const float*)(F.ws + WS_ROUTE + RT_WS)};
            pg8::gemm_phase<pg8::EpiMoeOut8, pg8::MoeOrder, true, true, true>(F.lds + RING_OFF, g, S, E, F.wave);
        } SEAM(16);
    }
    if (IN(17)) { REFRESH(); p17_final(F); }
#undef IN
#undef SEAM
}

#ifndef N_LAUNCH_MODE
#define N_LAUNCH_MODE 1
#endif
extern "C" void kernel_launch(void* const* d_in, const int* in_sizes, int n_in, void* d_out, int out_size, void* d_ws, size_t ws_size, hipStream_t stream) {
    static int grid = 0;
    if (grid == 0) {
        if (n_in != 25 || out_size != RL * DM || ws_size < WS_END) { fprintf(stderr, "kernel_launch: unexpected shapes (n_in %d out %d ws %zu)\n", n_in, out_size, ws_size); grid = -1; return; }
        int dev = 0, cus = 0, per_cu = 0;
        if (hipGetDevice(&dev) != hipSuccess || hipDeviceGetAttribute(&cus, hipDeviceAttributeMultiprocessorCount, dev) != hipSuccess) { grid = -1; return; }
        if (hipFuncSetAttribute((const void*)fwd_kernel, hipFuncAttributeMaxDynamicSharedMemorySize, LDS_BYTES) != hipSuccess) { fprintf(stderr, "kernel_launch: hipFuncSetAttribute failed\n"); grid = -1; return; }
        if (hipOccupancyMaxActiveBlocksPerMultiprocessor(&per_cu, (const void*)fwd_kernel, NWAVES * 64, LDS_BYTES) != hipSuccess || per_cu < 1) { fprintf(stderr, "kernel_launch: occupancy query says %d\n", per_cu); per_cu = 1; }
        (void)hipGetLastError();
        grid = cus;
    }
    if (grid < 0) return;
    (void)hipMemsetAsync((char*)d_ws + WS_CTL, 0, CTL_ZERO_BYTES, stream);
    Args a{};
    for (int i = 0; i < 25; ++i) a.in[i] = (const float*)d_in[i];
    a.out = (float*)d_out; a.ws = (unsigned char*)d_ws;
#if N_LAUNCH_MODE == 1
    a.ph_lo = 0; a.ph_hi = N_PHASES;
    hipLaunchKernelGGL(fwd_kernel, dim3(grid), dim3(NWAVES * 64), LDS_BYTES, stream, a);
#else
    for (int p = 0; p < N_PHASES; ++p) { a.ph_lo = p; a.ph_hi = p + 1; hipLaunchKernelGGL(fwd_kernel, dim3(grid), dim3(NWAVES * 64), LDS_BYTES, stream, a); }
#endif
    const hipError_t le = hipPeekAtLastError();
    if (le != hipSuccess) fprintf(stderr, "kernel_launch: launch failed: %s\n", hipGetErrorName(le));
}
```

```cpp
#include <hip/hip_runtime.h>
#include <cstdio>
#include <cstdint>

#define GAS __attribute__((address_space(1)))
#define LAS __attribute__((address_space(3)))
typedef unsigned short bf16;
typedef short bf16x8 __attribute__((ext_vector_type(8)));
typedef short s16x4 __attribute__((ext_vector_type(4)));
typedef float f32x4 __attribute__((ext_vector_type(4)));
typedef float f32x2 __attribute__((ext_vector_type(2)));
typedef float f32x16 __attribute__((ext_vector_type(16)));
typedef unsigned u32x4 __attribute__((ext_vector_type(4)));
typedef unsigned u32x2 __attribute__((ext_vector_type(2)));
typedef GAS unsigned gu32;

constexpr int NB = 8, SEQ = 4096, DM = 1024, LCTX = 256;
constexpr int RL = NB * SEQ;
constexpr int RC = NB * LCTX;
constexpr int RT = RL + RC;
constexpr int NHEAD = 8, NKVH = 2, HDIM = 128, QKVD = 1536;
constexpr int DFF = 3584, NEXP = 8;
constexpr float ALPHA = 1.4142135623730951f;
constexpr float LN_EPS = 1e-5f;
constexpr float LOG2E = 1.4426950408889634f;
constexpr int NWAVES = 8;

__device__ __forceinline__ unsigned cvtpk(float lo, float hi) { unsigned r; asm volatile("v_cvt_pk_bf16_f32 %0, %1, %2" : "=v"(r) : "v"(lo), "v"(hi)); return r; }
__device__ __forceinline__ float bflo(unsigned w) { return __uint_as_float(w << 16); }
__device__ __forceinline__ float bfhi(unsigned w) { return __uint_as_float(w & 0xffff0000u); }
__device__ __forceinline__ float ex2(float x) { return __builtin_amdgcn_exp2f(x); }
__device__ __forceinline__ float rcpf_(float x) { return __builtin_amdgcn_rcpf(x); }
__device__ __forceinline__ float sigm(float x) { return rcpf_(1.0f + ex2(-LOG2E * x)); }
typedef int v8i __attribute__((ext_vector_type(8)));
typedef int v4i __attribute__((ext_vector_type(4)));
__device__ __forceinline__ float clamp8(float x) { return __builtin_amdgcn_fmed3f(x, -448.f, 448.f); }
__device__ __forceinline__ unsigned pk4_fp8(float a, float b, float c, float d) {
    int p = __builtin_amdgcn_cvt_pk_fp8_f32(clamp8(a), clamp8(b), 0, false); p = __builtin_amdgcn_cvt_pk_fp8_f32(clamp8(c), clamp8(d), p, true); return (unsigned)p; }
__device__ __forceinline__ int lane_id() { int l; asm volatile("v_mbcnt_lo_u32_b32 %0, -1, 0\n\tv_mbcnt_hi_u32_b32 %0, -1, %0" : "=v"(l)); return l; }
#define REFRESH_F(F) do { (F).lane = lane_id(); (F).tid = (F).wave * 64 + (F).lane; } while (0)
__device__ __forceinline__ float dpp_add(float v, const int ctrl_sel) {
    int r;
    switch (ctrl_sel) { case 0: r = __builtin_amdgcn_update_dpp(0, __float_as_int(v), 0xB1, 0xf, 0xf, true); break;
                        case 1: r = __builtin_amdgcn_update_dpp(0, __float_as_int(v), 0x4E, 0xf, 0xf, true); break;
                        case 2: r = __builtin_amdgcn_update_dpp(0, __float_as_int(v), 0x141, 0xf, 0xf, true); break;
                        default: r = __builtin_amdgcn_update_dpp(0, __float_as_int(v), 0x140, 0xf, 0xf, true); break; }
    return v + __int_as_float(r);
}
__device__ __forceinline__ float wave_sum(float v) {
    v = dpp_add(v, 0); v = dpp_add(v, 1); v = dpp_add(v, 2); v = dpp_add(v, 3);
    const float r0 = __int_as_float(__builtin_amdgcn_readlane(__float_as_int(v), 0)), r1 = __int_as_float(__builtin_amdgcn_readlane(__float_as_int(v), 16)),
                r2 = __int_as_float(__builtin_amdgcn_readlane(__float_as_int(v), 32)), r3 = __int_as_float(__builtin_amdgcn_readlane(__float_as_int(v), 48));
    return (r0 + r1) + (r2 + r3);
}

namespace pg8 {
#define PG8_LAS __attribute__((address_space(3)))
typedef unsigned short bf16_t;
constexpr int BM = 256, BK = 64, HALF = 128, HTB = HALF * BK * 2, STAGE_BYTES = 8 * HTB, NXCD = 8, WGM = 8;
__host__ __device__ __forceinline__ int lds_byte(int r, int c) { const int st = (r >> 4) * 2 + (c >> 5), rr = r & 15, cc = c & 31, ob = rr * 64 + cc * 2; return st * 1024 + (ob ^ (((ob >> 9) & 1) << 5)); }
__host__ __device__ __forceinline__ void stage_rc(int b, int& R, int& C) { const int st = b / 1024, sb = b % 1024, swz = sb ^ (((sb >> 9) & 1) << 5); R = (st >> 1) * 16 + swz / 64; C = (st & 1) * 32 + (swz % 64) / 2; }
__host__ __device__ __forceinline__ int perm32(int rho) { const int n = rho >> 4, i = rho & 15; return 8 * (i >> 2) + 4 * n + (i & 3); }
struct Unit { int pm, pn; };
struct Gemm { const bf16_t* A; const bf16_t* Bt; int M, N, K; };
struct StaticOrder {
    int nM, nN, nwg, G, c;
    __host__ __device__ void init(int M, int N, int G_, int c_) { nM = M / BM; nN = N / BM; nwg = nM * nN; G = G_; c = c_; }
    __host__ __device__ bool next(int i, Unit& u) const {
        const long L = (long)i * G + c; if (L >= nwg) return false;
        int wgid = (int)L; { const int q = nwg / NXCD, r = nwg % NXCD, xcd = wgid % NXCD, off = wgid / NXCD; wgid = (xcd < r ? xcd * (q + 1) : r * (q + 1) + (xcd - r) * q) + off; }
        const int nig = WGM * nN, gid = wgid / nig, fm = gid * WGM, gsz = (nM - fm) < WGM ? (nM - fm) : WGM;
        u.pm = fm + ((wgid % nig) % gsz); u.pn = (wgid % nig) / gsz; return true;
    }
    __device__ __forceinline__ void a_ready(const Unit&) const {}
    __device__ __forceinline__ void done(const Unit&) const {}
};
struct MoeOrder {
    int nM, nN, nwg, G, c, npe; int t1, t2, t3, t4, t5, t6, t7;
    __device__ bool next(int i, Unit& u) const {
        const long L = (long)i * G + c; if (L >= nwg) return false;
        int wgid = (int)L; { const int q = nwg / NXCD, r = nwg % NXCD, xcd = wgid % NXCD, off = wgid / NXCD; wgid = (xcd < r ? xcd * (q + 1) : r * (q + 1) + (xcd - r) * q) + off; }
        const int nig = WGM * nN, gid = wgid / nig, fm = gid * WGM, gsz = (nM - fm) < WGM ? (nM - fm) : WGM;
        const int pm = fm + ((wgid % nig) % gsz), pnl = (wgid % nig) / gsz;
        const int e = (pm >= t1) + (pm >= t2) + (pm >= t3) + (pm >= t4) + (pm >= t5) + (pm >= t6) + (pm >= t7);
        u.pm = pm; u.pn = e * npe + pnl; return true;
    }
    __device__ __forceinline__ void a_ready(const Unit&) const {}
    __device__ __forceinline__ void done(const Unit&) const {}
};


struct EpiQKV {
    static constexpr bool PERM = true, AFTER_DRAIN = false;
    bf16_t* O; const float* rope; float ascale;
    __device__ __forceinline__ void operator()(const f32x4 (&acc)[2][2][4][2], const Unit& u, int wr, int wc, int fr, int fq) const {
        const int row0 = u.pm * BM + wr * 64 + fr;
        const bool rope_on = (u.pm < (RL / BM)) && (u.pn < 5);
        const int axis = wc & 1;
        const int colb = u.pn * 256 + (wc >> 1) * 128 + axis * 64 + 8 * fq;
#pragma unroll
        for (int ai = 0; ai < 2; ++ai)
#pragma unroll
            for (int m = 0; m < 4; ++m) {
                const int r = row0 + ai * HALF + m * 16;
                f32x4 a0 = acc[ai][0][m][0] * ascale, a1 = acc[ai][0][m][1] * ascale, b0 = acc[ai][1][m][0] * ascale, b1 = acc[ai][1][m][1] * ascale;
                if (rope_on) {
                    const int t = r & (SEQ - 1); const int pos = axis ? (t & 63) : (t >> 6);
                    const float* cp = rope + pos * 32 + 8 * fq;
                    const f32x4 c0 = *(const f32x4*)cp, c1 = *(const f32x4*)(cp + 4), s0 = *(const f32x4*)(cp + 2048), s1 = *(const f32x4*)(cp + 2052);
                    const f32x4 o0 = a0 * c0 - b0 * s0, o1 = a1 * c1 - b1 * s1, q0 = b0 * c0 + a0 * s0, q1 = b1 * c1 + a1 * s1;
                    a0 = o0; a1 = o1; b0 = q0; b1 = q1;
                }
                bf16_t* rowp = O + (size_t)r * QKVD + colb;
                u32x4 w; w.x = cvtpk(a0[0], a0[1]); w.y = cvtpk(a0[2], a0[3]); w.z = cvtpk(a1[0], a1[1]); w.w = cvtpk(a1[2], a1[3]);
                *(u32x4*)rowp = w;
                u32x4 v; v.x = cvtpk(b0[0], b0[1]); v.y = cvtpk(b0[2], b0[3]); v.z = cvtpk(b1[0], b1[1]); v.w = cvtpk(b1[2], b1[3]);
                *(u32x4*)(rowp + 32) = v;
            }
    }
};
template <bool LN> struct EpiResid {
    static constexpr bool PERM = true, AFTER_DRAIN = false;
    const float* xin_lat; const float* xin_ctx; bf16_t* y; const float* gate; float ascale; const f32x2* st; const float* lng; const float* lnb;
    __device__ __forceinline__ void operator()(const f32x4 (&acc)[2][2][4][2], const Unit& u, int wr, int wc, int fr, int fq) const {
        const bool lat = u.pm < (RL / BM);
        const int b = lat ? (u.pm >> 4) : 8;
        const int row0 = u.pm * BM + wr * 64 + fr, col0 = u.pn * BM + wc * 32 + 8 * fq;
        const float* xin = lat ? xin_lat + (size_t)row0 * DM : xin_ctx + (size_t)(row0 - RL) * DM;
        f32x2 sv[2][4];
        if constexpr (LN) {
#pragma unroll
            for (int ai = 0; ai < 2; ++ai)
#pragma unroll
                for (int m = 0; m < 4; ++m) sv[ai][m] = st[row0 + ai * HALF + m * 16];
        }
#pragma unroll
        for (int bj = 0; bj < 2; ++bj) { const int cc = col0 + bj * HALF;
            const f32x4 g0 = *(const f32x4*)(gate + (size_t)b * 6144 + cc) * ascale, g1 = *(const f32x4*)(gate + (size_t)b * 6144 + cc + 4) * ascale;
            f32x4 lg0, lg1, lb0, lb1; if constexpr (LN) { lg0 = *(const f32x4*)(lng + cc) * ALPHA; lg1 = *(const f32x4*)(lng + cc + 4) * ALPHA; lb0 = *(const f32x4*)(lnb + cc) * ALPHA; lb1 = *(const f32x4*)(lnb + cc + 4) * ALPHA; }
#pragma unroll
            for (int ai = 0; ai < 2; ++ai)
#pragma unroll
                for (int m = 0; m < 4; ++m) { const int rr = ai * HALF + m * 16; f32x4 x0, x1;
                    if constexpr (LN) { const u32x4 w = *(const u32x4*)(y + (size_t)(row0 + rr) * DM + cc);
                        x0 = (f32x4){bflo(w.x), bfhi(w.x), bflo(w.y), bfhi(w.y)}; x1 = (f32x4){bflo(w.z), bfhi(w.z), bflo(w.w), bfhi(w.w)};
                        x0 = (x0 - sv[ai][m].x) * sv[ai][m].y * lg0 + lb0; x1 = (x1 - sv[ai][m].x) * sv[ai][m].y * lg1 + lb1; }
                    else { x0 = *(const f32x4*)(xin + (size_t)rr * DM + cc) * ALPHA; x1 = *(const f32x4*)(xin + (size_t)rr * DM + cc + 4) * ALPHA; }
                    const f32x4 o0 = x0 + g0 * acc[ai][bj][m][0], o1 = x1 + g1 * acc[ai][bj][m][1];
                    u32x4 w; w.x = cvtpk(o0[0], o0[1]); w.y = cvtpk(o0[2], o0[3]); w.z = cvtpk(o1[0], o1[1]); w.w = cvtpk(o1[2], o1[3]);
                    *(u32x4*)(y + (size_t)(row0 + rr) * DM + cc) = w; }
            asm volatile("" ::: "memory"); }
    }
};
struct EpiSwiGLU {
    static constexpr bool PERM = true, AFTER_DRAIN = false;
    bf16_t* O; int npe;
    __device__ __forceinline__ void operator()(const f32x4 (&acc)[2][2][4][2], const Unit& u, int wr, int wc, int fr, int fq) const {
        const int row0 = u.pm * BM + wr * 64 + fr, pnl = u.pn % npe, col0 = pnl * 128 + wc * 32 + 8 * fq;
#pragma unroll
        for (int ai = 0; ai < 2; ++ai)
#pragma unroll
            for (int m = 0; m < 4; ++m) {
                unsigned w[4];
#pragma unroll
                for (int n = 0; n < 2; ++n) { const f32x4 g = acc[ai][0][m][n], uu = acc[ai][1][m][n]; float o[4];
#pragma unroll
                    for (int j = 0; j < 4; ++j) o[j] = g[j] * sigm(g[j]) * uu[j];
                    w[2 * n] = cvtpk(o[0], o[1]); w[2 * n + 1] = cvtpk(o[2], o[3]); }
                u32x4 ww; ww.x = w[0]; ww.y = w[1]; ww.z = w[2]; ww.w = w[3];
                *(u32x4*)(O + (size_t)(row0 + ai * HALF + m * 16) * DFF + col0) = ww;
            }
    }
};
struct EpiLruIn {
    static constexpr bool PERM = true, AFTER_DRAIN = false;
    bf16_t* G; bf16_t* XB;
    __device__ __forceinline__ void operator()(const f32x4 (&acc)[2][2][4][2], const Unit& u, int wr, int wc, int fr, int fq) const {
        const int row0 = u.pm * BM + wr * 64 + fr; const bool isg = u.pn < 4;
        bf16_t* base = isg ? G : XB; const int col0 = (u.pn & 3) * BM + wc * 32 + 8 * fq;
#pragma unroll
        for (int ai = 0; ai < 2; ++ai)
#pragma unroll
            for (int m = 0; m < 4; ++m)
#pragma unroll
                for (int bj = 0; bj < 2; ++bj) {
                    f32x4 v0 = acc[ai][bj][m][0], v1 = acc[ai][bj][m][1];
                    if (isg) {
#pragma unroll
                        for (int j = 0; j < 4; ++j) { float x = v0[j]; float z = 0.7978845608028654f * (x + 0.044715f * x * x * x); v0[j] = x * sigm(2.0f * z);
                            x = v1[j]; z = 0.7978845608028654f * (x + 0.044715f * x * x * x); v1[j] = x * sigm(2.0f * z); }
                    }
                    u32x4 w; w.x = cvtpk(v0[0], v0[1]); w.y = cvtpk(v0[2], v0[3]); w.z = cvtpk(v1[0], v1[1]); w.w = cvtpk(v1[2], v1[3]);
                    *(u32x4*)(base + (size_t)(row0 + ai * HALF + m * 16) * DM + col0 + bj * HALF) = w;
                }
    }
};
struct EpiMoeOut {
    static constexpr bool PERM = true, AFTER_DRAIN = false;
    bf16_t* O; const float* wrow;
    __device__ __forceinline__ void operator()(const f32x4 (&acc)[2][2][4][2], const Unit& u, int wr, int wc, int fr, int fq) const {
        const int row0 = u.pm * BM + wr * 64 + fr, col0 = (u.pn & 3) * BM + wc * 32 + 8 * fq;
#pragma unroll
        for (int ai = 0; ai < 2; ++ai)
#pragma unroll
            for (int m = 0; m < 4; ++m) { const int r = row0 + ai * HALF + m * 16; const float g = wrow[r];
#pragma unroll
                for (int bj = 0; bj < 2; ++bj) { const f32x4 v0 = acc[ai][bj][m][0] * g, v1 = acc[ai][bj][m][1] * g;
                    u32x4 w; w.x = cvtpk(v0[0], v0[1]); w.y = cvtpk(v0[2], v0[3]); w.z = cvtpk(v1[0], v1[1]); w.w = cvtpk(v1[2], v1[3]);
                    *(u32x4*)(O + (size_t)r * DM + col0 + bj * HALF) = w; } }
    }
};

struct EpiSwiGLU8 {
    static constexpr bool PERM = true, AFTER_DRAIN = false;
    unsigned char* O; int npe;
    __device__ __forceinline__ void operator()(const f32x4 (&acc)[2][2][4][2], const Unit& u, int wr, int wc, int fr, int fq) const {
        const int row0 = u.pm * BM + wr * 64 + fr, pnl = u.pn % npe, col0 = pnl * 128 + wc * 32 + 8 * fq;
        constexpr float C1 = -LOG2E / 512.0f, KK = 32768.0f;
#pragma unroll
        for (int ai = 0; ai < 2; ++ai)
#pragma unroll
            for (int m = 0; m < 4; ++m) {
                u32x2 w;
#pragma unroll
                for (int n = 0; n < 2; ++n) { const f32x4 g = acc[ai][0][m][n], uu = acc[ai][1][m][n];
                    const f32x2 g0 = __builtin_shufflevector(g, g, 0, 1), g1 = __builtin_shufflevector(g, g, 2, 3), u0 = __builtin_shufflevector(uu, uu, 0, 1), u1 = __builtin_shufflevector(uu, uu, 2, 3);
                    const f32x2 t0 = g0 * C1, t1 = g1 * C1;
                    const f32x2 e0 = (f32x2){ex2(t0.x), ex2(t0.y)}, e1 = (f32x2){ex2(t1.x), ex2(t1.y)};
                    const f32x2 d0 = e0 * KK + KK, d1 = e1 * KK + KK;
                    const f32x2 o0 = (g0 * u0) * (f32x2){rcpf_(d0.x), rcpf_(d0.y)}, o1 = (g1 * u1) * (f32x2){rcpf_(d1.x), rcpf_(d1.y)};
                    w[n] = pk4_fp8(o0.x, o0.y, o1.x, o1.y); }
                *(u32x2*)(O + (size_t)(row0 + ai * HALF + m * 16) * DFF + col0) = w;
            }
    }
};
struct EpiMoeOut8 {
    static constexpr bool PERM = true, AFTER_DRAIN = false;
    bf16_t* O; const float* wrow;
    __device__ __forceinline__ void operator()(const f32x4 (&acc)[2][2][4][2], const Unit& u, int wr, int wc, int fr, int fq) const {
        const int row0 = u.pm * BM + wr * 64 + fr, col0 = (u.pn & 3) * BM + wc * 32 + 8 * fq;
#pragma unroll
        for (int ai = 0; ai < 2; ++ai)
#pragma unroll
            for (int m = 0; m < 4; ++m) { const int r = row0 + ai * HALF + m * 16; const float g = wrow[r] * (1.0f / 4096.0f);
#pragma unroll
                for (int bj = 0; bj < 2; ++bj) { const f32x4 v0 = acc[ai][bj][m][0] * g, v1 = acc[ai][bj][m][1] * g;
                    u32x4 w; w.x = cvtpk(v0[0], v0[1]); w.y = cvtpk(v0[2], v0[3]); w.z = cvtpk(v1[0], v1[1]); w.w = cvtpk(v1[2], v1[3]);
                    *(u32x4*)(O + (size_t)r * DM + col0 + bj * HALF) = w; } }
    }
};

template <class Epi, class Sched, bool ALIGN_EPI = false, bool SP2 = false, bool FP8 = false>
__device__ __forceinline__ void gemm_phase(PG8_LAS unsigned char* lds, const Gemm g, const Sched& S, const Epi& E, const int wid) {
    const int lane = lane_id(), tid = wid * 64 + lane, wr = wid >> 2, wc = wid & 3, fr = lane & 15, fq = lane >> 4;
    const int K = g.K, nt = K / BK;
    unsigned voffA[2], voffB[2];
#pragma unroll
    for (int i = 0; i < 2; ++i) { int R, C; stage_rc(tid * 16 + i * 8192, R, C); const int Rb = Epi::PERM ? ((R & ~31) + perm32(R & 31)) : R;
        voffA[i] = (unsigned)(R * K + C) * 2u; voffB[i] = (unsigned)(Rb * K + C) * 2u; }
    const unsigned kstep = (unsigned)(BK * 2);
    const unsigned hstep = (unsigned)HALF * K * 2;
    const unsigned tstep = 2 * hstep;
    const __amdgpu_buffer_rsrc_t rs_voffA = __builtin_amdgcn_make_buffer_rsrc((void*)g.A, 0, -1, 0x00020000), rs_voffB = __builtin_amdgcn_make_buffer_rsrc((void*)g.Bt, 0, -1, 0x00020000);
    const unsigned ldsw = (unsigned)wid * 1024u;
    const int aoff = lds_byte(wr * 64 + fr, fq * 8), boff = lds_byte(wc * 32 + fr, fq * 8);
#define PG8_SA(b, h) (((b) * 2 + (h)) * HTB)
#define PG8_SB(b, h) ((4 + (b) * 2 + (h)) * HTB)
#define PG8_STAGE(bufoff, gbase, voff) do { _Pragma("unroll") for (int _i = 0; _i < 2; ++_i) \
        __builtin_amdgcn_raw_ptr_buffer_load_lds(rs_##voff, (PG8_LAS void*)(lds + (bufoff) + ldsw + _i * 8192), 16, (voff)[_i], (gbase), 0, 0); } while (0)
#define PG8_LDA(dst, b, h) do { if constexpr (FP8) { _Pragma("unroll") for (int m = 0; m < 4; ++m) { const v4i _l = *(const PG8_LAS v4i*)(lds + PG8_SA(b, h) + aoff + m * 2048), _h = *(const PG8_LAS v4i*)(lds + PG8_SA(b, h) + aoff + m * 2048 + 1024); \
            dst##8[m] = __builtin_shufflevector(_l, _h, 0, 1, 2, 3, 4, 5, 6, 7); } } \
        else { _Pragma("unroll") for (int m = 0; m < 4; ++m) _Pragma("unroll") for (int k = 0; k < 2; ++k) dst[m][k] = *(const PG8_LAS bf16x8*)(lds + PG8_SA(b, h) + aoff + m * 2048 + k * 1024); } } while (0)
#define PG8_LDB(dst, b, h) do { if constexpr (FP8) { _Pragma("unroll") for (int n = 0; n < 2; ++n) { const v4i _l = *(const PG8_LAS v4i*)(lds + PG8_SB(b, h) + boff + n * 2048), _h = *(const PG8_LAS v4i*)(lds + PG8_SB(b, h) + boff + n * 2048 + 1024); \
            dst##8[n] = __builtin_shufflevector(_l, _h, 0, 1, 2, 3, 4, 5, 6, 7); } } \
        else { _Pragma("unroll") for (int n = 0; n < 2; ++n) _Pragma("unroll") for (int k = 0; k < 2; ++k) dst[n][k] = *(const PG8_LAS bf16x8*)(lds + PG8_SB(b, h) + boff + n * 2048 + k * 1024); } } while (0)
#define PG8_MMA(ai, bj, At, Bt) do { if constexpr (FP8) __builtin_amdgcn_sched_barrier(0); __builtin_amdgcn_s_setprio(1); \
        if constexpr (FP8) { _Pragma("unroll") for (int m = 0; m < 4; ++m) _Pragma("unroll") for (int n = 0; n < 2; ++n) \
            acc[ai][bj][m][n] = __builtin_amdgcn_mfma_scale_f32_16x16x128_f8f6f4(Bt##8[n], At##8[m], acc[ai][bj][m][n], 0, 0, 0, 0, 0, 0); } \
        else { _Pragma("unroll") for (int m = 0; m < 4; ++m) _Pragma("unroll") for (int n = 0; n < 2; ++n) _Pragma("unroll") for (int k = 0; k < 2; ++k) \
            acc[ai][bj][m][n] = __builtin_amdgcn_mfma_f32_16x16x32_bf16(Bt[n][k], At[m][k], acc[ai][bj][m][n], 0, 0, 0); } \
        __builtin_amdgcn_s_setprio(0); if constexpr (FP8) __builtin_amdgcn_sched_barrier(0); } while (0)
#define PG8_WAIT_V(n) asm volatile("s_waitcnt vmcnt(" #n ")" ::: "memory")
#define PG8_WAIT_L(n) asm volatile("s_waitcnt lgkmcnt(" #n ")" ::: "memory")
#define PG8_BAR __builtin_amdgcn_s_barrier()
#define PG8_SCHED __builtin_amdgcn_sched_barrier(0)
    Unit cur, nxt; int ui = 0;
    if (!S.next(0, cur)) return;
    f32x4 acc[2][2][4][2];
#pragma unroll
    for (int a = 0; a < 2; ++a)
#pragma unroll
        for (int b = 0; b < 2; ++b)
#pragma unroll
            for (int m = 0; m < 4; ++m)
#pragma unroll
                for (int n = 0; n < 2; ++n) acc[a][b][m][n] = (f32x4){0.f, 0.f, 0.f, 0.f};
    bf16x8 At[4][2], B0[2][2], B1[2][2]; v8i At8[4], B08[2], B18[2];
    unsigned cA = (unsigned)cur.pm * tstep, cB = (unsigned)cur.pn * tstep;
    S.a_ready(cur);
    if constexpr (SP2) {
        PG8_STAGE(PG8_SB(0, 0), cB, voffB); PG8_STAGE(PG8_SB(0, 1), cB + hstep, voffB); PG8_STAGE(PG8_SA(0, 0), cA, voffA); PG8_STAGE(PG8_SA(0, 1), cA + hstep, voffA);
        if (wr == 1) PG8_BAR;
        PG8_WAIT_V(2); PG8_BAR;
        PG8_STAGE(PG8_SB(1, 0), cB + kstep, voffB); PG8_STAGE(PG8_SA(1, 0), cA + kstep, voffA); PG8_STAGE(PG8_SB(1, 1), cB + hstep + kstep, voffB);
        PG8_WAIT_V(6); PG8_BAR;
    } else {
        PG8_STAGE(PG8_SB(0, 0), cB, voffB); PG8_STAGE(PG8_SA(0, 0), cA, voffA); PG8_STAGE(PG8_SB(0, 1), cB + hstep, voffB); PG8_STAGE(PG8_SA(0, 1), cA + hstep, voffA);
        if (wr == 1) PG8_BAR;
        PG8_WAIT_V(4); PG8_BAR;
        PG8_STAGE(PG8_SB(1, 0), cB + kstep, voffB); PG8_STAGE(PG8_SA(1, 0), cA + kstep, voffA); PG8_STAGE(PG8_SB(1, 1), cB + hstep + kstep, voffB);
        PG8_WAIT_V(6); PG8_BAR;
    }
    for (;;) {
        const bool has_next = S.next(ui + 1, nxt);
        const unsigned nA = has_next ? (unsigned)nxt.pm * tstep : cA, nB = has_next ? (unsigned)nxt.pn * tstep : cB;
        _Pragma("clang loop unroll(disable)") for (int t = 0; t < nt; t += 2) {
            const bool last = (t == nt - 2);
            const unsigned a1 = cA + (unsigned)(t + 1) * kstep;
            const unsigned a2 = last ? nA : cA + (unsigned)(t + 2) * kstep, b2 = last ? nB : cB + (unsigned)(t + 2) * kstep;
            const unsigned a3 = a2 + kstep, b3 = b2 + kstep;
            if (last && has_next) S.a_ready(nxt);
            if constexpr (SP2) {
            PG8_LDB(B0, 0, 0); PG8_LDB(B1, 0, 1); PG8_SCHED; PG8_LDA(At, 0, 0); PG8_STAGE(PG8_SA(1, 1), a1 + hstep, voffA);
            PG8_WAIT_V(8); PG8_WAIT_L(0); PG8_BAR; PG8_MMA(0, 0, At, B0); PG8_MMA(0, 1, At, B1); PG8_BAR; PG8_SCHED;
            PG8_LDA(At, 0, 1); PG8_STAGE(PG8_SB(0, 0), b2, voffB); PG8_STAGE(PG8_SB(0, 1), b2 + hstep, voffB); PG8_STAGE(PG8_SA(0, 0), a2, voffA);
            PG8_WAIT_V(8); PG8_WAIT_L(0); PG8_BAR; PG8_MMA(1, 0, At, B0); PG8_MMA(1, 1, At, B1); PG8_BAR; PG8_SCHED;
            PG8_LDB(B0, 1, 0); PG8_LDB(B1, 1, 1); PG8_SCHED; PG8_LDA(At, 1, 0); PG8_STAGE(PG8_SA(0, 1), a2 + hstep, voffA);
            PG8_WAIT_V(8); PG8_WAIT_L(0); PG8_BAR; PG8_MMA(0, 0, At, B0); PG8_MMA(0, 1, At, B1); PG8_BAR; PG8_SCHED;
            PG8_LDA(At, 1, 1); PG8_STAGE(PG8_SB(1, 0), b3, voffB); PG8_STAGE(PG8_SB(1, 1), b3 + hstep, voffB); PG8_STAGE(PG8_SA(1, 0), a3, voffA);
            PG8_WAIT_V(8); PG8_WAIT_L(0); PG8_BAR; PG8_MMA(1, 0, At, B0); PG8_MMA(1, 1, At, B1); PG8_BAR; PG8_SCHED;
            } else {
            PG8_LDB(B0, 0, 0); PG8_SCHED; PG8_LDA(At, 0, 0); PG8_STAGE(PG8_SA(1, 1), a1 + hstep, voffA);
            PG8_WAIT_L(8); PG8_BAR; PG8_WAIT_L(0); PG8_MMA(0, 0, At, B0); PG8_BAR; PG8_SCHED;
            PG8_LDB(B1, 0, 1); PG8_STAGE(PG8_SB(0, 0), b2, voffB);
            PG8_BAR; PG8_WAIT_L(0); PG8_MMA(0, 1, At, B1); PG8_BAR;
            PG8_LDA(At, 0, 1); PG8_STAGE(PG8_SA(0, 0), a2, voffA);
            PG8_BAR; PG8_WAIT_L(0); PG8_MMA(1, 0, At, B0); PG8_BAR; PG8_SCHED;
            PG8_STAGE(PG8_SB(0, 1), b2 + hstep, voffB);
            PG8_WAIT_V(6); PG8_BAR; PG8_MMA(1, 1, At, B1); PG8_BAR;
            PG8_LDB(B0, 1, 0); PG8_SCHED; PG8_LDA(At, 1, 0); PG8_STAGE(PG8_SA(0, 1), a2 + hstep, voffA);
            PG8_WAIT_L(8); PG8_BAR; PG8_WAIT_L(0); PG8_MMA(0, 0, At, B0); PG8_BAR; PG8_SCHED;
            PG8_LDB(B1, 1, 1); PG8_STAGE(PG8_SB(1, 0), b3, voffB);
            PG8_BAR; PG8_WAIT_L(0); PG8_MMA(0, 1, At, B1); PG8_BAR;
            PG8_LDA(At, 1, 1); PG8_STAGE(PG8_SA(1, 0), a3, voffA);
            PG8_BAR; PG8_WAIT_L(0); PG8_MMA(1, 0, At, B0); PG8_BAR; PG8_SCHED;
            PG8_STAGE(PG8_SB(1, 1), b3 + hstep, voffB);
            PG8_WAIT_V(6); PG8_BAR; PG8_MMA(1, 1, At, B1); PG8_BAR;
            }
        }
        if constexpr (ALIGN_EPI) { if (wr == 0) PG8_BAR; }
        if constexpr (!Epi::AFTER_DRAIN) { int le = lane_id();
            E(acc, cur, wr, wc, le & 15, le >> 4); S.done(cur); }
        if (!has_next) break;
#pragma unroll
        for (int a = 0; a < 2; ++a)
#pragma unroll
            for (int b = 0; b < 2; ++b)
#pragma unroll
                for (int m = 0; m < 4; ++m)
#pragma unroll
                    for (int n = 0; n < 2; ++n) acc[a][b][m][n] = (f32x4){0.f, 0.f, 0.f, 0.f};
        cur = nxt; cA = nA; cB = nB; ++ui;
        if constexpr (ALIGN_EPI) { if (wr == 1) PG8_BAR; }
    }
    PG8_WAIT_V(0);
    if constexpr (!ALIGN_EPI) { if (wr == 0) PG8_BAR; }
    PG8_BAR;
    if constexpr (Epi::AFTER_DRAIN) { E.fused(acc, cur, wr, wc, fr, fq, lds, wid, lane); S.done(cur); }
#undef PG8_SA
#undef PG8_SB
#undef PG8_STAGE
#undef PG8_LDA
#undef PG8_LDB
#undef PG8_MMA
#undef PG8_WAIT_V
#undef PG8_WAIT_L
#undef PG8_BAR
#undef PG8_SCHED
}
}

constexpr size_t MiB = 1u << 20;
constexpr size_t WS_CTL = 0, CTL_ZERO_BYTES = 65536;
constexpr size_t WS_MOD = 65536;
constexpr size_t WS_ROPE = 65536 + 458752;
constexpr size_t WS_WQKV = 1 * MiB, WS_WO = 4 * MiB, WS_WGU = 6 * MiB, WS_WDN = 20 * MiB, WS_WIN = 27 * MiB, WS_WOUT = 31 * MiB, WS_WLG = 33 * MiB;
constexpr size_t WS_WMGU = 34 * MiB, WS_WMDN = 146 * MiB;
constexpr size_t WS_YB = 760 * MiB;
constexpr size_t WS_H = 210 * MiB;
constexpr size_t WS_ACTV = 278 * MiB;
constexpr size_t WS_QKV = WS_ACTV, WS_O = WS_ACTV + 102 * MiB, WS_ACT = WS_ACTV + 170 * MiB;
constexpr size_t WS_G = WS_ACTV, WS_XB = WS_ACTV + 68 * MiB, WS_HF = WS_ACTV + 136 * MiB, WS_HH = WS_ACTV + 200 * MiB;
constexpr size_t WS_U = WS_ACTV + 264 * MiB;
constexpr size_t WS_HS = WS_ACTV, WS_FO = WS_ACTV + 68 * MiB, WS_MACT = WS_ACTV + 200 * MiB;
constexpr size_t WS_ROUTE = 872 * MiB;
constexpr size_t WS_LRUS = 874 * MiB;
constexpr size_t WS_END = 875 * MiB;
constexpr int MOE_MAXT = 264;
constexpr size_t RT_EIDX = 0, RT_WGT = 262144, RT_SLOT = 524288, RT_WS = 786432, RT_CNT = 786432 + 270336 + 0;
constexpr size_t LS_SUM = 0, LS_CTX = 524288;
constexpr size_t WS_STATS = WS_LRUS + 655360;

constexpr int RING_OFF = 0, RING_BYTES = 135168;
constexpr int LDSCTL_OFF = RING_BYTES, MISC_OFF = LDSCTL_OFF + 320;
constexpr int LDS_BYTES = 136192;

#define RLX_AGENT __ATOMIC_RELAXED, __HIP_MEMORY_SCOPE_AGENT
#define LDS_WAIT() asm volatile("s_waitcnt lgkmcnt(0)" ::: "memory")
#define VM_WAIT() asm volatile("s_waitcnt vmcnt(0)" ::: "memory")
#define XB_TMO      128
#define XB_XCNT(j)  (256  + 64 * (j))
#define XB_XSUB(j)  (1280 + 64 * (j))
#define XB_XGEN(j)  (2304 + 64 * (j))
#define XB_TOP      3328
#define XB_TOPGEN   3392
#define XCD_BAR_WORDS 3456
#define XB_SPIN_CAP (1u << 18)

__device__ __forceinline__ unsigned xb_ld(unsigned* p)              { return __hip_atomic_load(p, __ATOMIC_RELAXED, __HIP_MEMORY_SCOPE_AGENT); }
__device__ __forceinline__ unsigned xb_add(unsigned* p, unsigned v) { return __hip_atomic_fetch_add(p, v, __ATOMIC_RELAXED, __HIP_MEMORY_SCOPE_AGENT); }
__device__ __forceinline__ unsigned xb_xcc_id() { return (unsigned)__builtin_amdgcn_s_getreg((3 << 11) | 20) & 0xFu; }
#define XB_SPIN(cond, bar) do { unsigned _sp = 0; while (cond) { __builtin_amdgcn_s_sleep(1); \
    if ((++_sp & 255u) == 0u) { if (xb_ld(&(bar)[XB_TMO])) break; if (_sp > XB_SPIN_CAP) { atomicAdd(&(bar)[XB_TMO], 1u); break; } } } } while (0)

struct XcdBarrier {
    unsigned* bar; unsigned x;
    volatile LAS unsigned* st;
};

__device__ __forceinline__ XcdBarrier xcd_barrier_post(unsigned* bar, volatile LAS unsigned* st, const bool t0  ) {
    XcdBarrier b; b.bar = bar; b.x = xb_xcc_id(); b.st = st;
    if (t0) (void)xb_add(&bar[XB_XCNT(b.x)], 1u);
    return b;
}
__device__ __forceinline__ void xcd_barrier_complete(unsigned* bar, unsigned x, unsigned& nloc, unsigned& nx) {
    const unsigned G = gridDim.x * gridDim.y * gridDim.z;
    unsigned sum, cnt, mine, sp = 0u;
    for (;;) {
        sum = 0u; cnt = 0u; mine = 0u;
#pragma unroll
        for (unsigned j = 0; j < 16; ++j) { const unsigned c = xb_ld(&bar[XB_XCNT(j)]); sum += c; cnt += (c > 0u) ? 1u : 0u; mine = (j == x) ? c : mine; }
        if (sum == G) break;
        __builtin_amdgcn_s_sleep(1);
        if ((++sp & 255u) == 0u) { if (xb_ld(&bar[XB_TMO])) break; if (sp > XB_SPIN_CAP) { atomicAdd(&bar[XB_TMO], 1u); break; } }
    }
    nloc = mine > 0u ? mine : 1u; nx = cnt > 0u ? cnt : 1u;
}

__device__ __forceinline__ void xcd_barrier(const XcdBarrier& b, const bool t0  ) {
    asm volatile("s_waitcnt vmcnt(0)" ::: "memory");
    __syncthreads();
    if (t0) {
        unsigned* bar = b.bar;
        __builtin_amdgcn_s_waitcnt(0);
        unsigned nloc = b.st[0], nx = b.st[1];
        if (nloc == 0u) { xcd_barrier_complete(bar, b.x, nloc, nx); b.st[0] = nloc; b.st[1] = nx; }
        const unsigned old = xb_add(&bar[XB_XSUB(b.x)], 1u);
        const unsigned gen = old / nloc;
        if (old + 1u == (gen + 1u) * nloc) {
            __builtin_amdgcn_fence(__ATOMIC_RELEASE, "agent");
            asm volatile("s_waitcnt vmcnt(0)" ::: "memory");
            const unsigned og = xb_add(&bar[XB_TOP], 1u);
            const unsigned tg = og / nx;
            if (og + 1u == (tg + 1u) * nx) xb_add(&bar[XB_TOPGEN], 1u);
            else XB_SPIN(xb_ld(&bar[XB_TOPGEN]) == tg, bar);
            __builtin_amdgcn_fence(__ATOMIC_ACQUIRE, "agent");
            xb_add(&bar[XB_XGEN(b.x)], 1u);
            asm volatile("s_waitcnt vmcnt(0)" ::: "memory");
        } else {
            XB_SPIN(xb_ld(&bar[XB_XGEN(b.x)]) == gen, bar);
            __builtin_amdgcn_fence(__ATOMIC_ACQUIRE, "agent");
            asm volatile("s_waitcnt vmcnt(0)" ::: "memory");
        }
    }
    __syncthreads();
}


struct Frame {
    LAS unsigned char* lds;
    volatile LAS unsigned* MISC;
    int tid, lane, wave, vcu, G;
    const float *x, *c, *ctx, *cctx, *w_mod, *b_mod, *ln_g, *ln_b, *w_qkv, *w_o, *sink, *w_gu, *w_dn, *w_in, *conv_w, *conv_b, *lam, *w_r, *b_r, *w_i, *b_i, *w_out, *router, *mw_gu, *mw_dn;
    float* out; unsigned char* ws;
};
#define WSP(T, off) ((T*)(F.ws + (off)))

__device__ __forceinline__ void p0_mod_task(Frame& F, int task) {
    const int li = task / 96, cb = task % 96;
    LAS float* S = (LAS float*)F.lds;
    LAS float* red = (LAS float*)(F.lds + 36864);
    for (int idx = F.tid; idx < 9 * 1024; idx += NWAVES * 64) { const int b = idx >> 10, k = idx & 1023; const float v = (b < 8) ? F.c[b * 1024 + k] : F.cctx[k]; S[idx] = v * sigm(v); }
    __syncthreads();
    const float* W = F.w_mod + (size_t)li * 1024 * 6144 + cb * 64;
    const int cl = F.lane & 15, kr = F.lane >> 4;
    f32x4 acc[9];
#pragma unroll
    for (int b = 0; b < 9; ++b) acc[b] = (f32x4){0.f, 0.f, 0.f, 0.f};
#pragma unroll 4
    for (int kk = 0; kk < 32; ++kk) { const int k = 128 * F.wave + 4 * kk + kr; const f32x4 wv = *(const f32x4*)(W + (size_t)k * 6144 + 4 * cl);
#pragma unroll
        for (int b = 0; b < 9; ++b) acc[b] += wv * S[b * 1024 + k]; }
#pragma unroll
    for (int b = 0; b < 9; ++b)
#pragma unroll
        for (int j = 0; j < 4; ++j) { float v = acc[b][j]; v += __shfl_xor(v, 16); v += __shfl_xor(v, 32); acc[b][j] = v; }
    if (kr == 0) {
#pragma unroll
        for (int b = 0; b < 9; ++b) *(LAS f32x4*)(red + (F.wave * 9 + b) * 64 + 4 * cl) = acc[b]; }
    __syncthreads();
    float* mod = WSP(float, WS_MOD);
    for (int idx = F.tid; idx < 9 * 64; idx += NWAVES * 64) { const int b = idx >> 6, col = idx & 63; float s = 0.f;
#pragma unroll
        for (int w = 0; w < 8; ++w) s += red[(w * 9 + b) * 64 + col];
        mod[(size_t)(li * 9 + b) * 6144 + cb * 64 + col] = s + F.b_mod[li * 6144 + cb * 64 + col]; }
    __syncthreads();
}
__device__ __forceinline__ void p0_transpose_item(const float* W, int K, int N, bf16* WT, int kb, int n0, int drow0, LAS float* scr, int lane) {
    const int k0 = 64 * kb;
#pragma unroll
    for (int i = 0; i < 8; ++i) { const int kk = 8 * i + (lane >> 3); const f32x4 wv = *(const f32x4*)(W + (size_t)(k0 + kk) * N + n0 + 4 * (lane & 7));
        LAS float* d = scr + kk * 33 + 4 * (lane & 7); d[0] = wv[0]; d[1] = wv[1]; d[2] = wv[2]; d[3] = wv[3]; }
    LDS_WAIT(); asm volatile("" ::: "memory");
    const int c = lane & 7;
#pragma unroll
    for (int j = 0; j < 4; ++j) { const int n = (lane >> 3) + 8 * j; const LAS float* s = scr + (8 * c) * 33 + n;
        u32x4 o; o.x = cvtpk(s[0 * 33], s[1 * 33]); o.y = cvtpk(s[2 * 33], s[3 * 33]); o.z = cvtpk(s[4 * 33], s[5 * 33]); o.w = cvtpk(s[6 * 33], s[7 * 33]);
        *(GAS u32x4*)(WT + (size_t)(drow0 + n) * K + k0 + 8 * c) = o; }
    LDS_WAIT(); asm volatile("" ::: "memory");
}
template <int QS> __device__ __forceinline__ void p0_transpose_item8(const float* W, int K, int N, unsigned char* WT, int kb, int n0, int drow0, LAS float* scr, int lane) {
    const int k0 = 64 * kb; constexpr float qs = (float)(1 << QS);
#pragma unroll
    for (int i = 0; i < 8; ++i) { const int kk = 8 * i + (lane >> 3); const f32x4 wv = *(const f32x4*)(W + (size_t)(k0 + kk) * N + n0 + 4 * (lane & 7)) * qs;
        LAS float* d = scr + kk * 33 + 4 * (lane & 7); d[0] = wv[0]; d[1] = wv[1]; d[2] = wv[2]; d[3] = wv[3]; }
    LDS_WAIT(); asm volatile("" ::: "memory");
    const int c = lane & 7;
#pragma unroll
    for (int j = 0; j < 4; ++j) { const int n = (lane >> 3) + 8 * j; const LAS float* s = scr + (8 * c) * 33 + n;
        u32x2 o; o.x = pk4_fp8(s[0 * 33], s[1 * 33], s[2 * 33], s[3 * 33]); o.y = pk4_fp8(s[4 * 33], s[5 * 33], s[6 * 33], s[7 * 33]);
        *(GAS u32x2*)(WT + (size_t)(drow0 + n) * K + k0 + 8 * c) = o; }
    LDS_WAIT(); asm volatile("" ::: "memory");
}
__device__ __forceinline__ int gu_row(int j) { const int isu = j >= DFF, jj = isu ? j - DFF : j; return (jj >> 7) * 256 + isu * 128 + (jj & 127); }
__device__ __forceinline__ int qkv_row(int L) { const int pn = L >> 8, rem = L & 255, hsel = rem >> 7, axis = (rem >> 6) & 1, half = (rem >> 5) & 1, x = rem & 31; return pn * 256 + 128 * half + 32 * (2 * hsel + axis) + x; }

__device__ __forceinline__ void p0_prologue(Frame& F) {
    for (int task = F.vcu; task < 192; task += F.G) p0_mod_task(F, task);
    if (F.vcu == F.G - 1) {
        float* rope = WSP(float, WS_ROPE);
        for (int idx = F.tid; idx < 2048; idx += NWAVES * 64) { const int pos = idx >> 5, i = idx & 31;
            const double freq = exp2(-(double)i * (13.287712379549449 / 32.0));
            const float ang = (float)pos * (float)freq;
            double rev = (double)ang * 0.15915494309189535; rev -= floor(rev);
            rope[idx] = __builtin_amdgcn_cosf((float)rev); rope[2048 + idx] = __builtin_amdgcn_sinf((float)rev); }
    }
    LAS float* scr = (LAS float*)(F.lds + F.wave * 8704);
    const int gw = F.vcu * NWAVES + F.wave, NGW = F.G * NWAVES;
    constexpr int I_QKV = 16 * 48;
    for (int r = gw; r < I_QKV; r += NGW) { const int kb = r / 48, n0 = (r % 48) * 32; p0_transpose_item8<7>(F.w_qkv, 1024, 1536, WSP(unsigned char, WS_WQKV), kb, n0, qkv_row(n0), scr, F.lane); }
}

constexpr int MOE_I_GU = 16 * 224, MOE_I_DN = 56 * 32, MOE_ITEMS = 8 * (MOE_I_GU + MOE_I_DN);
constexpr int DR_O = 16 * 32, DR_GU = 16 * 224, DR_DN = 56 * 32, DR_IN = 16 * 64, DR_OUT = 16 * 32, DR_LG = 32 * 8, DR_ITEMS = DR_O + DR_GU + DR_DN + DR_IN + DR_OUT + DR_LG;
constexpr int CV_ITEMS = DR_ITEMS + MOE_ITEMS;
__device__ __forceinline__ void moe_convert_items(Frame& F, int lo, int hi, int rank, int nranks) {
    LAS float* scr = (LAS float*)(F.lds + F.wave * 8704);
    for (int it0 = lo + rank * NWAVES + F.wave; it0 < hi; it0 += nranks * NWAVES) {
        int r = it0;
        if (r < DR_O) { const int kb = r / 32, n0 = (r % 32) * 32; p0_transpose_item8<7>(F.w_o, 1024, 1024, WSP(unsigned char, WS_WO), kb, n0, n0, scr, F.lane); continue; } r -= DR_O;
        if (r < DR_GU) { const int kb = r / 224, n0 = (r % 224) * 32; p0_transpose_item8<7>(F.w_gu, 1024, 7168, WSP(unsigned char, WS_WGU), kb, n0, gu_row(n0), scr, F.lane); continue; } r -= DR_GU;
        if (r < DR_DN) { const int kb = r / 32, n0 = (r % 32) * 32; p0_transpose_item8<9>(F.w_dn, 3584, 1024, WSP(unsigned char, WS_WDN), kb, n0, n0, scr, F.lane); continue; } r -= DR_DN;
        if (r < DR_IN) { const int kb = r / 64, n0 = (r % 64) * 32; p0_transpose_item(F.w_in, 1024, 2048, WSP(bf16, WS_WIN), kb, n0, n0, scr, F.lane); continue; } r -= DR_IN;
        if (r < DR_OUT) { const int kb = r / 32, n0 = (r % 32) * 32; p0_transpose_item(F.w_out, 1024, 1024, WSP(bf16, WS_WOUT), kb, n0, n0, scr, F.lane); continue; } r -= DR_OUT;
        if (r < DR_LG) { const int mi = r >> 3, sub = r & 7, which = mi >> 4, d = (mi >> 3) & 1, n = mi & 7, kb = sub >> 2, n0 = (sub & 3) * 32;
            p0_transpose_item((which ? F.w_i : F.w_r) + (size_t)(d * 8 + n) * 16384, 128, 128, WSP(bf16, WS_WLG) + (size_t)(n * 4 + 2 * d + which) * 16384, kb, n0, n0, scr, F.lane); continue; } r -= DR_LG;
        if (r < 8 * MOE_I_GU) { const int e = r / MOE_I_GU, q = r % MOE_I_GU, kb = q / 224, n0 = (q % 224) * 32;
            p0_transpose_item8<7>(F.mw_gu + (size_t)e * 1024 * 7168, 1024, 7168, WSP(unsigned char, WS_WMGU) + (size_t)e * 7168 * 1024, kb, n0, gu_row(n0), scr, F.lane); }
        else { r -= 8 * MOE_I_GU; const int e = r / MOE_I_DN, q = r % MOE_I_DN, kb = q / 32, n0 = (q % 32) * 32;
            p0_transpose_item8<9>(F.mw_dn + (size_t)e * 3584 * 1024, 3584, 1024, WSP(unsigned char, WS_WMDN) + (size_t)e * 1024 * 3584, kb, n0, n0, scr, F.lane); }
    }
}
__device__ __forceinline__ void moe_convert_filler(Frame& F, int nwg, int c, int lo, int hi) {
    const int R = (nwg + F.G - 1) / F.G, rem = nwg - (R - 1) * F.G;
    if (rem >= F.G) { moe_convert_items(F, lo, hi, c, F.G); return; }
    if (c >= rem) { REFRESH_F(F); moe_convert_items(F, lo, hi, c - rem, F.G - rem); }
}
__device__ __forceinline__ void row_load(f32x4 (&v)[4], const float* p, int lane) {
#pragma unroll
    for (int j = 0; j < 4; ++j) v[j] = *(const f32x4*)(p + 4 * lane + 256 * j);
}
__device__ __forceinline__ void row_load_bf(f32x4 (&v)[4], const bf16* p, int lane) {
#pragma unroll
    for (int j = 0; j < 4; ++j) { const u32x2 w = *(const u32x2*)(p + 4 * lane + 256 * j); v[j] = (f32x4){bflo(w.x), bfhi(w.x), bflo(w.y), bfhi(w.y)}; }
}
__device__ __forceinline__ void row_store(const f32x4 (&v)[4], float* p, int lane) {
#pragma unroll
    for (int j = 0; j < 4; ++j) *(f32x4*)(p + 4 * lane + 256 * j) = v[j];
}
struct Vec16 { f32x4 q[4]; };
__device__ __forceinline__ Vec16 vec_load(const float* p, int lane) { Vec16 r;
#pragma unroll
    for (int j = 0; j < 4; ++j) r.q[j] = *(const f32x4*)(p + 4 * lane + 256 * j);
    return r; }
__device__ __forceinline__ f32x2 row_ln_v(f32x4 (&v)[4], const Vec16& g, const Vec16& bt) {
    float s = 0.f;
#pragma unroll
    for (int j = 0; j < 4; ++j) s += (v[j].x + v[j].y) + (v[j].z + v[j].w);
    const float mean = wave_sum(s) * (1.f / DM); float s2 = 0.f;
#pragma unroll
    for (int j = 0; j < 4; ++j) { v[j] = v[j] - mean; s2 += (v[j].x * v[j].x + v[j].y * v[j].y) + (v[j].z * v[j].z + v[j].w * v[j].w); }
    const float rstd = 1.f / sqrtf(wave_sum(s2) * (1.f / DM) + LN_EPS);
#pragma unroll
    for (int j = 0; j < 4; ++j) v[j] = v[j] * rstd * g.q[j] + bt.q[j];
    return (f32x2){mean, rstd};
}
template <bool H8> __device__ __forceinline__ void row_mod_store_v(const f32x4 (&v)[4], const Vec16& sh, const Vec16& sc, void* hbase, size_t r, int lane) {
#pragma unroll
    for (int j = 0; j < 4; ++j) { const f32x4 h = v[j] * (sc.q[j] + 1.0f) + sh.q[j];
        if constexpr (H8) *(unsigned*)((unsigned char*)hbase + r * DM + 4 * lane + 256 * j) = pk4_fp8(h[0] * 4.f, h[1] * 4.f, h[2] * 4.f, h[3] * 4.f);
        else { u32x2 w; w.x = cvtpk(h[0], h[1]); w.y = cvtpk(h[2], h[3]); *(u32x2*)((bf16*)hbase + r * DM + 4 * lane + 256 * j) = w; } }
}
#define ROWS_LAT(...) do { const int nwb_ = NGW / 8; if (nwb_ > 0 && gw < 8 * nwb_) { const int b = gw / nwb_, nwin_ = (SEQ + nwb_ - 1) / nwb_; \
    for (int i_ = 0; i_ < nwin_; ++i_) { const int r = b * SEQ + ((i_ + 2 * b) % nwin_) * nwb_ + gw % nwb_;     \
        if (r < (b + 1) * SEQ) { __VA_ARGS__ } } } } while (0)
#define ROWS_CTX(...) do { const int b = 8; for (int r = RL + gw; r < RT; r += NGW) { __VA_ARGS__ } } while (0)
__device__ __forceinline__ void p1_modulate(Frame& F) {
    const int gw = F.vcu * NWAVES + F.wave, NGW = F.G * NWAVES; const float* mod = WSP(float, WS_MOD); bf16* H = WSP(bf16, WS_H);
    { const int bb = gw / (NGW / 8) < 8 ? gw / (NGW / 8) : 7; const Vec16 sh = vec_load(mod + (size_t)bb * 6144, F.lane), sc = vec_load(mod + (size_t)bb * 6144 + 1024, F.lane);
      ROWS_LAT( (void)b; f32x4 v[4]; row_load(v, F.x + (size_t)r * DM, F.lane); row_mod_store_v<true>(v, sh, sc, H, (size_t)r, F.lane); ); }
    { const Vec16 sh = vec_load(mod + (size_t)8 * 6144, F.lane), sc = vec_load(mod + (size_t)8 * 6144 + 1024, F.lane);
      ROWS_CTX( (void)b; f32x4 v[4]; row_load(v, F.ctx + (size_t)(r - RL) * DM, F.lane); row_mod_store_v<true>(v, sh, sc, H, (size_t)r, F.lane); ); }
}
template <bool H8> __device__ __forceinline__ void ln_mod_pass(Frame& F, bool with_ctx, const float* g, const float* bt, int ml, int cs) {
    const int gw = F.vcu * NWAVES + F.wave, NGW = F.G * NWAVES; const float* mod = WSP(float, WS_MOD) + (size_t)ml * 9 * 6144; bf16* H = WSP(bf16, WS_H); const bf16* YB = WSP(bf16, WS_YB);
    const Vec16 gv = vec_load(g, F.lane), bv = vec_load(bt, F.lane);
    { const int bb = gw / (NGW / 8) < 8 ? gw / (NGW / 8) : 7; const Vec16 sh = vec_load(mod + (size_t)bb * 6144 + cs, F.lane), sc = vec_load(mod + (size_t)bb * 6144 + cs + 1024, F.lane);
      ROWS_LAT( (void)b; f32x4 v[4]; row_load_bf(v, YB + (size_t)r * DM, F.lane); const f32x2 sv = row_ln_v(v, gv, bv); if (F.lane == 0) ((f32x2*)(F.ws + WS_STATS))[r] = sv;
                row_mod_store_v<H8>(v, sh, sc, H, (size_t)r, F.lane); ); }
    if (with_ctx) { const Vec16 sh = vec_load(mod + (size_t)8 * 6144 + cs, F.lane), sc = vec_load(mod + (size_t)8 * 6144 + cs + 1024, F.lane);
      ROWS_CTX( (void)b; f32x4 v[4]; row_load_bf(v, YB + (size_t)r * DM, F.lane); const f32x2 sv = row_ln_v(v, gv, bv); if (F.lane == 0) ((f32x2*)(F.ws + WS_STATS))[r] = sv;
                row_mod_store_v<H8>(v, sh, sc, H, (size_t)r, F.lane); ); }
}

namespace att {
constexpr float SCALE = 0.08838834764831845f, THR = 8.f;
constexpr int SHM_V = 64 * 128 * 2, SHM_K = 64 * 128 * 2;
#define KSWZ(row, colB) ((row) * 256 + ((colB) ^ (((row) & 7) << 4)))
#define SBAR() __builtin_amdgcn_sched_barrier(0)
__device__ __forceinline__ int crow(int r, int hi) { return (r & 3) + 8 * (r >> 2) + 4 * hi; }
__device__ __forceinline__ void partialSM(f32x16& p0, f32x16& p1, float& m_reg, float& mn, float& alpha, bool domask, int d0) {
    constexpr float C = SCALE * 1.4426950408889634f;
    if (domask) {
#pragma unroll
        for (int r = 0; r < 16; ++r) { const int rel = d0 + (r & 3) + 8 * (r >> 2);
            p0[r] = ((unsigned)(rel + 128) <= 256u) ? p0[r] : -1e30f; p1[r] = ((unsigned)(rel + 160) <= 256u) ? p1[r] : -1e30f; }
    }
    float pmax = p0[0];
#pragma unroll
    for (int r = 1; r < 16; ++r) pmax = fmaxf(pmax, p0[r]);
#pragma unroll
    for (int r = 0; r < 16; ++r) pmax = fmaxf(pmax, p1[r]);
    { auto rr = __builtin_amdgcn_permlane32_swap(__float_as_uint(pmax), __float_as_uint(pmax), false, false);
      pmax = fmaxf(__uint_as_float(rr[0]), __uint_as_float(rr[1])); }
    if (__builtin_expect(__all(pmax - m_reg <= THR / SCALE), 1)) { mn = m_reg; alpha = 1.f; }
    else { mn = fmaxf(m_reg, pmax); alpha = ex2((m_reg - mn) * C); m_reg = mn; }
    const float mnC = -mn * C;
#pragma unroll
    for (int r = 0; r < 16; ++r) p0[r] = fmaf(p0[r], C, mnC);
#pragma unroll
    for (int r = 0; r < 16; ++r) p1[r] = fmaf(p1[r], C, mnC);
#pragma unroll
    for (int r = 0; r < 16; ++r) p0[r] = ex2(p0[r]);
}
__device__ __forceinline__ void finishSM(f32x16& p0, f32x16& p1, float alpha, float& l_reg, bf16x8& pa0, bf16x8& pa1, bf16x8& pa2, bf16x8& pa3) {
#pragma unroll
    for (int r = 0; r < 16; ++r) p1[r] = ex2(p1[r]);
    float ps = 0;
#pragma unroll
    for (int r = 0; r < 16; ++r) ps += p0[r];
#pragma unroll
    for (int r = 0; r < 16; ++r) ps += p1[r];
    { auto rr = __builtin_amdgcn_permlane32_swap(__float_as_uint(ps), __float_as_uint(ps), false, false);
      ps = __uint_as_float(rr[0]) + __uint_as_float(rr[1]); }
    l_reg = l_reg * alpha + ps;
#define PK4(P, BASE, OUT) do { unsigned a0 = cvtpk(P[BASE + 0], P[BASE + 1]), a1 = cvtpk(P[BASE + 2], P[BASE + 3]);   \
    unsigned b0 = cvtpk(P[BASE + 4], P[BASE + 5]), b1 = cvtpk(P[BASE + 6], P[BASE + 7]);                              \
    auto r0 = __builtin_amdgcn_permlane32_swap(a0, b0, false, false); auto r1 = __builtin_amdgcn_permlane32_swap(a1, b1, false, false); \
    u32x4 w = {r0[0], r1[0], r0[1], r1[1]}; OUT = __builtin_bit_cast(bf16x8, w); } while (0)
    PK4(p0, 0, pa0); PK4(p0, 8, pa1); PK4(p1, 0, pa2); PK4(p1, 8, pa3);
#undef PK4
}
__device__ __forceinline__ void qkt(f32x16& p0, f32x16& p1, LAS const unsigned char* Ks, const bf16x8* qr, int r32, int hi) {
    p0 = f32x16{}; p1 = f32x16{};
#pragma unroll
    for (int d0 = 0; d0 < 8; ++d0) { const int cb = (d0 * 16 + hi * 8) * 2;
        const bf16x8 b0 = *(LAS const bf16x8*)(Ks + KSWZ(r32, cb));
        const bf16x8 b1 = *(LAS const bf16x8*)(Ks + KSWZ(32 + r32, cb));
        p0 = __builtin_amdgcn_mfma_f32_32x32x16_bf16(b0, qr[d0], p0, 0, 0, 0);
        p1 = __builtin_amdgcn_mfma_f32_32x32x16_bf16(b1, qr[d0], p1, 0, 0, 0); }
}
__device__ __forceinline__ int v_st(int k, int c) { const int kk = (k & ~0xC) | ((k & 4) << 1) | ((k & 8) >> 1); return ((kk >> 3) * 4 + (c >> 5)) * 512 + ((kk & 7) * 32 + (c & 31)) * 2; }
__device__ __forceinline__ int v_rd_base(int lane) { return ((lane & 3) << 3) | (((lane >> 2) & 3) << 6) | (((lane >> 4) & 1) << 5) | (((lane >> 5) & 1) << 8); }
constexpr int v_rd_off(int d0, int ks, int half) { return d0 * 512 + ks * 4096 + half * 2048; }
template <int OFF> __device__ __forceinline__ s16x4 tr_read(int vb) {
    s16x4 r; asm volatile("ds_read_b64_tr_b16 %0, %1 offset:%2" : "=&v"(r) : "v"(vb), "i"(OFF) : "memory"); return r;
}
template <int D0> __device__ __forceinline__ void pv_one(f32x16& od, int vb, bf16x8 pa0, bf16x8 pa1, bf16x8 pa2, bf16x8 pa3) {
    const s16x4 l0 = tr_read<v_rd_off(D0, 0, 0)>(vb), h0 = tr_read<v_rd_off(D0, 0, 1)>(vb), l1 = tr_read<v_rd_off(D0, 1, 0)>(vb), h1 = tr_read<v_rd_off(D0, 1, 1)>(vb);
    const s16x4 l2 = tr_read<v_rd_off(D0, 2, 0)>(vb), h2 = tr_read<v_rd_off(D0, 2, 1)>(vb), l3 = tr_read<v_rd_off(D0, 3, 0)>(vb), h3 = tr_read<v_rd_off(D0, 3, 1)>(vb);
    asm volatile("s_waitcnt lgkmcnt(0)" ::: "memory"); SBAR();
#define PKV(L, H) (bf16x8){L[0], L[1], L[2], L[3], H[0], H[1], H[2], H[3]}
    od = __builtin_amdgcn_mfma_f32_32x32x16_bf16(pa0, PKV(l0, h0), od, 0, 0, 0);
    od = __builtin_amdgcn_mfma_f32_32x32x16_bf16(pa1, PKV(l1, h1), od, 0, 0, 0);
    od = __builtin_amdgcn_mfma_f32_32x32x16_bf16(pa2, PKV(l2, h2), od, 0, 0, 0);
    od = __builtin_amdgcn_mfma_f32_32x32x16_bf16(pa3, PKV(l3, h3), od, 0, 0, 0);
#undef PKV
}
__device__ __forceinline__ void pv_d0(f32x16* o, int vb, bf16x8 pa0, bf16x8 pa1, bf16x8 pa2, bf16x8 pa3) {
    pv_one<0>(o[0], vb, pa0, pa1, pa2, pa3); pv_one<1>(o[1], vb, pa0, pa1, pa2, pa3); pv_one<2>(o[2], vb, pa0, pa1, pa2, pa3); pv_one<3>(o[3], vb, pa0, pa1, pa2, pa3);
}
__device__ __forceinline__ void attn_unit(const bf16* __restrict__ QKV, bf16* __restrict__ O, const float* __restrict__ sink, int qrow0, int head0, int kvh, int krow_band, int nband, int krow_ctx, int dpos0, LAS unsigned char* lds, const int wid) {
    const int lane = lane_id(), tid = wid * 64 + lane, r32 = lane & 31, hi = lane >> 5;
    LAS unsigned char* V_lds = lds; LAS unsigned char* K_lds = lds + 2 * SHM_V;
    LAS float* wsf = (LAS float*)(lds + 2 * SHM_V + 2 * SHM_K) + wid * 64; LAS float* li_l = wsf; LAS float* al_l = wsf + 32;
    const int head = head0 + (wid >> 2), qoff = 32 * (wid & 3);
    float m_reg = sink[head] * (1.0f / SCALE), l_reg = 1.0f; f32x16 o[4] = {}; bf16x8 qr[8];
    const bf16* Qw = QKV + (size_t)(qrow0 + qoff + r32) * QKVD + head * HDIM + hi * 8;
#pragma unroll
    for (int d0 = 0; d0 < 8; ++d0) qr[d0] = *(const bf16x8*)(Qw + d0 * 16);
    const bf16* Kg = QKV + 1024 + kvh * HDIM; const bf16* Vg = QKV + 1280 + kvh * HDIM;
    const int sr = tid >> 4, sc = (tid & 15) * 8, vst0 = v_st(sr, sc), vst1 = v_st(32 + sr, sc);
    const int vb0 = (int)(unsigned)(uintptr_t)V_lds + v_rd_base(lane);
    const int NT = nband + 4;
    struct { bf16x8 vs0, vs1, ks0, ks1; } sr_[2];
#define TROW(j) ((j) < nband ? krow_band + 64 * (j) : krow_ctx + 64 * ((j) - nband))
#define SLOAD(i, j) do { const size_t _r0 = (size_t)(TROW(j) + sr) * QKVD + sc, _r1 = _r0 + (size_t)32 * QKVD; \
    sr_[i].vs0 = *(const bf16x8*)(Vg + _r0); sr_[i].vs1 = *(const bf16x8*)(Vg + _r1); sr_[i].ks0 = *(const bf16x8*)(Kg + _r0); sr_[i].ks1 = *(const bf16x8*)(Kg + _r1); } while (0)
#define SWRITE(b, i) do { *(LAS bf16x8*)(V_lds + (b) * SHM_V + vst0) = sr_[i].vs0; *(LAS bf16x8*)(V_lds + (b) * SHM_V + vst1) = sr_[i].vs1; const int kc = sc * 2; \
    *(LAS bf16x8*)(K_lds + (b) * SHM_K + KSWZ(sr, kc)) = sr_[i].ks0; *(LAS bf16x8*)(K_lds + (b) * SHM_K + KSWZ(32 + sr, kc)) = sr_[i].ks1; } while (0)
#define SWAIT() asm volatile("s_waitcnt vmcnt(4)" ::: "memory")
#define RESC(a) do { if (__any((a) < 1.f)) { if (hi == 0) al_l[r32] = (a); asm volatile("s_waitcnt lgkmcnt(0)" ::: "memory"); \
    _Pragma("unroll") for (int d = 0; d < 4; ++d) _Pragma("unroll") for (int r = 0; r < 16; ++r) o[d][r] *= al_l[crow(r, hi)]; } } while (0)
#define TMASK(j, dm, dd) const int _dl##j = dpos0 + 64 * (j) - qoff; const bool dm = ((j) < nband) && !(_dl##j >= -97 && _dl##j <= 65); const int dd = _dl##j - r32 + 4 * hi
    f32x16 pA0, pA1, pB0, pB1; float mnA, mnB, alA, alB; bf16x8 pa0, pa1, pa2, pa3;
    constexpr int SE = 0, SO = 1;
    SLOAD(SE, 0); asm volatile("s_waitcnt vmcnt(0)" ::: "memory"); SWRITE(0, SE); __syncthreads();
    qkt(pA0, pA1, K_lds, qr, r32, hi); { TMASK(0, dm, dd); partialSM(pA0, pA1, m_reg, mnA, alA, dm, dd); }
    SLOAD(SO, 1); if (2 < NT) SLOAD(SE, 2);
    SWAIT(); SWRITE(1, SO); __syncthreads();
    for (int j = 1; j + 1 < NT; j += 2) {
        SBAR(); qkt(pB0, pB1, K_lds + SHM_K, qr, r32, hi);
        finishSM(pA0, pA1, alA, l_reg, pa0, pa1, pa2, pa3); SBAR();
        SLOAD(SO, (j + 2 < NT ? j + 2 : j)); SBAR();
        pv_d0(o, vb0, pa0, pa1, pa2, pa3); { const int jj = j; const int dl = dpos0 + 64 * jj - qoff; const bool dm = (jj < nband) && !(dl >= -97 && dl <= 65); partialSM(pB0, pB1, m_reg, mnB, alB, dm, dl - r32 + 4 * hi); }
        __syncthreads(); SWAIT(); SWRITE(0, SE);
        RESC(alB); __syncthreads();
        SBAR(); qkt(pA0, pA1, K_lds, qr, r32, hi);
        finishSM(pB0, pB1, alB, l_reg, pa0, pa1, pa2, pa3); SBAR();
        SLOAD(SE, (j + 3 < NT ? j + 3 : j)); SBAR();
        pv_d0(o, vb0 + SHM_V, pa0, pa1, pa2, pa3); { const int jj = j + 1; const int dl = dpos0 + 64 * jj - qoff; const bool dm = (jj < nband) && !(dl >= -97 && dl <= 65); partialSM(pA0, pA1, m_reg, mnA, alA, dm, dl - r32 + 4 * hi); }
        __syncthreads(); SWAIT(); SWRITE(1, SO);
        RESC(alA); __syncthreads();
    }
    SBAR(); qkt(pB0, pB1, K_lds + SHM_K, qr, r32, hi);
    finishSM(pA0, pA1, alA, l_reg, pa0, pa1, pa2, pa3); SBAR();
    pv_d0(o, vb0, pa0, pa1, pa2, pa3); { const int jj = NT - 1; const int dl = dpos0 + 64 * jj - qoff; const bool dm = (jj < nband) && !(dl >= -97 && dl <= 65); partialSM(pB0, pB1, m_reg, mnB, alB, dm, dl - r32 + 4 * hi); }
    asm volatile("s_waitcnt vmcnt(0)" ::: "memory");
    __syncthreads(); RESC(alB);
    finishSM(pB0, pB1, alB, l_reg, pa0, pa1, pa2, pa3); SBAR();
    pv_d0(o, vb0 + SHM_V, pa0, pa1, pa2, pa3);
    if (hi == 0) li_l[r32] = l_reg; asm volatile("s_waitcnt lgkmcnt(0)" ::: "memory");
    float rli[16];
#pragma unroll
    for (int r = 0; r < 16; ++r) rli[r] = rcpf_(li_l[crow(r, hi)]);
    { LAS unsigned char* ot = lds + 2 * SHM_V + 2 * SHM_K + 4096 + wid * 4096;
#pragma unroll
      for (int r = 0; r < 16; ++r) { const int orow = crow(r, hi);
#pragma unroll
          for (int d0 = 0; d0 < 4; ++d0) { const float x = clamp8(o[d0][r] * rli[r] * 16.0f); ot[orow * 128 + d0 * 32 + r32] = (unsigned char)(__builtin_amdgcn_cvt_pk_fp8_f32(x, x, 0, false) & 0xff); } }
      asm volatile("s_waitcnt lgkmcnt(0)" ::: "memory");
      unsigned char* Ob = (unsigned char*)O + (size_t)(qrow0 + qoff) * DM + head * HDIM;
#pragma unroll
      for (int i = 0; i < 4; ++i) { const int row = (lane >> 3) + 8 * i, ch = lane & 7; *(u32x4*)(Ob + (size_t)row * DM + ch * 16) = *(LAS const u32x4*)(ot + row * 128 + ch * 16); } }
    __syncthreads();
#undef TROW
#undef SLOAD
#undef SWRITE
#undef SWAIT
#undef RESC
#undef TMASK
}
constexpr int N_LAT_UNITS = NB * 32 * NKVH * 2, N_CTX_UNITS = NB * 2 * NKVH * 2, N_UNITS = N_LAT_UNITS + N_CTX_UNITS;
__device__ __forceinline__ void attn_phase(const bf16* QKV, bf16* O, const float* sink, int G, int c, LAS unsigned char* lds, const int wid) {
    for (int L = c; L < N_UNITS; L += G) {
        if (L < N_LAT_UNITS) { const int hp = L & 1, kh = (L >> 1) & 1, n = (L >> 2) & 31, b = L >> 7;
            const int nlo = n > 0 ? n - 1 : 0, nhi = n < 31 ? n + 1 : 31, nband = 2 * (nhi - nlo + 1);
            attn_unit(QKV, O, sink, b * SEQ + n * 128, kh * 4 + hp * 2, kh, b * SEQ + nlo * 128, nband, RL + b * LCTX, (nlo - n) * 128, lds, wid);
        } else { const int u = L - N_LAT_UNITS, hp = u & 1, kh = (u >> 1) & 1, qh = (u >> 2) & 1, b = u >> 3;
            attn_unit(QKV, O, sink, RL + b * LCTX + qh * 128, kh * 4 + hp * 2, kh, 0, 0, RL + b * LCTX, 0, lds, wid);
        }
    }
}
#undef KSWZ
#undef SBAR
}

__device__ __forceinline__ void p10_conv(Frame& F) {
    const int gw = F.vcu * NWAVES + F.wave, NGW = F.G * NWAVES; const bf16* XB = WSP(bf16, WS_XB); bf16* U = WSP(bf16, WS_U);
    float cw[4][16], cb[16];
#pragma unroll
    for (int j = 0; j < 4; ++j)
#pragma unroll
        for (int q = 0; q < 4; ++q) { const f32x4 w = *(const f32x4*)(F.conv_w + j * 1024 + 16 * F.lane + 4 * q); cw[j][4 * q] = w[0]; cw[j][4 * q + 1] = w[1]; cw[j][4 * q + 2] = w[2]; cw[j][4 * q + 3] = w[3]; }
#pragma unroll
    for (int q = 0; q < 4; ++q) { const f32x4 w = *(const f32x4*)(F.conv_b + 16 * F.lane + 4 * q); cb[4 * q] = w[0]; cb[4 * q + 1] = w[1]; cb[4 * q + 2] = w[2]; cb[4 * q + 3] = w[3]; }
    const int per = (RT + NGW - 1) / NGW, r0 = gw * per, r1 = (r0 + per < RT) ? r0 + per : RT;
    if (r0 >= RT) return;
    u32x4 w0[4], w1[4];
#pragma unroll
    for (int j = 0; j < 4; ++j) { int rr = r0 + j - 2; rr = rr < 0 ? 0 : (rr >= RT ? RT - 1 : rr); const u32x4* p = (const u32x4*)(XB + (size_t)rr * DM + 16 * F.lane); w0[j] = p[0]; w1[j] = p[1]; }
    for (int r = r0; r < r1; ++r) { const bool lat = r < RL; const int t = lat ? (r & (SEQ - 1)) : ((r - RL) & (LCTX - 1)); const int Ls = lat ? SEQ : LCTX;
        u32x4 n0, n1; { int rn = r + 2; rn = rn >= RT ? RT - 1 : rn; const u32x4* p = (const u32x4*)(XB + (size_t)rn * DM + 16 * F.lane); n0 = p[0]; n1 = p[1]; }
        float acc[16];
#pragma unroll
        for (int i = 0; i < 16; ++i) acc[i] = cb[i];
#pragma unroll
        for (int j = 0; j < 4; ++j) { const int tj = t + j - 2;
            if (tj >= 0 && tj < Ls) { const u32x4 x0 = w0[j], x1 = w1[j];
#pragma unroll
                for (int q = 0; q < 4; ++q) { acc[2 * q] += cw[j][2 * q] * bflo(x0[q]); acc[2 * q + 1] += cw[j][2 * q + 1] * bfhi(x0[q]); acc[8 + 2 * q] += cw[j][8 + 2 * q] * bflo(x1[q]); acc[8 + 2 * q + 1] += cw[j][8 + 2 * q + 1] * bfhi(x1[q]); } } }
        u32x4 o0, o1;
#pragma unroll
        for (int q = 0; q < 4; ++q) { o0[q] = cvtpk(acc[2 * q], acc[2 * q + 1]); o1[q] = cvtpk(acc[8 + 2 * q], acc[8 + 2 * q + 1]); }
        u32x4* op = (u32x4*)(U + (size_t)r * DM + 16 * F.lane); op[0] = o0; op[1] = o1;
        w0[0] = w0[1]; w0[1] = w0[2]; w0[2] = w0[3]; w0[3] = n0; w1[0] = w1[1]; w1[1] = w1[2]; w1[2] = w1[3]; w1[3] = n1; }
}
namespace lru {
constexpr int AIMG_BYTES = 65536;
constexpr int EX_OFF = 2 * AIMG_BYTES;
struct Ctx { const bf16* U; const bf16* G; bf16* HH; u32x4* HF; const bf16* WLG; const float *lam, *b_r, *b_i; };

__device__ __forceinline__ void issue_u(const __amdgpu_buffer_rsrc_t rs, LAS unsigned char* buf, int n, size_t row0, int wid, unsigned voff) {
#pragma unroll
    for (int ii = 0; ii < 8; ++ii) { const int i = wid + 8 * ii;
        __builtin_amdgcn_raw_ptr_buffer_load_lds(rs, (LAS void*)(buf + i * 1024), 16, voff, (unsigned)((row0 + 32 * ii) * DM * 2 + n * 256), 0, 0); }
}
__device__ __forceinline__ void chunk_geom(int DIR, int k, int b, size_t& row0, int& lc) {
    if (k == 0) { row0 = (size_t)RL + b * LCTX; lc = -1; } else { lc = DIR ? 16 - k : k - 1; row0 = (size_t)b * SEQ + 256 * lc; }
}
#define LRU_BAR() do { asm volatile("s_waitcnt lgkmcnt(0)" ::: "memory"); __builtin_amdgcn_s_barrier(); asm volatile("" ::: "memory"); } while (0)
template <int DIR>
__device__ __forceinline__ void walk(const Ctx& C, LAS unsigned char* lds, int task, const int wid) {
    const int cq = task & 3, n = (task >> 2) & 7, b = task >> 5;
    const int lane = lane_id(), tid = wid * 64 + lane, c = lane & 15, g = lane >> 4;
    const int chalf = wid & 1, tq = wid >> 1;
    const int chl = 32 * cq + 16 * chalf + c;
    const int ch = n * 128 + chl;
    bf16x8 Br[4], Bi[4];
    { const bf16* wr = C.WLG + ((size_t)(n * 4 + 2 * DIR) * 128 + chl) * 128 + 8 * g; const bf16* wi = wr + 16384;
#pragma unroll
      for (int ks = 0; ks < 4; ++ks) { Br[ks] = *(const bf16x8*)(wr + ks * 32); Bi[ks] = *(const bf16x8*)(wi + ks * 32); } }
    const float br = C.b_r[DIR * 1024 + ch], bi = C.b_i[DIR * 1024 + ch];
    const float sp8 = 8.0f * log1pf(expf(-C.lam[DIR * 1024 + ch]));
    const float kbr = -LOG2E * br, kbi = -LOG2E * bi, ka = -sp8 * LOG2E;
    float H = 0.f;
    unsigned fb[4], ub[4];
#pragma unroll
    for (int ks = 0; ks < 4; ++ks) fb[ks] = (unsigned)((64 * tq + c) * 256 + ((ks * 64 + 16 * g) ^ (c << 4)));
#pragma unroll
    for (int r = 0; r < 4; ++r) ub[r] = (unsigned)((64 * tq + 4 * g + r) * 256 + ((2 * chl) ^ ((4 * g + r) << 4)));
    const __amdgpu_buffer_rsrc_t urs = __builtin_amdgcn_make_buffer_rsrc((void*)C.U, 0, -1, 0x00020000);
    const unsigned uvoff = (unsigned)((4 * wid + (lane >> 4)) * DM * 2 + (((lane & 15) ^ ((4 * wid + (lane >> 4)) & 15)) * 16));
    { size_t r0; int lc; chunk_geom(DIR, 0, b, r0, lc); issue_u(urs, lds, n, r0, wid, uvoff); }
    for (int k = 0; k < 17; ++k) {
        size_t row0; int lc; chunk_geom(DIR, k, b, row0, lc);
        LAS unsigned char* img = lds + (k & 1) * AIMG_BYTES;
        asm volatile("s_waitcnt vmcnt(0)" ::: "memory");
        LRU_BAR();
        if (k + 1 < 17) { size_t r1; int l1; chunk_geom(DIR, k + 1, b, r1, l1); issue_u(urs, lds + ((k + 1) & 1) * AIMG_BYTES, n, r1, wid, uvoff); }
        u32x4 hf0, hf1;
        u32x4 gp0, gp1;
        if (DIR == 1 && lc >= 0) { const u32x4* hp = C.HF + ((((size_t)task * 16 + lc) * 8 + wid) * 2) * 64 + lane; hf0 = hp[0]; hf1 = hp[64];
            const size_t grow = (row0 + (tid >> 1)) * DM + n * 128 + 32 * cq + 16 * (tid & 1); gp0 = *(const u32x4*)(C.G + grow); gp1 = *(const u32x4*)(C.G + grow + 8); }
        f32x4 ar[4], ai[4];
#pragma unroll
        for (int mt = 0; mt < 4; ++mt) { ar[mt] = (f32x4){0.f, 0.f, 0.f, 0.f}; ai[mt] = (f32x4){0.f, 0.f, 0.f, 0.f};
#pragma unroll
            for (int ks = 0; ks < 4; ++ks) { const bf16x8 af = *(LAS const bf16x8*)(img + fb[ks] + mt * 4096);
                ar[mt] = __builtin_amdgcn_mfma_f32_16x16x32_bf16(af, Br[ks], ar[mt], 0, 0, 0);
                ai[mt] = __builtin_amdgcn_mfma_f32_16x16x32_bf16(af, Bi[ks], ai[mt], 0, 0, 0); } }
        float y0[4][4], P[4][4]; float TA = 1.f, TB = 0.f;
#pragma unroll
        for (int mm = 0; mm < 4; ++mm) { const int mt = DIR ? 3 - mm : mm;
            float a[4], bb[4];
#pragma unroll
            for (int r = 0; r < 4; ++r) {
                const float rg = rcpf_(1.0f + ex2(fmaf(ar[mt][r], -LOG2E, kbr))), ig = rcpf_(1.0f + ex2(fmaf(ai[mt][r], -LOG2E, kbi)));
                a[r] = ex2(rg * ka);
                const float em = fmaf(-a[r], a[r], 1.0f);
                const float uu = __uint_as_float((unsigned)*(LAS const bf16*)(img + ub[r] + mt * 4096) << 16);
                bb[r] = __builtin_amdgcn_sqrtf(em) * (ig * uu); }
            float p[4], yl[4];
            if (DIR == 0) { p[0] = a[0]; yl[0] = bb[0];
#pragma unroll
                for (int r = 1; r < 4; ++r) { p[r] = a[r] * p[r - 1]; yl[r] = a[r] * yl[r - 1] + bb[r]; } }
            else { p[3] = a[3]; yl[3] = bb[3];
#pragma unroll
                for (int r = 2; r >= 0; --r) { p[r] = a[r] * p[r + 1]; yl[r] = a[r] * yl[r + 1] + bb[r]; } }
            const float Al = DIR ? p[0] : p[3], Bl = DIR ? yl[0] : yl[3];
            const float A0 = __shfl(Al, c), A1 = __shfl(Al, 16 + c), A2 = __shfl(Al, 32 + c), A3 = __shfl(Al, 48 + c);
            const float B0 = __shfl(Bl, c), B1 = __shfl(Bl, 16 + c), B2 = __shfl(Bl, 32 + c), B3 = __shfl(Bl, 48 + c);
            float EA, EB, At, Bt;
            if (DIR == 0) { const float e1a = A0, e1b = B0, e2a = A1 * e1a, e2b = A1 * e1b + B1, e3a = A2 * e2a, e3b = A2 * e2b + B2;
                EA = g == 0 ? 1.f : (g == 1 ? e1a : (g == 2 ? e2a : e3a)); EB = g == 0 ? 0.f : (g == 1 ? e1b : (g == 2 ? e2b : e3b)); At = A3 * e3a; Bt = A3 * e3b + B3; }
            else { const float e2a = A3, e2b = B3, e1a = A2 * e2a, e1b = A2 * e2b + B2, e0a = A1 * e1a, e0b = A1 * e1b + B1;
                EA = g == 3 ? 1.f : (g == 2 ? e2a : (g == 1 ? e1a : e0a)); EB = g == 3 ? 0.f : (g == 2 ? e2b : (g == 1 ? e1b : e0b)); At = A0 * e0a; Bt = A0 * e0b + B0; }
            const float QA = EA * TA, QB = EA * TB + EB;
#pragma unroll
            for (int r = 0; r < 4; ++r) { P[mt][r] = p[r] * QA; y0[mt][r] = p[r] * QB + yl[r]; }
            TB = At * TB + Bt; TA = At * TA;
        }
        if (g == 0) *(LAS f32x2*)(lds + EX_OFF + ((tq * 2 + chalf) * 16 + c) * 8) = (f32x2){TA, TB};
        LRU_BAR();
        float Hw;
        { const f32x2 e0 = *(LAS const f32x2*)(lds + EX_OFF + ((0 * 2 + chalf) * 16 + c) * 8), e1 = *(LAS const f32x2*)(lds + EX_OFF + ((1 * 2 + chalf) * 16 + c) * 8),
                      e2 = *(LAS const f32x2*)(lds + EX_OFF + ((2 * 2 + chalf) * 16 + c) * 8), e3 = *(LAS const f32x2*)(lds + EX_OFF + ((3 * 2 + chalf) * 16 + c) * 8);
          if (DIR == 0) { const float h1 = e0.x * H + e0.y, h2 = e1.x * h1 + e1.y, h3 = e2.x * h2 + e2.y; Hw = tq == 0 ? H : (tq == 1 ? h1 : (tq == 2 ? h2 : h3)); H = e3.x * h3 + e3.y; }
          else { const float h2 = e3.x * H + e3.y, h1 = e2.x * h2 + e2.y, h0 = e1.x * h1 + e1.y; Hw = tq == 3 ? H : (tq == 2 ? h2 : (tq == 1 ? h1 : h0)); H = e0.x * h0 + e0.y; } }
        if (lc >= 0) {
#pragma unroll
            for (int mt = 0; mt < 4; ++mt)
#pragma unroll
                for (int r = 0; r < 4; ++r) y0[mt][r] += P[mt][r] * Hw;
            if (DIR == 0) {
                u32x4* hp = C.HF + ((((size_t)task * 16 + lc) * 8 + wid) * 2) * 64 + lane;
                u32x4 w0, w1; w0.x = cvtpk(y0[0][0], y0[0][1]); w0.y = cvtpk(y0[0][2], y0[0][3]); w0.z = cvtpk(y0[1][0], y0[1][1]); w0.w = cvtpk(y0[1][2], y0[1][3]);
                w1.x = cvtpk(y0[2][0], y0[2][1]); w1.y = cvtpk(y0[2][2], y0[2][3]); w1.z = cvtpk(y0[3][0], y0[3][1]); w1.w = cvtpk(y0[3][2], y0[3][3]);
                hp[0] = w0; hp[64] = w1;
            } else {
                const unsigned hw[8] = {hf0.x, hf0.y, hf0.z, hf0.w, hf1.x, hf1.y, hf1.z, hf1.w};
#pragma unroll
                for (int mt = 0; mt < 4; ++mt)
#pragma unroll
                    for (int r = 0; r < 4; ++r) { const unsigned w = hw[mt * 2 + (r >> 1)]; const float hfv = (r & 1) ? bfhi(w) : bflo(w); const float s = y0[mt][r] + hfv;
                        *(LAS bf16*)(img + (64 * tq + mt * 16 + 4 * g + r) * 64 + (16 * chalf + c) * 2) = (bf16)(cvtpk(s, 0.f) & 0xffffu); }
                LRU_BAR();
                { const int tt = tid >> 1, hh = tid & 1; const size_t grow = (row0 + tt) * DM + n * 128 + 32 * cq + 16 * hh;
                  const u32x4 s0 = *(LAS const u32x4*)(img + tt * 64 + hh * 32), s1 = *(LAS const u32x4*)(img + tt * 64 + hh * 32 + 16);
                  const u32x4 g0 = gp0, g1 = gp1;
                  u32x4 o0, o1;
#pragma unroll
                  for (int j = 0; j < 4; ++j) { o0[j] = cvtpk(bflo(s0[j]) * bflo(g0[j]), bfhi(s0[j]) * bfhi(g0[j])); o1[j] = cvtpk(bflo(s1[j]) * bflo(g1[j]), bfhi(s1[j]) * bfhi(g1[j])); }
                  *(u32x4*)(C.HH + grow) = o0; *(u32x4*)(C.HH + grow + 8) = o1; }
            }
        }
    }
    asm volatile("s_waitcnt vmcnt(0)" ::: "memory");
    LRU_BAR();
}
#undef LRU_BAR
}
__device__ __forceinline__ void p11_lru(Frame& F, const lru::Ctx& C) {
    for (int task = F.vcu; task < 256; task += F.G) { lru::walk<0>(C, F.lds, task, F.wave); lru::walk<1>(C, F.lds, task, F.wave); }
}

__device__ __forceinline__ void p13_ln_router(Frame& F) {
    LAS float* RTR = (LAS float*)F.lds;
    LAS int* lcnt = (LAS int*)(F.lds + 32768);
    for (int idx = F.tid; idx < 8192; idx += NWAVES * 64) RTR[(idx & 7) * 1024 + (idx >> 3)] = F.router[idx];
    const float* mod = WSP(float, WS_MOD) + (size_t)1 * 9 * 6144; unsigned char* H8 = WSP(unsigned char, WS_H);
    int* eidx = (int*)(F.ws + WS_ROUTE + RT_EIDX); float* wgt = (float*)(F.ws + WS_ROUTE + RT_WGT); int* cnt = (int*)(F.ws + WS_ROUTE + RT_CNT);
    const Vec16 gv = vec_load(F.ln_g + 2 * 1024, F.lane), bv = vec_load(F.ln_b + 2 * 1024, F.lane);
    for (int batch = F.vcu; batch < RL / 128; batch += F.G) {
        const float* mb0 = mod + (size_t)((batch * 128) >> 12) * 6144 + 3072; const Vec16 sh = vec_load(mb0, F.lane), sc = vec_load(mb0 + 1024, F.lane);
        if (F.tid < 8) lcnt[F.tid] = 0;
        __syncthreads();
        u32x2 nx[4]; { const bf16* yp = WSP(bf16, WS_YB) + (size_t)(batch * 128 + F.wave * 16) * DM;
#pragma unroll
            for (int j = 0; j < 4; ++j) nx[j] = *(const u32x2*)(yp + 4 * F.lane + 256 * j); }
        for (int i = 0; i < 16; ++i) { const int r = batch * 128 + F.wave * 16 + i;
            f32x4 v[4];
#pragma unroll
            for (int j = 0; j < 4; ++j) v[j] = (f32x4){bflo(nx[j].x), bfhi(nx[j].x), bflo(nx[j].y), bfhi(nx[j].y)};
            if (i + 1 < 16) { const bf16* yp = WSP(bf16, WS_YB) + (size_t)(r + 1) * DM;
#pragma unroll
                for (int j = 0; j < 4; ++j) nx[j] = *(const u32x2*)(yp + 4 * F.lane + 256 * j); }
            row_ln_v(v, gv, bv);
            float lg[8];
#pragma unroll
            for (int e = 0; e < 8; ++e) lg[e] = 0.f;
#pragma unroll
            for (int j = 0; j < 4; ++j) { const f32x4 hm = v[j] * (sc.q[j] + 1.0f) + sh.q[j];
                *(unsigned*)(H8 + (size_t)r * DM + 4 * F.lane + 256 * j) = pk4_fp8(hm[0] * 4.f, hm[1] * 4.f, hm[2] * 4.f, hm[3] * 4.f);
#pragma unroll
                for (int e = 0; e < 8; ++e) { const f32x4 rt = *(LAS const f32x4*)(RTR + e * 1024 + 4 * F.lane + 256 * j); lg[e] += (hm[0] * rt[0] + hm[1] * rt[1]) + (hm[2] * rt[2] + hm[3] * rt[3]); } }
#pragma unroll
            for (int e = 0; e < 8; ++e) lg[e] = wave_sum(lg[e]);
            int ea = 0; float la = lg[0];
#pragma unroll
            for (int e = 1; e < 8; ++e) if (lg[e] > la) { la = lg[e]; ea = e; }
            int eb = -1; float lb = -3.0e38f;
#pragma unroll
            for (int e = 0; e < 8; ++e) if (e != ea && lg[e] > lb) { lb = lg[e]; eb = e; }
            const float wa = 1.0f / (1.0f + __expf(lb - la)), wb = 1.0f - wa;
            if (F.lane == 0) { *(int2*)(eidx + 2 * r) = make_int2(ea, eb); *(float2*)(wgt + 2 * r) = make_float2(wa, wb); atomicAdd((int*)(lcnt + ea), 1); atomicAdd((int*)(lcnt + eb), 1); }
        }
        __syncthreads();
        if (F.tid < 8) cnt[batch * 8 + F.tid] = lcnt[F.tid];
        __syncthreads();
    }
}
__device__ __forceinline__ void moe_totals(Frame& F, int upto_batch, int (&tot)[8], int (&before)[8]) {
    const int* cnt = (const int*)(F.ws + WS_ROUTE + RT_CNT);
#pragma unroll
    for (int e = 0; e < 8; ++e) { tot[e] = 0; before[e] = 0; }
#pragma unroll
    for (int k = 0; k < 4; ++k) { const int bb = 4 * F.lane + k; const int4 c0 = *(const int4*)(cnt + bb * 8), c1 = *(const int4*)(cnt + bb * 8 + 4); const int m = bb < upto_batch ? 1 : 0;
        tot[0] += c0.x; tot[1] += c0.y; tot[2] += c0.z; tot[3] += c0.w; tot[4] += c1.x; tot[5] += c1.y; tot[6] += c1.z; tot[7] += c1.w;
        before[0] += m * c0.x; before[1] += m * c0.y; before[2] += m * c0.z; before[3] += m * c0.w; before[4] += m * c1.x; before[5] += m * c1.y; before[6] += m * c1.z; before[7] += m * c1.w; }
#pragma unroll
    for (int e = 0; e < 8; ++e) {
#pragma unroll
        for (int o = 1; o < 64; o <<= 1) { tot[e] += __shfl_xor(tot[e], o); before[e] += __shfl_xor(before[e], o); } }
}
__device__ __forceinline__ void p14_gather(Frame& F) {
    const int* eidx = (const int*)(F.ws + WS_ROUTE + RT_EIDX); const float* wgt = (const float*)(F.ws + WS_ROUTE + RT_WGT);
    int* slot = (int*)(F.ws + WS_ROUTE + RT_SLOT); float* wsort = (float*)(F.ws + WS_ROUTE + RT_WS);
    const unsigned char* H8 = WSP(unsigned char, WS_H); unsigned char* HS8 = WSP(unsigned char, WS_HS);
    LAS int* wcnt = (LAS int*)F.lds;
    LAS int* dsts = (LAS int*)(F.lds + 256);
    for (int batch = F.vcu; batch < RL / 128; batch += F.G) {
        int tot[8], before[8]; moe_totals(F, batch, tot, before);
        int base[8]; { int tp = 0;
#pragma unroll
            for (int e = 0; e < 8; ++e) { base[e] = tp * 256 + before[e]; tp += (tot[e] + 255) >> 8; } }
        int my_e = 0, rank_in_wave = 0;
        if (F.tid < 256) { my_e = eidx[batch * 256 + F.tid];
#pragma unroll
            for (int e = 0; e < 8; ++e) { const unsigned long long m = __ballot(my_e == e); if (my_e == e) rank_in_wave = __popcll(m & ((1ull << F.lane) - 1ull)); if (F.lane == 0) wcnt[F.wave * 8 + e] = __popcll(m); } }
        __syncthreads();
        if (F.tid < 256) { int off = 0;
#pragma unroll
            for (int w = 0; w < 4; ++w) if (w < F.wave) off += wcnt[w * 8 + my_e];
            int bs = 0;
#pragma unroll
            for (int e = 0; e < 8; ++e) bs = (my_e == e) ? base[e] : bs;
            const int d = bs + off + rank_in_wave; dsts[F.tid] = d; slot[batch * 256 + F.tid] = d; wsort[d] = wgt[batch * 256 + F.tid]; }
        __syncthreads();
        for (int i = 0; i < 32; ++i) { const int a = F.wave * 32 + i; const int d = dsts[a]; const int r = batch * 128 + (a >> 1);
            const u32x4* src = (const u32x4*)(H8 + (size_t)r * DM); u32x4* dp = (u32x4*)(HS8 + (size_t)d * DM);
            dp[F.lane] = src[F.lane]; }
        __syncthreads();
    }
}
__device__ __forceinline__ void p17_final(Frame& F) {
    const int gw = F.vcu * NWAVES + F.wave, NGW = F.G * NWAVES; const float* mod = WSP(float, WS_MOD) + (size_t)1 * 9 * 6144; const bf16* FO = WSP(bf16, WS_FO);
    const int* slot = (const int*)(F.ws + WS_ROUTE + RT_SLOT);
    const Vec16 g0 = vec_load(F.ln_g + 2 * 1024, F.lane), b0 = vec_load(F.ln_b + 2 * 1024, F.lane), g1 = vec_load(F.ln_g + 3 * 1024, F.lane), b1 = vec_load(F.ln_b + 3 * 1024, F.lane);
    const int bb = gw / (NGW / 8) < 8 ? gw / (NGW / 8) : 7; const Vec16 g2 = vec_load(mod + (size_t)bb * 6144 + 5120, F.lane);
    ROWS_LAT( (void)b; float* yp = F.out + (size_t)r * DM; const int2 s = *(const int2*)(slot + 2 * r);
        const bf16* fa = FO + (size_t)s.x * DM, * fb = FO + (size_t)s.y * DM;
        f32x4 v[4]; row_load_bf(v, WSP(bf16, WS_YB) + (size_t)r * DM, F.lane); row_ln_v(v, g0, b0);
        _Pragma("unroll") for (int j = 0; j < 4; ++j) { const u32x2 a = *(const u32x2*)(fa + 4 * F.lane + 256 * j), c = *(const u32x2*)(fb + 4 * F.lane + 256 * j);
            const f32x4 f = {bflo(a.x) + bflo(c.x), bfhi(a.x) + bfhi(c.x), bflo(a.y) + bflo(c.y), bfhi(a.y) + bfhi(c.y)};
            v[j] = v[j] * ALPHA + g2.q[j] * f; }
        row_ln_v(v, g1, b1); row_store(v, yp, F.lane); );
}

constexpr int N_PHASES = 18;
#ifndef REP_PHASE
#define REP_PHASE -1
#endif
struct Args { const float* in[25]; float* out; unsigned char* ws; int ph_lo, ph_hi; };
__global__ void __launch_bounds__(NWAVES * 64, 2) fwd_kernel(Args args) {
    extern __shared__ __attribute__((aligned(16))) unsigned char lds[];
    Frame F;
    F.lds = (LAS unsigned char*)lds;
    F.MISC = (volatile LAS unsigned*)(F.lds + MISC_OFF);
    F.wave = __builtin_amdgcn_readfirstlane((int)(threadIdx.x >> 6)); F.lane = lane_id(); F.tid = F.wave * 64 + F.lane;
    F.G = gridDim.x; { const int bx = blockIdx.x; F.vcu = (F.G % 8 == 0) ? (bx % 8) * (F.G / 8) + bx / 8 : bx; }
    F.x = args.in[0]; F.c = args.in[1]; F.ctx = args.in[2]; F.cctx = args.in[3]; F.w_mod = args.in[4]; F.b_mod = args.in[5]; F.ln_g = args.in[6]; F.ln_b = args.in[7];
    F.w_qkv = args.in[8]; F.w_o = args.in[9]; F.sink = args.in[10]; F.w_gu = args.in[11]; F.w_dn = args.in[12]; F.w_in = args.in[13]; F.conv_w = args.in[14]; F.conv_b = args.in[15];
    F.lam = args.in[16]; F.w_r = args.in[17]; F.b_r = args.in[18]; F.w_i = args.in[19]; F.b_i = args.in[20]; F.w_out = args.in[21]; F.router = args.in[22]; F.mw_gu = args.in[23]; F.mw_dn = args.in[24];
    F.out = args.out; F.ws = args.ws;
    for (int u = F.tid; u < (LDS_BYTES - LDSCTL_OFF) / 4; u += NWAVES * 64) ((LAS unsigned*)(F.lds + LDSCTL_OFF))[u] = 0u;
    __syncthreads();
    const int lo = args.ph_lo, hi = args.ph_hi;
    const bool multi = (hi - lo) > 1;
    XcdBarrier bar; bar.bar = (unsigned*)(F.ws + WS_CTL) + 1024; bar.x = 0; bar.st = nullptr;
    if (multi) bar = xcd_barrier_post((unsigned*)(F.ws + WS_CTL) + 1024, F.MISC + 8, F.wave == 0 && lane_id() == 0);
#define IN(k) (lo <= (k) && (k) < hi)
#define REFRESH() do { F.lane = lane_id(); F.tid = F.wave * 64 + F.lane; } while (0)
#define SEAM(k) do { if (IN(k) && IN((k) + 1)) xcd_barrier(bar, F.wave == 0 && lane_id() == 0); } while (0)
    const float* MOD = WSP(float, WS_MOD);
    bf16* H = WSP(bf16, WS_H); bf16* YB = WSP(bf16, WS_YB); const f32x2* ST = (const f32x2*)(F.ws + WS_STATS);

    if (IN(0)) { REFRESH(); p0_prologue(F); if (REP_PHASE == 0) { xcd_barrier(bar, F.wave == 0 && lane_id() == 0); p0_prologue(F); } } SEAM(0);
    if (IN(1)) { REFRESH(); p1_modulate(F); if (REP_PHASE == 1) { xcd_barrier(bar, F.wave == 0 && lane_id() == 0); p1_modulate(F); } } SEAM(1);
    if (IN(2)) {
        pg8::Gemm g{H, WSP(bf16, WS_WQKV), RT, QKVD, DM / 2}; pg8::StaticOrder S; S.init(RT, QKVD, F.G, (int)blockIdx.x);
        pg8::EpiQKV E{WSP(bf16, WS_QKV), WSP(float, WS_ROPE), 1.0f / 512.0f};
        pg8::gemm_phase<pg8::EpiQKV, pg8::StaticOrder, true, true, true>(F.lds + RING_OFF, g, S, E, F.wave);
        moe_convert_filler(F, (RT / 256) * (QKVD / 256), (int)blockIdx.x, 0, 6400);
    } SEAM(2);
    if (IN(3)) { att::attn_phase(WSP(bf16, WS_QKV), WSP(bf16, WS_O), F.sink, F.G, F.vcu, F.lds + RING_OFF, F.wave); if (REP_PHASE == 3) { xcd_barrier(bar, F.wave == 0 && lane_id() == 0); att::attn_phase(WSP(bf16, WS_QKV), WSP(bf16, WS_O), F.sink, F.G, F.vcu, F.lds + RING_OFF, F.wave); } } SEAM(3);
    if (IN(4)) {
        pg8::Gemm g{WSP(bf16, WS_O), WSP(bf16, WS_WO), RT, DM, DM / 2}; pg8::StaticOrder S; S.init(RT, DM, F.G, (int)blockIdx.x);
        pg8::EpiResid<false> E{F.x, F.ctx, YB, MOD + 2048, 1.0f / 2048.0f, nullptr, nullptr, nullptr};
        pg8::gemm_phase<pg8::EpiResid<false>, pg8::StaticOrder, true, true, true>(F.lds + RING_OFF, g, S, E, F.wave);
        moe_convert_filler(F, (RT / 256) * (DM / 256), (int)blockIdx.x, 6400, 17408);
    } SEAM(4);
    if (IN(5)) { REFRESH(); ln_mod_pass<true>(F, true, F.ln_g, F.ln_b, 0, 3072); } SEAM(5);
    if (IN(6)) {
        pg8::Gemm g{H, WSP(bf16, WS_WGU), RT, 2 * DFF, DM / 2}; pg8::StaticOrder S; S.init(RT, 2 * DFF, F.G, (int)blockIdx.x);
        pg8::EpiSwiGLU8 E{WSP(unsigned char, WS_ACT), 28};
        pg8::gemm_phase<pg8::EpiSwiGLU8, pg8::StaticOrder, true, true, true>(F.lds + RING_OFF, g, S, E, F.wave);
    } SEAM(6);
    if (IN(7)) {
        pg8::Gemm g{WSP(bf16, WS_ACT), WSP(bf16, WS_WDN), RT, DM, DFF / 2}; pg8::StaticOrder S; S.init(RT, DM, F.G, (int)blockIdx.x);
        pg8::EpiResid<true> E{nullptr, nullptr, YB, MOD + 5120, 1.0f / 4096.0f, ST, F.ln_g, F.ln_b};
        pg8::gemm_phase<pg8::EpiResid<true>, pg8::StaticOrder, true, true, true>(F.lds + RING_OFF, g, S, E, F.wave);
        moe_convert_filler(F, (RT / 256) * (DM / 256), (int)blockIdx.x, 17408, 37888);
    } SEAM(7);
    if (IN(8)) { REFRESH(); ln_mod_pass<false>(F, true, F.ln_g + 1024, F.ln_b + 1024, 1, 0); } SEAM(8);
    if (IN(9)) {
        pg8::Gemm g{H, WSP(bf16, WS_WIN), RT, 2048, DM}; pg8::StaticOrder S; S.init(RT, 2048, F.G, (int)blockIdx.x);
        pg8::EpiLruIn E{WSP(bf16, WS_G), WSP(bf16, WS_XB)};
        pg8::gemm_phase<pg8::EpiLruIn, pg8::StaticOrder, true, true>(F.lds + RING_OFF, g, S, E, F.wave);
        moe_convert_filler(F, (RT / 256) * (2048 / 256), (int)blockIdx.x, 37888, CV_ITEMS);
    } SEAM(9);
    {
        const lru::Ctx LC{WSP(bf16, WS_U), WSP(bf16, WS_G), WSP(bf16, WS_HH), WSP(u32x4, WS_HF), WSP(bf16, WS_WLG), F.lam, F.b_r, F.b_i};
        if (IN(10)) { REFRESH(); p10_conv(F); } SEAM(10);
        if (IN(11)) { REFRESH(); p11_lru(F, LC); if (REP_PHASE == 11) { xcd_barrier(bar, F.wave == 0 && lane_id() == 0); p11_lru(F, LC); } } SEAM(11);
    }
    if (IN(12)) {
        pg8::Gemm g{WSP(bf16, WS_HH), WSP(bf16, WS_WOUT), RL, DM, DM}; pg8::StaticOrder S; S.init(RL, DM, F.G, (int)blockIdx.x);
        pg8::EpiResid<true> E{nullptr, nullptr, YB, MOD + 9 * 6144 + 2048, 1.0f, ST, F.ln_g + 1024, F.ln_b + 1024};
        pg8::gemm_phase<pg8::EpiResid<true>, pg8::StaticOrder, true, true>(F.lds + RING_OFF, g, S, E, F.wave);
    } SEAM(12);
    if (IN(13)) { REFRESH(); p13_ln_router(F); } SEAM(13);
    if (IN(14)) { REFRESH(); p14_gather(F); if (REP_PHASE == 14) { xcd_barrier(bar, F.wave == 0 && lane_id() == 0); p14_gather(F); } } SEAM(14);
    if (IN(15) || IN(16)) {
        REFRESH();
        int tot[8], before[8]; moe_totals(F, 0, tot, before);
        int tp[9]; tp[0] = 0;
#pragma unroll
        for (int e = 0; e < 8; ++e) tp[e + 1] = __builtin_amdgcn_readfirstlane(tp[e] + ((tot[e] + 255) >> 8));
        const int ntiles = tp[8];
        if (IN(15)) {
            pg8::Gemm g{WSP(bf16, WS_HS), WSP(bf16, WS_WMGU), ntiles * 256, 2 * DFF, DM / 2};
            pg8::MoeOrder S{ntiles, 28, ntiles * 28, F.G, (int)blockIdx.x, 28, tp[1], tp[2], tp[3], tp[4], tp[5], tp[6], tp[7]};
            pg8::EpiSwiGLU8 E{WSP(unsigned char, WS_MACT), 28};
            pg8::gemm_phase<pg8::EpiSwiGLU8, pg8::MoeOrder, true, true, true>(F.lds + RING_OFF, g, S, E, F.wave);
        } SEAM(15);
        if (IN(16)) {
            pg8::Gemm g{WSP(bf16, WS_MACT), WSP(bf16, WS_WMDN), ntiles * 256, DM, DFF / 2};
            pg8::MoeOrder S{ntiles, 4, ntiles * 4, F.G, (int)blockIdx.x, 4, tp[1], tp[2], tp[3], tp[4], tp[5], tp[6], tp[7]};
            pg8::EpiMoeOut8 E{WSP(bf16, WS_FO), (const float*)(F.ws + WS_ROUTE + RT_WS)};
            pg8::gemm_phase<pg8::EpiMoeOut8, pg8::MoeOrder, true, true, true>(F.lds + RING_OFF, g, S, E, F.wave);
        } SEAM(16);
    }
    if (IN(17)) { REFRESH(); p17_final(F); }
#undef IN
#undef SEAM
}

#ifndef N_LAUNCH_MODE
#define N_LAUNCH_MODE 1
#endif
extern "C" void kernel_launch(void* const* d_in, const int* in_sizes, int n_in, void* d_out, int out_size, void* d_ws, size_t ws_size, hipStream_t stream) {
    static int grid = 0;
    if (grid == 0) {
        if (n_in != 25 || out_size != RL * DM || ws_size < WS_END) { fprintf(stderr, "kernel_launch: unexpected shapes (n_in %d out %d ws %zu)\n", n_in, out_size, ws_size); grid = -1; return; }
        int dev = 0, cus = 0, per_cu = 0;
        if (hipGetDevice(&dev) != hipSuccess || hipDeviceGetAttribute(&cus, hipDeviceAttributeMultiprocessorCount, dev) != hipSuccess) { grid = -1; return; }
        if (hipFuncSetAttribute((const void*)fwd_kernel, hipFuncAttributeMaxDynamicSharedMemorySize, LDS_BYTES) != hipSuccess) { fprintf(stderr, "kernel_launch: hipFuncSetAttribute failed\n"); grid = -1; return; }
        if (hipOccupancyMaxActiveBlocksPerMultiprocessor(&per_cu, (const void*)fwd_kernel, NWAVES * 64, LDS_BYTES) != hipSuccess || per_cu < 1) { fprintf(stderr, "kernel_launch: occupancy query says %d\n", per_cu); per_cu = 1; }
        (void)hipGetLastError();
        grid = cus;
    }
    if (grid < 0) return;
    (void)hipMemsetAsync((char*)d_ws + WS_CTL, 0, CTL_ZERO_BYTES, stream);
    Args a{};
    for (int i = 0; i < 25; ++i) a.in[i] = (const float*)d_in[i];
    a.out = (float*)d_out; a.ws = (unsigned char*)d_ws;
#if N_LAUNCH_MODE == 1
    a.ph_lo = 0; a.ph_hi = N_PHASES;
    hipLaunchKernelGGL(fwd_kernel, dim3(grid), dim3(NWAVES * 64), LDS_BYTES, stream, a);
#else
    for (int p = 0; p < N_PHASES; ++p) { a.ph_lo = p; a.ph_hi = p + 1; hipLaunchKernelGGL(fwd_kernel, dim3(grid), dim3(NWAVES * 64), LDS_BYTES, stream, a); }
#endif
    const hipError_t le = hipPeekAtLastError();
    if (le != hipSuccess) fprintf(stderr, "kernel_launch: launch failed: %s\n", hipGetErrorName(le));
}
```

```cpp
#include <hip/hip_runtime.h>
#include <cstdio>
#include <cstdint>

#define GAS __attribute__((address_space(1)))
#define LAS __attribute__((address_space(3)))
typedef unsigned short bf16;
typedef short bf16x8 __attribute__((ext_vector_type(8)));
typedef short s16x4 __attribute__((ext_vector_type(4)));
typedef float f32x4 __attribute__((ext_vector_type(4)));
typedef float f32x2 __attribute__((ext_vector_type(2)));
typedef float f32x16 __attribute__((ext_vector_type(16)));
typedef unsigned u32x4 __attribute__((ext_vector_type(4)));
typedef unsigned u32x2 __attribute__((ext_vector_type(2)));
typedef GAS unsigned gu32;

constexpr int NB = 8, SEQ = 4096, DM = 1024, LCTX = 256;
constexpr int RL = NB * SEQ;
constexpr int RC = NB * LCTX;
constexpr int RT = RL + RC;
constexpr int NHEAD = 8, NKVH = 2, HDIM = 128, QKVD = 1536;
constexpr int DFF = 3584, NEXP = 8;
constexpr float ALPHA = 1.4142135623730951f;
constexpr float LN_EPS = 1e-5f;
constexpr float LOG2E = 1.4426950408889634f;
constexpr int NWAVES = 8;

__device__ __forceinline__ unsigned cvtpk(float lo, float hi) { unsigned r; asm volatile("v_cvt_pk_bf16_f32 %0, %1, %2" : "=v"(r) : "v"(lo), "v"(hi)); return r; }
__device__ __forceinline__ float bflo(unsigned w) { return __uint_as_float(w << 16); }
__device__ __forceinline__ float bfhi(unsigned w) { return __uint_as_float(w & 0xffff0000u); }
__device__ __forceinline__ float ex2(float x) { return __builtin_amdgcn_exp2f(x); }
__device__ __forceinline__ float rcpf_(float x) { return __builtin_amdgcn_rcpf(x); }
__device__ __forceinline__ float sigm(float x) { return rcpf_(1.0f + ex2(-LOG2E * x)); }
typedef int v8i __attribute__((ext_vector_type(8)));
typedef int v4i __attribute__((ext_vector_type(4)));
__device__ __forceinline__ float clamp8(float x) { return __builtin_amdgcn_fmed3f(x, -448.f, 448.f); }
__device__ __forceinline__ unsigned pk4_fp8(float a, float b, float c, float d) {
    int p = __builtin_amdgcn_cvt_pk_fp8_f32(clamp8(a), clamp8(b), 0, false); p = __builtin_amdgcn_cvt_pk_fp8_f32(clamp8(c), clamp8(d), p, true); return (unsigned)p; }
__device__ __forceinline__ int lane_id() { int l; asm volatile("v_mbcnt_lo_u32_b32 %0, -1, 0\n\tv_mbcnt_hi_u32_b32 %0, -1, %0" : "=v"(l)); return l; }
#define REFRESH_F(F) do { (F).lane = lane_id(); (F).tid = (F).wave * 64 + (F).lane; } while (0)
__device__ __forceinline__ float dpp_add(float v, const int ctrl_sel) {
    int r;
    switch (ctrl_sel) { case 0: r = __builtin_amdgcn_update_dpp(0, __float_as_int(v), 0xB1, 0xf, 0xf, true); break;
                        case 1: r = __builtin_amdgcn_update_dpp(0, __float_as_int(v), 0x4E, 0xf, 0xf, true); break;
                        case 2: r = __builtin_amdgcn_update_dpp(0, __float_as_int(v), 0x141, 0xf, 0xf, true); break;
                        default: r = __builtin_amdgcn_update_dpp(0, __float_as_int(v), 0x140, 0xf, 0xf, true); break; }
    return v + __int_as_float(r);
}
__device__ __forceinline__ float wave_sum(float v) {
    v = dpp_add(v, 0); v = dpp_add(v, 1); v = dpp_add(v, 2); v = dpp_add(v, 3);
    const float r0 = __int_as_float(__builtin_amdgcn_readlane(__float_as_int(v), 0)), r1 = __int_as_float(__builtin_amdgcn_readlane(__float_as_int(v), 16)),
                r2 = __int_as_float(__builtin_amdgcn_readlane(__float_as_int(v), 32)), r3 = __int_as_float(__builtin_amdgcn_readlane(__float_as_int(v), 48));
    return (r0 + r1) + (r2 + r3);
}

namespace pg8 {
#define PG8_LAS __attribute__((address_space(3)))
typedef unsigned short bf16_t;
constexpr int BM = 256, BK = 64, HALF = 128, HTB = HALF * BK * 2, STAGE_BYTES = 8 * HTB, NXCD = 8, WGM = 8;
__host__ __device__ __forceinline__ int lds_byte(int r, int c) { const int st = (r >> 4) * 2 + (c >> 5), rr = r & 15, cc = c & 31, ob = rr * 64 + cc * 2; return st * 1024 + (ob ^ (((ob >> 9) & 1) << 5)); }
__host__ __device__ __forceinline__ void stage_rc(int b, int& R, int& C) { const int st = b / 1024, sb = b % 1024, swz = sb ^ (((sb >> 9) & 1) << 5); R = (st >> 1) * 16 + swz / 64; C = (st & 1) * 32 + (swz % 64) / 2; }
__host__ __device__ __forceinline__ int perm32(int rho) { const int n = rho >> 4, i = rho & 15; return 8 * (i >> 2) + 4 * n + (i & 3); }
struct Unit { int pm, pn; };
struct Gemm { const bf16_t* A; const bf16_t* Bt; int M, N, K; };
struct StaticOrder {
    int nM, nN, nwg, G, c;
    __host__ __device__ void init(int M, int N, int G_, int c_) { nM = M / BM; nN = N / BM; nwg = nM * nN; G = G_; c = c_; }
    __host__ __device__ bool next(int i, Unit& u) const {
        const long L = (long)i * G + c; if (L >= nwg) return false;
        int wgid = (int)L; { const int q = nwg / NXCD, r = nwg % NXCD, xcd = wgid % NXCD, off = wgid / NXCD; wgid = (xcd < r ? xcd * (q + 1) : r * (q + 1) + (xcd - r) * q) + off; }
        const int nig = WGM * nN, gid = wgid / nig, fm = gid * WGM, gsz = (nM - fm) < WGM ? (nM - fm) : WGM;
        u.pm = fm + ((wgid % nig) % gsz); u.pn = (wgid % nig) / gsz; return true;
    }
    __device__ __forceinline__ void a_ready(const Unit&) const {}
    __device__ __forceinline__ void done(const Unit&) const {}
};
struct MoeOrder {
    int nM, nN, nwg, G, c, npe; int t1, t2, t3, t4, t5, t6, t7;
    __device__ bool next(int i, Unit& u) const {
        const long L = (long)i * G + c; if (L >= nwg) return false;
        int wgid = (int)L; { const int q = nwg / NXCD, r = nwg % NXCD, xcd = wgid % NXCD, off = wgid / NXCD; wgid = (xcd < r ? xcd * (q + 1) : r * (q + 1) + (xcd - r) * q) + off; }
        const int nig = WGM * nN, gid = wgid / nig, fm = gid * WGM, gsz = (nM - fm) < WGM ? (nM - fm) : WGM;
        const int pm = fm + ((wgid % nig) % gsz), pnl = (wgid % nig) / gsz;
        const int e = (pm >= t1) + (pm >= t2) + (pm >= t3) + (pm >= t4) + (pm >= t5) + (pm >= t6) + (pm >= t7);
        u.pm = pm; u.pn = e * npe + pnl; return true;
    }
    __device__ __forceinline__ void a_ready(const Unit&) const {}
    __device__ __forceinline__ void done(const Unit&) const {}
};


struct EpiQKV {
    static constexpr bool PERM = true, AFTER_DRAIN = false;
    bf16_t* O; const float* rope; float ascale;
    __device__ __forceinline__ void operator()(const f32x4 (&acc)[2][2][4][2], const Unit& u, int wr, int wc, int fr, int fq) const {
        const int row0 = u.pm * BM + wr * 64 + fr;
        const bool rope_on = (u.pm < (RL / BM)) && (u.pn < 5);
        const int axis = wc & 1;
        const int colb = u.pn * 256 + (wc >> 1) * 128 + axis * 64 + 8 * fq;
#pragma unroll
        for (int ai = 0; ai < 2; ++ai)
#pragma unroll
            for (int m = 0; m < 4; ++m) {
                const int r = row0 + ai * HALF + m * 16;
                f32x4 a0 = acc[ai][0][m][0] * ascale, a1 = acc[ai][0][m][1] * ascale, b0 = acc[ai][1][m][0] * ascale, b1 = acc[ai][1][m][1] * ascale;
                if (rope_on) {
                    const int t = r & (SEQ - 1); const int pos = axis ? (t & 63) : (t >> 6);
                    const float* cp = rope + pos * 32 + 8 * fq;
                    const f32x4 c0 = *(const f32x4*)cp, c1 = *(const f32x4*)(cp + 4), s0 = *(const f32x4*)(cp + 2048), s1 = *(const f32x4*)(cp + 2052);
                    const f32x4 o0 = a0 * c0 - b0 * s0, o1 = a1 * c1 - b1 * s1, q0 = b0 * c0 + a0 * s0, q1 = b1 * c1 + a1 * s1;
                    a0 = o0; a1 = o1; b0 = q0; b1 = q1;
                }
                bf16_t* rowp = O + (size_t)r * QKVD + colb;
                u32x4 w; w.x = cvtpk(a0[0], a0[1]); w.y = cvtpk(a0[2], a0[3]); w.z = cvtpk(a1[0], a1[1]); w.w = cvtpk(a1[2], a1[3]);
                *(u32x4*)rowp = w;
                u32x4 v; v.x = cvtpk(b0[0], b0[1]); v.y = cvtpk(b0[2], b0[3]); v.z = cvtpk(b1[0], b1[1]); v.w = cvtpk(b1[2], b1[3]);
                *(u32x4*)(rowp + 32) = v;
            }
    }
};
template <bool LN> struct EpiResid {
    static constexpr bool PERM = true, AFTER_DRAIN = false;
    const float* xin_lat; const float* xin_ctx; bf16_t* y; const float* gate; float ascale; const f32x2* st; const float* lng; const float* lnb;
    __device__ __forceinline__ void operator()(const f32x4 (&acc)[2][2][4][2], const Unit& u, int wr, int wc, int fr, int fq) const {
        const bool lat = u.pm < (RL / BM);
        const int b = lat ? (u.pm >> 4) : 8;
        const int row0 = u.pm * BM + wr * 64 + fr, col0 = u.pn * BM + wc * 32 + 8 * fq;
        const float* xin = lat ? xin_lat + (size_t)row0 * DM : xin_ctx + (size_t)(row0 - RL) * DM;
        f32x2 sv[2][4];
        if constexpr (LN) {
#pragma unroll
            for (int ai = 0; ai < 2; ++ai)
#pragma unroll
                for (int m = 0; m < 4; ++m) sv[ai][m] = st[row0 + ai * HALF + m * 16];
        }
#pragma unroll
        for (int bj = 0; bj < 2; ++bj) { const int cc = col0 + bj * HALF;
            const f32x4 g0 = *(const f32x4*)(gate + (size_t)b * 6144 + cc) * ascale, g1 = *(const f32x4*)(gate + (size_t)b * 6144 + cc + 4) * ascale;
            f32x4 lg0, lg1, lb0, lb1; if constexpr (LN) { lg0 = *(const f32x4*)(lng + cc) * ALPHA; lg1 = *(const f32x4*)(lng + cc + 4) * ALPHA; lb0 = *(const f32x4*)(lnb + cc) * ALPHA; lb1 = *(const f32x4*)(lnb + cc + 4) * ALPHA; }
#pragma unroll
            for (int ai = 0; ai < 2; ++ai)
#pragma unroll
                for (int m = 0; m < 4; ++m) { const int rr = ai * HALF + m * 16; f32x4 x0, x1;
                    if constexpr (LN) { const u32x4 w = *(const u32x4*)(y + (size_t)(row0 + rr) * DM + cc);
                        x0 = (f32x4){bflo(w.x), bfhi(w.x), bflo(w.y), bfhi(w.y)}; x1 = (f32x4){bflo(w.z), bfhi(w.z), bflo(w.w), bfhi(w.w)};
                        x0 = (x0 - sv[ai][m].x) * sv[ai][m].y * lg0 + lb0; x1 = (x1 - sv[ai][m].x) * sv[ai][m].y * lg1 + lb1; }
                    else { x0 = *(const f32x4*)(xin + (size_t)rr * DM + cc) * ALPHA; x1 = *(const f32x4*)(xin + (size_t)rr * DM + cc + 4) * ALPHA; }
                    const f32x4 o0 = x0 + g0 * acc[ai][bj][m][0], o1 = x1 + g1 * acc[ai][bj][m][1];
                    u32x4 w; w.x = cvtpk(o0[0], o0[1]); w.y = cvtpk(o0[2], o0[3]); w.z = cvtpk(o1[0], o1[1]); w.w = cvtpk(o1[2], o1[3]);
                    *(u32x4*)(y + (size_t)(row0 + rr) * DM + cc) = w; }
            asm volatile("" ::: "memory"); }
    }
};
struct EpiSwiGLU {
    static constexpr bool PERM = true, AFTER_DRAIN = false;
    bf16_t* O; int npe;
    __device__ __forceinline__ void operator()(const f32x4 (&acc)[2][2][4][2], const Unit& u, int wr, int wc, int fr, int fq) const {
        const int row0 = u.pm * BM + wr * 64 + fr, pnl = u.pn % npe, col0 = pnl * 128 + wc * 32 + 8 * fq;
#pragma unroll
        for (int ai = 0; ai < 2; ++ai)
#pragma unroll
            for (int m = 0; m < 4; ++m) {
                unsigned w[4];
#pragma unroll
                for (int n = 0; n < 2; ++n) { const f32x4 g = acc[ai][0][m][n], uu = acc[ai][1][m][n]; float o[4];
#pragma unroll
                    for (int j = 0; j < 4; ++j) o[j] = g[j] * sigm(g[j]) * uu[j];
                    w[2 * n] = cvtpk(o[0], o[1]); w[2 * n + 1] = cvtpk(o[2], o[3]); }
                u32x4 ww; ww.x = w[0]; ww.y = w[1]; ww.z = w[2]; ww.w = w[3];
                *(u32x4*)(O + (size_t)(row0 + ai * HALF + m * 16) * DFF + col0) = ww;
            }
    }
};
struct EpiLruIn {
    static constexpr bool PERM = true, AFTER_DRAIN = false;
    bf16_t* G; bf16_t* XB;
    __device__ __forceinline__ void operator()(const f32x4 (&acc)[2][2][4][2], const Unit& u, int wr, int wc, int fr, int fq) const {
        const int row0 = u.pm * BM + wr * 64 + fr; const bool isg = u.pn < 4;
        bf16_t* base = isg ? G : XB; const int col0 = (u.pn & 3) * BM + wc * 32 + 8 * fq;
#pragma unroll
        for (int ai = 0; ai < 2; ++ai)
#pragma unroll
            for (int m = 0; m < 4; ++m)
#pragma unroll
                for (int bj = 0; bj < 2; ++bj) {
                    f32x4 v0 = acc[ai][bj][m][0], v1 = acc[ai][bj][m][1];
                    if (isg) {
#pragma unroll
                        for (int j = 0; j < 4; ++j) { float x = v0[j]; float z = 0.7978845608028654f * (x + 0.044715f * x * x * x); v0[j] = x * sigm(2.0f * z);
                            x = v1[j]; z = 0.7978845608028654f * (x + 0.044715f * x * x * x); v1[j] = x * sigm(2.0f * z); }
                    }
                    u32x4 w; w.x = cvtpk(v0[0], v0[1]); w.y = cvtpk(v0[2], v0[3]); w.z = cvtpk(v1[0], v1[1]); w.w = cvtpk(v1[2], v1[3]);
                    *(u32x4*)(base + (size_t)(row0 + ai * HALF + m * 16) * DM + col0 + bj * HALF) = w;
                }
    }
};
struct EpiMoeOut {
    static constexpr bool PERM = true, AFTER_DRAIN = false;
    bf16_t* O; const float* wrow;
    __device__ __forceinline__ void operator()(const f32x4 (&acc)[2][2][4][2], const Unit& u, int wr, int wc, int fr, int fq) const {
        const int row0 = u.pm * BM + wr * 64 + fr, col0 = (u.pn & 3) * BM + wc * 32 + 8 * fq;
#pragma unroll
        for (int ai = 0; ai < 2; ++ai)
#pragma unroll
            for (int m = 0; m < 4; ++m) { const int r = row0 + ai * HALF + m * 16; const float g = wrow[r];
#pragma unroll
                for (int bj = 0; bj < 2; ++bj) { const f32x4 v0 = acc[ai][bj][m][0] * g, v1 = acc[ai][bj][m][1] * g;
                    u32x4 w; w.x = cvtpk(v0[0], v0[1]); w.y = cvtpk(v0[2], v0[3]); w.z = cvtpk(v1[0], v1[1]); w.w = cvtpk(v1[2], v1[3]);
                    *(u32x4*)(O + (size_t)r * DM + col0 + bj * HALF) = w; } }
    }
};

struct EpiSwiGLU8 {
    static constexpr bool PERM = true, AFTER_DRAIN = false;
    unsigned char* O; int npe;
    __device__ __forceinline__ void operator()(const f32x4 (&acc)[2][2][4][2], const Unit& u, int wr, int wc, int fr, int fq) const {
        const int row0 = u.pm * BM + wr * 64 + fr, pnl = u.pn % npe, col0 = pnl * 128 + wc * 32 + 8 * fq;
        constexpr float C1 = -LOG2E / 512.0f, KK = 32768.0f;
#pragma unroll
        for (int ai = 0; ai < 2; ++ai)
#pragma unroll
            for (int m = 0; m < 4; ++m) {
                u32x2 w;
#pragma unroll
                for (int n = 0; n < 2; ++n) { const f32x4 g = acc[ai][0][m][n], uu = acc[ai][1][m][n];
                    const f32x2 g0 = __builtin_shufflevector(g, g, 0, 1), g1 = __builtin_shufflevector(g, g, 2, 3), u0 = __builtin_shufflevector(uu, uu, 0, 1), u1 = __builtin_shufflevector(uu, uu, 2, 3);
                    const f32x2 t0 = g0 * C1, t1 = g1 * C1;
                    const f32x2 e0 = (f32x2){ex2(t0.x), ex2(t0.y)}, e1 = (f32x2){ex2(t1.x), ex2(t1.y)};
                    const f32x2 d0 = e0 * KK + KK, d1 = e1 * KK + KK;
                    const f32x2 o0 = (g0 * u0) * (f32x2){rcpf_(d0.x), rcpf_(d0.y)}, o1 = (g1 * u1) * (f32x2){rcpf_(d1.x), rcpf_(d1.y)};
                    w[n] = pk4_fp8(o0.x, o0.y, o1.x, o1.y); }
                *(u32x2*)(O + (size_t)(row0 + ai * HALF + m * 16) * DFF + col0) = w;
            }
    }
};
struct EpiMoeOut8 {
    static constexpr bool PERM = true, AFTER_DRAIN = false;
    bf16_t* O; const float* wrow;
    __device__ __forceinline__ void operator()(const f32x4 (&acc)[2][2][4][2], const Unit& u, int wr, int wc, int fr, int fq) const {
        const int row0 = u.pm * BM + wr * 64 + fr, col0 = (u.pn & 3) * BM + wc * 32 + 8 * fq;
#pragma unroll
        for (int ai = 0; ai < 2; ++ai)
#pragma unroll
            for (int m = 0; m < 4; ++m) { const int r = row0 + ai * HALF + m * 16; const float g = wrow[r] * (1.0f / 4096.0f);
#pragma unroll
                for (int bj = 0; bj < 2; ++bj) { const f32x4 v0 = acc[ai][bj][m][0] * g, v1 = acc[ai][bj][m][1] * g;
                    u32x4 w; w.x = cvtpk(v0[0], v0[1]); w.y = cvtpk(v0[2], v0[3]); w.z = cvtpk(v1[0], v1[1]); w.w = cvtpk(v1[2], v1[3]);
                    *(u32x4*)(O + (size_t)r * DM + col0 + bj * HALF) = w; } }
    }
};

template <class Epi, class Sched, bool ALIGN_EPI = false, bool SP2 = false, bool FP8 = false>
__device__ __forceinline__ void gemm_phase(PG8_LAS unsigned char* lds, const Gemm g, const Sched& S, const Epi& E, const int wid) {
    const int lane = lane_id(), tid = wid * 64 + lane, wr = wid >> 2, wc = wid & 3, fr = lane & 15, fq = lane >> 4;
    const int K = g.K, nt = K / BK;
    unsigned voffA[2], voffB[2];
#pragma unroll
    for (int i = 0; i < 2; ++i) { int R, C; stage_rc(tid * 16 + i * 8192, R, C); const int Rb = Epi::PERM ? ((R & ~31) + perm32(R & 31)) : R;
        voffA[i] = (unsigned)(R * K + C) * 2u; voffB[i] = (unsigned)(Rb * K + C) * 2u; }
    const unsigned kstep = (unsigned)(BK * 2);
    const unsigned hstep = (unsigned)HALF * K * 2;
    const unsigned tstep = 2 * hstep;
    const __amdgpu_buffer_rsrc_t rs_voffA = __builtin_amdgcn_make_buffer_rsrc((void*)g.A, 0, -1, 0x00020000), rs_voffB = __builtin_amdgcn_make_buffer_rsrc((void*)g.Bt, 0, -1, 0x00020000);
    const unsigned ldsw = (unsigned)wid * 1024u;
    const int aoff = lds_byte(wr * 64 + fr, fq * 8), boff = lds_byte(wc * 32 + fr, fq * 8);
#define PG8_SA(b, h) (((b) * 2 + (h)) * HTB)
#define PG8_SB(b, h) ((4 + (b) * 2 + (h)) * HTB)
#define PG8_STAGE(bufoff, gbase, voff) do { _Pragma("unroll") for (int _i = 0; _i < 2; ++_i) \
        __builtin_amdgcn_raw_ptr_buffer_load_lds(rs_##voff, (PG8_LAS void*)(lds + (bufoff) + ldsw + _i * 8192), 16, (voff)[_i], (gbase), 0, 0); } while (0)
#define PG8_LDA(dst, b, h) do { if constexpr (FP8) { _Pragma("unroll") for (int m = 0; m < 4; ++m) { const v4i _l = *(const PG8_LAS v4i*)(lds + PG8_SA(b, h) + aoff + m * 2048), _h = *(const PG8_LAS v4i*)(lds + PG8_SA(b, h) + aoff + m * 2048 + 1024); \
            dst##8[m] = __builtin_shufflevector(_l, _h, 0, 1, 2, 3, 4, 5, 6, 7); } } \
        else { _Pragma("unroll") for (int m = 0; m < 4; ++m) _Pragma("unroll") for (int k = 0; k < 2; ++k) dst[m][k] = *(const PG8_LAS bf16x8*)(lds + PG8_SA(b, h) + aoff + m * 2048 + k * 1024); } } while (0)
#define PG8_LDB(dst, b, h) do { if constexpr (FP8) { _Pragma("unroll") for (int n = 0; n < 2; ++n) { const v4i _l = *(const PG8_LAS v4i*)(lds + PG8_SB(b, h) + boff + n * 2048), _h = *(const PG8_LAS v4i*)(lds + PG8_SB(b, h) + boff + n * 2048 + 1024); \
            dst##8[n] = __builtin_shufflevector(_l, _h, 0, 1, 2, 3, 4, 5, 6, 7); } } \
        else { _Pragma("unroll") for (int n = 0; n < 2; ++n) _Pragma("unroll") for (int k = 0; k < 2; ++k) dst[n][k] = *(const PG8_LAS bf16x8*)(lds + PG8_SB(b, h) + boff + n * 2048 + k * 1024); } } while (0)
#define PG8_MMA(ai, bj, At, Bt) do { if constexpr (FP8) __builtin_amdgcn_sched_barrier(0); __builtin_amdgcn_s_setprio(1); \
        if constexpr (FP8) { _Pragma("unroll") for (int m = 0; m < 4; ++m) _Pragma("unroll") for (int n = 0; n < 2; ++n) \
            acc[ai][bj][m][n] = __builtin_amdgcn_mfma_scale_f32_16x16x128_f8f6f4(Bt##8[n], At##8[m], acc[ai][bj][m][n], 0, 0, 0, 0, 0, 0); } \
        else { _Pragma("unroll") for (int m = 0; m < 4; ++m) _Pragma("unroll") for (int n = 0; n < 2; ++n) _Pragma("unroll") for (int k = 0; k < 2; ++k) \
            acc[ai][bj][m][n] = __builtin_amdgcn_mfma_f32_16x16x32_bf16(Bt[n][k], At[m][k], acc[ai][bj][m][n], 0, 0, 0); } \
        __builtin_amdgcn_s_setprio(0); if constexpr (FP8) __builtin_amdgcn_sched_barrier(0); } while (0)
#define PG8_WAIT_V(n) asm volatile("s_waitcnt vmcnt(" #n ")" ::: "memory")
#define PG8_WAIT_L(n) asm volatile("s_waitcnt lgkmcnt(" #n ")" ::: "memory")
#define PG8_BAR __builtin_amdgcn_s_barrier()
#define PG8_SCHED __builtin_amdgcn_sched_barrier(0)
    Unit cur, nxt; int ui = 0;
    if (!S.next(0, cur)) return;
    f32x4 acc[2][2][4][2];
#pragma unroll
    for (int a = 0; a < 2; ++a)
#pragma unroll
        for (int b = 0; b < 2; ++b)
#pragma unroll
            for (int m = 0; m < 4; ++m)
#pragma unroll
                for (int n = 0; n < 2; ++n) acc[a][b][m][n] = (f32x4){0.f, 0.f, 0.f, 0.f};
    bf16x8 At[4][2], B0[2][2], B1[2][2]; v8i At8[4], B08[2], B18[2];
    unsigned cA = (unsigned)cur.pm * tstep, cB = (unsigned)cur.pn * tstep;
    S.a_ready(cur);
    if constexpr (SP2) {
        PG8_STAGE(PG8_SB(0, 0), cB, voffB); PG8_STAGE(PG8_SB(0, 1), cB + hstep, voffB); PG8_STAGE(PG8_SA(0, 0), cA, voffA); PG8_STAGE(PG8_SA(0, 1), cA + hstep, voffA);
        if (wr == 1) PG8_BAR;
        PG8_WAIT_V(2); PG8_BAR;
        PG8_STAGE(PG8_SB(1, 0), cB + kstep, voffB); PG8_STAGE(PG8_SA(1, 0), cA + kstep, voffA); PG8_STAGE(PG8_SB(1, 1), cB + hstep + kstep, voffB);
        PG8_WAIT_V(6); PG8_BAR;
    } else {
        PG8_STAGE(PG8_SB(0, 0), cB, voffB); PG8_STAGE(PG8_SA(0, 0), cA, voffA); PG8_STAGE(PG8_SB(0, 1), cB + hstep, voffB); PG8_STAGE(PG8_SA(0, 1), cA + hstep, voffA);
        if (wr == 1) PG8_BAR;
        PG8_WAIT_V(4); PG8_BAR;
        PG8_STAGE(PG8_SB(1, 0), cB + kstep, voffB); PG8_STAGE(PG8_SA(1, 0), cA + kstep, voffA); PG8_STAGE(PG8_SB(1, 1), cB + hstep + kstep, voffB);
        PG8_WAIT_V(6); PG8_BAR;
    }
    for (;;) {
        const bool has_next = S.next(ui + 1, nxt);
        const unsigned nA = has_next ? (unsigned)nxt.pm * tstep : cA, nB = has_next ? (unsigned)nxt.pn * tstep : cB;
        _Pragma("clang loop unroll(disable)") for (int t = 0; t < nt; t += 2) {
            const bool last = (t == nt - 2);
            const unsigned a1 = cA + (unsigned)(t + 1) * kstep;
            const unsigned a2 = last ? nA : cA + (unsigned)(t + 2) * kstep, b2 = last ? nB : cB + (unsigned)(t + 2) * kstep;
            const unsigned a3 = a2 + kstep, b3 = b2 + kstep;
            if (last && has_next) S.a_ready(nxt);
            if constexpr (SP2) {
            PG8_LDB(B0, 0, 0); PG8_LDB(B1, 0, 1); PG8_SCHED; PG8_LDA(At, 0, 0); PG8_STAGE(PG8_SA(1, 1), a1 + hstep, voffA);
            PG8_WAIT_V(8); PG8_WAIT_L(0); PG8_BAR; PG8_MMA(0, 0, At, B0); PG8_MMA(0, 1, At, B1); PG8_BAR; PG8_SCHED;
            PG8_LDA(At, 0, 1); PG8_STAGE(PG8_SB(0, 0), b2, voffB); PG8_STAGE(PG8_SB(0, 1), b2 + hstep, voffB); PG8_STAGE(PG8_SA(0, 0), a2, voffA);
            PG8_WAIT_V(8); PG8_WAIT_L(0); PG8_BAR; PG8_MMA(1, 0, At, B0); PG8_MMA(1, 1, At, B1); PG8_BAR; PG8_SCHED;
            PG8_LDB(B0, 1, 0); PG8_LDB(B1, 1, 1); PG8_SCHED; PG8_LDA(At, 1, 0); PG8_STAGE(PG8_SA(0, 1), a2 + hstep, voffA);
            PG8_WAIT_V(8); PG8_WAIT_L(0); PG8_BAR; PG8_MMA(0, 0, At, B0); PG8_MMA(0, 1, At, B1); PG8_BAR; PG8_SCHED;
            PG8_LDA(At, 1, 1); PG8_STAGE(PG8_SB(1, 0), b3, voffB); PG8_STAGE(PG8_SB(1, 1), b3 + hstep, voffB); PG8_STAGE(PG8_SA(1, 0), a3, voffA);
            PG8_WAIT_V(8); PG8_WAIT_L(0); PG8_BAR; PG8_MMA(1, 0, At, B0); PG8_MMA(1, 1, At, B1); PG8_BAR; PG8_SCHED;
            } else {
            PG8_LDB(B0, 0, 0); PG8_SCHED; PG8_LDA(At, 0, 0); PG8_STAGE(PG8_SA(1, 1), a1 + hstep, voffA);
            PG8_WAIT_L(8); PG8_BAR; PG8_WAIT_L(0); PG8_MMA(0, 0, At, B0); PG8_BAR; PG8_SCHED;
            PG8_LDB(B1, 0, 1); PG8_STAGE(PG8_SB(0, 0), b2, voffB);
            PG8_BAR; PG8_WAIT_L(0); PG8_MMA(0, 1, At, B1); PG8_BAR;
            PG8_LDA(At, 0, 1); PG8_STAGE(PG8_SA(0, 0), a2, voffA);
            PG8_BAR; PG8_WAIT_L(0); PG8_MMA(1, 0, At, B0); PG8_BAR; PG8_SCHED;
            PG8_STAGE(PG8_SB(0, 1), b2 + hstep, voffB);
            PG8_WAIT_V(6); PG8_BAR; PG8_MMA(1, 1, At, B1); PG8_BAR;
            PG8_LDB(B0, 1, 0); PG8_SCHED; PG8_LDA(At, 1, 0); PG8_STAGE(PG8_SA(0, 1), a2 + hstep, voffA);
            PG8_WAIT_L(8); PG8_BAR; PG8_WAIT_L(0); PG8_MMA(0, 0, At, B0); PG8_BAR; PG8_SCHED;
            PG8_LDB(B1, 1, 1); PG8_STAGE(PG8_SB(1, 0), b3, voffB);
            PG8_BAR; PG8_WAIT_L(0); PG8_MMA(0, 1, At, B1); PG8_BAR;
            PG8_LDA(At, 1, 1); PG8_STAGE(PG8_SA(1, 0), a3, voffA);
            PG8_BAR; PG8_WAIT_L(0); PG8_MMA(1, 0, At, B0); PG8_BAR; PG8_SCHED;
            PG8_STAGE(PG8_SB(1, 1), b3 + hstep, voffB);
            PG8_WAIT_V(6); PG8_BAR; PG8_MMA(1, 1, At, B1); PG8_BAR;
            }
        }
        if constexpr (ALIGN_EPI) { if (wr == 0) PG8_BAR; }
        if constexpr (!Epi::AFTER_DRAIN) { int le = lane_id();
            E(acc, cur, wr, wc, le & 15, le >> 4); S.done(cur); }
        if (!has_next) break;
#pragma unroll
        for (int a = 0; a < 2; ++a)
#pragma unroll
            for (int b = 0; b < 2; ++b)
#pragma unroll
                for (int m = 0; m < 4; ++m)
#pragma unroll
                    for (int n = 0; n < 2; ++n) acc[a][b][m][n] = (f32x4){0.f, 0.f, 0.f, 0.f};
        cur = nxt; cA = nA; cB = nB; ++ui;
        if constexpr (ALIGN_EPI) { if (wr == 1) PG8_BAR; }
    }
    PG8_WAIT_V(0);
    if constexpr (!ALIGN_EPI) { if (wr == 0) PG8_BAR; }
    PG8_BAR;
    if constexpr (Epi::AFTER_DRAIN) { E.fused(acc, cur, wr, wc, fr, fq, lds, wid, lane); S.done(cur); }
#undef PG8_SA
#undef PG8_SB
#undef PG8_STAGE
#undef PG8_LDA
#undef PG8_LDB
#undef PG8_MMA
#undef PG8_WAIT_V
#undef PG8_WAIT_L
#undef PG8_BAR
#undef PG8_SCHED
}
}

constexpr size_t MiB = 1u << 20;
constexpr size_t WS_CTL = 0, CTL_ZERO_BYTES = 65536;
constexpr size_t WS_MOD = 65536;
constexpr size_t WS_ROPE = 65536 + 458752;
constexpr size_t WS_WQKV = 1 * MiB, WS_WO = 4 * MiB, WS_WGU = 6 * MiB, WS_WDN = 20 * MiB, WS_WIN = 27 * MiB, WS_WOUT = 31 * MiB, WS_WLG = 33 * MiB;
constexpr size_t WS_WMGU = 34 * MiB, WS_WMDN = 146 * MiB;
constexpr size_t WS_YB = 760 * MiB;
constexpr size_t WS_H = 210 * MiB;
constexpr size_t WS_ACTV = 278 * MiB;
constexpr size_t WS_QKV = WS_ACTV, WS_O = WS_ACTV + 102 * MiB, WS_ACT = WS_ACTV + 170 * MiB;
constexpr size_t WS_G = WS_ACTV, WS_XB = WS_ACTV + 68 * MiB, WS_HF = WS_ACTV + 136 * MiB, WS_HH = WS_ACTV + 200 * MiB;
constexpr size_t WS_U = WS_ACTV + 264 * MiB;
constexpr size_t WS_HS = WS_ACTV, WS_FO = WS_ACTV + 68 * MiB, WS_MACT = WS_ACTV + 200 * MiB;
constexpr size_t WS_ROUTE = 872 * MiB;
constexpr size_t WS_LRUS = 874 * MiB;
constexpr size_t WS_END = 875 * MiB;
constexpr int MOE_MAXT = 264;
constexpr size_t RT_EIDX = 0, RT_WGT = 262144, RT_SLOT = 524288, RT_WS = 786432, RT_CNT = 786432 + 270336 + 0;
constexpr size_t LS_SUM = 0, LS_CTX = 524288;
constexpr size_t WS_STATS = WS_LRUS + 655360;

constexpr int RING_OFF = 0, RING_BYTES = 135168;
constexpr int LDSCTL_OFF = RING_BYTES, MISC_OFF = LDSCTL_OFF + 320;
constexpr int LDS_BYTES = 136192;

#define RLX_AGENT __ATOMIC_RELAXED, __HIP_MEMORY_SCOPE_AGENT
#define LDS_WAIT() asm volatile("s_waitcnt lgkmcnt(0)" ::: "memory")
#define VM_WAIT() asm volatile("s_waitcnt vmcnt(0)" ::: "memory")
#define XB_TMO      128
#define XB_XCNT(j)  (256  + 64 * (j))
#define XB_XSUB(j)  (1280 + 64 * (j))
#define XB_XGEN(j)  (2304 + 64 * (j))
#define XB_TOP      3328
#define XB_TOPGEN   3392
#define XCD_BAR_WORDS 3456
#define XB_SPIN_CAP (1u << 18)

__device__ __forceinline__ unsigned xb_ld(unsigned* p)              { return __hip_atomic_load(p, __ATOMIC_RELAXED, __HIP_MEMORY_SCOPE_AGENT); }
__device__ __forceinline__ unsigned xb_add(unsigned* p, unsigned v) { return __hip_atomic_fetch_add(p, v, __ATOMIC_RELAXED, __HIP_MEMORY_SCOPE_AGENT); }
__device__ __forceinline__ unsigned xb_xcc_id() { return (unsigned)__builtin_amdgcn_s_getreg((3 << 11) | 20) & 0xFu; }
#define XB_SPIN(cond, bar) do { unsigned _sp = 0; while (cond) { __builtin_amdgcn_s_sleep(1); \
    if ((++_sp & 255u) == 0u) { if (xb_ld(&(bar)[XB_TMO])) break; if (_sp > XB_SPIN_CAP) { atomicAdd(&(bar)[XB_TMO], 1u); break; } } } } while (0)

struct XcdBarrier {
    unsigned* bar; unsigned x;
    volatile LAS unsigned* st;
};

__device__ __forceinline__ XcdBarrier xcd_barrier_post(unsigned* bar, volatile LAS unsigned* st, const bool t0  ) {
    XcdBarrier b; b.bar = bar; b.x = xb_xcc_id(); b.st = st;
    if (t0) (void)xb_add(&bar[XB_XCNT(b.x)], 1u);
    return b;
}
__device__ __forceinline__ void xcd_barrier_complete(unsigned* bar, unsigned x, unsigned& nloc, unsigned& nx) {
    const unsigned G = gridDim.x * gridDim.y * gridDim.z;
    unsigned sum, cnt, mine, sp = 0u;
    for (;;) {
        sum = 0u; cnt = 0u; mine = 0u;
#pragma unroll
        for (unsigned j = 0; j < 16; ++j) { const unsigned c = xb_ld(&bar[XB_XCNT(j)]); sum += c; cnt += (c > 0u) ? 1u : 0u; mine = (j == x) ? c : mine; }
        if (sum == G) break;
        __builtin_amdgcn_s_sleep(1);
        if ((++sp & 255u) == 0u) { if (xb_ld(&bar[XB_TMO])) break; if (sp > XB_SPIN_CAP) { atomicAdd(&bar[XB_TMO], 1u); break; } }
    }
    nloc = mine > 0u ? mine : 1u; nx = cnt > 0u ? cnt : 1u;
}

__device__ __forceinline__ void xcd_barrier(const XcdBarrier& b, const bool t0  ) {
    asm volatile("s_waitcnt vmcnt(0)" ::: "memory");
    __syncthreads();
    if (t0) {
        unsigned* bar = b.bar;
        __builtin_amdgcn_s_waitcnt(0);
        unsigned nloc = b.st[0], nx = b.st[1];
        if (nloc == 0u) { xcd_barrier_complete(bar, b.x, nloc, nx); b.st[0] = nloc; b.st[1] = nx; }
        const unsigned old = xb_add(&bar[XB_XSUB(b.x)], 1u);
        const unsigned gen = old / nloc;
        if (old + 1u == (gen + 1u) * nloc) {
            __builtin_amdgcn_fence(__ATOMIC_RELEASE, "agent");
            asm volatile("s_waitcnt vmcnt(0)" ::: "memory");
            const unsigned og = xb_add(&bar[XB_TOP], 1u);
            const unsigned tg = og / nx;
            if (og + 1u == (tg + 1u) * nx) xb_add(&bar[XB_TOPGEN], 1u);
            else XB_SPIN(xb_ld(&bar[XB_TOPGEN]) == tg, bar);
            __builtin_amdgcn_fence(__ATOMIC_ACQUIRE, "agent");
            xb_add(&bar[XB_XGEN(b.x)], 1u);
            asm volatile("s_waitcnt vmcnt(0)" ::: "memory");
        } else {
            XB_SPIN(xb_ld(&bar[XB_XGEN(b.x)]) == gen, bar);
            __builtin_amdgcn_fence(__ATOMIC_ACQUIRE, "agent");
            asm volatile("s_waitcnt vmcnt(0)" ::: "memory");
        }
    }
    __syncthreads();
}


struct Frame {
    LAS unsigned char* lds;
    volatile LAS unsigned* MISC;
    int tid, lane, wave, vcu, G;
    const float *x, *c, *ctx, *cctx, *w_mod, *b_mod, *ln_g, *ln_b, *w_qkv, *w_o, *sink, *w_gu, *w_dn, *w_in, *conv_w, *conv_b, *lam, *w_r, *b_r, *w_i, *b_i, *w_out, *router, *mw_gu, *mw_dn;
    float* out; unsigned char* ws;
};
#define WSP(T, off) ((T*)(F.ws + (off)))

__device__ __forceinline__ void p0_mod_task(Frame& F, int task) {
    const int li = task / 96, cb = task % 96;
    LAS float* S = (LAS float*)F.lds;
    LAS float* red = (LAS float*)(F.lds + 36864);
    for (int idx = F.tid; idx < 9 * 1024; idx += NWAVES * 64) { const int b = idx >> 10, k = idx & 1023; const float v = (b < 8) ? F.c[b * 1024 + k] : F.cctx[k]; S[idx] = v * sigm(v); }
    __syncthreads();
    const float* W = F.w_mod + (size_t)li * 1024 * 6144 + cb * 64;
    const int cl = F.lane & 15, kr = F.lane >> 4;
    f32x4 acc[9];
#pragma unroll
    for (int b = 0; b < 9; ++b) acc[b] = (f32x4){0.f, 0.f, 0.f, 0.f};
#pragma unroll 4
    for (int kk = 0; kk < 32; ++kk) { const int k = 128 * F.wave + 4 * kk + kr; const f32x4 wv = *(const f32x4*)(W + (size_t)k * 6144 + 4 * cl);
#pragma unroll
        for (int b = 0; b < 9; ++b) acc[b] += wv * S[b * 1024 + k]; }
#pragma unroll
    for (int b = 0; b < 9; ++b)
#pragma unroll
        for (int j = 0; j < 4; ++j) { float v = acc[b][j]; v += __shfl_xor(v, 16); v += __shfl_xor(v, 32); acc[b][j] = v; }
    if (kr == 0) {
#pragma unroll
        for (int b = 0; b < 9; ++b) *(LAS f32x4*)(red + (F.wave * 9 + b) * 64 + 4 * cl) = acc[b]; }
    __syncthreads();
    float* mod = WSP(float, WS_MOD);
    for (int idx = F.tid; idx < 9 * 64; idx += NWAVES * 64) { const int b = idx >> 6, col = idx & 63; float s = 0.f;
#pragma unroll
        for (int w = 0; w < 8; ++w) s += red[(w * 9 + b) * 64 + col];
        mod[(size_t)(li * 9 + b) * 6144 + cb * 64 + col] = s + F.b_mod[li * 6144 + cb * 64 + col]; }
    __syncthreads();
}
__device__ __forceinline__ void p0_transpose_item(const float* W, int K, int N, bf16* WT, int kb, int n0, int drow0, LAS float* scr, int lane) {
    const int k0 = 64 * kb;
#pragma unroll
    for (int i = 0; i < 8; ++i) { const int kk = 8 * i + (lane >> 3); const f32x4 wv = *(const f32x4*)(W + (size_t)(k0 + kk) * N + n0 + 4 * (lane & 7));
        LAS float* d = scr + kk * 33 + 4 * (lane & 7); d[0] = wv[0]; d[1] = wv[1]; d[2] = wv[2]; d[3] = wv[3]; }
    LDS_WAIT(); asm volatile("" ::: "memory");
    const int c = lane & 7;
#pragma unroll
    for (int j = 0; j < 4; ++j) { const int n = (lane >> 3) + 8 * j; const LAS float* s = scr + (8 * c) * 33 + n;
        u32x4 o; o.x = cvtpk(s[0 * 33], s[1 * 33]); o.y = cvtpk(s[2 * 33], s[3 * 33]); o.z = cvtpk(s[4 * 33], s[5 * 33]); o.w = cvtpk(s[6 * 33], s[7 * 33]);
        *(GAS u32x4*)(WT + (size_t)(drow0 + n) * K + k0 + 8 * c) = o; }
    LDS_WAIT(); asm volatile("" ::: "memory");
}
template <int QS> __device__ __forceinline__ void p0_transpose_item8(const float* W, int K, int N, unsigned char* WT, int kb, int n0, int drow0, LAS float* scr, int lane) {
    const int k0 = 64 * kb; constexpr float qs = (float)(1 << QS);
#pragma unroll
    for (int i = 0; i < 8; ++i) { const int kk = 8 * i + (lane >> 3); const f32x4 wv = *(const f32x4*)(W + (size_t)(k0 + kk) * N + n0 + 4 * (lane & 7)) * qs;
        LAS float* d = scr + kk * 33 + 4 * (lane & 7); d[0] = wv[0]; d[1] = wv[1]; d[2] = wv[2]; d[3] = wv[3]; }
    LDS_WAIT(); asm volatile("" ::: "memory");
    const int c = lane & 7;
#pragma unroll
    for (int j = 0; j < 4; ++j) { const int n = (lane >> 3) + 8 * j; const LAS float* s = scr + (8 * c) * 33 + n;
        u32x2 o; o.x = pk4_fp8(s[0 * 33], s[1 * 33], s[2 * 33], s[3 * 33]); o.y = pk4_fp8(s[4 * 33], s[5 * 33], s[6 * 33], s[7 * 33]);
        *(GAS u32x2*)(WT + (size_t)(drow0 + n) * K + k0 + 8 * c) = o; }
    LDS_WAIT(); asm volatile("" ::: "memory");
}
__device__ __forceinline__ int gu_row(int j) { const int isu = j >= DFF, jj = isu ? j - DFF : j; return (jj >> 7) * 256 + isu * 128 + (jj & 127); }
__device__ __forceinline__ int qkv_row(int L) { const int pn = L >> 8, rem = L & 255, hsel = rem >> 7, axis = (rem >> 6) & 1, half = (rem >> 5) & 1, x = rem & 31; return pn * 256 + 128 * half + 32 * (2 * hsel + axis) + x; }

__device__ __forceinline__ void p0_prologue(Frame& F) {
    for (int task = F.vcu; task < 192; task += F.G) p0_mod_task(F, task);
    if (F.vcu == F.G - 1) {
        float* rope = WSP(float, WS_ROPE);
        for (int idx = F.tid; idx < 2048; idx += NWAVES * 64) { const int pos = idx >> 5, i = idx & 31;
            const double freq = exp2(-(double)i * (13.287712379549449 / 32.0));
            const float ang = (float)pos * (float)freq;
            double rev = (double)ang * 0.15915494309189535; rev -= floor(rev);
            rope[idx] = __builtin_amdgcn_cosf((float)rev); rope[2048 + idx] = __builtin_amdgcn_sinf((float)rev); }
    }
    LAS float* scr = (LAS float*)(F.lds + F.wave * 8704);
    const int gw = F.vcu * NWAVES + F.wave, NGW = F.G * NWAVES;
    constexpr int I_QKV = 16 * 48;
    for (int r = gw; r < I_QKV; r += NGW) { const int kb = r / 48, n0 = (r % 48) * 32; p0_transpose_item8<7>(F.w_qkv, 1024, 1536, WSP(unsigned char, WS_WQKV), kb, n0, qkv_row(n0), scr, F.lane); }
}

constexpr int MOE_I_GU = 16 * 224, MOE_I_DN = 56 * 32, MOE_ITEMS = 8 * (MOE_I_GU + MOE_I_DN);
constexpr int DR_O = 16 * 32, DR_GU = 16 * 224, DR_DN = 56 * 32, DR_IN = 16 * 64, DR_OUT = 16 * 32, DR_LG = 32 * 8, DR_ITEMS = DR_O + DR_GU + DR_DN + DR_IN + DR_OUT + DR_LG;
constexpr int CV_ITEMS = DR_ITEMS + MOE_ITEMS;
__device__ __forceinline__ void moe_convert_items(Frame& F, int lo, int hi, int rank, int nranks) {
    LAS float* scr = (LAS float*)(F.lds + F.wave * 8704);
    for (int it0 = lo + rank * NWAVES + F.wave; it0 < hi; it0 += nranks * NWAVES) {
        int r = it0;
        if (r < DR_O) { const int kb = r / 32, n0 = (r % 32) * 32; p0_transpose_item8<7>(F.w_o, 1024, 1024, WSP(unsigned char, WS_WO), kb, n0, n0, scr, F.lane); continue; } r -= DR_O;
        if (r < DR_GU) { const int kb = r / 224, n0 = (r % 224) * 32; p0_transpose_item8<7>(F.w_gu, 1024, 7168, WSP(unsigned char, WS_WGU), kb, n0, gu_row(n0), scr, F.lane); continue; } r -= DR_GU;
        if (r < DR_DN) { const int kb = r / 32, n0 = (r % 32) * 32; p0_transpose_item8<9>(F.w_dn, 3584, 1024, WSP(unsigned char, WS_WDN), kb, n0, n0, scr, F.lane); continue; } r -= DR_DN;
        if (r < DR_IN) { const int kb = r / 64, n0 = (r % 64) * 32; p0_transpose_item(F.w_in, 1024, 2048, WSP(bf16, WS_WIN), kb, n0, n0, scr, F.lane); continue; } r -= DR_IN;
        if (r < DR_OUT) { const int kb = r / 32, n0 = (r % 32) * 32; p0_transpose_item(F.w_out, 1024, 1024, WSP(bf16, WS_WOUT), kb, n0, n0, scr, F.lane); continue; } r -= DR_OUT;
        if (r < DR_LG) { const int mi = r >> 3, sub = r & 7, which = mi >> 4, d = (mi >> 3) & 1, n = mi & 7, kb = sub >> 2, n0 = (sub & 3) * 32;
            p0_transpose_item((which ? F.w_i : F.w_r) + (size_t)(d * 8 + n) * 16384, 128, 128, WSP(bf16, WS_WLG) + (size_t)(n * 4 + 2 * d + which) * 16384, kb, n0, n0, scr, F.lane); continue; } r -= DR_LG;
        if (r < 8 * MOE_I_GU) { const int e = r / MOE_I_GU, q = r % MOE_I_GU, kb = q / 224, n0 = (q % 224) * 32;
            p0_transpose_item8<7>(F.mw_gu + (size_t)e * 1024 * 7168, 1024, 7168, WSP(unsigned char, WS_WMGU) + (size_t)e * 7168 * 1024, kb, n0, gu_row(n0), scr, F.lane); }
        else { r -= 8 * MOE_I_GU; const int e = r / MOE_I_DN, q = r % MOE_I_DN, kb = q / 32, n0 = (q % 32) * 32;
            p0_transpose_item8<9>(F.mw_dn + (size_t)e * 3584 * 1024, 3584, 1024, WSP(unsigned char, WS_WMDN) + (size_t)e * 1024 * 3584, kb, n0, n0, scr, F.lane); }
    }
}
__device__ __forceinline__ void moe_convert_filler(Frame& F, int nwg, int c, int lo, int hi) {
    const int R = (nwg + F.G - 1) / F.G, rem = nwg - (R - 1) * F.G;
    if (rem >= F.G) { moe_convert_items(F, lo, hi, c, F.G); return; }
    if (c >= rem) { REFRESH_F(F); moe_convert_items(F, lo, hi, c - rem, F.G - rem); }
}
__device__ __forceinline__ void row_load(f32x4 (&v)[4], const float* p, int lane) {
#pragma unroll
    for (int j = 0; j < 4; ++j) v[j] = *(const f32x4*)(p + 4 * lane + 256 * j);
}
__device__ __forceinline__ void row_load_bf(f32x4 (&v)[4], const bf16* p, int lane) {
#pragma unroll
    for (int j = 0; j < 4; ++j) { const u32x2 w = *(const u32x2*)(p + 4 * lane + 256 * j); v[j] = (f32x4){bflo(w.x), bfhi(w.x), bflo(w.y), bfhi(w.y)}; }
}
__device__ __forceinline__ void row_store(const f32x4 (&v)[4], float* p, int lane) {
#pragma unroll
    for (int j = 0; j < 4; ++j) *(f32x4*)(p + 4 * lane + 256 * j) = v[j];
}
struct Vec16 { f32x4 q[4]; };
__device__ __forceinline__ Vec16 vec_load(const float* p, int lane) { Vec16 r;
#pragma unroll
    for (int j = 0; j < 4; ++j) r.q[j] = *(const f32x4*)(p + 4 * lane + 256 * j);
    return r; }
__device__ __forceinline__ f32x2 row_ln_v(f32x4 (&v)[4], const Vec16& g, const Vec16& bt) {
    float s = 0.f;
#pragma unroll
    for (int j = 0; j < 4; ++j) s += (v[j].x + v[j].y) + (v[j].z + v[j].w);
    const float mean = wave_sum(s) * (1.f / DM); float s2 = 0.f;
#pragma unroll
    for (int j = 0; j < 4; ++j) { v[j] = v[j] - mean; s2 += (v[j].x * v[j].x + v[j].y * v[j].y) + (v[j].z * v[j].z + v[j].w * v[j].w); }
    const float rstd = 1.f / sqrtf(wave_sum(s2) * (1.f / DM) + LN_EPS);
#pragma unroll
    for (int j = 0; j < 4; ++j) v[j] = v[j] * rstd * g.q[j] + bt.q[j];
    return (f32x2){mean, rstd};
}
template <bool H8> __device__ __forceinline__ void row_mod_store_v(const f32x4 (&v)[4], const Vec16& sh, const Vec16& sc, void* hbase, size_t r, int lane) {
#pragma unroll
    for (int j = 0; j < 4; ++j) { const f32x4 h = v[j] * (sc.q[j] + 1.0f) + sh.q[j];
        if constexpr (H8) *(unsigned*)((unsigned char*)hbase + r * DM + 4 * lane + 256 * j) = pk4_fp8(h[0] * 4.f, h[1] * 4.f, h[2] * 4.f, h[3] * 4.f);
        else { u32x2 w; w.x = cvtpk(h[0], h[1]); w.y = cvtpk(h[2], h[3]); *(u32x2*)((bf16*)hbase + r * DM + 4 * lane + 256 * j) = w; } }
}
#define ROWS_LAT(...) do { const int nwb_ = NGW / 8; if (nwb_ > 0 && gw < 8 * nwb_) { const int b = gw / nwb_, nwin_ = (SEQ + nwb_ - 1) / nwb_; \
    for (int i_ = 0; i_ < nwin_; ++i_) { const int r = b * SEQ + ((i_ + 2 * b) % nwin_) * nwb_ + gw % nwb_;     \
        if (r < (b + 1) * SEQ) { __VA_ARGS__ } } } } while (0)
#define ROWS_CTX(...) do { const int b = 8; for (int r = RL + gw; r < RT; r += NGW) { __VA_ARGS__ } } while (0)
__device__ __forceinline__ void p1_modulate(Frame& F) {
    const int gw = F.vcu * NWAVES + F.wave, NGW = F.G * NWAVES; const float* mod = WSP(float, WS_MOD); bf16* H = WSP(bf16, WS_H);
    { const int bb = gw / (NGW / 8) < 8 ? gw / (NGW / 8) : 7; const Vec16 sh = vec_load(mod + (size_t)bb * 6144, F.lane), sc = vec_load(mod + (size_t)bb * 6144 + 1024, F.lane);
      ROWS_LAT( (void)b; f32x4 v[4]; row_load(v, F.x + (size_t)r * DM, F.lane); row_mod_store_v<true>(v, sh, sc, H, (size_t)r, F.lane); ); }
    { const Vec16 sh = vec_load(mod + (size_t)8 * 6144, F.lane), sc = vec_load(mod + (size_t)8 * 6144 + 1024, F.lane);
      ROWS_CTX( (void)b; f32x4 v[4]; row_load(v, F.ctx + (size_t)(r - RL) * DM, F.lane); row_mod_store_v<true>(v, sh, sc, H, (size_t)r, F.lane); ); }
}
template <bool H8> __device__ __forceinline__ void ln_mod_pass(Frame& F, bool with_ctx, const float* g, const float* bt, int ml, int cs) {
    const int gw = F.vcu * NWAVES + F.wave, NGW = F.G * NWAVES; const float* mod = WSP(float, WS_MOD) + (size_t)ml * 9 * 6144; bf16* H = WSP(bf16, WS_H); const bf16* YB = WSP(bf16, WS_YB);
    const Vec16 gv = vec_load(g, F.lane), bv = vec_load(bt, F.lane);
    { const int bb = gw / (NGW / 8) < 8 ? gw / (NGW / 8) : 7; const Vec16 sh = vec_load(mod + (size_t)bb * 6144 + cs, F.lane), sc = vec_load(mod + (size_t)bb * 6144 + cs + 1024, F.lane);
      ROWS_LAT( (void)b; f32x4 v[4]; row_load_bf(v, YB + (size_t)r * DM, F.lane); const f32x2 sv = row_ln_v(v, gv, bv); if (F.lane == 0) ((f32x2*)(F.ws + WS_STATS))[r] = sv;
                row_mod_store_v<H8>(v, sh, sc, H, (size_t)r, F.lane); ); }
    if (with_ctx) { const Vec16 sh = vec_load(mod + (size_t)8 * 6144 + cs, F.lane), sc = vec_load(mod + (size_t)8 * 6144 + cs + 1024, F.lane);
      ROWS_CTX( (void)b; f32x4 v[4]; row_load_bf(v, YB + (size_t)r * DM, F.lane); const f32x2 sv = row_ln_v(v, gv, bv); if (F.lane == 0) ((f32x2*)(F.ws + WS_STATS))[r] = sv;
                row_mod_store_v<H8>(v, sh, sc, H, (size_t)r, F.lane); ); }
}

namespace att {
constexpr float SCALE = 0.08838834764831845f, THR = 8.f;
constexpr int SHM_V = 64 * 128 * 2, SHM_K = 64 * 128 * 2;
#define KSWZ(row, colB) ((row) * 256 + ((colB) ^ (((row) & 7) << 4)))
#define SBAR() __builtin_amdgcn_sched_barrier(0)
__device__ __forceinline__ int crow(int r, int hi) { return (r & 3) + 8 * (r >> 2) + 4 * hi; }
__device__ __forceinline__ float psm_max(const f32x16& p) {
    float a = fmaxf(fmaxf(p[0], p[1]), p[2]), b = fmaxf(fmaxf(p[3], p[4]), p[5]), c = fmaxf(fmaxf(p[6], p[7]), p[8]), d = fmaxf(fmaxf(p[9], p[10]), p[11]);
    a = fmaxf(fmaxf(a, p[12]), p[13]); b = fmaxf(fmaxf(b, p[14]), p[15]); return fmaxf(fmaxf(fmaxf(a, b), c), d);
}
__device__ __forceinline__ void psm_mask(f32x16& p0, f32x16& p1, int d0) {
#pragma unroll
    for (int r = 0; r < 16; ++r) { const int rel = d0 + (r & 3) + 8 * (r >> 2);
        p0[r] = ((unsigned)(rel + 128) <= 256u) ? p0[r] : -1e30f; p1[r] = ((unsigned)(rel + 160) <= 256u) ? p1[r] : -1e30f; }
}
__device__ __forceinline__ void partialSM(f32x16& p0, f32x16& p1, float& m_reg, float& mn, float& alpha, bool domask, int d0) {
    constexpr float C = SCALE * 1.4426950408889634f;
    if (domask) psm_mask(p0, p1, d0);
    float pmax = fmaxf(psm_max(p0), psm_max(p1));
    { auto rr = __builtin_amdgcn_permlane32_swap(__float_as_uint(pmax), __float_as_uint(pmax), false, false);
      pmax = fmaxf(__uint_as_float(rr[0]), __uint_as_float(rr[1])); }
    mn = (pmax - m_reg > THR / SCALE) ? pmax : m_reg; alpha = ex2((m_reg - mn) * C); m_reg = mn;
    const float mnC = -mn * C;
    p0 = p0 * C + mnC; p1 = p1 * C + mnC;
#pragma unroll
    for (int r = 0; r < 16; ++r) p0[r] = ex2(p0[r]);
}
__device__ __forceinline__ void finishSM(f32x16& p0, f32x16& p1, float alpha, float& l_reg, bf16x8& pa0, bf16x8& pa1, bf16x8& pa2, bf16x8& pa3) {
#pragma unroll
    for (int r = 0; r < 16; ++r) p1[r] = ex2(p1[r]);
    f32x2 s2 = (f32x2){0.f, 0.f};
#pragma unroll
    for (int r = 0; r < 16; r += 2) s2 += (f32x2){p0[r], p0[r + 1]} + (f32x2){p1[r], p1[r + 1]};
    float ps = s2.x + s2.y;
    { auto rr = __builtin_amdgcn_permlane32_swap(__float_as_uint(ps), __float_as_uint(ps), false, false);
      ps = __uint_as_float(rr[0]) + __uint_as_float(rr[1]); }
    l_reg = l_reg * alpha + ps;
#define PK4(P, BASE, OUT) do { unsigned a0 = cvtpk(P[BASE + 0], P[BASE + 1]), a1 = cvtpk(P[BASE + 2], P[BASE + 3]);   \
    unsigned b0 = cvtpk(P[BASE + 4], P[BASE + 5]), b1 = cvtpk(P[BASE + 6], P[BASE + 7]);                              \
    auto r0 = __builtin_amdgcn_permlane32_swap(a0, b0, false, false); auto r1 = __builtin_amdgcn_permlane32_swap(a1, b1, false, false); \
    u32x4 w = {r0[0], r1[0], r0[1], r1[1]}; OUT = __builtin_bit_cast(bf16x8, w); } while (0)
    PK4(p0, 0, pa0); PK4(p0, 8, pa1); PK4(p1, 0, pa2); PK4(p1, 8, pa3);
#undef PK4
}
__device__ __forceinline__ void qkt(f32x16& p0, f32x16& p1, LAS const unsigned char* Ks, const bf16x8* qr, int r32, int hi) {
    p0 = f32x16{}; p1 = f32x16{};
#pragma unroll
    for (int d0 = 0; d0 < 8; ++d0) { const int cb = (d0 * 16 + hi * 8) * 2;
        const bf16x8 b0 = *(LAS const bf16x8*)(Ks + KSWZ(r32, cb));
        const bf16x8 b1 = *(LAS const bf16x8*)(Ks + KSWZ(32 + r32, cb));
        p0 = __builtin_amdgcn_mfma_f32_32x32x16_bf16(b0, qr[d0], p0, 0, 0, 0);
        p1 = __builtin_amdgcn_mfma_f32_32x32x16_bf16(b1, qr[d0], p1, 0, 0, 0); }
}
__device__ __forceinline__ int v_st(int k, int c) { const int kk = (k & ~0xC) | ((k & 4) << 1) | ((k & 8) >> 1); return ((kk >> 3) * 4 + (c >> 5)) * 512 + ((kk & 7) * 32 + (c & 31)) * 2; }
__device__ __forceinline__ int v_rd_base(int lane) { return ((lane & 3) << 3) | (((lane >> 2) & 3) << 6) | (((lane >> 4) & 1) << 5) | (((lane >> 5) & 1) << 8); }
constexpr int v_rd_off(int d0, int ks, int half) { return d0 * 512 + ks * 4096 + half * 2048; }
template <int OFF> __device__ __forceinline__ s16x4 tr_read(int vb) {
    s16x4 r; asm volatile("ds_read_b64_tr_b16 %0, %1 offset:%2" : "=&v"(r) : "v"(vb), "i"(OFF) : "memory"); return r;
}
template <int D0> __device__ __forceinline__ void pv_one(f32x16& od, int vb, bf16x8 pa0, bf16x8 pa1, bf16x8 pa2, bf16x8 pa3) {
    const s16x4 l0 = tr_read<v_rd_off(D0, 0, 0)>(vb), h0 = tr_read<v_rd_off(D0, 0, 1)>(vb), l1 = tr_read<v_rd_off(D0, 1, 0)>(vb), h1 = tr_read<v_rd_off(D0, 1, 1)>(vb);
    const s16x4 l2 = tr_read<v_rd_off(D0, 2, 0)>(vb), h2 = tr_read<v_rd_off(D0, 2, 1)>(vb), l3 = tr_read<v_rd_off(D0, 3, 0)>(vb), h3 = tr_read<v_rd_off(D0, 3, 1)>(vb);
    asm volatile("s_waitcnt lgkmcnt(0)" ::: "memory"); SBAR();
#define PKV(L, H) (bf16x8){L[0], L[1], L[2], L[3], H[0], H[1], H[2], H[3]}
    od = __builtin_amdgcn_mfma_f32_32x32x16_bf16(pa0, PKV(l0, h0), od, 0, 0, 0);
    od = __builtin_amdgcn_mfma_f32_32x32x16_bf16(pa1, PKV(l1, h1), od, 0, 0, 0);
    od = __builtin_amdgcn_mfma_f32_32x32x16_bf16(pa2, PKV(l2, h2), od, 0, 0, 0);
    od = __builtin_amdgcn_mfma_f32_32x32x16_bf16(pa3, PKV(l3, h3), od, 0, 0, 0);
#undef PKV
}
__device__ __forceinline__ void pv_d0(f32x16* o, int vb, bf16x8 pa0, bf16x8 pa1, bf16x8 pa2, bf16x8 pa3) {
    pv_one<0>(o[0], vb, pa0, pa1, pa2, pa3); pv_one<1>(o[1], vb, pa0, pa1, pa2, pa3); pv_one<2>(o[2], vb, pa0, pa1, pa2, pa3); pv_one<3>(o[3], vb, pa0, pa1, pa2, pa3);
}
__device__ __forceinline__ void pv_partial(f32x16* o, int vb, bf16x8 pa0, bf16x8 pa1, bf16x8 pa2, bf16x8 pa3, f32x16& p0, f32x16& p1, float& m_reg, float& mn, float& alpha, bool domask, int d0) {
    constexpr float C = SCALE * 1.4426950408889634f;
#define PKV(L, H) (bf16x8){L[0], L[1], L[2], L[3], H[0], H[1], H[2], H[3]}
#define RD8(A, D0) A##0 = tr_read<v_rd_off(D0, 0, 0)>(vb); A##1 = tr_read<v_rd_off(D0, 0, 1)>(vb); A##2 = tr_read<v_rd_off(D0, 1, 0)>(vb); A##3 = tr_read<v_rd_off(D0, 1, 1)>(vb); \
    A##4 = tr_read<v_rd_off(D0, 2, 0)>(vb); A##5 = tr_read<v_rd_off(D0, 2, 1)>(vb); A##6 = tr_read<v_rd_off(D0, 3, 0)>(vb); A##7 = tr_read<v_rd_off(D0, 3, 1)>(vb)
#define MM4(OD, A) OD = __builtin_amdgcn_mfma_f32_32x32x16_bf16(pa0, PKV(A##0, A##1), OD, 0, 0, 0); OD = __builtin_amdgcn_mfma_f32_32x32x16_bf16(pa1, PKV(A##2, A##3), OD, 0, 0, 0); \
    OD = __builtin_amdgcn_mfma_f32_32x32x16_bf16(pa2, PKV(A##4, A##5), OD, 0, 0, 0); OD = __builtin_amdgcn_mfma_f32_32x32x16_bf16(pa3, PKV(A##6, A##7), OD, 0, 0, 0)
    s16x4 a0, a1, a2, a3, a4, a5, a6, a7, b0, b1, b2, b3, b4, b5, b6, b7;
    RD8(a, 0); RD8(b, 1);
    asm volatile("s_waitcnt lgkmcnt(8)" ::: "memory"); SBAR(); MM4(o[0], a);
    if (domask) psm_mask(p0, p1, d0);
    const float mx0 = psm_max(p0);
    SBAR(); RD8(a, 2);
    asm volatile("s_waitcnt lgkmcnt(8)" ::: "memory"); SBAR(); MM4(o[1], b);
    float pmax = fmaxf(mx0, psm_max(p1));
    { auto rr = __builtin_amdgcn_permlane32_swap(__float_as_uint(pmax), __float_as_uint(pmax), false, false);
      pmax = fmaxf(__uint_as_float(rr[0]), __uint_as_float(rr[1])); }
    mn = (pmax - m_reg > THR / SCALE) ? pmax : m_reg; alpha = ex2((m_reg - mn) * C); m_reg = mn;
    const float mnC = -mn * C;
    SBAR(); RD8(b, 3);
    asm volatile("s_waitcnt lgkmcnt(8)" ::: "memory"); SBAR(); MM4(o[2], a);
    p0 = p0 * C + mnC; p1 = p1 * C + mnC;
    SBAR();
    asm volatile("s_waitcnt lgkmcnt(0)" ::: "memory"); SBAR(); MM4(o[3], b);
#pragma unroll
    for (int r = 0; r < 16; ++r) p0[r] = ex2(p0[r]);
    SBAR();
#undef PKV
#undef RD8
#undef MM4
}
__device__ __forceinline__ void attn_unit(const bf16* __restrict__ QKV, bf16* __restrict__ O, const float* __restrict__ sink, int qrow0, int head0, int kvh, int krow_band, int nband, int krow_ctx, int dpos0, LAS unsigned char* lds, const int wid) {
    const int lane = lane_id(), r32 = lane & 31, hi = lane >> 5;
    LAS unsigned char* V_lds = lds; LAS unsigned char* K_lds = lds + 3 * SHM_V;
    LAS float* wsf = (LAS float*)(lds + 3 * SHM_V + 3 * SHM_K) + wid * 64; LAS float* li_l = wsf; LAS float* al_l = wsf + 32;
    const int head = head0 + (wid >> 2), qoff = 32 * (wid & 3);
    float m_reg = sink[head] * (1.0f / SCALE), l_reg = 1.0f; f32x16 o[4] = {}; bf16x8 qr[8];
    const bf16* Qw = QKV + (size_t)(qrow0 + qoff + r32) * QKVD + head * HDIM + hi * 8;
#pragma unroll
    for (int d0 = 0; d0 < 8; ++d0) qr[d0] = *(const bf16x8*)(Qw + d0 * 16);
    unsigned voK[2], voV[2];
#pragma unroll
    for (int i = 0; i < 2; ++i) { const int s = (i * 8 + wid) * 64 + lane;
        { const int row = s >> 4, ch = (s & 15) ^ (row & 7); voK[i] = (unsigned)(row * (QKVD * 2) + ch * 16); }
        { const int qlo = s & 3, kklo = (s >> 2) & 7, blk = s >> 5, qhi = blk & 3, kk = (blk >> 2) * 8 + kklo, k = (kk & ~0xC) | ((kk & 4) << 1) | ((kk & 8) >> 1); voV[i] = (unsigned)(k * (QKVD * 2) + (qhi * 4 + qlo) * 16); } }
    const __amdgpu_buffer_rsrc_t rs = __builtin_amdgcn_make_buffer_rsrc((void*)QKV, 0, -1, 0x00020000);
    const unsigned kcol = (unsigned)(1024 + kvh * HDIM) * 2u;
    const int vb0 = (int)(unsigned)(uintptr_t)V_lds + v_rd_base(lane);
    const int NT = nband + 4;
#define TROW(j) ((j) < nband ? krow_band + 64 * (j) : krow_ctx + 64 * ((j) - nband))
#define DMA(j, bo) do { const unsigned so_ = (unsigned)TROW(j) * (unsigned)(QKVD * 2) + kcol; _Pragma("unroll") for (int i_ = 0; i_ < 2; ++i_) { \
        __builtin_amdgcn_raw_ptr_buffer_load_lds(rs, (LAS void*)(K_lds + (bo) + (i_ * 8 + wid) * 1024), 16, voK[i_], so_, 0, 0); \
        __builtin_amdgcn_raw_ptr_buffer_load_lds(rs, (LAS void*)(V_lds + (bo) + (i_ * 8 + wid) * 1024), 16, voV[i_], so_ + 512u, 0, 0); } } while (0)
#define UBAR(n) do { asm volatile("s_waitcnt vmcnt(" #n ") lgkmcnt(0)" ::: "memory"); __builtin_amdgcn_s_barrier(); asm volatile("" ::: "memory"); } while (0)
#define RESC(a) do { if (__any((a) < 1.f)) { if (hi == 0) al_l[r32] = (a); asm volatile("s_waitcnt lgkmcnt(0)" ::: "memory"); \
    _Pragma("unroll") for (int d = 0; d < 4; ++d) _Pragma("unroll") for (int r = 0; r < 16; ++r) o[d][r] *= al_l[crow(r, hi)]; } } while (0)
    f32x16 pA0, pA1, pB0, pB1; float mnA, mnB, alA, alB; bf16x8 pa0, pa1, pa2, pa3;
    int bc = 0, bn = SHM_K, bnn = 2 * SHM_K;
    DMA(0, 0); DMA(1, SHM_K);
    UBAR(4);
    qkt(pA0, pA1, K_lds, qr, r32, hi); { const int dl = dpos0 - qoff; const bool dm = (0 < nband) && !(dl >= -97 && dl <= 65); partialSM(pA0, pA1, m_reg, mnA, alA, dm, dl - r32 + 4 * hi); }
#define STEP(Pc0, Pc1, alc, Pn0, Pn1, mnn, aln, t) do { UBAR(0); if ((t) + 2 < NT) DMA((t) + 2, bnn); \
        SBAR(); qkt(Pn0, Pn1, K_lds + bn, qr, r32, hi); finishSM(Pc0, Pc1, alc, l_reg, pa0, pa1, pa2, pa3); SBAR(); \
        { const int jj = (t) + 1; const int dl = dpos0 + 64 * jj - qoff; const bool dm = (jj < nband) && !(dl >= -97 && dl <= 65); \
          pv_partial(o, vb0 + bc, pa0, pa1, pa2, pa3, Pn0, Pn1, m_reg, mnn, aln, dm, dl - r32 + 4 * hi); } \
        RESC(aln); { const int t_ = bc; bc = bn; bn = bnn; bnn = t_; } } while (0)
    int t = 0;
    for (; t + 2 < NT - 1; t += 2) { STEP(pA0, pA1, alA, pB0, pB1, mnB, alB, t); STEP(pB0, pB1, alB, pA0, pA1, mnA, alA, t + 1); }
    STEP(pA0, pA1, alA, pB0, pB1, mnB, alB, t);
    finishSM(pB0, pB1, alB, l_reg, pa0, pa1, pa2, pa3); SBAR();
    pv_d0(o, vb0 + bc, pa0, pa1, pa2, pa3);
    if (hi == 0) li_l[r32] = l_reg; asm volatile("s_waitcnt lgkmcnt(0)" ::: "memory");
    float rli[16];
#pragma unroll
    for (int r = 0; r < 16; ++r) rli[r] = rcpf_(li_l[crow(r, hi)]);
    { LAS unsigned char* ot = lds + 3 * SHM_V + 3 * SHM_K + 4096 + wid * 4096;
#pragma unroll
      for (int r = 0; r < 16; ++r) { const int orow = crow(r, hi);
#pragma unroll
          for (int d0 = 0; d0 < 4; ++d0) { const float x = clamp8(o[d0][r] * rli[r] * 16.0f); ot[orow * 128 + d0 * 32 + r32] = (unsigned char)(__builtin_amdgcn_cvt_pk_fp8_f32(x, x, 0, false) & 0xff); } }
      asm volatile("s_waitcnt lgkmcnt(0)" ::: "memory");
      unsigned char* Ob = (unsigned char*)O + (size_t)(qrow0 + qoff) * DM + head * HDIM;
#pragma unroll
      for (int i = 0; i < 4; ++i) { const int row = (lane >> 3) + 8 * i, ch = lane & 7; *(u32x4*)(Ob + (size_t)row * DM + ch * 16) = *(LAS const u32x4*)(ot + row * 128 + ch * 16); } }
    __syncthreads();
#undef TROW
#undef DMA
#undef UBAR
#undef RESC
#undef STEP
}
constexpr int N_LAT_UNITS = NB * 32 * NKVH * 2, N_CTX_UNITS = NB * 2 * NKVH * 2, N_UNITS = N_LAT_UNITS + N_CTX_UNITS;
__device__ __forceinline__ void attn_phase(const bf16* QKV, bf16* O, const float* sink, int G, int c, LAS unsigned char* lds, const int wid) {
    for (int L = c; L < N_UNITS; L += G) {
        if (L < N_LAT_UNITS) { const int hp = L & 1, kh = (L >> 1) & 1, n = (L >> 2) & 31, b = L >> 7;
            const int nlo = n > 0 ? n - 1 : 0, nhi = n < 31 ? n + 1 : 31, nband = 2 * (nhi - nlo + 1);
            attn_unit(QKV, O, sink, b * SEQ + n * 128, kh * 4 + hp * 2, kh, b * SEQ + nlo * 128, nband, RL + b * LCTX, (nlo - n) * 128, lds, wid);
        } else { const int u = L - N_LAT_UNITS, hp = u & 1, kh = (u >> 1) & 1, qh = (u >> 2) & 1, b = u >> 3;
            attn_unit(QKV, O, sink, RL + b * LCTX + qh * 128, kh * 4 + hp * 2, kh, 0, 0, RL + b * LCTX, 0, lds, wid);
        }
    }
}
#undef KSWZ
#undef SBAR
}

__device__ __forceinline__ void p10_conv(Frame& F) {
    const int gw = F.vcu * NWAVES + F.wave, NGW = F.G * NWAVES; const bf16* XB = WSP(bf16, WS_XB); bf16* U = WSP(bf16, WS_U);
    float cw[4][16], cb[16];
#pragma unroll
    for (int j = 0; j < 4; ++j)
#pragma unroll
        for (int q = 0; q < 4; ++q) { const f32x4 w = *(const f32x4*)(F.conv_w + j * 1024 + 16 * F.lane + 4 * q); cw[j][4 * q] = w[0]; cw[j][4 * q + 1] = w[1]; cw[j][4 * q + 2] = w[2]; cw[j][4 * q + 3] = w[3]; }
#pragma unroll
    for (int q = 0; q < 4; ++q) { const f32x4 w = *(const f32x4*)(F.conv_b + 16 * F.lane + 4 * q); cb[4 * q] = w[0]; cb[4 * q + 1] = w[1]; cb[4 * q + 2] = w[2]; cb[4 * q + 3] = w[3]; }
    const int per = (RT + NGW - 1) / NGW, r0 = gw * per, r1 = (r0 + per < RT) ? r0 + per : RT;
    if (r0 >= RT) return;
    u32x4 w0[4], w1[4];
#pragma unroll
    for (int j = 0; j < 4; ++j) { int rr = r0 + j - 2; rr = rr < 0 ? 0 : (rr >= RT ? RT - 1 : rr); const u32x4* p = (const u32x4*)(XB + (size_t)rr * DM + 16 * F.lane); w0[j] = p[0]; w1[j] = p[1]; }
    for (int r = r0; r < r1; ++r) { const bool lat = r < RL; const int t = lat ? (r & (SEQ - 1)) : ((r - RL) & (LCTX - 1)); const int Ls = lat ? SEQ : LCTX;
        u32x4 n0, n1; { int rn = r + 2; rn = rn >= RT ? RT - 1 : rn; const u32x4* p = (const u32x4*)(XB + (size_t)rn * DM + 16 * F.lane); n0 = p[0]; n1 = p[1]; }
        float acc[16];
#pragma unroll
        for (int i = 0; i < 16; ++i) acc[i] = cb[i];
#pragma unroll
        for (int j = 0; j < 4; ++j) { const int tj = t + j - 2;
            if (tj >= 0 && tj < Ls) { const u32x4 x0 = w0[j], x1 = w1[j];
#pragma unroll
                for (int q = 0; q < 4; ++q) { acc[2 * q] += cw[j][2 * q] * bflo(x0[q]); acc[2 * q + 1] += cw[j][2 * q + 1] * bfhi(x0[q]); acc[8 + 2 * q] += cw[j][8 + 2 * q] * bflo(x1[q]); acc[8 + 2 * q + 1] += cw[j][8 + 2 * q + 1] * bfhi(x1[q]); } } }
        u32x4 o0, o1;
#pragma unroll
        for (int q = 0; q < 4; ++q) { o0[q] = cvtpk(acc[2 * q], acc[2 * q + 1]); o1[q] = cvtpk(acc[8 + 2 * q], acc[8 + 2 * q + 1]); }
        u32x4* op = (u32x4*)(U + (size_t)r * DM + 16 * F.lane); op[0] = o0; op[1] = o1;
        w0[0] = w0[1]; w0[1] = w0[2]; w0[2] = w0[3]; w0[3] = n0; w1[0] = w1[1]; w1[1] = w1[2]; w1[2] = w1[3]; w1[3] = n1; }
}
namespace lru {
constexpr int AIMG_BYTES = 65536;
constexpr int EX_OFF = 2 * AIMG_BYTES;
struct Ctx { const bf16* U; const bf16* G; bf16* HH; u32x4* HF; const bf16* WLG; const float *lam, *b_r, *b_i; };

__device__ __forceinline__ void issue_u(const __amdgpu_buffer_rsrc_t rs, LAS unsigned char* buf, int n, size_t row0, int wid, unsigned voff) {
#pragma unroll
    for (int ii = 0; ii < 8; ++ii) { const int i = wid + 8 * ii;
        __builtin_amdgcn_raw_ptr_buffer_load_lds(rs, (LAS void*)(buf + i * 1024), 16, voff, (unsigned)((row0 + 32 * ii) * DM * 2 + n * 256), 0, 0); }
}
__device__ __forceinline__ void chunk_geom(int DIR, int k, int b, size_t& row0, int& lc) {
    if (k == 0) { row0 = (size_t)RL + b * LCTX; lc = -1; } else { lc = DIR ? 16 - k : k - 1; row0 = (size_t)b * SEQ + 256 * lc; }
}
#define LRU_BAR() do { asm volatile("s_waitcnt lgkmcnt(0)" ::: "memory"); __builtin_amdgcn_s_barrier(); asm volatile("" ::: "memory"); } while (0)
template <int DIR>
__device__ __forceinline__ void walk(const Ctx& C, LAS unsigned char* lds, int task, const int wid) {
    const int cq = task & 3, n = (task >> 2) & 7, b = task >> 5;
    const int lane = lane_id(), tid = wid * 64 + lane, c = lane & 15, g = lane >> 4;
    const int chalf = wid & 1, tq = wid >> 1;
    const int chl = 32 * cq + 16 * chalf + c;
    const int ch = n * 128 + chl;
    bf16x8 Br[4], Bi[4];
    { const bf16* wr = C.WLG + ((size_t)(n * 4 + 2 * DIR) * 128 + chl) * 128 + 8 * g; const bf16* wi = wr + 16384;
#pragma unroll
      for (int ks = 0; ks < 4; ++ks) { Br[ks] = *(const bf16x8*)(wr + ks * 32); Bi[ks] = *(const bf16x8*)(wi + ks * 32); } }
    const float br = C.b_r[DIR * 1024 + ch], bi = C.b_i[DIR * 1024 + ch];
    const float sp8 = 8.0f * log1pf(expf(-C.lam[DIR * 1024 + ch]));
    const float kbr = -LOG2E * br, kbi = -LOG2E * bi, ka = -sp8 * LOG2E;
    float H = 0.f;
    unsigned fb[4], ub[4];
#pragma unroll
    for (int ks = 0; ks < 4; ++ks) fb[ks] = (unsigned)((64 * tq + c) * 256 + ((ks * 64 + 16 * g) ^ (c << 4)));
#pragma unroll
    for (int r = 0; r < 4; ++r) ub[r] = (unsigned)((64 * tq + 4 * g + r) * 256 + ((2 * chl) ^ ((4 * g + r) << 4)));
    const __amdgpu_buffer_rsrc_t urs = __builtin_amdgcn_make_buffer_rsrc((void*)C.U, 0, -1, 0x00020000);
    const unsigned uvoff = (unsigned)((4 * wid + (lane >> 4)) * DM * 2 + (((lane & 15) ^ ((4 * wid + (lane >> 4)) & 15)) * 16));
    { size_t r0; int lc; chunk_geom(DIR, 0, b, r0, lc); issue_u(urs, lds, n, r0, wid, uvoff); }
    for (int k = 0; k < 17; ++k) {
        size_t row0; int lc; chunk_geom(DIR, k, b, row0, lc);
        LAS unsigned char* img = lds + (k & 1) * AIMG_BYTES;
        asm volatile("s_waitcnt vmcnt(0)" ::: "memory");
        LRU_BAR();
        if (k + 1 < 17) { size_t r1; int l1; chunk_geom(DIR, k + 1, b, r1, l1); issue_u(urs, lds + ((k + 1) & 1) * AIMG_BYTES, n, r1, wid, uvoff); }
        u32x4 hf0, hf1;
        u32x4 gp0, gp1;
        if (DIR == 1 && lc >= 0) { const u32x4* hp = C.HF + ((((size_t)task * 16 + lc) * 8 + wid) * 2) * 64 + lane; hf0 = hp[0]; hf1 = hp[64];
            const size_t grow = (row0 + (tid >> 1)) * DM + n * 128 + 32 * cq + 16 * (tid & 1); gp0 = *(const u32x4*)(C.G + grow); gp1 = *(const u32x4*)(C.G + grow + 8); }
        f32x4 ar[4], ai[4];
#pragma unroll
        for (int mt = 0; mt < 4; ++mt) { ar[mt] = (f32x4){0.f, 0.f, 0.f, 0.f}; ai[mt] = (f32x4){0.f, 0.f, 0.f, 0.f};
#pragma unroll
            for (int ks = 0; ks < 4; ++ks) { const bf16x8 af = *(LAS const bf16x8*)(img + fb[ks] + mt * 4096);
                ar[mt] = __builtin_amdgcn_mfma_f32_16x16x32_bf16(af, Br[ks], ar[mt], 0, 0, 0);
                ai[mt] = __builtin_amdgcn_mfma_f32_16x16x32_bf16(af, Bi[ks], ai[mt], 0, 0, 0); } }
        float y0[4][4], P[4][4]; float TA = 1.f, TB = 0.f;
#pragma unroll
        for (int mm = 0; mm < 4; ++mm) { const int mt = DIR ? 3 - mm : mm;
            float a[4], bb[4];
#pragma unroll
            for (int r = 0; r < 4; ++r) {
                const float rg = rcpf_(1.0f + ex2(fmaf(ar[mt][r], -LOG2E, kbr))), ig = rcpf_(1.0f + ex2(fmaf(ai[mt][r], -LOG2E, kbi)));
                a[r] = ex2(rg * ka);
                const float em = fmaf(-a[r], a[r], 1.0f);
                const float uu = __uint_as_float((unsigned)*(LAS const bf16*)(img + ub[r] + mt * 4096) << 16);
                bb[r] = __builtin_amdgcn_sqrtf(em) * (ig * uu); }
            float p[4], yl[4];
            if (DIR == 0) { p[0] = a[0]; yl[0] = bb[0];
#pragma unroll
                for (int r = 1; r < 4; ++r) { p[r] = a[r] * p[r - 1]; yl[r] = a[r] * yl[r - 1] + bb[r]; } }
            else { p[3] = a[3]; yl[3] = bb[3];
#pragma unroll
                for (int r = 2; r >= 0; --r) { p[r] = a[r] * p[r + 1]; yl[r] = a[r] * yl[r + 1] + bb[r]; } }
            const float Al = DIR ? p[0] : p[3], Bl = DIR ? yl[0] : yl[3];
            const float A0 = __shfl(Al, c), A1 = __shfl(Al, 16 + c), A2 = __shfl(Al, 32 + c), A3 = __shfl(Al, 48 + c);
            const float B0 = __shfl(Bl, c), B1 = __shfl(Bl, 16 + c), B2 = __shfl(Bl, 32 + c), B3 = __shfl(Bl, 48 + c);
            float EA, EB, At, Bt;
            if (DIR == 0) { const float e1a = A0, e1b = B0, e2a = A1 * e1a, e2b = A1 * e1b + B1, e3a = A2 * e2a, e3b = A2 * e2b + B2;
                EA = g == 0 ? 1.f : (g == 1 ? e1a : (g == 2 ? e2a : e3a)); EB = g == 0 ? 0.f : (g == 1 ? e1b : (g == 2 ? e2b : e3b)); At = A3 * e3a; Bt = A3 * e3b + B3; }
            else { const float e2a = A3, e2b = B3, e1a = A2 * e2a, e1b = A2 * e2b + B2, e0a = A1 * e1a, e0b = A1 * e1b + B1;
                EA = g == 3 ? 1.f : (g == 2 ? e2a : (g == 1 ? e1a : e0a)); EB = g == 3 ? 0.f : (g == 2 ? e2b : (g == 1 ? e1b : e0b)); At = A0 * e0a; Bt = A0 * e0b + B0; }
            const float QA = EA * TA, QB = EA * TB + EB;
#pragma unroll
            for (int r = 0; r < 4; ++r) { P[mt][r] = p[r] * QA; y0[mt][r] = p[r] * QB + yl[r]; }
            TB = At * TB + Bt; TA = At * TA;
        }
        if (g == 0) *(LAS f32x2*)(lds + EX_OFF + ((tq * 2 + chalf) * 16 + c) * 8) = (f32x2){TA, TB};
        LRU_BAR();
        float Hw;
        { const f32x2 e0 = *(LAS const f32x2*)(lds + EX_OFF + ((0 * 2 + chalf) * 16 + c) * 8), e1 = *(LAS const f32x2*)(lds + EX_OFF + ((1 * 2 + chalf) * 16 + c) * 8),
                      e2 = *(LAS const f32x2*)(lds + EX_OFF + ((2 * 2 + chalf) * 16 + c) * 8), e3 = *(LAS const f32x2*)(lds + EX_OFF + ((3 * 2 + chalf) * 16 + c) * 8);
          if (DIR == 0) { const float h1 = e0.x * H + e0.y, h2 = e1.x * h1 + e1.y, h3 = e2.x * h2 + e2.y; Hw = tq == 0 ? H : (tq == 1 ? h1 : (tq == 2 ? h2 : h3)); H = e3.x * h3 + e3.y; }
          else { const float h2 = e3.x * H + e3.y, h1 = e2.x * h2 + e2.y, h0 = e1.x * h1 + e1.y; Hw = tq == 3 ? H : (tq == 2 ? h2 : (tq == 1 ? h1 : h0)); H = e0.x * h0 + e0.y; } }
        if (lc >= 0) {
#pragma unroll
            for (int mt = 0; mt < 4; ++mt)
#pragma unroll
                for (int r = 0; r < 4; ++r) y0[mt][r] += P[mt][r] * Hw;
            if (DIR == 0) {
                u32x4* hp = C.HF + ((((size_t)task * 16 + lc) * 8 + wid) * 2) * 64 + lane;
                u32x4 w0, w1; w0.x = cvtpk(y0[0][0], y0[0][1]); w0.y = cvtpk(y0[0][2], y0[0][3]); w0.z = cvtpk(y0[1][0], y0[1][1]); w0.w = cvtpk(y0[1][2], y0[1][3]);
                w1.x = cvtpk(y0[2][0], y0[2][1]); w1.y = cvtpk(y0[2][2], y0[2][3]); w1.z = cvtpk(y0[3][0], y0[3][1]); w1.w = cvtpk(y0[3][2], y0[3][3]);
                hp[0] = w0; hp[64] = w1;
            } else {
                const unsigned hw[8] = {hf0.x, hf0.y, hf0.z, hf0.w, hf1.x, hf1.y, hf1.z, hf1.w};
#pragma unroll
                for (int mt = 0; mt < 4; ++mt)
#pragma unroll
                    for (int r = 0; r < 4; ++r) { const unsigned w = hw[mt * 2 + (r >> 1)]; const float hfv = (r & 1) ? bfhi(w) : bflo(w); const float s = y0[mt][r] + hfv;
                        *(LAS bf16*)(img + (64 * tq + mt * 16 + 4 * g + r) * 64 + (16 * chalf + c) * 2) = (bf16)(cvtpk(s, 0.f) & 0xffffu); }
                LRU_BAR();
                { const int tt = tid >> 1, hh = tid & 1; const size_t grow = (row0 + tt) * DM + n * 128 + 32 * cq + 16 * hh;
                  const u32x4 s0 = *(LAS const u32x4*)(img + tt * 64 + hh * 32), s1 = *(LAS const u32x4*)(img + tt * 64 + hh * 32 + 16);
                  const u32x4 g0 = gp0, g1 = gp1;
                  u32x4 o0, o1;
#pragma unroll
                  for (int j = 0; j < 4; ++j) { o0[j] = cvtpk(bflo(s0[j]) * bflo(g0[j]), bfhi(s0[j]) * bfhi(g0[j])); o1[j] = cvtpk(bflo(s1[j]) * bflo(g1[j]), bfhi(s1[j]) * bfhi(g1[j])); }
                  *(u32x4*)(C.HH + grow) = o0; *(u32x4*)(C.HH + grow + 8) = o1; }
            }
        }
    }
    asm volatile("s_waitcnt vmcnt(0)" ::: "memory");
    LRU_BAR();
}
#undef LRU_BAR
}
__device__ __forceinline__ void p11_lru(Frame& F, const lru::Ctx& C) {
    for (int task = F.vcu; task < 256; task += F.G) { lru::walk<0>(C, F.lds, task, F.wave); lru::walk<1>(C, F.lds, task, F.wave); }
}

__device__ __forceinline__ void p13_ln_router(Frame& F) {
    LAS float* RTR = (LAS float*)F.lds;
    LAS int* lcnt = (LAS int*)(F.lds + 32768);
    for (int idx = F.tid; idx < 8192; idx += NWAVES * 64) RTR[(idx & 7) * 1024 + (idx >> 3)] = F.router[idx];
    const float* mod = WSP(float, WS_MOD) + (size_t)1 * 9 * 6144; unsigned char* H8 = WSP(unsigned char, WS_H);
    int* eidx = (int*)(F.ws + WS_ROUTE + RT_EIDX); float* wgt = (float*)(F.ws + WS_ROUTE + RT_WGT); int* cnt = (int*)(F.ws + WS_ROUTE + RT_CNT);
    const Vec16 gv = vec_load(F.ln_g + 2 * 1024, F.lane), bv = vec_load(F.ln_b + 2 * 1024, F.lane);
    for (int batch = F.vcu; batch < RL / 128; batch += F.G) {
        const float* mb0 = mod + (size_t)((batch * 128) >> 12) * 6144 + 3072; const Vec16 sh = vec_load(mb0, F.lane), sc = vec_load(mb0 + 1024, F.lane);
        if (F.tid < 8) lcnt[F.tid] = 0;
        __syncthreads();
        u32x2 nx[4]; { const bf16* yp = WSP(bf16, WS_YB) + (size_t)(batch * 128 + F.wave * 16) * DM;
#pragma unroll
            for (int j = 0; j < 4; ++j) nx[j] = *(const u32x2*)(yp + 4 * F.lane + 256 * j); }
        for (int i = 0; i < 16; ++i) { const int r = batch * 128 + F.wave * 16 + i;
            f32x4 v[4];
#pragma unroll
            for (int j = 0; j < 4; ++j) v[j] = (f32x4){bflo(nx[j].x), bfhi(nx[j].x), bflo(nx[j].y), bfhi(nx[j].y)};
            if (i + 1 < 16) { const bf16* yp = WSP(bf16, WS_YB) + (size_t)(r + 1) * DM;
#pragma unroll
                for (int j = 0; j < 4; ++j) nx[j] = *(const u32x2*)(yp + 4 * F.lane + 256 * j); }
            row_ln_v(v, gv, bv);
            float lg[8];
#pragma unroll
            for (int e = 0; e < 8; ++e) lg[e] = 0.f;
#pragma unroll
            for (int j = 0; j < 4; ++j) { const f32x4 hm = v[j] * (sc.q[j] + 1.0f) + sh.q[j];
                *(unsigned*)(H8 + (size_t)r * DM + 4 * F.lane + 256 * j) = pk4_fp8(hm[0] * 4.f, hm[1] * 4.f, hm[2] * 4.f, hm[3] * 4.f);
#pragma unroll
                for (int e = 0; e < 8; ++e) { const f32x4 rt = *(LAS const f32x4*)(RTR + e * 1024 + 4 * F.lane + 256 * j); lg[e] += (hm[0] * rt[0] + hm[1] * rt[1]) + (hm[2] * rt[2] + hm[3] * rt[3]); } }
#pragma unroll
            for (int e = 0; e < 8; ++e) lg[e] = wave_sum(lg[e]);
            int ea = 0; float la = lg[0];
#pragma unroll
            for (int e = 1; e < 8; ++e) if (lg[e] > la) { la = lg[e]; ea = e; }
            int eb = -1; float lb = -3.0e38f;
#pragma unroll
            for (int e = 0; e < 8; ++e) if (e != ea && lg[e] > lb) { lb = lg[e]; eb = e; }
            const float wa = 1.0f / (1.0f + __expf(lb - la)), wb = 1.0f - wa;
            if (F.lane == 0) { *(int2*)(eidx + 2 * r) = make_int2(ea, eb); *(float2*)(wgt + 2 * r) = make_float2(wa, wb); atomicAdd((int*)(lcnt + ea), 1); atomicAdd((int*)(lcnt + eb), 1); }
        }
        __syncthreads();
        if (F.tid < 8) cnt[batch * 8 + F.tid] = lcnt[F.tid];
        __syncthreads();
    }
}
__device__ __forceinline__ void moe_totals(Frame& F, int upto_batch, int (&tot)[8], int (&before)[8]) {
    const int* cnt = (const int*)(F.ws + WS_ROUTE + RT_CNT);
#pragma unroll
    for (int e = 0; e < 8; ++e) { tot[e] = 0; before[e] = 0; }
#pragma unroll
    for (int k = 0; k < 4; ++k) { const int bb = 4 * F.lane + k; const int4 c0 = *(const int4*)(cnt + bb * 8), c1 = *(const int4*)(cnt + bb * 8 + 4); const int m = bb < upto_batch ? 1 : 0;
        tot[0] += c0.x; tot[1] += c0.y; tot[2] += c0.z; tot[3] += c0.w; tot[4] += c1.x; tot[5] += c1.y; tot[6] += c1.z; tot[7] += c1.w;
        before[0] += m * c0.x; before[1] += m * c0.y; before[2] += m * c0.z; before[3] += m * c0.w; before[4] += m * c1.x; before[5] += m * c1.y; before[6] += m * c1.z; before[7] += m * c1.w; }
#pragma unroll
    for (int e = 0; e < 8; ++e) {
#pragma unroll
        for (int o = 1; o < 64; o <<= 1) { tot[e] += __shfl_xor(tot[e], o); before[e] += __shfl_xor(before[e], o); } }
}
__device__ __forceinline__ void p14_gather(Frame& F) {
    const int* eidx = (const int*)(F.ws + WS_ROUTE + RT_EIDX); const float* wgt = (const float*)(F.ws + WS_ROUTE + RT_WGT);
    int* slot = (int*)(F.ws + WS_ROUTE + RT_SLOT); float* wsort = (float*)(F.ws + WS_ROUTE + RT_WS);
    const unsigned char* H8 = WSP(unsigned char, WS_H); unsigned char* HS8 = WSP(unsigned char, WS_HS);
    LAS int* wcnt = (LAS int*)F.lds;
    LAS int* dsts = (LAS int*)(F.lds + 256);
    for (int batch = F.vcu; batch < RL / 128; batch += F.G) {
        int tot[8], before[8]; moe_totals(F, batch, tot, before);
        int base[8]; { int tp = 0;
#pragma unroll
            for (int e = 0; e < 8; ++e) { base[e] = tp * 256 + before[e]; tp += (tot[e] + 255) >> 8; } }
        int my_e = 0, rank_in_wave = 0;
        if (F.tid < 256) { my_e = eidx[batch * 256 + F.tid];
#pragma unroll
            for (int e = 0; e < 8; ++e) { const unsigned long long m = __ballot(my_e == e); if (my_e == e) rank_in_wave = __popcll(m & ((1ull << F.lane) - 1ull)); if (F.lane == 0) wcnt[F.wave * 8 + e] = __popcll(m); } }
        __syncthreads();
        if (F.tid < 256) { int off = 0;
#pragma unroll
            for (int w = 0; w < 4; ++w) if (w < F.wave) off += wcnt[w * 8 + my_e];
            int bs = 0;
#pragma unroll
            for (int e = 0; e < 8; ++e) bs = (my_e == e) ? base[e] : bs;
            const int d = bs + off + rank_in_wave; dsts[F.tid] = d; slot[batch * 256 + F.tid] = d; wsort[d] = wgt[batch * 256 + F.tid]; }
        __syncthreads();
        for (int i = 0; i < 32; ++i) { const int a = F.wave * 32 + i; const int d = dsts[a]; const int r = batch * 128 + (a >> 1);
            const u32x4* src = (const u32x4*)(H8 + (size_t)r * DM); u32x4* dp = (u32x4*)(HS8 + (size_t)d * DM);
            dp[F.lane] = src[F.lane]; }
        __syncthreads();
    }
}
__device__ __forceinline__ void p17_final(Frame& F) {
    const int gw = F.vcu * NWAVES + F.wave, NGW = F.G * NWAVES; const float* mod = WSP(float, WS_MOD) + (size_t)1 * 9 * 6144; const bf16* FO = WSP(bf16, WS_FO);
    const int* slot = (const int*)(F.ws + WS_ROUTE + RT_SLOT);
    const Vec16 g0 = vec_load(F.ln_g + 2 * 1024, F.lane), b0 = vec_load(F.ln_b + 2 * 1024, F.lane), g1 = vec_load(F.ln_g + 3 * 1024, F.lane), b1 = vec_load(F.ln_b + 3 * 1024, F.lane);
    const int bb = gw / (NGW / 8) < 8 ? gw / (NGW / 8) : 7; const Vec16 g2 = vec_load(mod + (size_t)bb * 6144 + 5120, F.lane);
    ROWS_LAT( (void)b; float* yp = F.out + (size_t)r * DM; const int2 s = *(const int2*)(slot + 2 * r);
        const bf16* fa = FO + (size_t)s.x * DM, * fb = FO + (size_t)s.y * DM;
        f32x4 v[4]; row_load_bf(v, WSP(bf16, WS_YB) + (size_t)r * DM, F.lane); row_ln_v(v, g0, b0);
        _Pragma("unroll") for (int j = 0; j < 4; ++j) { const u32x2 a = *(const u32x2*)(fa + 4 * F.lane + 256 * j), c = *(const u32x2*)(fb + 4 * F.lane + 256 * j);
            const f32x4 f = {bflo(a.x) + bflo(c.x), bfhi(a.x) + bfhi(c.x), bflo(a.y) + bflo(c.y), bfhi(a.y) + bfhi(c.y)};
            v[j] = v[j] * ALPHA + g2.q[j] * f; }
        row_ln_v(v, g1, b1); row_store(v, yp, F.lane); );
}

constexpr int N_PHASES = 18;
#ifndef REP_PHASE
#define REP_PHASE -1
#endif
struct Args { const float* in[25]; float* out; unsigned char* ws; int ph_lo, ph_hi; };
__global__ void __launch_bounds__(NWAVES * 64, 2) fwd_kernel(Args args) {
    extern __shared__ __attribute__((aligned(16))) unsigned char lds[];
    Frame F;
    F.lds = (LAS unsigned char*)lds;
    F.MISC = (volatile LAS unsigned*)(F.lds + MISC_OFF);
    F.wave = __builtin_amdgcn_readfirstlane((int)(threadIdx.x >> 6)); F.lane = lane_id(); F.tid = F.wave * 64 + F.lane;
    F.G = gridDim.x; { const int bx = blockIdx.x; F.vcu = (F.G % 8 == 0) ? (bx % 8) * (F.G / 8) + bx / 8 : bx; }
    F.x = args.in[0]; F.c = args.in[1]; F.ctx = args.in[2]; F.cctx = args.in[3]; F.w_mod = args.in[4]; F.b_mod = args.in[5]; F.ln_g = args.in[6]; F.ln_b = args.in[7];
    F.w_qkv = args.in[8]; F.w_o = args.in[9]; F.sink = args.in[10]; F.w_gu = args.in[11]; F.w_dn = args.in[12]; F.w_in = args.in[13]; F.conv_w = args.in[14]; F.conv_b = args.in[15];
    F.lam = args.in[16]; F.w_r = args.in[17]; F.b_r = args.in[18]; F.w_i = args.in[19]; F.b_i = args.in[20]; F.w_out = args.in[21]; F.router = args.in[22]; F.mw_gu = args.in[23]; F.mw_dn = args.in[24];
    F.out = args.out; F.ws = args.ws;
    for (int u = F.tid; u < (LDS_BYTES - LDSCTL_OFF) / 4; u += NWAVES * 64) ((LAS unsigned*)(F.lds + LDSCTL_OFF))[u] = 0u;
    __syncthreads();
    const int lo = args.ph_lo, hi = args.ph_hi;
    const bool multi = (hi - lo) > 1;
    XcdBarrier bar; bar.bar = (unsigned*)(F.ws + WS_CTL) + 1024; bar.x = 0; bar.st = nullptr;
    if (multi) bar = xcd_barrier_post((unsigned*)(F.ws + WS_CTL) + 1024, F.MISC + 8, F.wave == 0 && lane_id() == 0);
#define IN(k) (lo <= (k) && (k) < hi)
#define REFRESH() do { F.lane = lane_id(); F.tid = F.wave * 64 + F.lane; } while (0)
#define SEAM(k) do { if (IN(k) && IN((k) + 1)) xcd_barrier(bar, F.wave == 0 && lane_id() == 0); } while (0)
    const float* MOD = WSP(float, WS_MOD);
    bf16* H = WSP(bf16, WS_H); bf16* YB = WSP(bf16, WS_YB); const f32x2* ST = (const f32x2*)(F.ws + WS_STATS);

    if (IN(0)) { REFRESH(); p0_prologue(F); if (REP_PHASE == 0) { xcd_barrier(bar, F.wave == 0 && lane_id() == 0); p0_prologue(F); } } SEAM(0);
    if (IN(1)) { REFRESH(); p1_modulate(F); if (REP_PHASE == 1) { xcd_barrier(bar, F.wave == 0 && lane_id() == 0); p1_modulate(F); } } SEAM(1);
    if (IN(2)) {
        pg8::Gemm g{H, WSP(bf16, WS_WQKV), RT, QKVD, DM / 2}; pg8::StaticOrder S; S.init(RT, QKVD, F.G, (int)blockIdx.x);
        pg8::EpiQKV E{WSP(bf16, WS_QKV), WSP(float, WS_ROPE), 1.0f / 512.0f};
        pg8::gemm_phase<pg8::EpiQKV, pg8::StaticOrder, true, true, true>(F.lds + RING_OFF, g, S, E, F.wave);
        moe_convert_filler(F, (RT / 256) * (QKVD / 256), (int)blockIdx.x, 0, 6400);
    } SEAM(2);
    if (IN(3)) { att::attn_phase(WSP(bf16, WS_QKV), WSP(bf16, WS_O), F.sink, F.G, F.vcu, F.lds + RING_OFF, F.wave); if (REP_PHASE == 3) { xcd_barrier(bar, F.wave == 0 && lane_id() == 0); att::attn_phase(WSP(bf16, WS_QKV), WSP(bf16, WS_O), F.sink, F.G, F.vcu, F.lds + RING_OFF, F.wave); } } SEAM(3);
    if (IN(4)) {
        pg8::Gemm g{WSP(bf16, WS_O), WSP(bf16, WS_WO), RT, DM, DM / 2}; pg8::StaticOrder S; S.init(RT, DM, F.G, (int)blockIdx.x);
        pg8::EpiResid<false> E{F.x, F.ctx, YB, MOD + 2048, 1.0f / 2048.0f, nullptr, nullptr, nullptr};
        pg8::gemm_phase<pg8::EpiResid<false>, pg8::StaticOrder, true, true, true>(F.lds + RING_OFF, g, S, E, F.wave);
        moe_convert_filler(F, (RT / 256) * (DM / 256), (int)blockIdx.x, 6400, 17408);
    } SEAM(4);
    if (IN(5)) { REFRESH(); ln_mod_pass<true>(F, true, F.ln_g, F.ln_b, 0, 3072); } SEAM(5);
    if (IN(6)) {
        pg8::Gemm g{H, WSP(bf16, WS_WGU), RT, 2 * DFF, DM / 2}; pg8::StaticOrder S; S.init(RT, 2 * DFF, F.G, (int)blockIdx.x);
        pg8::EpiSwiGLU8 E{WSP(unsigned char, WS_ACT), 28};
        pg8::gemm_phase<pg8::EpiSwiGLU8, pg8::StaticOrder, true, true, true>(F.lds + RING_OFF, g, S, E, F.wave);
    } SEAM(6);
    if (IN(7)) {
        pg8::Gemm g{WSP(bf16, WS_ACT), WSP(bf16, WS_WDN), RT, DM, DFF / 2}; pg8::StaticOrder S; S.init(RT, DM, F.G, (int)blockIdx.x);
        pg8::EpiResid<true> E{nullptr, nullptr, YB, MOD + 5120, 1.0f / 4096.0f, ST, F.ln_g, F.ln_b};
        pg8::gemm_phase<pg8::EpiResid<true>, pg8::StaticOrder, true, true, true>(F.lds + RING_OFF, g, S, E, F.wave);
        moe_convert_filler(F, (RT / 256) * (DM / 256), (int)blockIdx.x, 17408, 37888);
    } SEAM(7);
    if (IN(8)) { REFRESH(); ln_mod_pass<false>(F, true, F.ln_g + 1024, F.ln_b + 1024, 1, 0); } SEAM(8);
    if (IN(9)) {
        pg8::Gemm g{H, WSP(bf16, WS_WIN), RT, 2048, DM}; pg8::StaticOrder S; S.init(RT, 2048, F.G, (int)blockIdx.x);
        pg8::EpiLruIn E{WSP(bf16, WS_G), WSP(bf16, WS_XB)};
        pg8::gemm_phase<pg8::EpiLruIn, pg8::StaticOrder, true, true>(F.lds + RING_OFF, g, S, E, F.wave);
        moe_convert_filler(F, (RT / 256) * (2048 / 256), (int)blockIdx.x, 37888, CV_ITEMS);
    } SEAM(9);
    {
        const lru::Ctx LC{WSP(bf16, WS_U), WSP(bf16, WS_G), WSP(bf16, WS_HH), WSP(u32x4, WS_HF), WSP(bf16, WS_WLG), F.lam, F.b_r, F.b_i};
        if (IN(10)) { REFRESH(); p10_conv(F); } SEAM(10);
        if (IN(11)) { REFRESH(); p11_lru(F, LC); if (REP_PHASE == 11) { xcd_barrier(bar, F.wave == 0 && lane_id() == 0); p11_lru(F, LC); } } SEAM(11);
    }
    if (IN(12)) {
        pg8::Gemm g{WSP(bf16, WS_HH), WSP(bf16, WS_WOUT), RL, DM, DM}; pg8::StaticOrder S; S.init(RL, DM, F.G, (int)blockIdx.x);
        pg8::EpiResid<true> E{nullptr, nullptr, YB, MOD + 9 * 6144 + 2048, 1.0f, ST, F.ln_g + 1024, F.ln_b + 1024};
        pg8::gemm_phase<pg8::EpiResid<true>, pg8::StaticOrder, true, true>(F.lds + RING_OFF, g, S, E, F.wave);
    } SEAM(12);
    if (IN(13)) { REFRESH(); p13_ln_router(F); } SEAM(13);
    if (IN(14)) { REFRESH(); p14_gather(F); if (REP_PHASE == 14) { xcd_barrier(bar, F.wave == 0 && lane_id() == 0); p14_gather(F); } } SEAM(14);
    if (IN(15) || IN(16)) {
        REFRESH();
        int tot[8], before[8]; moe_totals(F, 0, tot, before);
        int tp[9]; tp[0] = 0;
#pragma unroll
        for (int e = 0; e < 8; ++e) tp[e + 1] = __builtin_amdgcn_readfirstlane(tp[e] + ((tot[e] + 255) >> 8));
        const int ntiles = tp[8];
        if (IN(15)) {
            pg8::Gemm g{WSP(bf16, WS_HS), WSP(bf16, WS_WMGU), ntiles * 256, 2 * DFF, DM / 2};
            pg8::MoeOrder S{ntiles, 28, ntiles * 28, F.G, (int)blockIdx.x, 28, tp[1], tp[2], tp[3], tp[4], tp[5], tp[6], tp[7]};
            pg8::EpiSwiGLU8 E{WSP(unsigned char, WS_MACT), 28};
            pg8::gemm_phase<pg8::EpiSwiGLU8, pg8::MoeOrder, true, true, true>(F.lds + RING_OFF, g, S, E, F.wave);
        } SEAM(15);
        if (IN(16)) {
            pg8::Gemm g{WSP(bf16, WS_MACT), WSP(bf16, WS_WMDN), ntiles * 256, DM, DFF / 2};
            pg8::MoeOrder S{ntiles, 4, ntiles * 4, F.G, (int)blockIdx.x, 4, tp[1], tp[2], tp[3], tp[4], tp[5], tp[6], tp[7]};
            pg8::EpiMoeOut8 E{WSP(bf16, WS_FO), (const float*)(F.ws + WS_ROUTE + RT_WS)};
            pg8::gemm_phase<pg8::EpiMoeOut8, pg8::MoeOrder, true, true, true>(F.lds + RING_OFF, g, S, E, F.wave);
        } SEAM(16);
    }
    if (IN(17)) { REFRESH(); p17_final(F); }
#undef IN
#undef SEAM
}

#ifndef N_LAUNCH_MODE
#define N_LAUNCH_MODE 1
#endif
extern "C" void kernel_launch(void* const* d_in, const int* in_sizes, int n_in, void* d_out, int out_size, void* d_ws, size_t ws_size, hipStream_t stream) {
    static int grid = 0;
    if (grid == 0) {
        if (n_in != 25 || out_size != RL * DM || ws_size < WS_END) { fprintf(stderr, "kernel_launch: unexpected shapes (n_in %d out %d ws %zu)\n", n_in, out_size, ws_size); grid = -1; return; }
        int dev = 0, cus = 0, per_cu = 0;
        if (hipGetDevice(&dev) != hipSuccess || hipDeviceGetAttribute(&cus, hipDeviceAttributeMultiprocessorCount, dev) != hipSuccess) { grid = -1; return; }
        if (hipFuncSetAttribute((const void*)fwd_kernel, hipFuncAttributeMaxDynamicSharedMemorySize, LDS_BYTES) != hipSuccess) { fprintf(stderr, "kernel_launch: hipFuncSetAttribute failed\n"); grid = -1; return; }
        if (hipOccupancyMaxActiveBlocksPerMultiprocessor(&per_cu, (const void*)fwd_kernel, NWAVES * 64, LDS_BYTES) != hipSuccess || per_cu < 1) { fprintf(stderr, "kernel_launch: occupancy query says %d\n", per_cu); per_cu = 1; }
        (void)hipGetLastError();
        grid = cus;
    }
    if (grid < 0) return;
    (void)hipMemsetAsync((char*)d_ws + WS_CTL, 0, CTL_ZERO_BYTES, stream);
    Args a{};
    for (int i = 0; i < 25; ++i) a.in[i] = (const float*)d_in[i];
    a.out = (float*)d_out; a.ws = (unsigned char*)d_ws;
#if N_LAUNCH_MODE == 1
    a.ph_lo = 0; a.ph_hi = N_PHASES;
    hipLaunchKernelGGL(fwd_kernel, dim3(grid), dim3(NWAVES * 64), LDS_BYTES, stream, a);
#else
    for (int p = 0; p < N_PHASES; ++p) { a.ph_lo = p; a.ph_hi = p + 1; hipLaunchKernelGGL(fwd_kernel, dim3(grid), dim3(NWAVES * 64), LDS_BYTES, stream, a); }
#endif
    const hipError_t le = hipPeekAtLastError();
    if (le != hipSuccess) fprintf(stderr, "kernel_launch: launch failed: %s\n", hipGetErrorName(le));
}
```

```cpp
#include <hip/hip_runtime.h>
#include <cstdio>
#include <cstdint>

#define GAS __attribute__((address_space(1)))
#define LAS __attribute__((address_space(3)))
typedef unsigned short bf16;
typedef short bf16x8 __attribute__((ext_vector_type(8)));
typedef short s16x4 __attribute__((ext_vector_type(4)));
typedef float f32x4 __attribute__((ext_vector_type(4)));
typedef float f32x2 __attribute__((ext_vector_type(2)));
typedef float f32x16 __attribute__((ext_vector_type(16)));
typedef unsigned u32x4 __attribute__((ext_vector_type(4)));
typedef unsigned u32x2 __attribute__((ext_vector_type(2)));
typedef GAS unsigned gu32;

constexpr int NB = 8, SEQ = 4096, DM = 1024, LCTX = 256;
constexpr int RL = NB * SEQ;
constexpr int RC = NB * LCTX;
constexpr int RT = RL + RC;
constexpr int NHEAD = 8, NKVH = 2, HDIM = 128, QKVD = 1536;
constexpr int DFF = 3584, NEXP = 8;
constexpr float ALPHA = 1.4142135623730951f;
constexpr float LN_EPS = 1e-5f;
constexpr float LOG2E = 1.4426950408889634f;
constexpr int NWAVES = 8;

__device__ __forceinline__ unsigned cvtpk(float lo, float hi) { unsigned r; asm volatile("v_cvt_pk_bf16_f32 %0, %1, %2" : "=v"(r) : "v"(lo), "v"(hi)); return r; }
__device__ __forceinline__ float bflo(unsigned w) { return __uint_as_float(w << 16); }
__device__ __forceinline__ float bfhi(unsigned w) { return __uint_as_float(w & 0xffff0000u); }
__device__ __forceinline__ float ex2(float x) { return __builtin_amdgcn_exp2f(x); }
__device__ __forceinline__ float rcpf_(float x) { return __builtin_amdgcn_rcpf(x); }
__device__ __forceinline__ float sigm(float x) { return rcpf_(1.0f + ex2(-LOG2E * x)); }
typedef int v8i __attribute__((ext_vector_type(8)));
typedef int v4i __attribute__((ext_vector_type(4)));
__device__ __forceinline__ float clamp8(float x) { return __builtin_amdgcn_fmed3f(x, -448.f, 448.f); }
__device__ __forceinline__ unsigned pk4_fp8(float a, float b, float c, float d) {
    int p = __builtin_amdgcn_cvt_pk_fp8_f32(clamp8(a), clamp8(b), 0, false); p = __builtin_amdgcn_cvt_pk_fp8_f32(clamp8(c), clamp8(d), p, true); return (unsigned)p; }
__device__ __forceinline__ int lane_id() { int l; asm volatile("v_mbcnt_lo_u32_b32 %0, -1, 0\n\tv_mbcnt_hi_u32_b32 %0, -1, %0" : "=v"(l)); return l; }
#define REFRESH_F(F) do { (F).lane = lane_id(); (F).tid = (F).wave * 64 + (F).lane; } while (0)
__device__ __forceinline__ float dpp_add(float v, const int ctrl_sel) {
    int r;
    switch (ctrl_sel) { case 0: r = __builtin_amdgcn_update_dpp(0, __float_as_int(v), 0xB1, 0xf, 0xf, true); break;
                        case 1: r = __builtin_amdgcn_update_dpp(0, __float_as_int(v), 0x4E, 0xf, 0xf, true); break;
                        case 2: r = __builtin_amdgcn_update_dpp(0, __float_as_int(v), 0x141, 0xf, 0xf, true); break;
                        default: r = __builtin_amdgcn_update_dpp(0, __float_as_int(v), 0x140, 0xf, 0xf, true); break; }
    return v + __int_as_float(r);
}
__device__ __forceinline__ float wave_sum(float v) {
    v = dpp_add(v, 0); v = dpp_add(v, 1); v = dpp_add(v, 2); v = dpp_add(v, 3);
    const float r0 = __int_as_float(__builtin_amdgcn_readlane(__float_as_int(v), 0)), r1 = __int_as_float(__builtin_amdgcn_readlane(__float_as_int(v), 16)),
                r2 = __int_as_float(__builtin_amdgcn_readlane(__float_as_int(v), 32)), r3 = __int_as_float(__builtin_amdgcn_readlane(__float_as_int(v), 48));
    return (r0 + r1) + (r2 + r3);
}

namespace pg8 {
#define PG8_LAS __attribute__((address_space(3)))
typedef unsigned short bf16_t;
constexpr int BM = 256, BK = 64, HALF = 128, HTB = HALF * BK * 2, STAGE_BYTES = 8 * HTB, NXCD = 8, WGM = 8;
__host__ __device__ __forceinline__ int lds_byte(int r, int c) { const int st = (r >> 4) * 2 + (c >> 5), rr = r & 15, cc = c & 31, ob = rr * 64 + cc * 2; return st * 1024 + (ob ^ (((ob >> 9) & 1) << 5)); }
__host__ __device__ __forceinline__ void stage_rc(int b, int& R, int& C) { const int st = b / 1024, sb = b % 1024, swz = sb ^ (((sb >> 9) & 1) << 5); R = (st >> 1) * 16 + swz / 64; C = (st & 1) * 32 + (swz % 64) / 2; }
__host__ __device__ __forceinline__ int perm32(int rho) { const int n = rho >> 4, i = rho & 15; return 8 * (i >> 2) + 4 * n + (i & 3); }
struct Unit { int pm, pn; };
struct Gemm { const bf16_t* A; const bf16_t* Bt; int M, N, K; };
struct StaticOrder {
    int nM, nN, nwg, G, c;
    __host__ __device__ void init(int M, int N, int G_, int c_) { nM = M / BM; nN = N / BM; nwg = nM * nN; G = G_; c = c_; }
    __host__ __device__ bool next(int i, Unit& u) const {
        const long L = (long)i * G + c; if (L >= nwg) return false;
        int wgid = (int)L; { const int q = nwg / NXCD, r = nwg % NXCD, xcd = wgid % NXCD, off = wgid / NXCD; wgid = (xcd < r ? xcd * (q + 1) : r * (q + 1) + (xcd - r) * q) + off; }
        const int nig = WGM * nN, gid = wgid / nig, fm = gid * WGM, gsz = (nM - fm) < WGM ? (nM - fm) : WGM;
        u.pm = fm + ((wgid % nig) % gsz); u.pn = (wgid % nig) / gsz; return true;
    }
    __device__ __forceinline__ void a_ready(const Unit&) const {}
    __device__ __forceinline__ void done(const Unit&) const {}
};
struct MoeOrder {
    int nM, nN, nwg, G, c, npe; int t1, t2, t3, t4, t5, t6, t7;
    __device__ bool next(int i, Unit& u) const {
        const long L = (long)i * G + c; if (L >= nwg) return false;
        int wgid = (int)L; { const int q = nwg / NXCD, r = nwg % NXCD, xcd = wgid % NXCD, off = wgid / NXCD; wgid = (xcd < r ? xcd * (q + 1) : r * (q + 1) + (xcd - r) * q) + off; }
        const int nig = WGM * nN, gid = wgid / nig, fm = gid * WGM, gsz = (nM - fm) < WGM ? (nM - fm) : WGM;
        const int pm = fm + ((wgid % nig) % gsz), pnl = (wgid % nig) / gsz;
        const int e = (pm >= t1) + (pm >= t2) + (pm >= t3) + (pm >= t4) + (pm >= t5) + (pm >= t6) + (pm >= t7);
        u.pm = pm; u.pn = e * npe + pnl; return true;
    }
    __device__ __forceinline__ void a_ready(const Unit&) const {}
    __device__ __forceinline__ void done(const Unit&) const {}
};


struct EpiQKV {
    static constexpr bool PERM = true, AFTER_DRAIN = false;
    bf16_t* O; const float* rope; float ascale;
    __device__ __forceinline__ void operator()(const f32x4 (&acc)[2][2][4][2], const Unit& u, int wr, int wc, int fr, int fq) const {
        const int row0 = u.pm * BM + wr * 64 + fr;
        const bool rope_on = (u.pm < (RL / BM)) && (u.pn < 5);
        const int axis = wc & 1;
        const int colb = u.pn * 256 + (wc >> 1) * 128 + axis * 64 + 8 * fq;
#pragma unroll
        for (int ai = 0; ai < 2; ++ai)
#pragma unroll
            for (int m = 0; m < 4; ++m) {
                const int r = row0 + ai * HALF + m * 16;
                f32x4 a0 = acc[ai][0][m][0] * ascale, a1 = acc[ai][0][m][1] * ascale, b0 = acc[ai][1][m][0] * ascale, b1 = acc[ai][1][m][1] * ascale;
                if (rope_on) {
                    const int t = r & (SEQ - 1); const int pos = axis ? (t & 63) : (t >> 6);
                    const float* cp = rope + pos * 32 + 8 * fq;
                    const f32x4 c0 = *(const f32x4*)cp, c1 = *(const f32x4*)(cp + 4), s0 = *(const f32x4*)(cp + 2048), s1 = *(const f32x4*)(cp + 2052);
                    const f32x4 o0 = a0 * c0 - b0 * s0, o1 = a1 * c1 - b1 * s1, q0 = b0 * c0 + a0 * s0, q1 = b1 * c1 + a1 * s1;
                    a0 = o0; a1 = o1; b0 = q0; b1 = q1;
                }
                bf16_t* rowp = O + (size_t)r * QKVD + colb;
                u32x4 w; w.x = cvtpk(a0[0], a0[1]); w.y = cvtpk(a0[2], a0[3]); w.z = cvtpk(a1[0], a1[1]); w.w = cvtpk(a1[2], a1[3]);
                *(u32x4*)rowp = w;
                u32x4 v; v.x = cvtpk(b0[0], b0[1]); v.y = cvtpk(b0[2], b0[3]); v.z = cvtpk(b1[0], b1[1]); v.w = cvtpk(b1[2], b1[3]);
                *(u32x4*)(rowp + 32) = v;
            }
    }
};
template <bool LN> struct EpiResid {
    static constexpr bool PERM = true, AFTER_DRAIN = false;
    const float* xin_lat; const float* xin_ctx; bf16_t* y; const float* gate; float ascale; const f32x2* st; const float* lng; const float* lnb;
    __device__ __forceinline__ void operator()(const f32x4 (&acc)[2][2][4][2], const Unit& u, int wr, int wc, int fr, int fq) const {
        const bool lat = u.pm < (RL / BM);
        const int b = lat ? (u.pm >> 4) : 8;
        const int row0 = u.pm * BM + wr * 64 + fr, col0 = u.pn * BM + wc * 32 + 8 * fq;
        const float* xin = lat ? xin_lat + (size_t)row0 * DM : xin_ctx + (size_t)(row0 - RL) * DM;
        f32x2 sv[2][4];
        if constexpr (LN) {
#pragma unroll
            for (int ai = 0; ai < 2; ++ai)
#pragma unroll
                for (int m = 0; m < 4; ++m) sv[ai][m] = st[row0 + ai * HALF + m * 16];
        }
#pragma unroll
        for (int bj = 0; bj < 2; ++bj) { const int cc = col0 + bj * HALF;
            const f32x4 g0 = *(const f32x4*)(gate + (size_t)b * 6144 + cc) * ascale, g1 = *(const f32x4*)(gate + (size_t)b * 6144 + cc + 4) * ascale;
            f32x4 lg0, lg1, lb0, lb1; if constexpr (LN) { lg0 = *(const f32x4*)(lng + cc) * ALPHA; lg1 = *(const f32x4*)(lng + cc + 4) * ALPHA; lb0 = *(const f32x4*)(lnb + cc) * ALPHA; lb1 = *(const f32x4*)(lnb + cc + 4) * ALPHA; }
#pragma unroll
            for (int ai = 0; ai < 2; ++ai)
#pragma unroll
                for (int m = 0; m < 4; ++m) { const int rr = ai * HALF + m * 16; f32x4 x0, x1;
                    if constexpr (LN) { const u32x4 w = *(const u32x4*)(y + (size_t)(row0 + rr) * DM + cc);
                        x0 = (f32x4){bflo(w.x), bfhi(w.x), bflo(w.y), bfhi(w.y)}; x1 = (f32x4){bflo(w.z), bfhi(w.z), bflo(w.w), bfhi(w.w)};
                        x0 = (x0 - sv[ai][m].x) * sv[ai][m].y * lg0 + lb0; x1 = (x1 - sv[ai][m].x) * sv[ai][m].y * lg1 + lb1; }
                    else { x0 = *(const f32x4*)(xin + (size_t)rr * DM + cc) * ALPHA; x1 = *(const f32x4*)(xin + (size_t)rr * DM + cc + 4) * ALPHA; }
                    const f32x4 o0 = x0 + g0 * acc[ai][bj][m][0], o1 = x1 + g1 * acc[ai][bj][m][1];
                    u32x4 w; w.x = cvtpk(o0[0], o0[1]); w.y = cvtpk(o0[2], o0[3]); w.z = cvtpk(o1[0], o1[1]); w.w = cvtpk(o1[2], o1[3]);
                    *(u32x4*)(y + (size_t)(row0 + rr) * DM + cc) = w; }
            asm volatile("" ::: "memory"); }
    }
};
struct EpiSwiGLU {
    static constexpr bool PERM = true, AFTER_DRAIN = false;
    bf16_t* O; int npe;
    __device__ __forceinline__ void operator()(const f32x4 (&acc)[2][2][4][2], const Unit& u, int wr, int wc, int fr, int fq) const {
        const int row0 = u.pm * BM + wr * 64 + fr, pnl = u.pn % npe, col0 = pnl * 128 + wc * 32 + 8 * fq;
#pragma unroll
        for (int ai = 0; ai < 2; ++ai)
#pragma unroll
            for (int m = 0; m < 4; ++m) {
                unsigned w[4];
#pragma unroll
                for (int n = 0; n < 2; ++n) { const f32x4 g = acc[ai][0][m][n], uu = acc[ai][1][m][n]; float o[4];
#pragma unroll
                    for (int j = 0; j < 4; ++j) o[j] = g[j] * sigm(g[j]) * uu[j];
                    w[2 * n] = cvtpk(o[0], o[1]); w[2 * n + 1] = cvtpk(o[2], o[3]); }
                u32x4 ww; ww.x = w[0]; ww.y = w[1]; ww.z = w[2]; ww.w = w[3];
                *(u32x4*)(O + (size_t)(row0 + ai * HALF + m * 16) * DFF + col0) = ww;
            }
    }
};
struct EpiLruIn {
    static constexpr bool PERM = true, AFTER_DRAIN = false;
    bf16_t* G; bf16_t* XB;
    __device__ __forceinline__ void operator()(const f32x4 (&acc)[2][2][4][2], const Unit& u, int wr, int wc, int fr, int fq) const {
        const int row0 = u.pm * BM + wr * 64 + fr; const bool isg = u.pn < 4;
        bf16_t* base = isg ? G : XB; const int col0 = (u.pn & 3) * BM + wc * 32 + 8 * fq;
#pragma unroll
        for (int ai = 0; ai < 2; ++ai)
#pragma unroll
            for (int m = 0; m < 4; ++m)
#pragma unroll
                for (int bj = 0; bj < 2; ++bj) {
                    f32x4 v0 = acc[ai][bj][m][0], v1 = acc[ai][bj][m][1];
                    if (isg) {
#pragma unroll
                        for (int j = 0; j < 4; ++j) { float x = v0[j]; float z = 0.7978845608028654f * (x + 0.044715f * x * x * x); v0[j] = x * sigm(2.0f * z);
                            x = v1[j]; z = 0.7978845608028654f * (x + 0.044715f * x * x * x); v1[j] = x * sigm(2.0f * z); }
                    }
                    u32x4 w; w.x = cvtpk(v0[0], v0[1]); w.y = cvtpk(v0[2], v0[3]); w.z = cvtpk(v1[0], v1[1]); w.w = cvtpk(v1[2], v1[3]);
                    *(u32x4*)(base + (size_t)(row0 + ai * HALF + m * 16) * DM + col0 + bj * HALF) = w;
                }
    }
};
struct EpiMoeOut {
    static constexpr bool PERM = true, AFTER_DRAIN = false;
    bf16_t* O; const float* wrow;
    __device__ __forceinline__ void operator()(const f32x4 (&acc)[2][2][4][2], const Unit& u, int wr, int wc, int fr, int fq) const {
        const int row0 = u.pm * BM + wr * 64 + fr, col0 = (u.pn & 3) * BM + wc * 32 + 8 * fq;
#pragma unroll
        for (int ai = 0; ai < 2; ++ai)
#pragma unroll
            for (int m = 0; m < 4; ++m) { const int r = row0 + ai * HALF + m * 16; const float g = wrow[r];
#pragma unroll
                for (int bj = 0; bj < 2; ++bj) { const f32x4 v0 = acc[ai][bj][m][0] * g, v1 = acc[ai][bj][m][1] * g;
                    u32x4 w; w.x = cvtpk(v0[0], v0[1]); w.y = cvtpk(v0[2], v0[3]); w.z = cvtpk(v1[0], v1[1]); w.w = cvtpk(v1[2], v1[3]);
                    *(u32x4*)(O + (size_t)r * DM + col0 + bj * HALF) = w; } }
    }
};

struct EpiSwiGLU8 {
    static constexpr bool PERM = true, AFTER_DRAIN = false;
    unsigned char* O; int npe;
    __device__ __forceinline__ void operator()(const f32x4 (&acc)[2][2][4][2], const Unit& u, int wr, int wc, int fr, int fq) const {
        const int row0 = u.pm * BM + wr * 64 + fr, pnl = u.pn % npe, col0 = pnl * 128 + wc * 32 + 8 * fq;
        constexpr float C1 = -LOG2E / 512.0f, KK = 32768.0f;
#pragma unroll
        for (int ai = 0; ai < 2; ++ai)
#pragma unroll
            for (int m = 0; m < 4; ++m) {
                u32x2 w;
#pragma unroll
                for (int n = 0; n < 2; ++n) { const f32x4 g = acc[ai][0][m][n], uu = acc[ai][1][m][n];
                    const f32x2 g0 = __builtin_shufflevector(g, g, 0, 1), g1 = __builtin_shufflevector(g, g, 2, 3), u0 = __builtin_shufflevector(uu, uu, 0, 1), u1 = __builtin_shufflevector(uu, uu, 2, 3);
                    const f32x2 t0 = g0 * C1, t1 = g1 * C1;
                    const f32x2 e0 = (f32x2){ex2(t0.x), ex2(t0.y)}, e1 = (f32x2){ex2(t1.x), ex2(t1.y)};
                    const f32x2 d0 = e0 * KK + KK, d1 = e1 * KK + KK;
                    const f32x2 o0 = (g0 * u0) * (f32x2){rcpf_(d0.x), rcpf_(d0.y)}, o1 = (g1 * u1) * (f32x2){rcpf_(d1.x), rcpf_(d1.y)};
                    w[n] = pk4_fp8(o0.x, o0.y, o1.x, o1.y); }
                *(u32x2*)(O + (size_t)(row0 + ai * HALF + m * 16) * DFF + col0) = w;
            }
    }
};
struct EpiMoeOut8 {
    static constexpr bool PERM = true, AFTER_DRAIN = false;
    bf16_t* O; const float* wrow;
    __device__ __forceinline__ void operator()(const f32x4 (&acc)[2][2][4][2], const Unit& u, int wr, int wc, int fr, int fq) const {
        const int row0 = u.pm * BM + wr * 64 + fr, col0 = (u.pn & 3) * BM + wc * 32 + 8 * fq;
#pragma unroll
        for (int ai = 0; ai < 2; ++ai)
#pragma unroll
            for (int m = 0; m < 4; ++m) { const int r = row0 + ai * HALF + m * 16; const float g = wrow[r] * (1.0f / 4096.0f);
#pragma unroll
                for (int bj = 0; bj < 2; ++bj) { const f32x4 v0 = acc[ai][bj][m][0] * g, v1 = acc[ai][bj][m][1] * g;
                    u32x4 w; w.x = cvtpk(v0[0], v0[1]); w.y = cvtpk(v0[2], v0[3]); w.z = cvtpk(v1[0], v1[1]); w.w = cvtpk(v1[2], v1[3]);
                    *(u32x4*)(O + (size_t)r * DM + col0 + bj * HALF) = w; } }
    }
};

template <class Epi, class Sched, bool ALIGN_EPI = false, bool SP2 = false, bool FP8 = false>
__device__ __forceinline__ void gemm_phase(PG8_LAS unsigned char* lds, const Gemm g, const Sched& S, const Epi& E, const int wid) {
    const int lane = lane_id(), tid = wid * 64 + lane, wr = wid >> 2, wc = wid & 3, fr = lane & 15, fq = lane >> 4;
    const int K = g.K, nt = K / BK;
    unsigned voffA[2], voffB[2];
#pragma unroll
    for (int i = 0; i < 2; ++i) { int R, C; stage_rc(tid * 16 + i * 8192, R, C); const int Rb = Epi::PERM ? ((R & ~31) + perm32(R & 31)) : R;
        voffA[i] = (unsigned)(R * K + C) * 2u; voffB[i] = (unsigned)(Rb * K + C) * 2u; }
    const unsigned kstep = (unsigned)(BK * 2);
    const unsigned hstep = (unsigned)HALF * K * 2;
    const unsigned tstep = 2 * hstep;
    const __amdgpu_buffer_rsrc_t rs_voffA = __builtin_amdgcn_make_buffer_rsrc((void*)g.A, 0, -1, 0x00020000), rs_voffB = __builtin_amdgcn_make_buffer_rsrc((void*)g.Bt, 0, -1, 0x00020000);
    const unsigned ldsw = (unsigned)wid * 1024u;
    const int aoff = lds_byte(wr * 64 + fr, fq * 8), boff = lds_byte(wc * 32 + fr, fq * 8);
#define PG8_SA(b, h) (((b) * 2 + (h)) * HTB)
#define PG8_SB(b, h) ((4 + (b) * 2 + (h)) * HTB)
#define PG8_STAGE(bufoff, gbase, voff) do { _Pragma("unroll") for (int _i = 0; _i < 2; ++_i) \
        __builtin_amdgcn_raw_ptr_buffer_load_lds(rs_##voff, (PG8_LAS void*)(lds + (bufoff) + ldsw + _i * 8192), 16, (voff)[_i], (gbase), 0, 0); } while (0)
#define PG8_LDA(dst, b, h) do { if constexpr (FP8) { _Pragma("unroll") for (int m = 0; m < 4; ++m) { const v4i _l = *(const PG8_LAS v4i*)(lds + PG8_SA(b, h) + aoff + m * 2048), _h = *(const PG8_LAS v4i*)(lds + PG8_SA(b, h) + aoff + m * 2048 + 1024); \
            dst##8[m] = __builtin_shufflevector(_l, _h, 0, 1, 2, 3, 4, 5, 6, 7); } } \
        else { _Pragma("unroll") for (int m = 0; m < 4; ++m) _Pragma("unroll") for (int k = 0; k < 2; ++k) dst[m][k] = *(const PG8_LAS bf16x8*)(lds + PG8_SA(b, h) + aoff + m * 2048 + k * 1024); } } while (0)
#define PG8_LDB(dst, b, h) do { if constexpr (FP8) { _Pragma("unroll") for (int n = 0; n < 2; ++n) { const v4i _l = *(const PG8_LAS v4i*)(lds + PG8_SB(b, h) + boff + n * 2048), _h = *(const PG8_LAS v4i*)(lds + PG8_SB(b, h) + boff + n * 2048 + 1024); \
            dst##8[n] = __builtin_shufflevector(_l, _h, 0, 1, 2, 3, 4, 5, 6, 7); } } \
        else { _Pragma("unroll") for (int n = 0; n < 2; ++n) _Pragma("unroll") for (int k = 0; k < 2; ++k) dst[n][k] = *(const PG8_LAS bf16x8*)(lds + PG8_SB(b, h) + boff + n * 2048 + k * 1024); } } while (0)
#define PG8_MMA(ai, bj, At, Bt) do { if constexpr (FP8) __builtin_amdgcn_sched_barrier(0); __builtin_amdgcn_s_setprio(1); \
        if constexpr (FP8) { _Pragma("unroll") for (int m = 0; m < 4; ++m) _Pragma("unroll") for (int n = 0; n < 2; ++n) \
            acc[ai][bj][m][n] = __builtin_amdgcn_mfma_scale_f32_16x16x128_f8f6f4(Bt##8[n], At##8[m], acc[ai][bj][m][n], 0, 0, 0, 0, 0, 0); } \
        else { _Pragma("unroll") for (int m = 0; m < 4; ++m) _Pragma("unroll") for (int n = 0; n < 2; ++n) _Pragma("unroll") for (int k = 0; k < 2; ++k) \
            acc[ai][bj][m][n] = __builtin_amdgcn_mfma_f32_16x16x32_bf16(Bt[n][k], At[m][k], acc[ai][bj][m][n], 0, 0, 0); } \
        __builtin_amdgcn_s_setprio(0); if constexpr (FP8) __builtin_amdgcn_sched_barrier(0); } while (0)
#define PG8_WAIT_V(n) asm volatile("s_waitcnt vmcnt(" #n ")" ::: "memory")
#define PG8_WAIT_L(n) asm volatile("s_waitcnt lgkmcnt(" #n ")" ::: "memory")
#define PG8_BAR __builtin_amdgcn_s_barrier()
#define PG8_SCHED __builtin_amdgcn_sched_barrier(0)
    Unit cur, nxt; int ui = 0;
    if (!S.next(0, cur)) return;
    f32x4 acc[2][2][4][2];
#pragma unroll
    for (int a = 0; a < 2; ++a)
#pragma unroll
        for (int b = 0; b < 2; ++b)
#pragma unroll
            for (int m = 0; m < 4; ++m)
#pragma unroll
                for (int n = 0; n < 2; ++n) acc[a][b][m][n] = (f32x4){0.f, 0.f, 0.f, 0.f};
    bf16x8 At[4][2], B0[2][2], B1[2][2]; v8i At8[4], B08[2], B18[2];
    unsigned cA = (unsigned)cur.pm * tstep, cB = (unsigned)cur.pn * tstep;
    S.a_ready(cur);
    if constexpr (SP2) {
        PG8_STAGE(PG8_SB(0, 0), cB, voffB); PG8_STAGE(PG8_SB(0, 1), cB + hstep, voffB); PG8_STAGE(PG8_SA(0, 0), cA, voffA); PG8_STAGE(PG8_SA(0, 1), cA + hstep, voffA);
        if (wr == 1) PG8_BAR;
        PG8_WAIT_V(2); PG8_BAR;
        PG8_STAGE(PG8_SB(1, 0), cB + kstep, voffB); PG8_STAGE(PG8_SA(1, 0), cA + kstep, voffA); PG8_STAGE(PG8_SB(1, 1), cB + hstep + kstep, voffB);
        PG8_WAIT_V(6); PG8_BAR;
    } else {
        PG8_STAGE(PG8_SB(0, 0), cB, voffB); PG8_STAGE(PG8_SA(0, 0), cA, voffA); PG8_STAGE(PG8_SB(0, 1), cB + hstep, voffB); PG8_STAGE(PG8_SA(0, 1), cA + hstep, voffA);
        if (wr == 1) PG8_BAR;
        PG8_WAIT_V(4); PG8_BAR;
        PG8_STAGE(PG8_SB(1, 0), cB + kstep, voffB); PG8_STAGE(PG8_SA(1, 0), cA + kstep, voffA); PG8_STAGE(PG8_SB(1, 1), cB + hstep + kstep, voffB);
        PG8_WAIT_V(6); PG8_BAR;
    }
    for (;;) {
        const bool has_next = S.next(ui + 1, nxt);
        const unsigned nA = has_next ? (unsigned)nxt.pm * tstep : cA, nB = has_next ? (unsigned)nxt.pn * tstep : cB;
        _Pragma("clang loop unroll(disable)") for (int t = 0; t < nt; t += 2) {
            const bool last = (t == nt - 2);
            const unsigned a1 = cA + (unsigned)(t + 1) * kstep;
            const unsigned a2 = last ? nA : cA + (unsigned)(t + 2) * kstep, b2 = last ? nB : cB + (unsigned)(t + 2) * kstep;
            const unsigned a3 = a2 + kstep, b3 = b2 + kstep;
            if (last && has_next) S.a_ready(nxt);
            if constexpr (SP2) {
            PG8_LDB(B0, 0, 0); PG8_LDB(B1, 0, 1); PG8_SCHED; PG8_LDA(At, 0, 0); PG8_STAGE(PG8_SA(1, 1), a1 + hstep, voffA);
            PG8_WAIT_V(8); PG8_WAIT_L(0); PG8_BAR; PG8_MMA(0, 0, At, B0); PG8_MMA(0, 1, At, B1); PG8_BAR; PG8_SCHED;
            PG8_LDA(At, 0, 1); PG8_STAGE(PG8_SB(0, 0), b2, voffB); PG8_STAGE(PG8_SB(0, 1), b2 + hstep, voffB); PG8_STAGE(PG8_SA(0, 0), a2, voffA);
            PG8_WAIT_V(8); PG8_WAIT_L(0); PG8_BAR; PG8_MMA(1, 0, At, B0); PG8_MMA(1, 1, At, B1); PG8_BAR; PG8_SCHED;
            PG8_LDB(B0, 1, 0); PG8_LDB(B1, 1, 1); PG8_SCHED; PG8_LDA(At, 1, 0); PG8_STAGE(PG8_SA(0, 1), a2 + hstep, voffA);
            PG8_WAIT_V(8); PG8_WAIT_L(0); PG8_BAR; PG8_MMA(0, 0, At, B0); PG8_MMA(0, 1, At, B1); PG8_BAR; PG8_SCHED;
            PG8_LDA(At, 1, 1); PG8_STAGE(PG8_SB(1, 0), b3, voffB); PG8_STAGE(PG8_SB(1, 1), b3 + hstep, voffB); PG8_STAGE(PG8_SA(1, 0), a3, voffA);
            PG8_WAIT_V(8); PG8_WAIT_L(0); PG8_BAR; PG8_MMA(1, 0, At, B0); PG8_MMA(1, 1, At, B1); PG8_BAR; PG8_SCHED;
            } else {
            PG8_LDB(B0, 0, 0); PG8_SCHED; PG8_LDA(At, 0, 0); PG8_STAGE(PG8_SA(1, 1), a1 + hstep, voffA);
            PG8_WAIT_L(8); PG8_BAR; PG8_WAIT_L(0); PG8_MMA(0, 0, At, B0); PG8_BAR; PG8_SCHED;
            PG8_LDB(B1, 0, 1); PG8_STAGE(PG8_SB(0, 0), b2, voffB);
            PG8_BAR; PG8_WAIT_L(0); PG8_MMA(0, 1, At, B1); PG8_BAR;
            PG8_LDA(At, 0, 1); PG8_STAGE(PG8_SA(0, 0), a2, voffA);
            PG8_BAR; PG8_WAIT_L(0); PG8_MMA(1, 0, At, B0); PG8_BAR; PG8_SCHED;
            PG8_STAGE(PG8_SB(0, 1), b2 + hstep, voffB);
            PG8_WAIT_V(6); PG8_BAR; PG8_MMA(1, 1, At, B1); PG8_BAR;
            PG8_LDB(B0, 1, 0); PG8_SCHED; PG8_LDA(At, 1, 0); PG8_STAGE(PG8_SA(0, 1), a2 + hstep, voffA);
            PG8_WAIT_L(8); PG8_BAR; PG8_WAIT_L(0); PG8_MMA(0, 0, At, B0); PG8_BAR; PG8_SCHED;
            PG8_LDB(B1, 1, 1); PG8_STAGE(PG8_SB(1, 0), b3, voffB);
            PG8_BAR; PG8_WAIT_L(0); PG8_MMA(0, 1, At, B1); PG8_BAR;
            PG8_LDA(At, 1, 1); PG8_STAGE(PG8_SA(1, 0), a3, voffA);
            PG8_BAR; PG8_WAIT_L(0); PG8_MMA(1, 0, At, B0); PG8_BAR; PG8_SCHED;
            PG8_STAGE(PG8_SB(1, 1), b3 + hstep, voffB);
            PG8_WAIT_V(6); PG8_BAR; PG8_MMA(1, 1, At, B1); PG8_BAR;
            }
        }
        if constexpr (ALIGN_EPI) { if (wr == 0) PG8_BAR; }
        if constexpr (!Epi::AFTER_DRAIN) { int le = lane_id();
            E(acc, cur, wr, wc, le & 15, le >> 4); S.done(cur); }
        if (!has_next) break;
#pragma unroll
        for (int a = 0; a < 2; ++a)
#pragma unroll
            for (int b = 0; b < 2; ++b)
#pragma unroll
                for (int m = 0; m < 4; ++m)
#pragma unroll
                    for (int n = 0; n < 2; ++n) acc[a][b][m][n] = (f32x4){0.f, 0.f, 0.f, 0.f};
        cur = nxt; cA = nA; cB = nB; ++ui;
        if constexpr (ALIGN_EPI) { if (wr == 1) PG8_BAR; }
    }
    PG8_WAIT_V(0);
    if constexpr (!ALIGN_EPI) { if (wr == 0) PG8_BAR; }
    PG8_BAR;
    if constexpr (Epi::AFTER_DRAIN) { E.fused(acc, cur, wr, wc, fr, fq, lds, wid, lane); S.done(cur); }
#undef PG8_SA
#undef PG8_SB
#undef PG8_STAGE
#undef PG8_LDA
#undef PG8_LDB
#undef PG8_MMA
#undef PG8_WAIT_V
#undef PG8_WAIT_L
#undef PG8_BAR
#undef PG8_SCHED
}
}

constexpr size_t MiB = 1u << 20;
constexpr size_t WS_CTL = 0, CTL_ZERO_BYTES = 65536;
constexpr size_t WS_MOD = 65536;
constexpr size_t WS_ROPE = 65536 + 458752;
constexpr size_t WS_WQKV = 1 * MiB, WS_WO = 4 * MiB, WS_WGU = 6 * MiB, WS_WDN = 20 * MiB, WS_WIN = 27 * MiB, WS_WOUT = 31 * MiB, WS_WLG = 33 * MiB;
constexpr size_t WS_WMGU = 34 * MiB, WS_WMDN = 146 * MiB;
constexpr size_t WS_YB = 760 * MiB;
constexpr size_t WS_H = 210 * MiB;
constexpr size_t WS_ACTV = 278 * MiB;
constexpr size_t WS_QKV = WS_ACTV, WS_O = WS_ACTV + 102 * MiB, WS_ACT = WS_ACTV + 170 * MiB;
constexpr size_t WS_G = WS_ACTV, WS_XB = WS_ACTV + 68 * MiB, WS_HF = WS_ACTV + 136 * MiB, WS_HH = WS_ACTV + 200 * MiB;
constexpr size_t WS_U = WS_ACTV + 264 * MiB;
constexpr size_t WS_HS = WS_ACTV, WS_FO = WS_ACTV + 68 * MiB, WS_MACT = WS_ACTV + 200 * MiB;
constexpr size_t WS_ROUTE = 872 * MiB;
constexpr size_t WS_LRUS = 874 * MiB;
constexpr size_t WS_END = 875 * MiB;
constexpr int MOE_MAXT = 264;
constexpr size_t RT_EIDX = 0, RT_WGT = 262144, RT_SLOT = 524288, RT_WS = 786432, RT_CNT = 786432 + 270336 + 0;
constexpr size_t LS_SUM = 0, LS_CTX = 524288;
constexpr size_t WS_STATS = WS_LRUS + 655360;

constexpr int RING_OFF = 0, RING_BYTES = 135168;
constexpr int LDSCTL_OFF = RING_BYTES, MISC_OFF = LDSCTL_OFF + 320;
constexpr int LDS_BYTES = 136192;

#define RLX_AGENT __ATOMIC_RELAXED, __HIP_MEMORY_SCOPE_AGENT
#define LDS_WAIT() asm volatile("s_waitcnt lgkmcnt(0)" ::: "memory")
#define VM_WAIT() asm volatile("s_waitcnt vmcnt(0)" ::: "memory")
#define XB_TMO      128
#define XB_XCNT(j)  (256  + 64 * (j))
#define XB_XSUB(j)  (1280 + 64 * (j))
#define XB_XGEN(j)  (2304 + 64 * (j))
#define XB_TOP      3328
#define XB_TOPGEN   3392
#define XCD_BAR_WORDS 3456
#define XB_SPIN_CAP (1u << 18)

__device__ __forceinline__ unsigned xb_ld(unsigned* p)              { return __hip_atomic_load(p, __ATOMIC_RELAXED, __HIP_MEMORY_SCOPE_AGENT); }
__device__ __forceinline__ unsigned xb_add(unsigned* p, unsigned v) { return __hip_atomic_fetch_add(p, v, __ATOMIC_RELAXED, __HIP_MEMORY_SCOPE_AGENT); }
__device__ __forceinline__ unsigned xb_xcc_id() { return (unsigned)__builtin_amdgcn_s_getreg((3 << 11) | 20) & 0xFu; }
#define XB_SPIN(cond, bar) do { unsigned _sp = 0; while (cond) { __builtin_amdgcn_s_sleep(1); \
    if ((++_sp & 255u) == 0u) { if (xb_ld(&(bar)[XB_TMO])) break; if (_sp > XB_SPIN_CAP) { atomicAdd(&(bar)[XB_TMO], 1u); break; } } } } while (0)

struct XcdBarrier {
    unsigned* bar; unsigned x;
    volatile LAS unsigned* st;
};

__device__ __forceinline__ XcdBarrier xcd_barrier_post(unsigned* bar, volatile LAS unsigned* st, const bool t0  ) {
    XcdBarrier b; b.bar = bar; b.x = xb_xcc_id(); b.st = st;
    if (t0) (void)xb_add(&bar[XB_XCNT(b.x)], 1u);
    return b;
}
__device__ __forceinline__ void xcd_barrier_complete(unsigned* bar, unsigned x, unsigned& nloc, unsigned& nx) {
    const unsigned G = gridDim.x * gridDim.y * gridDim.z;
    unsigned sum, cnt, mine, sp = 0u;
    for (;;) {
        sum = 0u; cnt = 0u; mine = 0u;
#pragma unroll
        for (unsigned j = 0; j < 16; ++j) { const unsigned c = xb_ld(&bar[XB_XCNT(j)]); sum += c; cnt += (c > 0u) ? 1u : 0u; mine = (j == x) ? c : mine; }
        if (sum == G) break;
        __builtin_amdgcn_s_sleep(1);
        if ((++sp & 255u) == 0u) { if (xb_ld(&bar[XB_TMO])) break; if (sp > XB_SPIN_CAP) { atomicAdd(&bar[XB_TMO], 1u); break; } }
    }
    nloc = mine > 0u ? mine : 1u; nx = cnt > 0u ? cnt : 1u;
}

__device__ __forceinline__ void xcd_barrier(const XcdBarrier& b, const bool t0  ) {
    asm volatile("s_waitcnt vmcnt(0)" ::: "memory");
    __syncthreads();
    if (t0) {
        unsigned* bar = b.bar;
        __builtin_amdgcn_s_waitcnt(0);
        unsigned nloc = b.st[0], nx = b.st[1];
        if (nloc == 0u) { xcd_barrier_complete(bar, b.x, nloc, nx); b.st[0] = nloc; b.st[1] = nx; }
        const unsigned old = xb_add(&bar[XB_XSUB(b.x)], 1u);
        const unsigned gen = old / nloc;
        if (old + 1u == (gen + 1u) * nloc) {
            __builtin_amdgcn_fence(__ATOMIC_RELEASE, "agent");
            asm volatile("s_waitcnt vmcnt(0)" ::: "memory");
            const unsigned og = xb_add(&bar[XB_TOP], 1u);
            const unsigned tg = og / nx;
            if (og + 1u == (tg + 1u) * nx) xb_add(&bar[XB_TOPGEN], 1u);
            else XB_SPIN(xb_ld(&bar[XB_TOPGEN]) == tg, bar);
            __builtin_amdgcn_fence(__ATOMIC_ACQUIRE, "agent");
            xb_add(&bar[XB_XGEN(b.x)], 1u);
            asm volatile("s_waitcnt vmcnt(0)" ::: "memory");
        } else {
            XB_SPIN(xb_ld(&bar[XB_XGEN(b.x)]) == gen, bar);
            __builtin_amdgcn_fence(__ATOMIC_ACQUIRE, "agent");
            asm volatile("s_waitcnt vmcnt(0)" ::: "memory");
        }
    }
    __syncthreads();
}


struct Frame {
    LAS unsigned char* lds;
    volatile LAS unsigned* MISC;
    int tid, lane, wave, vcu, G;
    const float *x, *c, *ctx, *cctx, *w_mod, *b_mod, *ln_g, *ln_b, *w_qkv, *w_o, *sink, *w_gu, *w_dn, *w_in, *conv_w, *conv_b, *lam, *w_r, *b_r, *w_i, *b_i, *w_out, *router, *mw_gu, *mw_dn;
    float* out; unsigned char* ws;
};
#define WSP(T, off) ((T*)(F.ws + (off)))

__device__ __forceinline__ void p0_mod_task(Frame& F, int task) {
    const int li = task / 96, cb = task % 96;
    LAS float* S = (LAS float*)F.lds;
    LAS float* red = (LAS float*)(F.lds + 36864);
    for (int idx = F.tid; idx < 9 * 1024; idx += NWAVES * 64) { const int b = idx >> 10, k = idx & 1023; const float v = (b < 8) ? F.c[b * 1024 + k] : F.cctx[k]; S[idx] = v * sigm(v); }
    __syncthreads();
    const float* W = F.w_mod + (size_t)li * 1024 * 6144 + cb * 64;
    const int cl = F.lane & 15, kr = F.lane >> 4;
    f32x4 acc[9];
#pragma unroll
    for (int b = 0; b < 9; ++b) acc[b] = (f32x4){0.f, 0.f, 0.f, 0.f};
#pragma unroll 4
    for (int kk = 0; kk < 32; ++kk) { const int k = 128 * F.wave + 4 * kk + kr; const f32x4 wv = *(const f32x4*)(W + (size_t)k * 6144 + 4 * cl);
#pragma unroll
        for (int b = 0; b < 9; ++b) acc[b] += wv * S[b * 1024 + k]; }
#pragma unroll
    for (int b = 0; b < 9; ++b)
#pragma unroll
        for (int j = 0; j < 4; ++j) { float v = acc[b][j]; v += __shfl_xor(v, 16); v += __shfl_xor(v, 32); acc[b][j] = v; }
    if (kr == 0) {
#pragma unroll
        for (int b = 0; b < 9; ++b) *(LAS f32x4*)(red + (F.wave * 9 + b) * 64 + 4 * cl) = acc[b]; }
    __syncthreads();
    float* mod = WSP(float, WS_MOD);
    for (int idx = F.tid; idx < 9 * 64; idx += NWAVES * 64) { const int b = idx >> 6, col = idx & 63; float s = 0.f;
#pragma unroll
        for (int w = 0; w < 8; ++w) s += red[(w * 9 + b) * 64 + col];
        mod[(size_t)(li * 9 + b) * 6144 + cb * 64 + col] = s + F.b_mod[li * 6144 + cb * 64 + col]; }
    __syncthreads();
}
__device__ __forceinline__ void p0_transpose_item(const float* W, int K, int N, bf16* WT, int kb, int n0, int drow0, LAS float* scr, int lane) {
    const int k0 = 64 * kb;
#pragma unroll
    for (int i = 0; i < 8; ++i) { const int kk = 8 * i + (lane >> 3); const f32x4 wv = *(const f32x4*)(W + (size_t)(k0 + kk) * N + n0 + 4 * (lane & 7));
        LAS float* d = scr + kk * 33 + 4 * (lane & 7); d[0] = wv[0]; d[1] = wv[1]; d[2] = wv[2]; d[3] = wv[3]; }
    LDS_WAIT(); asm volatile("" ::: "memory");
    const int c = lane & 7;
#pragma unroll
    for (int j = 0; j < 4; ++j) { const int n = (lane >> 3) + 8 * j; const LAS float* s = scr + (8 * c) * 33 + n;
        u32x4 o; o.x = cvtpk(s[0 * 33], s[1 * 33]); o.y = cvtpk(s[2 * 33], s[3 * 33]); o.z = cvtpk(s[4 * 33], s[5 * 33]); o.w = cvtpk(s[6 * 33], s[7 * 33]);
        *(GAS u32x4*)(WT + (size_t)(drow0 + n) * K + k0 + 8 * c) = o; }
    LDS_WAIT(); asm volatile("" ::: "memory");
}
template <int QS> __device__ __forceinline__ void p0_transpose_item8(const float* W, int K, int N, unsigned char* WT, int kb, int n0, int drow0, LAS float* scr, int lane) {
    const int k0 = 64 * kb; constexpr float qs = (float)(1 << QS);
#pragma unroll
    for (int i = 0; i < 8; ++i) { const int kk = 8 * i + (lane >> 3); const f32x4 wv = *(const f32x4*)(W + (size_t)(k0 + kk) * N + n0 + 4 * (lane & 7)) * qs;
        LAS float* d = scr + kk * 33 + 4 * (lane & 7); d[0] = wv[0]; d[1] = wv[1]; d[2] = wv[2]; d[3] = wv[3]; }
    LDS_WAIT(); asm volatile("" ::: "memory");
    const int c = lane & 7;
#pragma unroll
    for (int j = 0; j < 4; ++j) { const int n = (lane >> 3) + 8 * j; const LAS float* s = scr + (8 * c) * 33 + n;
        u32x2 o; o.x = pk4_fp8(s[0 * 33], s[1 * 33], s[2 * 33], s[3 * 33]); o.y = pk4_fp8(s[4 * 33], s[5 * 33], s[6 * 33], s[7 * 33]);
        *(GAS u32x2*)(WT + (size_t)(drow0 + n) * K + k0 + 8 * c) = o; }
    LDS_WAIT(); asm volatile("" ::: "memory");
}
__device__ __forceinline__ int gu_row(int j) { const int isu = j >= DFF, jj = isu ? j - DFF : j; return (jj >> 7) * 256 + isu * 128 + (jj & 127); }
__device__ __forceinline__ int qkv_row(int L) { const int pn = L >> 8, rem = L & 255, hsel = rem >> 7, axis = (rem >> 6) & 1, half = (rem >> 5) & 1, x = rem & 31; return pn * 256 + 128 * half + 32 * (2 * hsel + axis) + x; }

__device__ __forceinline__ void p0_prologue(Frame& F) {
    for (int task = F.vcu; task < 192; task += F.G) p0_mod_task(F, task);
    if (F.vcu == F.G - 1) {
        float* rope = WSP(float, WS_ROPE);
        for (int idx = F.tid; idx < 2048; idx += NWAVES * 64) { const int pos = idx >> 5, i = idx & 31;
            const double freq = exp2(-(double)i * (13.287712379549449 / 32.0));
            const float ang = (float)pos * (float)freq;
            double rev = (double)ang * 0.15915494309189535; rev -= floor(rev);
            rope[idx] = __builtin_amdgcn_cosf((float)rev); rope[2048 + idx] = __builtin_amdgcn_sinf((float)rev); }
    }
    LAS float* scr = (LAS float*)(F.lds + F.wave * 8704);
    const int gw = F.vcu * NWAVES + F.wave, NGW = F.G * NWAVES;
    constexpr int I_QKV = 16 * 48;
    for (int r = gw; r < I_QKV; r += NGW) { const int kb = r / 48, n0 = (r % 48) * 32; p0_transpose_item8<7>(F.w_qkv, 1024, 1536, WSP(unsigned char, WS_WQKV), kb, n0, qkv_row(n0), scr, F.lane); }
}

constexpr int MOE_I_GU = 16 * 224, MOE_I_DN = 56 * 32, MOE_ITEMS = 8 * (MOE_I_GU + MOE_I_DN);
constexpr int DR_O = 16 * 32, DR_GU = 16 * 224, DR_DN = 56 * 32, DR_IN = 16 * 64, DR_OUT = 16 * 32, DR_LG = 32 * 8, DR_ITEMS = DR_O + DR_GU + DR_DN + DR_IN + DR_OUT + DR_LG;
constexpr int CV_ITEMS = DR_ITEMS + MOE_ITEMS;
__device__ __forceinline__ void moe_convert_items(Frame& F, int lo, int hi, int rank, int nranks) {
    LAS float* scr = (LAS float*)(F.lds + F.wave * 8704);
    for (int it0 = lo + rank * NWAVES + F.wave; it0 < hi; it0 += nranks * NWAVES) {
        int r = it0;
        if (r < DR_O) { const int kb = r / 32, n0 = (r % 32) * 32; p0_transpose_item8<7>(F.w_o, 1024, 1024, WSP(unsigned char, WS_WO), kb, n0, n0, scr, F.lane); continue; } r -= DR_O;
        if (r < DR_GU) { const int kb = r / 224, n0 = (r % 224) * 32; p0_transpose_item8<7>(F.w_gu, 1024, 7168, WSP(unsigned char, WS_WGU), kb, n0, gu_row(n0), scr, F.lane); continue; } r -= DR_GU;
        if (r < DR_DN) { const int kb = r / 32, n0 = (r % 32) * 32; p0_transpose_item8<9>(F.w_dn, 3584, 1024, WSP(unsigned char, WS_WDN), kb, n0, n0, scr, F.lane); continue; } r -= DR_DN;
        if (r < DR_IN) { const int kb = r / 64, n0 = (r % 64) * 32; p0_transpose_item(F.w_in, 1024, 2048, WSP(bf16, WS_WIN), kb, n0, n0, scr, F.lane); continue; } r -= DR_IN;
        if (r < DR_OUT) { const int kb = r / 32, n0 = (r % 32) * 32; p0_transpose_item(F.w_out, 1024, 1024, WSP(bf16, WS_WOUT), kb, n0, n0, scr, F.lane); continue; } r -= DR_OUT;
        if (r < DR_LG) { const int mi = r >> 3, sub = r & 7, which = mi >> 4, d = (mi >> 3) & 1, n = mi & 7, kb = sub >> 2, n0 = (sub & 3) * 32;
            p0_transpose_item((which ? F.w_i : F.w_r) + (size_t)(d * 8 + n) * 16384, 128, 128, WSP(bf16, WS_WLG) + (size_t)(n * 4 + 2 * d + which) * 16384, kb, n0, n0, scr, F.lane); continue; } r -= DR_LG;
        if (r < 8 * MOE_I_GU) { const int e = r / MOE_I_GU, q = r % MOE_I_GU, kb = q / 224, n0 = (q % 224) * 32;
            p0_transpose_item8<7>(F.mw_gu + (size_t)e * 1024 * 7168, 1024, 7168, WSP(unsigned char, WS_WMGU) + (size_t)e * 7168 * 1024, kb, n0, gu_row(n0), scr, F.lane); }
        else { r -= 8 * MOE_I_GU; const int e = r / MOE_I_DN, q = r % MOE_I_DN, kb = q / 32, n0 = (q % 32) * 32;
            p0_transpose_item8<9>(F.mw_dn + (size_t)e * 3584 * 1024, 3584, 1024, WSP(unsigned char, WS_WMDN) + (size_t)e * 1024 * 3584, kb, n0, n0, scr, F.lane); }
    }
}
__device__ __forceinline__ void moe_convert_filler(Frame& F, int nwg, int c, int lo, int hi) {
    const int R = (nwg + F.G - 1) / F.G, rem = nwg - (R - 1) * F.G;
    if (rem >= F.G) { moe_convert_items(F, lo, hi, c, F.G); return; }
    if (c >= rem) { REFRESH_F(F); moe_convert_items(F, lo, hi, c - rem, F.G - rem); }
}
__device__ __forceinline__ void row_load(f32x4 (&v)[4], const float* p, int lane) {
#pragma unroll
    for (int j = 0; j < 4; ++j) v[j] = *(const f32x4*)(p + 4 * lane + 256 * j);
}
__device__ __forceinline__ void row_load_bf(f32x4 (&v)[4], const bf16* p, int lane) {
#pragma unroll
    for (int j = 0; j < 4; ++j) { const u32x2 w = *(const u32x2*)(p + 4 * lane + 256 * j); v[j] = (f32x4){bflo(w.x), bfhi(w.x), bflo(w.y), bfhi(w.y)}; }
}
__device__ __forceinline__ void row_store(const f32x4 (&v)[4], float* p, int lane) {
#pragma unroll
    for (int j = 0; j < 4; ++j) *(f32x4*)(p + 4 * lane + 256 * j) = v[j];
}
struct Vec16 { f32x4 q[4]; };
__device__ __forceinline__ Vec16 vec_load(const float* p, int lane) { Vec16 r;
#pragma unroll
    for (int j = 0; j < 4; ++j) r.q[j] = *(const f32x4*)(p + 4 * lane + 256 * j);
    return r; }
__device__ __forceinline__ f32x2 row_ln_v(f32x4 (&v)[4], const Vec16& g, const Vec16& bt) {
    float s = 0.f;
#pragma unroll
    for (int j = 0; j < 4; ++j) s += (v[j].x + v[j].y) + (v[j].z + v[j].w);
    const float mean = wave_sum(s) * (1.f / DM); float s2 = 0.f;
#pragma unroll
    for (int j = 0; j < 4; ++j) { v[j] = v[j] - mean; s2 += (v[j].x * v[j].x + v[j].y * v[j].y) + (v[j].z * v[j].z + v[j].w * v[j].w); }
    const float rstd = 1.f / sqrtf(wave_sum(s2) * (1.f / DM) + LN_EPS);
#pragma unroll
    for (int j = 0; j < 4; ++j) v[j] = v[j] * rstd * g.q[j] + bt.q[j];
    return (f32x2){mean, rstd};
}
template <bool H8> __device__ __forceinline__ void row_mod_store_v(const f32x4 (&v)[4], const Vec16& sh, const Vec16& sc, void* hbase, size_t r, int lane) {
#pragma unroll
    for (int j = 0; j < 4; ++j) { const f32x4 h = v[j] * (sc.q[j] + 1.0f) + sh.q[j];
        if constexpr (H8) *(unsigned*)((unsigned char*)hbase + r * DM + 4 * lane + 256 * j) = pk4_fp8(h[0] * 4.f, h[1] * 4.f, h[2] * 4.f, h[3] * 4.f);
        else { u32x2 w; w.x = cvtpk(h[0], h[1]); w.y = cvtpk(h[2], h[3]); *(u32x2*)((bf16*)hbase + r * DM + 4 * lane + 256 * j) = w; } }
}
#define ROWS_LAT(...) do { const int nwb_ = NGW / 8; if (nwb_ > 0 && gw < 8 * nwb_) { const int b = gw / nwb_, nwin_ = (SEQ + nwb_ - 1) / nwb_; \
    for (int i_ = 0; i_ < nwin_; ++i_) { const int r = b * SEQ + ((i_ + 2 * b) % nwin_) * nwb_ + gw % nwb_;     \
        if (r < (b + 1) * SEQ) { __VA_ARGS__ } } } } while (0)
#define ROWS_CTX(...) do { const int b = 8; for (int r = RL + gw; r < RT; r += NGW) { __VA_ARGS__ } } while (0)
__device__ __forceinline__ void p1_modulate(Frame& F) {
    const int gw = F.vcu * NWAVES + F.wave, NGW = F.G * NWAVES; const float* mod = WSP(float, WS_MOD); bf16* H = WSP(bf16, WS_H);
    { const int bb = gw / (NGW / 8) < 8 ? gw / (NGW / 8) : 7; const Vec16 sh = vec_load(mod + (size_t)bb * 6144, F.lane), sc = vec_load(mod + (size_t)bb * 6144 + 1024, F.lane);
      ROWS_LAT( (void)b; f32x4 v[4]; row_load(v, F.x + (size_t)r * DM, F.lane); row_mod_store_v<true>(v, sh, sc, H, (size_t)r, F.lane); ); }
    { const Vec16 sh = vec_load(mod + (size_t)8 * 6144, F.lane), sc = vec_load(mod + (size_t)8 * 6144 + 1024, F.lane);
      ROWS_CTX( (void)b; f32x4 v[4]; row_load(v, F.ctx + (size_t)(r - RL) * DM, F.lane); row_mod_store_v<true>(v, sh, sc, H, (size_t)r, F.lane); ); }
}
template <bool H8> __device__ __forceinline__ void ln_mod_pass(Frame& F, bool with_ctx, const float* g, const float* bt, int ml, int cs) {
    const int gw = F.vcu * NWAVES + F.wave, NGW = F.G * NWAVES; const float* mod = WSP(float, WS_MOD) + (size_t)ml * 9 * 6144; bf16* H = WSP(bf16, WS_H); const bf16* YB = WSP(bf16, WS_YB);
    const Vec16 gv = vec_load(g, F.lane), bv = vec_load(bt, F.lane);
    { const int bb = gw / (NGW / 8) < 8 ? gw / (NGW / 8) : 7; const Vec16 sh = vec_load(mod + (size_t)bb * 6144 + cs, F.lane), sc = vec_load(mod + (size_t)bb * 6144 + cs + 1024, F.lane);
      ROWS_LAT( (void)b; f32x4 v[4]; row_load_bf(v, YB + (size_t)r * DM, F.lane); const f32x2 sv = row_ln_v(v, gv, bv); if (F.lane == 0) ((f32x2*)(F.ws + WS_STATS))[r] = sv;
                row_mod_store_v<H8>(v, sh, sc, H, (size_t)r, F.lane); ); }
    if (with_ctx) { const Vec16 sh = vec_load(mod + (size_t)8 * 6144 + cs, F.lane), sc = vec_load(mod + (size_t)8 * 6144 + cs + 1024, F.lane);
      ROWS_CTX( (void)b; f32x4 v[4]; row_load_bf(v, YB + (size_t)r * DM, F.lane); const f32x2 sv = row_ln_v(v, gv, bv); if (F.lane == 0) ((f32x2*)(F.ws + WS_STATS))[r] = sv;
                row_mod_store_v<H8>(v, sh, sc, H, (size_t)r, F.lane); ); }
}

namespace att {
constexpr float SCALE = 0.08838834764831845f, THR = 8.f;
constexpr int SHM_V = 64 * 128 * 2, SHM_K = 64 * 128 * 2;
#define KSWZ(row, colB) ((row) * 256 + ((colB) ^ (((row) & 7) << 4)))
#define SBAR() __builtin_amdgcn_sched_barrier(0)
__device__ __forceinline__ int crow(int r, int hi) { return (r & 3) + 8 * (r >> 2) + 4 * hi; }
__device__ __forceinline__ float psm_max(const f32x16& p) {
    float a = fmaxf(fmaxf(p[0], p[1]), p[2]), b = fmaxf(fmaxf(p[3], p[4]), p[5]), c = fmaxf(fmaxf(p[6], p[7]), p[8]), d = fmaxf(fmaxf(p[9], p[10]), p[11]);
    a = fmaxf(fmaxf(a, p[12]), p[13]); b = fmaxf(fmaxf(b, p[14]), p[15]); return fmaxf(fmaxf(fmaxf(a, b), c), d);
}
__device__ __forceinline__ void psm_mask(f32x16& p0, f32x16& p1, int d0) {
#pragma unroll
    for (int r = 0; r < 16; ++r) { const int rel = d0 + (r & 3) + 8 * (r >> 2);
        p0[r] = ((unsigned)(rel + 128) <= 256u) ? p0[r] : -1e30f; p1[r] = ((unsigned)(rel + 160) <= 256u) ? p1[r] : -1e30f; }
}
__device__ __forceinline__ void partialSM(f32x16& p0, f32x16& p1, float& m_reg, float& mn, float& alpha, bool domask, int d0) {
    constexpr float C = SCALE * 1.4426950408889634f;
    if (domask) psm_mask(p0, p1, d0);
    float pmax = fmaxf(psm_max(p0), psm_max(p1));
    { auto rr = __builtin_amdgcn_permlane32_swap(__float_as_uint(pmax), __float_as_uint(pmax), false, false);
      pmax = fmaxf(__uint_as_float(rr[0]), __uint_as_float(rr[1])); }
    mn = (pmax - m_reg > THR / SCALE) ? pmax : m_reg; alpha = ex2((m_reg - mn) * C); m_reg = mn;
    const float mnC = -mn * C;
    p0 = p0 * C + mnC; p1 = p1 * C + mnC;
#pragma unroll
    for (int r = 0; r < 16; ++r) p0[r] = ex2(p0[r]);
}
__device__ __forceinline__ void finishSM(f32x16& p0, f32x16& p1, float alpha, float& l_reg, bf16x8& pa0, bf16x8& pa1, bf16x8& pa2, bf16x8& pa3) {
#pragma unroll
    for (int r = 0; r < 16; ++r) p1[r] = ex2(p1[r]);
    f32x2 s2 = (f32x2){0.f, 0.f};
#pragma unroll
    for (int r = 0; r < 16; r += 2) s2 += (f32x2){p0[r], p0[r + 1]} + (f32x2){p1[r], p1[r + 1]};
    float ps = s2.x + s2.y;
    { auto rr = __builtin_amdgcn_permlane32_swap(__float_as_uint(ps), __float_as_uint(ps), false, false);
      ps = __uint_as_float(rr[0]) + __uint_as_float(rr[1]); }
    l_reg = l_reg * alpha + ps;
#define PK4(P, BASE, OUT) do { unsigned a0 = cvtpk(P[BASE + 0], P[BASE + 1]), a1 = cvtpk(P[BASE + 2], P[BASE + 3]);   \
    unsigned b0 = cvtpk(P[BASE + 4], P[BASE + 5]), b1 = cvtpk(P[BASE + 6], P[BASE + 7]);                              \
    auto r0 = __builtin_amdgcn_permlane32_swap(a0, b0, false, false); auto r1 = __builtin_amdgcn_permlane32_swap(a1, b1, false, false); \
    u32x4 w = {r0[0], r1[0], r0[1], r1[1]}; OUT = __builtin_bit_cast(bf16x8, w); } while (0)
    PK4(p0, 0, pa0); PK4(p0, 8, pa1); PK4(p1, 0, pa2); PK4(p1, 8, pa3);
#undef PK4
}
__device__ __forceinline__ void qkt(f32x16& p0, f32x16& p1, LAS const unsigned char* Ks, const bf16x8* qr, int r32, int hi) {
    p0 = f32x16{}; p1 = f32x16{};
#pragma unroll
    for (int d0 = 0; d0 < 8; ++d0) { const int cb = (d0 * 16 + hi * 8) * 2;
        const bf16x8 b0 = *(LAS const bf16x8*)(Ks + KSWZ(r32, cb));
        const bf16x8 b1 = *(LAS const bf16x8*)(Ks + KSWZ(32 + r32, cb));
        p0 = __builtin_amdgcn_mfma_f32_32x32x16_bf16(b0, qr[d0], p0, 0, 0, 0);
        p1 = __builtin_amdgcn_mfma_f32_32x32x16_bf16(b1, qr[d0], p1, 0, 0, 0); }
}
__device__ __forceinline__ int v_st(int k, int c) { const int kk = (k & ~0xC) | ((k & 4) << 1) | ((k & 8) >> 1); return ((kk >> 3) * 4 + (c >> 5)) * 512 + ((kk & 7) * 32 + (c & 31)) * 2; }
__device__ __forceinline__ int v_rd_base(int lane) { return ((lane & 3) << 3) | (((lane >> 2) & 3) << 6) | (((lane >> 4) & 1) << 5) | (((lane >> 5) & 1) << 8); }
constexpr int v_rd_off(int d0, int ks, int half) { return d0 * 512 + ks * 4096 + half * 2048; }
template <int OFF> __device__ __forceinline__ s16x4 tr_read(int vb) {
    s16x4 r; asm volatile("ds_read_b64_tr_b16 %0, %1 offset:%2" : "=&v"(r) : "v"(vb), "i"(OFF) : "memory"); return r;
}
template <int D0> __device__ __forceinline__ void pv_one(f32x16& od, int vb, bf16x8 pa0, bf16x8 pa1, bf16x8 pa2, bf16x8 pa3) {
    const s16x4 l0 = tr_read<v_rd_off(D0, 0, 0)>(vb), h0 = tr_read<v_rd_off(D0, 0, 1)>(vb), l1 = tr_read<v_rd_off(D0, 1, 0)>(vb), h1 = tr_read<v_rd_off(D0, 1, 1)>(vb);
    const s16x4 l2 = tr_read<v_rd_off(D0, 2, 0)>(vb), h2 = tr_read<v_rd_off(D0, 2, 1)>(vb), l3 = tr_read<v_rd_off(D0, 3, 0)>(vb), h3 = tr_read<v_rd_off(D0, 3, 1)>(vb);
    asm volatile("s_waitcnt lgkmcnt(0)" ::: "memory"); SBAR();
#define PKV(L, H) (bf16x8){L[0], L[1], L[2], L[3], H[0], H[1], H[2], H[3]}
    od = __builtin_amdgcn_mfma_f32_32x32x16_bf16(pa0, PKV(l0, h0), od, 0, 0, 0);
    od = __builtin_amdgcn_mfma_f32_32x32x16_bf16(pa1, PKV(l1, h1), od, 0, 0, 0);
    od = __builtin_amdgcn_mfma_f32_32x32x16_bf16(pa2, PKV(l2, h2), od, 0, 0, 0);
    od = __builtin_amdgcn_mfma_f32_32x32x16_bf16(pa3, PKV(l3, h3), od, 0, 0, 0);
#undef PKV
}
__device__ __forceinline__ void pv_d0(f32x16* o, int vb, bf16x8 pa0, bf16x8 pa1, bf16x8 pa2, bf16x8 pa3) {
    pv_one<0>(o[0], vb, pa0, pa1, pa2, pa3); pv_one<1>(o[1], vb, pa0, pa1, pa2, pa3); pv_one<2>(o[2], vb, pa0, pa1, pa2, pa3); pv_one<3>(o[3], vb, pa0, pa1, pa2, pa3);
}
__device__ __forceinline__ void pv_partial(f32x16* o, int vb, bf16x8 pa0, bf16x8 pa1, bf16x8 pa2, bf16x8 pa3, f32x16& p0, f32x16& p1, float& m_reg, float& mn, float& alpha, bool domask, int d0) {
    constexpr float C = SCALE * 1.4426950408889634f;
#define PKV(L, H) (bf16x8){L[0], L[1], L[2], L[3], H[0], H[1], H[2], H[3]}
#define RD8(A, D0) A##0 = tr_read<v_rd_off(D0, 0, 0)>(vb); A##1 = tr_read<v_rd_off(D0, 0, 1)>(vb); A##2 = tr_read<v_rd_off(D0, 1, 0)>(vb); A##3 = tr_read<v_rd_off(D0, 1, 1)>(vb); \
    A##4 = tr_read<v_rd_off(D0, 2, 0)>(vb); A##5 = tr_read<v_rd_off(D0, 2, 1)>(vb); A##6 = tr_read<v_rd_off(D0, 3, 0)>(vb); A##7 = tr_read<v_rd_off(D0, 3, 1)>(vb)
#define MM4(OD, A) OD = __builtin_amdgcn_mfma_f32_32x32x16_bf16(pa0, PKV(A##0, A##1), OD, 0, 0, 0); OD = __builtin_amdgcn_mfma_f32_32x32x16_bf16(pa1, PKV(A##2, A##3), OD, 0, 0, 0); \
    OD = __builtin_amdgcn_mfma_f32_32x32x16_bf16(pa2, PKV(A##4, A##5), OD, 0, 0, 0); OD = __builtin_amdgcn_mfma_f32_32x32x16_bf16(pa3, PKV(A##6, A##7), OD, 0, 0, 0)
    s16x4 a0, a1, a2, a3, a4, a5, a6, a7, b0, b1, b2, b3, b4, b5, b6, b7;
    RD8(a, 0); RD8(b, 1);
    asm volatile("s_waitcnt lgkmcnt(8)" ::: "memory"); SBAR(); MM4(o[0], a);
    if (domask) psm_mask(p0, p1, d0);
    const float mx0 = psm_max(p0);
    SBAR(); RD8(a, 2);
    asm volatile("s_waitcnt lgkmcnt(8)" ::: "memory"); SBAR(); MM4(o[1], b);
    float pmax = fmaxf(mx0, psm_max(p1));
    { auto rr = __builtin_amdgcn_permlane32_swap(__float_as_uint(pmax), __float_as_uint(pmax), false, false);
      pmax = fmaxf(__uint_as_float(rr[0]), __uint_as_float(rr[1])); }
    mn = (pmax - m_reg > THR / SCALE) ? pmax : m_reg; alpha = ex2((m_reg - mn) * C); m_reg = mn;
    const float mnC = -mn * C;
    SBAR(); RD8(b, 3);
    asm volatile("s_waitcnt lgkmcnt(8)" ::: "memory"); SBAR(); MM4(o[2], a);
    p0 = p0 * C + mnC; p1 = p1 * C + mnC;
    SBAR();
    asm volatile("s_waitcnt lgkmcnt(0)" ::: "memory"); SBAR(); MM4(o[3], b);
#pragma unroll
    for (int r = 0; r < 16; ++r) p0[r] = ex2(p0[r]);
    asm volatile("" : "+v"(p0), "+v"(p1));
    SBAR();
#undef PKV
#undef RD8
#undef MM4
}
__device__ __forceinline__ void attn_unit(const bf16* __restrict__ QKV, bf16* __restrict__ O, const float* __restrict__ sink, int qrow0, int head0, int kvh, int krow_band, int nband, int krow_ctx, int dpos0, LAS unsigned char* lds, const int wid) {
    const int lane = lane_id(), r32 = lane & 31, hi = lane >> 5;
    LAS unsigned char* V_lds = lds; LAS unsigned char* K_lds = lds + 3 * SHM_V;
    LAS float* wsf = (LAS float*)(lds + 3 * SHM_V + 3 * SHM_K) + wid * 64; LAS float* li_l = wsf; LAS float* al_l = wsf + 32;
    const int head = head0 + (wid >> 2), qoff = 32 * (wid & 3);
    float m_reg = sink[head] * (1.0f / SCALE), l_reg = 1.0f; f32x16 o[4] = {}; bf16x8 qr[8];
    const bf16* Qw = QKV + (size_t)(qrow0 + qoff + r32) * QKVD + head * HDIM + hi * 8;
#pragma unroll
    for (int d0 = 0; d0 < 8; ++d0) qr[d0] = *(const bf16x8*)(Qw + d0 * 16);
    unsigned voK[2], voV[2];
#pragma unroll
    for (int i = 0; i < 2; ++i) { const int s = (i * 8 + wid) * 64 + lane;
        { const int row = s >> 4, ch = (s & 15) ^ (row & 7); voK[i] = (unsigned)(row * (QKVD * 2) + ch * 16); }
        { const int qlo = s & 3, kklo = (s >> 2) & 7, blk = s >> 5, qhi = blk & 3, kk = (blk >> 2) * 8 + kklo, k = (kk & ~0xC) | ((kk & 4) << 1) | ((kk & 8) >> 1); voV[i] = (unsigned)(k * (QKVD * 2) + (qhi * 4 + qlo) * 16); } }
    const __amdgpu_buffer_rsrc_t rs = __builtin_amdgcn_make_buffer_rsrc((void*)QKV, 0, -1, 0x00020000);
    const unsigned kcol = (unsigned)(1024 + kvh * HDIM) * 2u;
    const int vb0 = (int)(unsigned)(uintptr_t)V_lds + v_rd_base(lane);
    const int NT = nband + 4;
#define TROW(j) ((j) < nband ? krow_band + 64 * (j) : krow_ctx + 64 * ((j) - nband))
#define DMA(j, bo) do { const unsigned so_ = (unsigned)TROW(j) * (unsigned)(QKVD * 2) + kcol; _Pragma("unroll") for (int i_ = 0; i_ < 2; ++i_) { \
        __builtin_amdgcn_raw_ptr_buffer_load_lds(rs, (LAS void*)(K_lds + (bo) + (i_ * 8 + wid) * 1024), 16, voK[i_], so_, 0, 0); \
        __builtin_amdgcn_raw_ptr_buffer_load_lds(rs, (LAS void*)(V_lds + (bo) + (i_ * 8 + wid) * 1024), 16, voV[i_], so_ + 512u, 0, 0); } } while (0)
#define UBAR(n) do { asm volatile("s_waitcnt vmcnt(" #n ") lgkmcnt(0)" ::: "memory"); __builtin_amdgcn_s_barrier(); asm volatile("" ::: "memory"); } while (0)
#define RESC(a) do { if (__any((a) < 1.f)) { if (hi == 0) al_l[r32] = (a); asm volatile("s_waitcnt lgkmcnt(0)" ::: "memory"); \
    _Pragma("unroll") for (int d = 0; d < 4; ++d) _Pragma("unroll") for (int r = 0; r < 16; ++r) o[d][r] *= al_l[crow(r, hi)]; } } while (0)
    f32x16 pA0, pA1, pB0, pB1; float mnA, mnB, alA, alB; bf16x8 pa0, pa1, pa2, pa3;
    int bc = 0, bn = SHM_K, bnn = 2 * SHM_K;
    DMA(0, 0); DMA(1, SHM_K);
    UBAR(4);
    qkt(pA0, pA1, K_lds, qr, r32, hi); { const int dl = dpos0 - qoff; const bool dm = (0 < nband) && !(dl >= -97 && dl <= 65); partialSM(pA0, pA1, m_reg, mnA, alA, dm, dl - r32 + 4 * hi); }
#define STEP(Pc0, Pc1, alc, Pn0, Pn1, mnn, aln, t) do { UBAR(0); if ((t) + 2 < NT) DMA((t) + 2, bnn); \
        SBAR(); qkt(Pn0, Pn1, K_lds + bn, qr, r32, hi); finishSM(Pc0, Pc1, alc, l_reg, pa0, pa1, pa2, pa3); SBAR(); \
        { const int jj = (t) + 1; const int dl = dpos0 + 64 * jj - qoff; const bool dm = (jj < nband) && !(dl >= -97 && dl <= 65); \
          pv_partial(o, vb0 + bc, pa0, pa1, pa2, pa3, Pn0, Pn1, m_reg, mnn, aln, dm, dl - r32 + 4 * hi); } \
        RESC(aln); { const int t_ = bc; bc = bn; bn = bnn; bnn = t_; } } while (0)
    int t = 0;
    for (; t + 2 < NT - 1; t += 2) { STEP(pA0, pA1, alA, pB0, pB1, mnB, alB, t); STEP(pB0, pB1, alB, pA0, pA1, mnA, alA, t + 1); }
    STEP(pA0, pA1, alA, pB0, pB1, mnB, alB, t);
    finishSM(pB0, pB1, alB, l_reg, pa0, pa1, pa2, pa3); SBAR();
    pv_d0(o, vb0 + bc, pa0, pa1, pa2, pa3);
    if (hi == 0) li_l[r32] = l_reg; asm volatile("s_waitcnt lgkmcnt(0)" ::: "memory");
    float rli[16];
#pragma unroll
    for (int r = 0; r < 16; ++r) rli[r] = rcpf_(li_l[crow(r, hi)]);
    { LAS unsigned char* ot = lds + 3 * SHM_V + 3 * SHM_K + 4096 + wid * 4096;
#pragma unroll
      for (int r = 0; r < 16; ++r) { const int orow = crow(r, hi);
#pragma unroll
          for (int d0 = 0; d0 < 4; ++d0) { const float x = clamp8(o[d0][r] * rli[r] * 16.0f); ot[orow * 128 + d0 * 32 + r32] = (unsigned char)(__builtin_amdgcn_cvt_pk_fp8_f32(x, x, 0, false) & 0xff); } }
      asm volatile("s_waitcnt lgkmcnt(0)" ::: "memory");
      unsigned char* Ob = (unsigned char*)O + (size_t)(qrow0 + qoff) * DM + head * HDIM;
#pragma unroll
      for (int i = 0; i < 4; ++i) { const int row = (lane >> 3) + 8 * i, ch = lane & 7; *(u32x4*)(Ob + (size_t)row * DM + ch * 16) = *(LAS const u32x4*)(ot + row * 128 + ch * 16); } }
    __syncthreads();
#undef TROW
#undef DMA
#undef UBAR
#undef RESC
#undef STEP
}
constexpr int N_LAT_UNITS = NB * 32 * NKVH * 2, N_CTX_UNITS = NB * 2 * NKVH * 2, N_UNITS = N_LAT_UNITS + N_CTX_UNITS;
__device__ __forceinline__ void attn_phase(const bf16* QKV, bf16* O, const float* sink, int G, int c, LAS unsigned char* lds, const int wid) {
    for (int L = c; L < N_UNITS; L += G) {
        if (L < N_LAT_UNITS) { const int hp = L & 1, kh = (L >> 1) & 1, n = (L >> 2) & 31, b = L >> 7;
            const int nlo = n > 0 ? n - 1 : 0, nhi = n < 31 ? n + 1 : 31, nband = 2 * (nhi - nlo + 1);
            attn_unit(QKV, O, sink, b * SEQ + n * 128, kh * 4 + hp * 2, kh, b * SEQ + nlo * 128, nband, RL + b * LCTX, (nlo - n) * 128, lds, wid);
        } else { const int u = L - N_LAT_UNITS, hp = u & 1, kh = (u >> 1) & 1, qh = (u >> 2) & 1, b = u >> 3;
            attn_unit(QKV, O, sink, RL + b * LCTX + qh * 128, kh * 4 + hp * 2, kh, 0, 0, RL + b * LCTX, 0, lds, wid);
        }
    }
}
#undef KSWZ
#undef SBAR
}

__device__ __forceinline__ void p10_conv(Frame& F) {
    const int gw = F.vcu * NWAVES + F.wave, NGW = F.G * NWAVES; const bf16* XB = WSP(bf16, WS_XB); bf16* U = WSP(bf16, WS_U);
    float cw[4][16], cb[16];
#pragma unroll
    for (int j = 0; j < 4; ++j)
#pragma unroll
        for (int q = 0; q < 4; ++q) { const f32x4 w = *(const f32x4*)(F.conv_w + j * 1024 + 16 * F.lane + 4 * q); cw[j][4 * q] = w[0]; cw[j][4 * q + 1] = w[1]; cw[j][4 * q + 2] = w[2]; cw[j][4 * q + 3] = w[3]; }
#pragma unroll
    for (int q = 0; q < 4; ++q) { const f32x4 w = *(const f32x4*)(F.conv_b + 16 * F.lane + 4 * q); cb[4 * q] = w[0]; cb[4 * q + 1] = w[1]; cb[4 * q + 2] = w[2]; cb[4 * q + 3] = w[3]; }
    const int per = (RT + NGW - 1) / NGW, r0 = gw * per, r1 = (r0 + per < RT) ? r0 + per : RT;
    if (r0 >= RT) return;
    u32x4 w0[4], w1[4];
#pragma unroll
    for (int j = 0; j < 4; ++j) { int rr = r0 + j - 2; rr = rr < 0 ? 0 : (rr >= RT ? RT - 1 : rr); const u32x4* p = (const u32x4*)(XB + (size_t)rr * DM + 16 * F.lane); w0[j] = p[0]; w1[j] = p[1]; }
    for (int r = r0; r < r1; ++r) { const bool lat = r < RL; const int t = lat ? (r & (SEQ - 1)) : ((r - RL) & (LCTX - 1)); const int Ls = lat ? SEQ : LCTX;
        u32x4 n0, n1; { int rn = r + 2; rn = rn >= RT ? RT - 1 : rn; const u32x4* p = (const u32x4*)(XB + (size_t)rn * DM + 16 * F.lane); n0 = p[0]; n1 = p[1]; }
        float acc[16];
#pragma unroll
        for (int i = 0; i < 16; ++i) acc[i] = cb[i];
#pragma unroll
        for (int j = 0; j < 4; ++j) { const int tj = t + j - 2;
            if (tj >= 0 && tj < Ls) { const u32x4 x0 = w0[j], x1 = w1[j];
#pragma unroll
                for (int q = 0; q < 4; ++q) { acc[2 * q] += cw[j][2 * q] * bflo(x0[q]); acc[2 * q + 1] += cw[j][2 * q + 1] * bfhi(x0[q]); acc[8 + 2 * q] += cw[j][8 + 2 * q] * bflo(x1[q]); acc[8 + 2 * q + 1] += cw[j][8 + 2 * q + 1] * bfhi(x1[q]); } } }
        u32x4 o0, o1;
#pragma unroll
        for (int q = 0; q < 4; ++q) { o0[q] = cvtpk(acc[2 * q], acc[2 * q + 1]); o1[q] = cvtpk(acc[8 + 2 * q], acc[8 + 2 * q + 1]); }
        u32x4* op = (u32x4*)(U + (size_t)r * DM + 16 * F.lane); op[0] = o0; op[1] = o1;
        w0[0] = w0[1]; w0[1] = w0[2]; w0[2] = w0[3]; w0[3] = n0; w1[0] = w1[1]; w1[1] = w1[2]; w1[2] = w1[3]; w1[3] = n1; }
}
namespace lru {
constexpr int AIMG_BYTES = 65536;
constexpr int EX_OFF = 2 * AIMG_BYTES;
struct Ctx { const bf16* U; const bf16* G; bf16* HH; u32x4* HF; const bf16* WLG; const float *lam, *b_r, *b_i; };

__device__ __forceinline__ void issue_u(const __amdgpu_buffer_rsrc_t rs, LAS unsigned char* buf, int n, size_t row0, int wid, unsigned voff) {
#pragma unroll
    for (int ii = 0; ii < 8; ++ii) { const int i = wid + 8 * ii;
        __builtin_amdgcn_raw_ptr_buffer_load_lds(rs, (LAS void*)(buf + i * 1024), 16, voff, (unsigned)((row0 + 32 * ii) * DM * 2 + n * 256), 0, 0); }
}
__device__ __forceinline__ void chunk_geom(int DIR, int k, int b, size_t& row0, int& lc) {
    if (k == 0) { row0 = (size_t)RL + b * LCTX; lc = -1; } else { lc = DIR ? 16 - k : k - 1; row0 = (size_t)b * SEQ + 256 * lc; }
}
#define LRU_BAR() do { asm volatile("s_waitcnt lgkmcnt(0)" ::: "memory"); __builtin_amdgcn_s_barrier(); asm volatile("" ::: "memory"); } while (0)
template <int DIR>
__device__ __forceinline__ void walk(const Ctx& C, LAS unsigned char* lds, int task, const int wid) {
    const int cq = task & 3, n = (task >> 2) & 7, b = task >> 5;
    const int lane = lane_id(), tid = wid * 64 + lane, c = lane & 15, g = lane >> 4;
    const int chalf = wid & 1, tq = wid >> 1;
    const int chl = 32 * cq + 16 * chalf + c;
    const int ch = n * 128 + chl;
    bf16x8 Br[4], Bi[4];
    { const bf16* wr = C.WLG + ((size_t)(n * 4 + 2 * DIR) * 128 + chl) * 128 + 8 * g; const bf16* wi = wr + 16384;
#pragma unroll
      for (int ks = 0; ks < 4; ++ks) { Br[ks] = *(const bf16x8*)(wr + ks * 32); Bi[ks] = *(const bf16x8*)(wi + ks * 32); } }
    const float br = C.b_r[DIR * 1024 + ch], bi = C.b_i[DIR * 1024 + ch];
    const float sp8 = 8.0f * log1pf(expf(-C.lam[DIR * 1024 + ch]));
    const float kbr = -LOG2E * br, kbi = -LOG2E * bi, ka = -sp8 * LOG2E;
    float H = 0.f;
    unsigned fb[4], ub[4];
#pragma unroll
    for (int ks = 0; ks < 4; ++ks) fb[ks] = (unsigned)((64 * tq + c) * 256 + ((ks * 64 + 16 * g) ^ (c << 4)));
#pragma unroll
    for (int r = 0; r < 4; ++r) ub[r] = (unsigned)((64 * tq + 4 * g + r) * 256 + ((2 * chl) ^ ((4 * g + r) << 4)));
    const __amdgpu_buffer_rsrc_t urs = __builtin_amdgcn_make_buffer_rsrc((void*)C.U, 0, -1, 0x00020000);
    const unsigned uvoff = (unsigned)((4 * wid + (lane >> 4)) * DM * 2 + (((lane & 15) ^ ((4 * wid + (lane >> 4)) & 15)) * 16));
    { size_t r0; int lc; chunk_geom(DIR, 0, b, r0, lc); issue_u(urs, lds, n, r0, wid, uvoff); }
    for (int k = 0; k < 17; ++k) {
        size_t row0; int lc; chunk_geom(DIR, k, b, row0, lc);
        LAS unsigned char* img = lds + (k & 1) * AIMG_BYTES;
        asm volatile("s_waitcnt vmcnt(0)" ::: "memory");
        LRU_BAR();
        if (k + 1 < 17) { size_t r1; int l1; chunk_geom(DIR, k + 1, b, r1, l1); issue_u(urs, lds + ((k + 1) & 1) * AIMG_BYTES, n, r1, wid, uvoff); }
        u32x4 hf0, hf1;
        u32x4 gp0, gp1;
        if (DIR == 1 && lc >= 0) { const u32x4* hp = C.HF + ((((size_t)task * 16 + lc) * 8 + wid) * 2) * 64 + lane; hf0 = hp[0]; hf1 = hp[64];
            const size_t grow = (row0 + (tid >> 1)) * DM + n * 128 + 32 * cq + 16 * (tid & 1); gp0 = *(const u32x4*)(C.G + grow); gp1 = *(const u32x4*)(C.G + grow + 8); }
        f32x4 ar[4], ai[4];
#pragma unroll
        for (int mt = 0; mt < 4; ++mt) { ar[mt] = (f32x4){0.f, 0.f, 0.f, 0.f}; ai[mt] = (f32x4){0.f, 0.f, 0.f, 0.f};
#pragma unroll
            for (int ks = 0; ks < 4; ++ks) { const bf16x8 af = *(LAS const bf16x8*)(img + fb[ks] + mt * 4096);
                ar[mt] = __builtin_amdgcn_mfma_f32_16x16x32_bf16(af, Br[ks], ar[mt], 0, 0, 0);
                ai[mt] = __builtin_amdgcn_mfma_f32_16x16x32_bf16(af, Bi[ks], ai[mt], 0, 0, 0); } }
        float y0[4][4], P[4][4]; float TA = 1.f, TB = 0.f;
#pragma unroll
        for (int mm = 0; mm < 4; ++mm) { const int mt = DIR ? 3 - mm : mm;
            float a[4], bb[4];
#pragma unroll
            for (int r = 0; r < 4; ++r) {
                const float rg = rcpf_(1.0f + ex2(fmaf(ar[mt][r], -LOG2E, kbr))), ig = rcpf_(1.0f + ex2(fmaf(ai[mt][r], -LOG2E, kbi)));
                a[r] = ex2(rg * ka);
                const float em = fmaf(-a[r], a[r], 1.0f);
                const float uu = __uint_as_float((unsigned)*(LAS const bf16*)(img + ub[r] + mt * 4096) << 16);
                bb[r] = __builtin_amdgcn_sqrtf(em) * (ig * uu); }
            float p[4], yl[4];
            if (DIR == 0) { p[0] = a[0]; yl[0] = bb[0];
#pragma unroll
                for (int r = 1; r < 4; ++r) { p[r] = a[r] * p[r - 1]; yl[r] = a[r] * yl[r - 1] + bb[r]; } }
            else { p[3] = a[3]; yl[3] = bb[3];
#pragma unroll
                for (int r = 2; r >= 0; --r) { p[r] = a[r] * p[r + 1]; yl[r] = a[r] * yl[r + 1] + bb[r]; } }
            const float Al = DIR ? p[0] : p[3], Bl = DIR ? yl[0] : yl[3];
            const float A0 = __shfl(Al, c), A1 = __shfl(Al, 16 + c), A2 = __shfl(Al, 32 + c), A3 = __shfl(Al, 48 + c);
            const float B0 = __shfl(Bl, c), B1 = __shfl(Bl, 16 + c), B2 = __shfl(Bl, 32 + c), B3 = __shfl(Bl, 48 + c);
            float EA, EB, At, Bt;
            if (DIR == 0) { const float e1a = A0, e1b = B0, e2a = A1 * e1a, e2b = A1 * e1b + B1, e3a = A2 * e2a, e3b = A2 * e2b + B2;
                EA = g == 0 ? 1.f : (g == 1 ? e1a : (g == 2 ? e2a : e3a)); EB = g == 0 ? 0.f : (g == 1 ? e1b : (g == 2 ? e2b : e3b)); At = A3 * e3a; Bt = A3 * e3b + B3; }
            else { const float e2a = A3, e2b = B3, e1a = A2 * e2a, e1b = A2 * e2b + B2, e0a = A1 * e1a, e0b = A1 * e1b + B1;
                EA = g == 3 ? 1.f : (g == 2 ? e2a : (g == 1 ? e1a : e0a)); EB = g == 3 ? 0.f : (g == 2 ? e2b : (g == 1 ? e1b : e0b)); At = A0 * e0a; Bt = A0 * e0b + B0; }
            const float QA = EA * TA, QB = EA * TB + EB;
#pragma unroll
            for (int r = 0; r < 4; ++r) { P[mt][r] = p[r] * QA; y0[mt][r] = p[r] * QB + yl[r]; }
            TB = At * TB + Bt; TA = At * TA;
        }
        if (g == 0) *(LAS f32x2*)(lds + EX_OFF + ((tq * 2 + chalf) * 16 + c) * 8) = (f32x2){TA, TB};
        LRU_BAR();
        float Hw;
        { const f32x2 e0 = *(LAS const f32x2*)(lds + EX_OFF + ((0 * 2 + chalf) * 16 + c) * 8), e1 = *(LAS const f32x2*)(lds + EX_OFF + ((1 * 2 + chalf) * 16 + c) * 8),
                      e2 = *(LAS const f32x2*)(lds + EX_OFF + ((2 * 2 + chalf) * 16 + c) * 8), e3 = *(LAS const f32x2*)(lds + EX_OFF + ((3 * 2 + chalf) * 16 + c) * 8);
          if (DIR == 0) { const float h1 = e0.x * H + e0.y, h2 = e1.x * h1 + e1.y, h3 = e2.x * h2 + e2.y; Hw = tq == 0 ? H : (tq == 1 ? h1 : (tq == 2 ? h2 : h3)); H = e3.x * h3 + e3.y; }
          else { const float h2 = e3.x * H + e3.y, h1 = e2.x * h2 + e2.y, h0 = e1.x * h1 + e1.y; Hw = tq == 3 ? H : (tq == 2 ? h2 : (tq == 1 ? h1 : h0)); H = e0.x * h0 + e0.y; } }
        if (lc >= 0) {
#pragma unroll
            for (int mt = 0; mt < 4; ++mt)
#pragma unroll
                for (int r = 0; r < 4; ++r) y0[mt][r] += P[mt][r] * Hw;
            if (DIR == 0) {
                u32x4* hp = C.HF + ((((size_t)task * 16 + lc) * 8 + wid) * 2) * 64 + lane;
                u32x4 w0, w1; w0.x = cvtpk(y0[0][0], y0[0][1]); w0.y = cvtpk(y0[0][2], y0[0][3]); w0.z = cvtpk(y0[1][0], y0[1][1]); w0.w = cvtpk(y0[1][2], y0[1][3]);
                w1.x = cvtpk(y0[2][0], y0[2][1]); w1.y = cvtpk(y0[2][2], y0[2][3]); w1.z = cvtpk(y0[3][0], y0[3][1]); w1.w = cvtpk(y0[3][2], y0[3][3]);
                hp[0] = w0; hp[64] = w1;
            } else {
                const unsigned hw[8] = {hf0.x, hf0.y, hf0.z, hf0.w, hf1.x, hf1.y, hf1.z, hf1.w};
#pragma unroll
                for (int mt = 0; mt < 4; ++mt)
#pragma unroll
                    for (int r = 0; r < 4; ++r) { const unsigned w = hw[mt * 2 + (r >> 1)]; const float hfv = (r & 1) ? bfhi(w) : bflo(w); const float s = y0[mt][r] + hfv;
                        *(LAS bf16*)(img + (64 * tq + mt * 16 + 4 * g + r) * 64 + (16 * chalf + c) * 2) = (bf16)(cvtpk(s, 0.f) & 0xffffu); }
                LRU_BAR();
                { const int tt = tid >> 1, hh = tid & 1; const size_t grow = (row0 + tt) * DM + n * 128 + 32 * cq + 16 * hh;
                  const u32x4 s0 = *(LAS const u32x4*)(img + tt * 64 + hh * 32), s1 = *(LAS const u32x4*)(img + tt * 64 + hh * 32 + 16);
                  const u32x4 g0 = gp0, g1 = gp1;
                  u32x4 o0, o1;
#pragma unroll
                  for (int j = 0; j < 4; ++j) { o0[j] = cvtpk(bflo(s0[j]) * bflo(g0[j]), bfhi(s0[j]) * bfhi(g0[j])); o1[j] = cvtpk(bflo(s1[j]) * bflo(g1[j]), bfhi(s1[j]) * bfhi(g1[j])); }
                  *(u32x4*)(C.HH + grow) = o0; *(u32x4*)(C.HH + grow + 8) = o1; }
            }
        }
    }
    asm volatile("s_waitcnt vmcnt(0)" ::: "memory");
    LRU_BAR();
}
#undef LRU_BAR
}
__device__ __forceinline__ void p11_lru(Frame& F, const lru::Ctx& C) {
    for (int task = F.vcu; task < 256; task += F.G) { lru::walk<0>(C, F.lds, task, F.wave); lru::walk<1>(C, F.lds, task, F.wave); }
}

__device__ __forceinline__ void p13_ln_router(Frame& F) {
    LAS float* RTR = (LAS float*)F.lds;
    LAS int* lcnt = (LAS int*)(F.lds + 32768);
    for (int idx = F.tid; idx < 8192; idx += NWAVES * 64) RTR[(idx & 7) * 1024 + (idx >> 3)] = F.router[idx];
    const float* mod = WSP(float, WS_MOD) + (size_t)1 * 9 * 6144; unsigned char* H8 = WSP(unsigned char, WS_H);
    int* eidx = (int*)(F.ws + WS_ROUTE + RT_EIDX); float* wgt = (float*)(F.ws + WS_ROUTE + RT_WGT); int* cnt = (int*)(F.ws + WS_ROUTE + RT_CNT);
    const Vec16 gv = vec_load(F.ln_g + 2 * 1024, F.lane), bv = vec_load(F.ln_b + 2 * 1024, F.lane);
    for (int batch = F.vcu; batch < RL / 128; batch += F.G) {
        const float* mb0 = mod + (size_t)((batch * 128) >> 12) * 6144 + 3072; const Vec16 sh = vec_load(mb0, F.lane), sc = vec_load(mb0 + 1024, F.lane);
        if (F.tid < 8) lcnt[F.tid] = 0;
        __syncthreads();
        u32x2 nx[4]; { const bf16* yp = WSP(bf16, WS_YB) + (size_t)(batch * 128 + F.wave * 16) * DM;
#pragma unroll
            for (int j = 0; j < 4; ++j) nx[j] = *(const u32x2*)(yp + 4 * F.lane + 256 * j); }
        for (int i = 0; i < 16; ++i) { const int r = batch * 128 + F.wave * 16 + i;
            f32x4 v[4];
#pragma unroll
            for (int j = 0; j < 4; ++j) v[j] = (f32x4){bflo(nx[j].x), bfhi(nx[j].x), bflo(nx[j].y), bfhi(nx[j].y)};
            if (i + 1 < 16) { const bf16* yp = WSP(bf16, WS_YB) + (size_t)(r + 1) * DM;
#pragma unroll
                for (int j = 0; j < 4; ++j) nx[j] = *(const u32x2*)(yp + 4 * F.lane + 256 * j); }
            row_ln_v(v, gv, bv);
            float lg[8];
#pragma unroll
            for (int e = 0; e < 8; ++e) lg[e] = 0.f;
#pragma unroll
            for (int j = 0; j < 4; ++j) { const f32x4 hm = v[j] * (sc.q[j] + 1.0f) + sh.q[j];
                *(unsigned*)(H8 + (size_t)r * DM + 4 * F.lane + 256 * j) = pk4_fp8(hm[0] * 4.f, hm[1] * 4.f, hm[2] * 4.f, hm[3] * 4.f);
#pragma unroll
                for (int e = 0; e < 8; ++e) { const f32x4 rt = *(LAS const f32x4*)(RTR + e * 1024 + 4 * F.lane + 256 * j); lg[e] += (hm[0] * rt[0] + hm[1] * rt[1]) + (hm[2] * rt[2] + hm[3] * rt[3]); } }
#pragma unroll
            for (int e = 0; e < 8; ++e) lg[e] = wave_sum(lg[e]);
            int ea = 0; float la = lg[0];
#pragma unroll
            for (int e = 1; e < 8; ++e) if (lg[e] > la) { la = lg[e]; ea = e; }
            int eb = -1; float lb = -3.0e38f;
#pragma unroll
            for (int e = 0; e < 8; ++e) if (e != ea && lg[e] > lb) { lb = lg[e]; eb = e; }
            const float wa = 1.0f / (1.0f + __expf(lb - la)), wb = 1.0f - wa;
            if (F.lane == 0) { *(int2*)(eidx + 2 * r) = make_int2(ea, eb); *(float2*)(wgt + 2 * r) = make_float2(wa, wb); atomicAdd((int*)(lcnt + ea), 1); atomicAdd((int*)(lcnt + eb), 1); }
        }
        __syncthreads();
        if (F.tid < 8) cnt[batch * 8 + F.tid] = lcnt[F.tid];
        __syncthreads();
    }
}
__device__ __forceinline__ void moe_totals(Frame& F, int upto_batch, int (&tot)[8], int (&before)[8]) {
    const int* cnt = (const int*)(F.ws + WS_ROUTE + RT_CNT);
#pragma unroll
    for (int e = 0; e < 8; ++e) { tot[e] = 0; before[e] = 0; }
#pragma unroll
    for (int k = 0; k < 4; ++k) { const int bb = 4 * F.lane + k; const int4 c0 = *(const int4*)(cnt + bb * 8), c1 = *(const int4*)(cnt + bb * 8 + 4); const int m = bb < upto_batch ? 1 : 0;
        tot[0] += c0.x; tot[1] += c0.y; tot[2] += c0.z; tot[3] += c0.w; tot[4] += c1.x; tot[5] += c1.y; tot[6] += c1.z; tot[7] += c1.w;
        before[0] += m * c0.x; before[1] += m * c0.y; before[2] += m * c0.z; before[3] += m * c0.w; before[4] += m * c1.x; before[5] += m * c1.y; before[6] += m * c1.z; before[7] += m * c1.w; }
#pragma unroll
    for (int e = 0; e < 8; ++e) {
#pragma unroll
        for (int o = 1; o < 64; o <<= 1) { tot[e] += __shfl_xor(tot[e], o); before[e] += __shfl_xor(before[e], o); } }
}
__device__ __forceinline__ void p14_gather(Frame& F) {
    const int* eidx = (const int*)(F.ws + WS_ROUTE + RT_EIDX); const float* wgt = (const float*)(F.ws + WS_ROUTE + RT_WGT);
    int* slot = (int*)(F.ws + WS_ROUTE + RT_SLOT); float* wsort = (float*)(F.ws + WS_ROUTE + RT_WS);
    const unsigned char* H8 = WSP(unsigned char, WS_H); unsigned char* HS8 = WSP(unsigned char, WS_HS);
    LAS int* wcnt = (LAS int*)F.lds;
    LAS int* dsts = (LAS int*)(F.lds + 256);
    for (int batch = F.vcu; batch < RL / 128; batch += F.G) {
        int tot[8], before[8]; moe_totals(F, batch, tot, before);
        int base[8]; { int tp = 0;
#pragma unroll
            for (int e = 0; e < 8; ++e) { base[e] = tp * 256 + before[e]; tp += (tot[e] + 255) >> 8; } }
        int my_e = 0, rank_in_wave = 0;
        if (F.tid < 256) { my_e = eidx[batch * 256 + F.tid];
#pragma unroll
            for (int e = 0; e < 8; ++e) { const unsigned long long m = __ballot(my_e == e); if (my_e == e) rank_in_wave = __popcll(m & ((1ull << F.lane) - 1ull)); if (F.lane == 0) wcnt[F.wave * 8 + e] = __popcll(m); } }
        __syncthreads();
        if (F.tid < 256) { int off = 0;
#pragma unroll
            for (int w = 0; w < 4; ++w) if (w < F.wave) off += wcnt[w * 8 + my_e];
            int bs = 0;
#pragma unroll
            for (int e = 0; e < 8; ++e) bs = (my_e == e) ? base[e] : bs;
            const int d = bs + off + rank_in_wave; dsts[F.tid] = d; slot[batch * 256 + F.tid] = d; wsort[d] = wgt[batch * 256 + F.tid]; }
        __syncthreads();
        for (int i = 0; i < 32; ++i) { const int a = F.wave * 32 + i; const int d = dsts[a]; const int r = batch * 128 + (a >> 1);
            const u32x4* src = (const u32x4*)(H8 + (size_t)r * DM); u32x4* dp = (u32x4*)(HS8 + (size_t)d * DM);
            dp[F.lane] = src[F.lane]; }
        __syncthreads();
    }
}
__device__ __forceinline__ void p17_final(Frame& F) {
    const int gw = F.vcu * NWAVES + F.wave, NGW = F.G * NWAVES; const float* mod = WSP(float, WS_MOD) + (size_t)1 * 9 * 6144; const bf16* FO = WSP(bf16, WS_FO);
    const int* slot = (const int*)(F.ws + WS_ROUTE + RT_SLOT);
    const Vec16 g0 = vec_load(F.ln_g + 2 * 1024, F.lane), b0 = vec_load(F.ln_b + 2 * 1024, F.lane), g1 = vec_load(F.ln_g + 3 * 1024, F.lane), b1 = vec_load(F.ln_b + 3 * 1024, F.lane);
    const int bb = gw / (NGW / 8) < 8 ? gw / (NGW / 8) : 7; const Vec16 g2 = vec_load(mod + (size_t)bb * 6144 + 5120, F.lane);
    ROWS_LAT( (void)b; float* yp = F.out + (size_t)r * DM; const int2 s = *(const int2*)(slot + 2 * r);
        const bf16* fa = FO + (size_t)s.x * DM, * fb = FO + (size_t)s.y * DM;
        f32x4 v[4]; row_load_bf(v, WSP(bf16, WS_YB) + (size_t)r * DM, F.lane); row_ln_v(v, g0, b0);
        _Pragma("unroll") for (int j = 0; j < 4; ++j) { const u32x2 a = *(const u32x2*)(fa + 4 * F.lane + 256 * j), c = *(const u32x2*)(fb + 4 * F.lane + 256 * j);
            const f32x4 f = {bflo(a.x) + bflo(c.x), bfhi(a.x) + bfhi(c.x), bflo(a.y) + bflo(c.y), bfhi(a.y) + bfhi(c.y)};
            v[j] = v[j] * ALPHA + g2.q[j] * f; }
        row_ln_v(v, g1, b1); row_store(v, yp, F.lane); );
}

constexpr int N_PHASES = 18;
#ifndef REP_PHASE
#define REP_PHASE -1
#endif
struct Args { const float* in[25]; float* out; unsigned char* ws; int ph_lo, ph_hi; };
__global__ void __launch_bounds__(NWAVES * 64, 2) fwd_kernel(Args args) {
    extern __shared__ __attribute__((aligned(16))) unsigned char lds[];
    Frame F;
    F.lds = (LAS unsigned char*)lds;
    F.MISC = (volatile LAS unsigned*)(F.lds + MISC_OFF);
    F.wave = __builtin_amdgcn_readfirstlane((int)(threadIdx.x >> 6)); F.lane = lane_id(); F.tid = F.wave * 64 + F.lane;
    F.G = gridDim.x; { const int bx = blockIdx.x; F.vcu = (F.G % 8 == 0) ? (bx % 8) * (F.G / 8) + bx / 8 : bx; }
    F.x = args.in[0]; F.c = args.in[1]; F.ctx = args.in[2]; F.cctx = args.in[3]; F.w_mod = args.in[4]; F.b_mod = args.in[5]; F.ln_g = args.in[6]; F.ln_b = args.in[7];
    F.w_qkv = args.in[8]; F.w_o = args.in[9]; F.sink = args.in[10]; F.w_gu = args.in[11]; F.w_dn = args.in[12]; F.w_in = args.in[13]; F.conv_w = args.in[14]; F.conv_b = args.in[15];
    F.lam = args.in[16]; F.w_r = args.in[17]; F.b_r = args.in[18]; F.w_i = args.in[19]; F.b_i = args.in[20]; F.w_out = args.in[21]; F.router = args.in[22]; F.mw_gu = args.in[23]; F.mw_dn = args.in[24];
    F.out = args.out; F.ws = args.ws;
    for (int u = F.tid; u < (LDS_BYTES - LDSCTL_OFF) / 4; u += NWAVES * 64) ((LAS unsigned*)(F.lds + LDSCTL_OFF))[u] = 0u;
    __syncthreads();
    const int lo = args.ph_lo, hi = args.ph_hi;
    const bool multi = (hi - lo) > 1;
    XcdBarrier bar; bar.bar = (unsigned*)(F.ws + WS_CTL) + 1024; bar.x = 0; bar.st = nullptr;
    if (multi) bar = xcd_barrier_post((unsigned*)(F.ws + WS_CTL) + 1024, F.MISC + 8, F.wave == 0 && lane_id() == 0);
#define IN(k) (lo <= (k) && (k) < hi)
#define REFRESH() do { F.lane = lane_id(); F.tid = F.wave * 64 + F.lane; } while (0)
#define SEAM(k) do { if (IN(k) && IN((k) + 1)) xcd_barrier(bar, F.wave == 0 && lane_id() == 0); } while (0)
    const float* MOD = WSP(float, WS_MOD);
    bf16* H = WSP(bf16, WS_H); bf16* YB = WSP(bf16, WS_YB); const f32x2* ST = (const f32x2*)(F.ws + WS_STATS);

    if (IN(0)) { REFRESH(); p0_prologue(F); if (REP_PHASE == 0) { xcd_barrier(bar, F.wave == 0 && lane_id() == 0); p0_prologue(F); } } SEAM(0);
    if (IN(1)) { REFRESH(); p1_modulate(F); if (REP_PHASE == 1) { xcd_barrier(bar, F.wave == 0 && lane_id() == 0); p1_modulate(F); } } SEAM(1);
    if (IN(2)) {
        pg8::Gemm g{H, WSP(bf16, WS_WQKV), RT, QKVD, DM / 2}; pg8::StaticOrder S; S.init(RT, QKVD, F.G, (int)blockIdx.x);
        pg8::EpiQKV E{WSP(bf16, WS_QKV), WSP(float, WS_ROPE), 1.0f / 512.0f};
        pg8::gemm_phase<pg8::EpiQKV, pg8::StaticOrder, true, true, true>(F.lds + RING_OFF, g, S, E, F.wave);
        moe_convert_filler(F, (RT / 256) * (QKVD / 256), (int)blockIdx.x, 0, 6400);
    } SEAM(2);
    if (IN(3)) { att::attn_phase(WSP(bf16, WS_QKV), WSP(bf16, WS_O), F.sink, F.G, F.vcu, F.lds + RING_OFF, F.wave); if (REP_PHASE == 3) { xcd_barrier(bar, F.wave == 0 && lane_id() == 0); att::attn_phase(WSP(bf16, WS_QKV), WSP(bf16, WS_O), F.sink, F.G, F.vcu, F.lds + RING_OFF, F.wave); } } SEAM(3);
    if (IN(4)) {
        pg8::Gemm g{WSP(bf16, WS_O), WSP(bf16, WS_WO), RT, DM, DM / 2}; pg8::StaticOrder S; S.init(RT, DM, F.G, (int)blockIdx.x);
        pg8::EpiResid<false> E{F.x, F.ctx, YB, MOD + 2048, 1.0f / 2048.0f, nullptr, nullptr, nullptr};
        pg8::gemm_phase<pg8::EpiResid<false>, pg8::StaticOrder, true, true, true>(F.lds + RING_OFF, g, S, E, F.wave);
        moe_convert_filler(F, (RT / 256) * (DM / 256), (int)blockIdx.x, 6400, 17408);
    } SEAM(4);
    if (IN(5)) { REFRESH(); ln_mod_pass<true>(F, true, F.ln_g, F.ln_b, 0, 3072); } SEAM(5);
    if (IN(6)) {
        pg8::Gemm g{H, WSP(bf16, WS_WGU), RT, 2 * DFF, DM / 2}; pg8::StaticOrder S; S.init(RT, 2 * DFF, F.G, (int)blockIdx.x);
        pg8::EpiSwiGLU8 E{WSP(unsigned char, WS_ACT), 28};
        pg8::gemm_phase<pg8::EpiSwiGLU8, pg8::StaticOrder, true, true, true>(F.lds + RING_OFF, g, S, E, F.wave);
    } SEAM(6);
    if (IN(7)) {
        pg8::Gemm g{WSP(bf16, WS_ACT), WSP(bf16, WS_WDN), RT, DM, DFF / 2}; pg8::StaticOrder S; S.init(RT, DM, F.G, (int)blockIdx.x);
        pg8::EpiResid<true> E{nullptr, nullptr, YB, MOD + 5120, 1.0f / 4096.0f, ST, F.ln_g, F.ln_b};
        pg8::gemm_phase<pg8::EpiResid<true>, pg8::StaticOrder, true, true, true>(F.lds + RING_OFF, g, S, E, F.wave);
        moe_convert_filler(F, (RT / 256) * (DM / 256), (int)blockIdx.x, 17408, 37888);
    } SEAM(7);
    if (IN(8)) { REFRESH(); ln_mod_pass<false>(F, true, F.ln_g + 1024, F.ln_b + 1024, 1, 0); } SEAM(8);
    if (IN(9)) {
        pg8::Gemm g{H, WSP(bf16, WS_WIN), RT, 2048, DM}; pg8::StaticOrder S; S.init(RT, 2048, F.G, (int)blockIdx.x);
        pg8::EpiLruIn E{WSP(bf16, WS_G), WSP(bf16, WS_XB)};
        pg8::gemm_phase<pg8::EpiLruIn, pg8::StaticOrder, true, true>(F.lds + RING_OFF, g, S, E, F.wave);
        moe_convert_filler(F, (RT / 256) * (2048 / 256), (int)blockIdx.x, 37888, CV_ITEMS);
    } SEAM(9);
    {
        const lru::Ctx LC{WSP(bf16, WS_U), WSP(bf16, WS_G), WSP(bf16, WS_HH), WSP(u32x4, WS_HF), WSP(bf16, WS_WLG), F.lam, F.b_r, F.b_i};
        if (IN(10)) { REFRESH(); p10_conv(F); } SEAM(10);
        if (IN(11)) { REFRESH(); p11_lru(F, LC); if (REP_PHASE == 11) { xcd_barrier(bar, F.wave == 0 && lane_id() == 0); p11_lru(F, LC); } } SEAM(11);
    }
    if (IN(12)) {
        pg8::Gemm g{WSP(bf16, WS_HH), WSP(bf16, WS_WOUT), RL, DM, DM}; pg8::StaticOrder S; S.init(RL, DM, F.G, (int)blockIdx.x);
        pg8::EpiResid<true> E{nullptr, nullptr, YB, MOD + 9 * 6144 + 2048, 1.0f, ST, F.ln_g + 1024, F.ln_b + 1024};
        pg8::gemm_phase<pg8::EpiResid<true>, pg8::StaticOrder, true, true>(F.lds + RING_OFF, g, S, E, F.wave);
    } SEAM(12);
    if (IN(13)) { REFRESH(); p13_ln_router(F); } SEAM(13);
    if (IN(14)) { REFRESH(); p14_gather(F); if (REP_PHASE == 14) { xcd_barrier(bar, F.wave == 0 && lane_id() == 0); p14_gather(F); } } SEAM(14);
    if (IN(15) || IN(16)) {
        REFRESH();
        int tot[8], before[8]; moe_totals(F, 0, tot, before);
        int tp[9]; tp[0] = 0;
#pragma unroll
        for (int e = 0; e < 8; ++e) tp[e + 1] = __builtin_amdgcn_readfirstlane(tp[e] + ((tot[e] + 255) >> 8));
        const int ntiles = tp[8];
        if (IN(15)) {
            pg8::Gemm g{WSP(bf16, WS_HS), WSP(bf16, WS_WMGU), ntiles * 256, 2 * DFF, DM / 2};
            pg8::MoeOrder S{ntiles, 28, ntiles * 28, F.G, (int)blockIdx.x, 28, tp[1], tp[2], tp[3], tp[4], tp[5], tp[6], tp[7]};
            pg8::EpiSwiGLU8 E{WSP(unsigned char, WS_MACT), 28};
            pg8::gemm_phase<pg8::EpiSwiGLU8, pg8::MoeOrder, true, true, true>(F.lds + RING_OFF, g, S, E, F.wave);
        } SEAM(15);
        if (IN(16)) {
            pg8::Gemm g{WSP(bf16, WS_MACT), WSP(bf16, WS_WMDN), ntiles * 256, DM, DFF / 2};
            pg8::MoeOrder S{ntiles, 4, ntiles * 4, F.G, (int)blockIdx.x, 4, tp[1], tp[2], tp[3], tp[4], tp[5], tp[6], tp[7]};
            pg8::EpiMoeOut8 E{WSP(bf16, WS_FO), (const float*)(F.ws + WS_ROUTE + RT_WS)};
            pg8::gemm_phase<pg8::EpiMoeOut8, pg8::MoeOrder, true, true, true>(F.lds + RING_OFF, g, S, E, F.wave);
        } SEAM(16);
    }
    if (IN(17)) { REFRESH(); p17_final(F); }
#undef IN
#undef SEAM
}

#ifndef N_LAUNCH_MODE
#define N_LAUNCH_MODE 1
#endif
extern "C" void kernel_launch(void* const* d_in, const int* in_sizes, int n_in, void* d_out, int out_size, void* d_ws, size_t ws_size, hipStream_t stream) {
    static int grid = 0;
    if (grid == 0) {
        if (n_in != 25 || out_size != RL * DM || ws_size < WS_END) { fprintf(stderr, "kernel_launch: unexpected shapes (n_in %d out %d ws %zu)\n", n_in, out_size, ws_size); grid = -1; return; }
        int dev = 0, cus = 0, per_cu = 0;
        if (hipGetDevice(&dev) != hipSuccess || hipDeviceGetAttribute(&cus, hipDeviceAttributeMultiprocessorCount, dev) != hipSuccess) { grid = -1; return; }
        if (hipFuncSetAttribute((const void*)fwd_kernel, hipFuncAttributeMaxDynamicSharedMemorySize, LDS_BYTES) != hipSuccess) { fprintf(stderr, "kernel_launch: hipFuncSetAttribute failed\n"); grid = -1; return; }
        if (hipOccupancyMaxActiveBlocksPerMultiprocessor(&per_cu, (const void*)fwd_kernel, NWAVES * 64, LDS_BYTES) != hipSuccess || per_cu < 1) { fprintf(stderr, "kernel_launch: occupancy query says %d\n", per_cu); per_cu = 1; }
        (void)hipGetLastError();
        grid = cus;
    }
    if (grid < 0) return;
    (void)hipMemsetAsync((char*)d_ws + WS_CTL, 0, CTL_ZERO_BYTES, stream);
    Args a{};
    for (int i = 0; i < 25; ++i) a.in[i] = (const float*)d_in[i];
    a.out = (float*)d_out; a.ws = (unsigned char*)d_ws;
#if N_LAUNCH_MODE == 1
    a.ph_lo = 0; a.ph_hi = N_PHASES;
    hipLaunchKernelGGL(fwd_kernel, dim3(grid), dim3(NWAVES * 64), LDS_BYTES, stream, a);
#else
    for (int p = 0; p < N_PHASES; ++p) { a.ph_lo = p; a.ph_hi = p + 1; hipLaunchKernelGGL(fwd_kernel, dim3(grid), dim3(NWAVES * 64), LDS_BYTES, stream, a); }
#endif
    const hipError_t le = hipPeekAtLastError();
    if (le != hipSuccess) fprintf(stderr, "kernel_launch: launch failed: %s\n", hipGetErrorName(le));
}
```

```cpp
#include <hip/hip_runtime.h>
#include <cstdio>
#include <cstdint>

#define GAS __attribute__((address_space(1)))
#define LAS __attribute__((address_space(3)))
typedef unsigned short bf16;
typedef short bf16x8 __attribute__((ext_vector_type(8)));
typedef short s16x4 __attribute__((ext_vector_type(4)));
typedef float f32x4 __attribute__((ext_vector_type(4)));
typedef float f32x2 __attribute__((ext_vector_type(2)));
typedef float f32x16 __attribute__((ext_vector_type(16)));
typedef unsigned u32x4 __attribute__((ext_vector_type(4)));
typedef unsigned u32x2 __attribute__((ext_vector_type(2)));
typedef GAS unsigned gu32;

constexpr int NB = 8, SEQ = 4096, DM = 1024, LCTX = 256;
constexpr int RL = NB * SEQ;
constexpr int RC = NB * LCTX;
constexpr int RT = RL + RC;
constexpr int NHEAD = 8, NKVH = 2, HDIM = 128, QKVD = 1536;
constexpr int DFF = 3584, NEXP = 8;
constexpr float ALPHA = 1.4142135623730951f;
constexpr float LN_EPS = 1e-5f;
constexpr float LOG2E = 1.4426950408889634f;
constexpr int NWAVES = 8;

__device__ __forceinline__ unsigned cvtpk(float lo, float hi) { unsigned r; asm volatile("v_cvt_pk_bf16_f32 %0, %1, %2" : "=v"(r) : "v"(lo), "v"(hi)); return r; }
__device__ __forceinline__ float bflo(unsigned w) { return __uint_as_float(w << 16); }
__device__ __forceinline__ float bfhi(unsigned w) { return __uint_as_float(w & 0xffff0000u); }
__device__ __forceinline__ float ex2(float x) { return __builtin_amdgcn_exp2f(x); }
__device__ __forceinline__ float rcpf_(float x) { return __builtin_amdgcn_rcpf(x); }
__device__ __forceinline__ float sigm(float x) { return rcpf_(1.0f + ex2(-LOG2E * x)); }
typedef int v8i __attribute__((ext_vector_type(8)));
typedef int v4i __attribute__((ext_vector_type(4)));
__device__ __forceinline__ float clamp8(float x) { return __builtin_amdgcn_fmed3f(x, -448.f, 448.f); }
__device__ __forceinline__ unsigned pk4_fp8(float a, float b, float c, float d) {
    int p = __builtin_amdgcn_cvt_pk_fp8_f32(clamp8(a), clamp8(b), 0, false); p = __builtin_amdgcn_cvt_pk_fp8_f32(clamp8(c), clamp8(d), p, true); return (unsigned)p; }
__device__ __forceinline__ int lane_id() { int l; asm volatile("v_mbcnt_lo_u32_b32 %0, -1, 0\n\tv_mbcnt_hi_u32_b32 %0, -1, %0" : "=v"(l)); return l; }
#define REFRESH_F(F) do { (F).lane = lane_id(); (F).tid = (F).wave * 64 + (F).lane; } while (0)
__device__ __forceinline__ float dpp_add(float v, const int ctrl_sel) {
    int r;
    switch (ctrl_sel) { case 0: r = __builtin_amdgcn_update_dpp(0, __float_as_int(v), 0xB1, 0xf, 0xf, true); break;
                        case 1: r = __builtin_amdgcn_update_dpp(0, __float_as_int(v), 0x4E, 0xf, 0xf, true); break;
                        case 2: r = __builtin_amdgcn_update_dpp(0, __float_as_int(v), 0x141, 0xf, 0xf, true); break;
                        default: r = __builtin_amdgcn_update_dpp(0, __float_as_int(v), 0x140, 0xf, 0xf, true); break; }
    return v + __int_as_float(r);
}
__device__ __forceinline__ float wave_sum(float v) {
    v = dpp_add(v, 0); v = dpp_add(v, 1); v = dpp_add(v, 2); v = dpp_add(v, 3);
    const float r0 = __int_as_float(__builtin_amdgcn_readlane(__float_as_int(v), 0)), r1 = __int_as_float(__builtin_amdgcn_readlane(__float_as_int(v), 16)),
                r2 = __int_as_float(__builtin_amdgcn_readlane(__float_as_int(v), 32)), r3 = __int_as_float(__builtin_amdgcn_readlane(__float_as_int(v), 48));
    return (r0 + r1) + (r2 + r3);
}

namespace pg8 {
#define PG8_LAS __attribute__((address_space(3)))
typedef unsigned short bf16_t;
constexpr int BM = 256, BK = 64, HALF = 128, HTB = HALF * BK * 2, STAGE_BYTES = 8 * HTB, NXCD = 8, WGM = 8;
__host__ __device__ __forceinline__ int lds_byte(int r, int c) { const int st = (r >> 4) * 2 + (c >> 5), rr = r & 15, cc = c & 31, ob = rr * 64 + cc * 2; return st * 1024 + (ob ^ (((ob >> 9) & 1) << 5)); }
__host__ __device__ __forceinline__ void stage_rc(int b, int& R, int& C) { const int st = b / 1024, sb = b % 1024, swz = sb ^ (((sb >> 9) & 1) << 5); R = (st >> 1) * 16 + swz / 64; C = (st & 1) * 32 + (swz % 64) / 2; }
__host__ __device__ __forceinline__ int perm32(int rho) { const int n = rho >> 4, i = rho & 15; return 8 * (i >> 2) + 4 * n + (i & 3); }
struct Unit { int pm, pn; };
struct Gemm { const bf16_t* A; const bf16_t* Bt; int M, N, K; };
struct StaticOrder {
    int nM, nN, nwg, G, c;
    __host__ __device__ void init(int M, int N, int G_, int c_) { nM = M / BM; nN = N / BM; nwg = nM * nN; G = G_; c = c_; }
    __host__ __device__ bool next(int i, Unit& u) const {
        const long L = (long)i * G + c; if (L >= nwg) return false;
        int wgid = (int)L; { const int q = nwg / NXCD, r = nwg % NXCD, xcd = wgid % NXCD, off = wgid / NXCD; wgid = (xcd < r ? xcd * (q + 1) : r * (q + 1) + (xcd - r) * q) + off; }
        const int nig = WGM * nN, gid = wgid / nig, fm = gid * WGM, gsz = (nM - fm) < WGM ? (nM - fm) : WGM;
        u.pm = fm + ((wgid % nig) % gsz); u.pn = (wgid % nig) / gsz; return true;
    }
    __device__ __forceinline__ void a_ready(const Unit&) const {}
    __device__ __forceinline__ void done(const Unit&) const {}
};
struct MoeOrder {
    int nM, nN, nwg, G, c, npe; int t1, t2, t3, t4, t5, t6, t7;
    __device__ bool next(int i, Unit& u) const {
        const long L = (long)i * G + c; if (L >= nwg) return false;
        int wgid = (int)L; { const int q = nwg / NXCD, r = nwg % NXCD, xcd = wgid % NXCD, off = wgid / NXCD; wgid = (xcd < r ? xcd * (q + 1) : r * (q + 1) + (xcd - r) * q) + off; }
        const int nig = WGM * nN, gid = wgid / nig, fm = gid * WGM, gsz = (nM - fm) < WGM ? (nM - fm) : WGM;
        const int pm = fm + ((wgid % nig) % gsz), pnl = (wgid % nig) / gsz;
        const int e = (pm >= t1) + (pm >= t2) + (pm >= t3) + (pm >= t4) + (pm >= t5) + (pm >= t6) + (pm >= t7);
        u.pm = pm; u.pn = e * npe + pnl; return true;
    }
    __device__ __forceinline__ void a_ready(const Unit&) const {}
    __device__ __forceinline__ void done(const Unit&) const {}
};


struct EpiQKV {
    static constexpr bool PERM = true, AFTER_DRAIN = false;
    bf16_t* O; const float* rope; float ascale;
    __device__ __forceinline__ void operator()(const f32x4 (&acc)[2][2][4][2], const Unit& u, int wr, int wc, int fr, int fq) const {
        const int row0 = u.pm * BM + wr * 64 + fr;
        const bool rope_on = (u.pm < (RL / BM)) && (u.pn < 5);
        const int axis = wc & 1;
        const int colb = u.pn * 256 + (wc >> 1) * 128 + axis * 64 + 8 * fq;
#pragma unroll
        for (int ai = 0; ai < 2; ++ai)
#pragma unroll
            for (int m = 0; m < 4; ++m) {
                const int r = row0 + ai * HALF + m * 16;
                f32x4 a0 = acc[ai][0][m][0] * ascale, a1 = acc[ai][0][m][1] * ascale, b0 = acc[ai][1][m][0] * ascale, b1 = acc[ai][1][m][1] * ascale;
                if (rope_on) {
                    const int t = r & (SEQ - 1); const int pos = axis ? (t & 63) : (t >> 6);
                    const float* cp = rope + pos * 32 + 8 * fq;
                    const f32x4 c0 = *(const f32x4*)cp, c1 = *(const f32x4*)(cp + 4), s0 = *(const f32x4*)(cp + 2048), s1 = *(const f32x4*)(cp + 2052);
                    const f32x4 o0 = a0 * c0 - b0 * s0, o1 = a1 * c1 - b1 * s1, q0 = b0 * c0 + a0 * s0, q1 = b1 * c1 + a1 * s1;
                    a0 = o0; a1 = o1; b0 = q0; b1 = q1;
                }
                bf16_t* rowp = O + (size_t)r * QKVD + colb;
                u32x4 w; w.x = cvtpk(a0[0], a0[1]); w.y = cvtpk(a0[2], a0[3]); w.z = cvtpk(a1[0], a1[1]); w.w = cvtpk(a1[2], a1[3]);
                *(u32x4*)rowp = w;
                u32x4 v; v.x = cvtpk(b0[0], b0[1]); v.y = cvtpk(b0[2], b0[3]); v.z = cvtpk(b1[0], b1[1]); v.w = cvtpk(b1[2], b1[3]);
                *(u32x4*)(rowp + 32) = v;
            }
    }
};
template <bool LN> struct EpiResid {
    static constexpr bool PERM = true, AFTER_DRAIN = false;
    const float* xin_lat; const float* xin_ctx; bf16_t* y; const float* gate; float ascale; const f32x2* st; const float* lng; const float* lnb;
    __device__ __forceinline__ void operator()(const f32x4 (&acc)[2][2][4][2], const Unit& u, int wr, int wc, int fr, int fq) const {
        const bool lat = u.pm < (RL / BM);
        const int b = lat ? (u.pm >> 4) : 8;
        const int row0 = u.pm * BM + wr * 64 + fr, col0 = u.pn * BM + wc * 32 + 8 * fq;
        const float* xin = lat ? xin_lat + (size_t)row0 * DM : xin_ctx + (size_t)(row0 - RL) * DM;
        f32x2 sv[2][4];
        if constexpr (LN) {
#pragma unroll
            for (int ai = 0; ai < 2; ++ai)
#pragma unroll
                for (int m = 0; m < 4; ++m) sv[ai][m] = st[row0 + ai * HALF + m * 16];
        }
#pragma unroll
        for (int bj = 0; bj < 2; ++bj) { const int cc = col0 + bj * HALF;
            const f32x4 g0 = *(const f32x4*)(gate + (size_t)b * 6144 + cc) * ascale, g1 = *(const f32x4*)(gate + (size_t)b * 6144 + cc + 4) * ascale;
            f32x4 lg0, lg1, lb0, lb1; if constexpr (LN) { lg0 = *(const f32x4*)(lng + cc) * ALPHA; lg1 = *(const f32x4*)(lng + cc + 4) * ALPHA; lb0 = *(const f32x4*)(lnb + cc) * ALPHA; lb1 = *(const f32x4*)(lnb + cc + 4) * ALPHA; }
#pragma unroll
            for (int ai = 0; ai < 2; ++ai)
#pragma unroll
                for (int m = 0; m < 4; ++m) { const int rr = ai * HALF + m * 16; f32x4 x0, x1;
                    if constexpr (LN) { const u32x4 w = *(const u32x4*)(y + (size_t)(row0 + rr) * DM + cc);
                        x0 = (f32x4){bflo(w.x), bfhi(w.x), bflo(w.y), bfhi(w.y)}; x1 = (f32x4){bflo(w.z), bfhi(w.z), bflo(w.w), bfhi(w.w)};
                        x0 = (x0 - sv[ai][m].x) * sv[ai][m].y * lg0 + lb0; x1 = (x1 - sv[ai][m].x) * sv[ai][m].y * lg1 + lb1; }
                    else { x0 = *(const f32x4*)(xin + (size_t)rr * DM + cc) * ALPHA; x1 = *(const f32x4*)(xin + (size_t)rr * DM + cc + 4) * ALPHA; }
                    const f32x4 o0 = x0 + g0 * acc[ai][bj][m][0], o1 = x1 + g1 * acc[ai][bj][m][1];
                    u32x4 w; w.x = cvtpk(o0[0], o0[1]); w.y = cvtpk(o0[2], o0[3]); w.z = cvtpk(o1[0], o1[1]); w.w = cvtpk(o1[2], o1[3]);
                    *(u32x4*)(y + (size_t)(row0 + rr) * DM + cc) = w; }
            asm volatile("" ::: "memory"); }
    }
};
struct EpiSwiGLU {
    static constexpr bool PERM = true, AFTER_DRAIN = false;
    bf16_t* O; int npe;
    __device__ __forceinline__ void operator()(const f32x4 (&acc)[2][2][4][2], const Unit& u, int wr, int wc, int fr, int fq) const {
        const int row0 = u.pm * BM + wr * 64 + fr, pnl = u.pn % npe, col0 = pnl * 128 + wc * 32 + 8 * fq;
#pragma unroll
        for (int ai = 0; ai < 2; ++ai)
#pragma unroll
            for (int m = 0; m < 4; ++m) {
                unsigned w[4];
#pragma unroll
                for (int n = 0; n < 2; ++n) { const f32x4 g = acc[ai][0][m][n], uu = acc[ai][1][m][n]; float o[4];
#pragma unroll
                    for (int j = 0; j < 4; ++j) o[j] = g[j] * sigm(g[j]) * uu[j];
                    w[2 * n] = cvtpk(o[0], o[1]); w[2 * n + 1] = cvtpk(o[2], o[3]); }
                u32x4 ww; ww.x = w[0]; ww.y = w[1]; ww.z = w[2]; ww.w = w[3];
                *(u32x4*)(O + (size_t)(row0 + ai * HALF + m * 16) * DFF + col0) = ww;
            }
    }
};
struct EpiLruIn {
    static constexpr bool PERM = true, AFTER_DRAIN = false;
    bf16_t* G; bf16_t* XB;
    __device__ __forceinline__ void operator()(const f32x4 (&acc)[2][2][4][2], const Unit& u, int wr, int wc, int fr, int fq) const {
        const int row0 = u.pm * BM + wr * 64 + fr; const bool isg = u.pn < 4;
        bf16_t* base = isg ? G : XB; const int col0 = (u.pn & 3) * BM + wc * 32 + 8 * fq;
#pragma unroll
        for (int ai = 0; ai < 2; ++ai)
#pragma unroll
            for (int m = 0; m < 4; ++m)
#pragma unroll
                for (int bj = 0; bj < 2; ++bj) {
                    f32x4 v0 = acc[ai][bj][m][0], v1 = acc[ai][bj][m][1];
                    if (isg) {
#pragma unroll
                        for (int j = 0; j < 4; ++j) { float x = v0[j]; float z = 0.7978845608028654f * (x + 0.044715f * x * x * x); v0[j] = x * sigm(2.0f * z);
                            x = v1[j]; z = 0.7978845608028654f * (x + 0.044715f * x * x * x); v1[j] = x * sigm(2.0f * z); }
                    }
                    u32x4 w; w.x = cvtpk(v0[0], v0[1]); w.y = cvtpk(v0[2], v0[3]); w.z = cvtpk(v1[0], v1[1]); w.w = cvtpk(v1[2], v1[3]);
                    *(u32x4*)(base + (size_t)(row0 + ai * HALF + m * 16) * DM + col0 + bj * HALF) = w;
                }
    }
};
struct EpiMoeOut {
    static constexpr bool PERM = true, AFTER_DRAIN = false;
    bf16_t* O; const float* wrow;
    __device__ __forceinline__ void operator()(const f32x4 (&acc)[2][2][4][2], const Unit& u, int wr, int wc, int fr, int fq) const {
        const int row0 = u.pm * BM + wr * 64 + fr, col0 = (u.pn & 3) * BM + wc * 32 + 8 * fq;
#pragma unroll
        for (int ai = 0; ai < 2; ++ai)
#pragma unroll
            for (int m = 0; m < 4; ++m) { const int r = row0 + ai * HALF + m * 16; const float g = wrow[r];
#pragma unroll
                for (int bj = 0; bj < 2; ++bj) { const f32x4 v0 = acc[ai][bj][m][0] * g, v1 = acc[ai][bj][m][1] * g;
                    u32x4 w; w.x = cvtpk(v0[0], v0[1]); w.y = cvtpk(v0[2], v0[3]); w.z = cvtpk(v1[0], v1[1]); w.w = cvtpk(v1[2], v1[3]);
                    *(u32x4*)(O + (size_t)r * DM + col0 + bj * HALF) = w; } }
    }
};

struct EpiSwiGLU8 {
    static constexpr bool PERM = true, AFTER_DRAIN = false;
    unsigned char* O; int npe;
    __device__ __forceinline__ void operator()(const f32x4 (&acc)[2][2][4][2], const Unit& u, int wr, int wc, int fr, int fq) const {
        const int row0 = u.pm * BM + wr * 64 + fr, pnl = u.pn % npe, col0 = pnl * 128 + wc * 32 + 8 * fq;
        constexpr float C1 = -LOG2E / 512.0f, KK = 32768.0f;
#pragma unroll
        for (int ai = 0; ai < 2; ++ai)
#pragma unroll
            for (int m = 0; m < 4; ++m) {
                u32x2 w;
#pragma unroll
                for (int n = 0; n < 2; ++n) { const f32x4 g = acc[ai][0][m][n], uu = acc[ai][1][m][n];
                    const f32x2 g0 = __builtin_shufflevector(g, g, 0, 1), g1 = __builtin_shufflevector(g, g, 2, 3), u0 = __builtin_shufflevector(uu, uu, 0, 1), u1 = __builtin_shufflevector(uu, uu, 2, 3);
                    const f32x2 t0 = g0 * C1, t1 = g1 * C1;
                    const f32x2 e0 = (f32x2){ex2(t0.x), ex2(t0.y)}, e1 = (f32x2){ex2(t1.x), ex2(t1.y)};
                    const f32x2 d0 = e0 * KK + KK, d1 = e1 * KK + KK;
                    const f32x2 o0 = (g0 * u0) * (f32x2){rcpf_(d0.x), rcpf_(d0.y)}, o1 = (g1 * u1) * (f32x2){rcpf_(d1.x), rcpf_(d1.y)};
                    w[n] = pk4_fp8(o0.x, o0.y, o1.x, o1.y); }
                *(u32x2*)(O + (size_t)(row0 + ai * HALF + m * 16) * DFF + col0) = w;
            }
    }
};
struct EpiMoeOut8 {
    static constexpr bool PERM = true, AFTER_DRAIN = false;
    bf16_t* O; const float* wrow;
    __device__ __forceinline__ void operator()(const f32x4 (&acc)[2][2][4][2], const Unit& u, int wr, int wc, int fr, int fq) const {
        const int row0 = u.pm * BM + wr * 64 + fr, col0 = (u.pn & 3) * BM + wc * 32 + 8 * fq;
#pragma unroll
        for (int ai = 0; ai < 2; ++ai)
#pragma unroll
            for (int m = 0; m < 4; ++m) { const int r = row0 + ai * HALF + m * 16; const float g = wrow[r] * (1.0f / 4096.0f);
#pragma unroll
                for (int bj = 0; bj < 2; ++bj) { const f32x4 v0 = acc[ai][bj][m][0] * g, v1 = acc[ai][bj][m][1] * g;
                    u32x4 w; w.x = cvtpk(v0[0], v0[1]); w.y = cvtpk(v0[2], v0[3]); w.z = cvtpk(v1[0], v1[1]); w.w = cvtpk(v1[2], v1[3]);
                    *(u32x4*)(O + (size_t)r * DM + col0 + bj * HALF) = w; } }
    }
};

template <class Epi, class Sched, bool ALIGN_EPI = false, bool SP2 = false, bool FP8 = false>
__device__ __forceinline__ void gemm_phase(PG8_LAS unsigned char* lds, const Gemm g, const Sched& S, const Epi& E, const int wid) {
    const int lane = lane_id(), tid = wid * 64 + lane, wr = wid >> 2, wc = wid & 3, fr = lane & 15, fq = lane >> 4;
    const int K = g.K, nt = K / BK;
    unsigned voffA[2], voffB[2];
#pragma unroll
    for (int i = 0; i < 2; ++i) { int R, C; stage_rc(tid * 16 + i * 8192, R, C); const int Rb = Epi::PERM ? ((R & ~31) + perm32(R & 31)) : R;
        voffA[i] = (unsigned)(R * K + C) * 2u; voffB[i] = (unsigned)(Rb * K + C) * 2u; }
    const unsigned kstep = (unsigned)(BK * 2);
    const unsigned hstep = (unsigned)HALF * K * 2;
    const unsigned tstep = 2 * hstep;
    const __amdgpu_buffer_rsrc_t rs_voffA = __builtin_amdgcn_make_buffer_rsrc((void*)g.A, 0, -1, 0x00020000), rs_voffB = __builtin_amdgcn_make_buffer_rsrc((void*)g.Bt, 0, -1, 0x00020000);
    const unsigned ldsw = (unsigned)wid * 1024u;
    const int aoff = lds_byte(wr * 64 + fr, fq * 8), boff = lds_byte(wc * 32 + fr, fq * 8);
#define PG8_SA(b, h) (((b) * 2 + (h)) * HTB)
#define PG8_SB(b, h) ((4 + (b) * 2 + (h)) * HTB)
#define PG8_STAGE(bufoff, gbase, voff) do { _Pragma("unroll") for (int _i = 0; _i < 2; ++_i) \
        __builtin_amdgcn_raw_ptr_buffer_load_lds(rs_##voff, (PG8_LAS void*)(lds + (bufoff) + ldsw + _i * 8192), 16, (voff)[_i], (gbase), 0, 0); } while (0)
#define PG8_LDA(dst, b, h) do { if constexpr (FP8) { _Pragma("unroll") for (int m = 0; m < 4; ++m) { const v4i _l = *(const PG8_LAS v4i*)(lds + PG8_SA(b, h) + aoff + m * 2048), _h = *(const PG8_LAS v4i*)(lds + PG8_SA(b, h) + aoff + m * 2048 + 1024); \
            dst##8[m] = __builtin_shufflevector(_l, _h, 0, 1, 2, 3, 4, 5, 6, 7); } } \
        else { _Pragma("unroll") for (int m = 0; m < 4; ++m) _Pragma("unroll") for (int k = 0; k < 2; ++k) dst[m][k] = *(const PG8_LAS bf16x8*)(lds + PG8_SA(b, h) + aoff + m * 2048 + k * 1024); } } while (0)
#define PG8_LDB(dst, b, h) do { if constexpr (FP8) { _Pragma("unroll") for (int n = 0; n < 2; ++n) { const v4i _l = *(const PG8_LAS v4i*)(lds + PG8_SB(b, h) + boff + n * 2048), _h = *(const PG8_LAS v4i*)(lds + PG8_SB(b, h) + boff + n * 2048 + 1024); \
            dst##8[n] = __builtin_shufflevector(_l, _h, 0, 1, 2, 3, 4, 5, 6, 7); } } \
        else { _Pragma("unroll") for (int n = 0; n < 2; ++n) _Pragma("unroll") for (int k = 0; k < 2; ++k) dst[n][k] = *(const PG8_LAS bf16x8*)(lds + PG8_SB(b, h) + boff + n * 2048 + k * 1024); } } while (0)
#define PG8_MMA(ai, bj, At, Bt) do { if constexpr (FP8) __builtin_amdgcn_sched_barrier(0); __builtin_amdgcn_s_setprio(1); \
        if constexpr (FP8) { _Pragma("unroll") for (int m = 0; m < 4; ++m) _Pragma("unroll") for (int n = 0; n < 2; ++n) \
            acc[ai][bj][m][n] = __builtin_amdgcn_mfma_scale_f32_16x16x128_f8f6f4(Bt##8[n], At##8[m], acc[ai][bj][m][n], 0, 0, 0, 0, 0, 0); } \
        else { _Pragma("unroll") for (int m = 0; m < 4; ++m) _Pragma("unroll") for (int n = 0; n < 2; ++n) _Pragma("unroll") for (int k = 0; k < 2; ++k) \
            acc[ai][bj][m][n] = __builtin_amdgcn_mfma_f32_16x16x32_bf16(Bt[n][k], At[m][k], acc[ai][bj][m][n], 0, 0, 0); } \
        __builtin_amdgcn_s_setprio(0); if constexpr (FP8) __builtin_amdgcn_sched_barrier(0); } while (0)
#define PG8_WAIT_V(n) asm volatile("s_waitcnt vmcnt(" #n ")" ::: "memory")
#define PG8_WAIT_L(n) asm volatile("s_waitcnt lgkmcnt(" #n ")" ::: "memory")
#define PG8_BAR __builtin_amdgcn_s_barrier()
#define PG8_SCHED __builtin_amdgcn_sched_barrier(0)
    Unit cur, nxt; int ui = 0;
    if (!S.next(0, cur)) return;
    f32x4 acc[2][2][4][2];
#pragma unroll
    for (int a = 0; a < 2; ++a)
#pragma unroll
        for (int b = 0; b < 2; ++b)
#pragma unroll
            for (int m = 0; m < 4; ++m)
#pragma unroll
                for (int n = 0; n < 2; ++n) acc[a][b][m][n] = (f32x4){0.f, 0.f, 0.f, 0.f};
    bf16x8 At[4][2], B0[2][2], B1[2][2]; v8i At8[4], B08[2], B18[2];
    unsigned cA = (unsigned)cur.pm * tstep, cB = (unsigned)cur.pn * tstep;
    S.a_ready(cur);
    if constexpr (SP2) {
        PG8_STAGE(PG8_SB(0, 0), cB, voffB); PG8_STAGE(PG8_SB(0, 1), cB + hstep, voffB); PG8_STAGE(PG8_SA(0, 0), cA, voffA); PG8_STAGE(PG8_SA(0, 1), cA + hstep, voffA);
        if (wr == 1) PG8_BAR;
        PG8_WAIT_V(2); PG8_BAR;
        PG8_STAGE(PG8_SB(1, 0), cB + kstep, voffB); PG8_STAGE(PG8_SA(1, 0), cA + kstep, voffA); PG8_STAGE(PG8_SB(1, 1), cB + hstep + kstep, voffB);
        PG8_WAIT_V(6); PG8_BAR;
    } else {
        PG8_STAGE(PG8_SB(0, 0), cB, voffB); PG8_STAGE(PG8_SA(0, 0), cA, voffA); PG8_STAGE(PG8_SB(0, 1), cB + hstep, voffB); PG8_STAGE(PG8_SA(0, 1), cA + hstep, voffA);
        if (wr == 1) PG8_BAR;
        PG8_WAIT_V(4); PG8_BAR;
        PG8_STAGE(PG8_SB(1, 0), cB + kstep, voffB); PG8_STAGE(PG8_SA(1, 0), cA + kstep, voffA); PG8_STAGE(PG8_SB(1, 1), cB + hstep + kstep, voffB);
        PG8_WAIT_V(6); PG8_BAR;
    }
    for (;;) {
        const bool has_next = S.next(ui + 1, nxt);
        const unsigned nA = has_next ? (unsigned)nxt.pm * tstep : cA, nB = has_next ? (unsigned)nxt.pn * tstep : cB;
        _Pragma("clang loop unroll(disable)") for (int t = 0; t < nt; t += 2) {
            const bool last = (t == nt - 2);
            const unsigned a1 = cA + (unsigned)(t + 1) * kstep;
            const unsigned a2 = last ? nA : cA + (unsigned)(t + 2) * kstep, b2 = last ? nB : cB + (unsigned)(t + 2) * kstep;
            const unsigned a3 = a2 + kstep, b3 = b2 + kstep;
            if (last && has_next) S.a_ready(nxt);
            if constexpr (SP2) {
            PG8_LDB(B0, 0, 0); PG8_LDB(B1, 0, 1); PG8_SCHED; PG8_LDA(At, 0, 0); PG8_STAGE(PG8_SA(1, 1), a1 + hstep, voffA);
            PG8_WAIT_V(8); PG8_WAIT_L(0); PG8_BAR; PG8_MMA(0, 0, At, B0); PG8_MMA(0, 1, At, B1); PG8_BAR; PG8_SCHED;
            PG8_LDA(At, 0, 1); PG8_STAGE(PG8_SB(0, 0), b2, voffB); PG8_STAGE(PG8_SB(0, 1), b2 + hstep, voffB); PG8_STAGE(PG8_SA(0, 0), a2, voffA);
            PG8_WAIT_V(8); PG8_WAIT_L(0); PG8_BAR; PG8_MMA(1, 0, At, B0); PG8_MMA(1, 1, At, B1); PG8_BAR; PG8_SCHED;
            PG8_LDB(B0, 1, 0); PG8_LDB(B1, 1, 1); PG8_SCHED; PG8_LDA(At, 1, 0); PG8_STAGE(PG8_SA(0, 1), a2 + hstep, voffA);
            PG8_WAIT_V(8); PG8_WAIT_L(0); PG8_BAR; PG8_MMA(0, 0, At, B0); PG8_MMA(0, 1, At, B1); PG8_BAR; PG8_SCHED;
            PG8_LDA(At, 1, 1); PG8_STAGE(PG8_SB(1, 0), b3, voffB); PG8_STAGE(PG8_SB(1, 1), b3 + hstep, voffB); PG8_STAGE(PG8_SA(1, 0), a3, voffA);
            PG8_WAIT_V(8); PG8_WAIT_L(0); PG8_BAR; PG8_MMA(1, 0, At, B0); PG8_MMA(1, 1, At, B1); PG8_BAR; PG8_SCHED;
            } else {
            PG8_LDB(B0, 0, 0); PG8_SCHED; PG8_LDA(At, 0, 0); PG8_STAGE(PG8_SA(1, 1), a1 + hstep, voffA);
            PG8_WAIT_L(8); PG8_BAR; PG8_WAIT_L(0); PG8_MMA(0, 0, At, B0); PG8_BAR; PG8_SCHED;
            PG8_LDB(B1, 0, 1); PG8_STAGE(PG8_SB(0, 0), b2, voffB);
            PG8_BAR; PG8_WAIT_L(0); PG8_MMA(0, 1, At, B1); PG8_BAR;
            PG8_LDA(At, 0, 1); PG8_STAGE(PG8_SA(0, 0), a2, voffA);
            PG8_BAR; PG8_WAIT_L(0); PG8_MMA(1, 0, At, B0); PG8_BAR; PG8_SCHED;
            PG8_STAGE(PG8_SB(0, 1), b2 + hstep, voffB);
            PG8_WAIT_V(6); PG8_BAR; PG8_MMA(1, 1, At, B1); PG8_BAR;
            PG8_LDB(B0, 1, 0); PG8_SCHED; PG8_LDA(At, 1, 0); PG8_STAGE(PG8_SA(0, 1), a2 + hstep, voffA);
            PG8_WAIT_L(8); PG8_BAR; PG8_WAIT_L(0); PG8_MMA(0, 0, At, B0); PG8_BAR; PG8_SCHED;
            PG8_LDB(B1, 1, 1); PG8_STAGE(PG8_SB(1, 0), b3, voffB);
            PG8_BAR; PG8_WAIT_L(0); PG8_MMA(0, 1, At, B1); PG8_BAR;
            PG8_LDA(At, 1, 1); PG8_STAGE(PG8_SA(1, 0), a3, voffA);
            PG8_BAR; PG8_WAIT_L(0); PG8_MMA(1, 0, At, B0); PG8_BAR; PG8_SCHED;
            PG8_STAGE(PG8_SB(1, 1), b3 + hstep, voffB);
            PG8_WAIT_V(6); PG8_BAR; PG8_MMA(1, 1, At, B1); PG8_BAR;
            }
        }
        if constexpr (ALIGN_EPI) { if (wr == 0) PG8_BAR; }
        if constexpr (!Epi::AFTER_DRAIN) { int le = lane_id();
            E(acc, cur, wr, wc, le & 15, le >> 4); S.done(cur); }
        if (!has_next) break;
#pragma unroll
        for (int a = 0; a < 2; ++a)
#pragma unroll
            for (int b = 0; b < 2; ++b)
#pragma unroll
                for (int m = 0; m < 4; ++m)
#pragma unroll
                    for (int n = 0; n < 2; ++n) acc[a][b][m][n] = (f32x4){0.f, 0.f, 0.f, 0.f};
        cur = nxt; cA = nA; cB = nB; ++ui;
        if constexpr (ALIGN_EPI) { if (wr == 1) PG8_BAR; }
    }
    PG8_WAIT_V(0);
    if constexpr (!ALIGN_EPI) { if (wr == 0) PG8_BAR; }
    PG8_BAR;
    if constexpr (Epi::AFTER_DRAIN) { E.fused(acc, cur, wr, wc, fr, fq, lds, wid, lane); S.done(cur); }
#undef PG8_SA
#undef PG8_SB
#undef PG8_STAGE
#undef PG8_LDA
#undef PG8_LDB
#undef PG8_MMA
#undef PG8_WAIT_V
#undef PG8_WAIT_L
#undef PG8_BAR
#undef PG8_SCHED
}
}

constexpr size_t MiB = 1u << 20;
constexpr size_t WS_CTL = 0, CTL_ZERO_BYTES = 65536;
constexpr size_t WS_MOD = 65536;
constexpr size_t WS_ROPE = 65536 + 458752;
constexpr size_t WS_WQKV = 1 * MiB, WS_WO = 4 * MiB, WS_WGU = 6 * MiB, WS_WDN = 20 * MiB, WS_WIN = 27 * MiB, WS_WOUT = 31 * MiB, WS_WLG = 33 * MiB;
constexpr size_t WS_WMGU = 34 * MiB, WS_WMDN = 146 * MiB;
constexpr size_t WS_YB = 760 * MiB;
constexpr size_t WS_H = 210 * MiB;
constexpr size_t WS_ACTV = 278 * MiB;
constexpr size_t WS_QKV = WS_ACTV, WS_O = WS_ACTV + 102 * MiB, WS_ACT = WS_ACTV + 170 * MiB;
constexpr size_t WS_G = WS_ACTV, WS_XB = WS_ACTV + 68 * MiB, WS_HF = WS_ACTV + 136 * MiB, WS_HH = WS_ACTV + 200 * MiB;
constexpr size_t WS_U = WS_ACTV + 264 * MiB;
constexpr size_t WS_HS = WS_ACTV, WS_FO = WS_ACTV + 68 * MiB, WS_MACT = WS_ACTV + 200 * MiB;
constexpr size_t WS_ROUTE = 872 * MiB;
constexpr size_t WS_LRUS = 874 * MiB;
constexpr size_t WS_END = 875 * MiB;
constexpr int MOE_MAXT = 264;
constexpr size_t RT_EIDX = 0, RT_WGT = 262144, RT_SLOT = 524288, RT_WS = 786432, RT_CNT = 786432 + 270336 + 0;
constexpr size_t LS_SUM = 0, LS_CTX = 524288;
constexpr size_t WS_STATS = WS_LRUS + 655360;

constexpr int RING_OFF = 0, RING_BYTES = 135168;
constexpr int LDSCTL_OFF = RING_BYTES, MISC_OFF = LDSCTL_OFF + 320;
constexpr int LDS_BYTES = 136192;

#define RLX_AGENT __ATOMIC_RELAXED, __HIP_MEMORY_SCOPE_AGENT
#define LDS_WAIT() asm volatile("s_waitcnt lgkmcnt(0)" ::: "memory")
#define VM_WAIT() asm volatile("s_waitcnt vmcnt(0)" ::: "memory")
#define XB_TMO      128
#define XB_XCNT(j)  (256  + 64 * (j))
#define XB_XSUB(j)  (1280 + 64 * (j))
#define XB_XGEN(j)  (2304 + 64 * (j))
#define XB_TOP      3328
#define XB_TOPGEN   3392
#define XCD_BAR_WORDS 3456
#define XB_SPIN_CAP (1u << 18)

__device__ __forceinline__ unsigned xb_ld(unsigned* p)              { return __hip_atomic_load(p, __ATOMIC_RELAXED, __HIP_MEMORY_SCOPE_AGENT); }
__device__ __forceinline__ unsigned xb_add(unsigned* p, unsigned v) { return __hip_atomic_fetch_add(p, v, __ATOMIC_RELAXED, __HIP_MEMORY_SCOPE_AGENT); }
__device__ __forceinline__ unsigned xb_xcc_id() { return (unsigned)__builtin_amdgcn_s_getreg((3 << 11) | 20) & 0xFu; }
#define XB_SPIN(cond, bar) do { unsigned _sp = 0; while (cond) { __builtin_amdgcn_s_sleep(1); \
    if ((++_sp & 255u) == 0u) { if (xb_ld(&(bar)[XB_TMO])) break; if (_sp > XB_SPIN_CAP) { atomicAdd(&(bar)[XB_TMO], 1u); break; } } } } while (0)

struct XcdBarrier {
    unsigned* bar; unsigned x;
    volatile LAS unsigned* st;
};

__device__ __forceinline__ XcdBarrier xcd_barrier_post(unsigned* bar, volatile LAS unsigned* st, const bool t0  ) {
    XcdBarrier b; b.bar = bar; b.x = xb_xcc_id(); b.st = st;
    if (t0) (void)xb_add(&bar[XB_XCNT(b.x)], 1u);
    return b;
}
__device__ __forceinline__ void xcd_barrier_complete(unsigned* bar, unsigned x, unsigned& nloc, unsigned& nx) {
    const unsigned G = gridDim.x * gridDim.y * gridDim.z;
    unsigned sum, cnt, mine, sp = 0u;
    for (;;) {
        sum = 0u; cnt = 0u; mine = 0u;
#pragma unroll
        for (unsigned j = 0; j < 16; ++j) { const unsigned c = xb_ld(&bar[XB_XCNT(j)]); sum += c; cnt += (c > 0u) ? 1u : 0u; mine = (j == x) ? c : mine; }
        if (sum == G) break;
        __builtin_amdgcn_s_sleep(1);
        if ((++sp & 255u) == 0u) { if (xb_ld(&bar[XB_TMO])) break; if (sp > XB_SPIN_CAP) { atomicAdd(&bar[XB_TMO], 1u); break; } }
    }
    nloc = mine > 0u ? mine : 1u; nx = cnt > 0u ? cnt : 1u;
}

__device__ __forceinline__ void xcd_barrier(const XcdBarrier& b, const bool t0  ) {
    asm volatile("s_waitcnt vmcnt(0)" ::: "memory");
    __syncthreads();
    if (t0) {
        unsigned* bar = b.bar;
        __builtin_amdgcn_s_waitcnt(0);
        unsigned nloc = b.st[0], nx = b.st[1];
        if (nloc == 0u) { xcd_barrier_complete(bar, b.x, nloc, nx); b.st[0] = nloc; b.st[1] = nx; }
        const unsigned old = xb_add(&bar[XB_XSUB(b.x)], 1u);
        const unsigned gen = old / nloc;
        if (old + 1u == (gen + 1u) * nloc) {
            __builtin_amdgcn_fence(__ATOMIC_RELEASE, "agent");
            asm volatile("s_waitcnt vmcnt(0)" ::: "memory");
            const unsigned og = xb_add(&bar[XB_TOP], 1u);
            const unsigned tg = og / nx;
            if (og + 1u == (tg + 1u) * nx) xb_add(&bar[XB_TOPGEN], 1u);
            else XB_SPIN(xb_ld(&bar[XB_TOPGEN]) == tg, bar);
            __builtin_amdgcn_fence(__ATOMIC_ACQUIRE, "agent");
            xb_add(&bar[XB_XGEN(b.x)], 1u);
            asm volatile("s_waitcnt vmcnt(0)" ::: "memory");
        } else {
            XB_SPIN(xb_ld(&bar[XB_XGEN(b.x)]) == gen, bar);
            __builtin_amdgcn_fence(__ATOMIC_ACQUIRE, "agent");
            asm volatile("s_waitcnt vmcnt(0)" ::: "memory");
        }
    }
    __syncthreads();
}


struct Frame {
    LAS unsigned char* lds;
    volatile LAS unsigned* MISC;
    int tid, lane, wave, vcu, G;
    const float *x, *c, *ctx, *cctx, *w_mod, *b_mod, *ln_g, *ln_b, *w_qkv, *w_o, *sink, *w_gu, *w_dn, *w_in, *conv_w, *conv_b, *lam, *w_r, *b_r, *w_i, *b_i, *w_out, *router, *mw_gu, *mw_dn;
    float* out; unsigned char* ws;
};
#define WSP(T, off) ((T*)(F.ws + (off)))

__device__ __forceinline__ void p0_mod_task(Frame& F, int task) {
    const int li = task / 96, cb = task % 96;
    LAS float* S = (LAS float*)F.lds;
    LAS float* red = (LAS float*)(F.lds + 36864);
    for (int idx = F.tid; idx < 9 * 1024; idx += NWAVES * 64) { const int b = idx >> 10, k = idx & 1023; const float v = (b < 8) ? F.c[b * 1024 + k] : F.cctx[k]; S[idx] = v * sigm(v); }
    __syncthreads();
    const float* W = F.w_mod + (size_t)li * 1024 * 6144 + cb * 64;
    const int cl = F.lane & 15, kr = F.lane >> 4;
    f32x4 acc[9];
#pragma unroll
    for (int b = 0; b < 9; ++b) acc[b] = (f32x4){0.f, 0.f, 0.f, 0.f};
#pragma unroll 4
    for (int kk = 0; kk < 32; ++kk) { const int k = 128 * F.wave + 4 * kk + kr; const f32x4 wv = *(const f32x4*)(W + (size_t)k * 6144 + 4 * cl);
#pragma unroll
        for (int b = 0; b < 9; ++b) acc[b] += wv * S[b * 1024 + k]; }
#pragma unroll
    for (int b = 0; b < 9; ++b)
#pragma unroll
        for (int j = 0; j < 4; ++j) { float v = acc[b][j]; v += __shfl_xor(v, 16); v += __shfl_xor(v, 32); acc[b][j] = v; }
    if (kr == 0) {
#pragma unroll
        for (int b = 0; b < 9; ++b) *(LAS f32x4*)(red + (F.wave * 9 + b) * 64 + 4 * cl) = acc[b]; }
    __syncthreads();
    float* mod = WSP(float, WS_MOD);
    for (int idx = F.tid; idx < 9 * 64; idx += NWAVES * 64) { const int b = idx >> 6, col = idx & 63; float s = 0.f;
#pragma unroll
        for (int w = 0; w < 8; ++w) s += red[(w * 9 + b) * 64 + col];
        mod[(size_t)(li * 9 + b) * 6144 + cb * 64 + col] = s + F.b_mod[li * 6144 + cb * 64 + col]; }
    __syncthreads();
}
__device__ __forceinline__ void p0_transpose_item(const float* W, int K, int N, bf16* WT, int kb, int n0, int drow0, LAS float* scr, int lane) {
    const int k0 = 64 * kb;
#pragma unroll
    for (int i = 0; i < 8; ++i) { const int kk = 8 * i + (lane >> 3); const f32x4 wv = *(const f32x4*)(W + (size_t)(k0 + kk) * N + n0 + 4 * (lane & 7));
        LAS float* d = scr + kk * 33 + 4 * (lane & 7); d[0] = wv[0]; d[1] = wv[1]; d[2] = wv[2]; d[3] = wv[3]; }
    LDS_WAIT(); asm volatile("" ::: "memory");
    const int c = lane & 7;
#pragma unroll
    for (int j = 0; j < 4; ++j) { const int n = (lane >> 3) + 8 * j; const LAS float* s = scr + (8 * c) * 33 + n;
        u32x4 o; o.x = cvtpk(s[0 * 33], s[1 * 33]); o.y = cvtpk(s[2 * 33], s[3 * 33]); o.z = cvtpk(s[4 * 33], s[5 * 33]); o.w = cvtpk(s[6 * 33], s[7 * 33]);
        *(GAS u32x4*)(WT + (size_t)(drow0 + n) * K + k0 + 8 * c) = o; }
    LDS_WAIT(); asm volatile("" ::: "memory");
}
template <int QS> __device__ __forceinline__ void p0_transpose_item8(const float* W, int K, int N, unsigned char* WT, int kb, int n0, int drow0, LAS float* scr, int lane) {
    const int k0 = 64 * kb; constexpr float qs = (float)(1 << QS);
#pragma unroll
    for (int i = 0; i < 8; ++i) { const int kk = 8 * i + (lane >> 3); const f32x4 wv = *(const f32x4*)(W + (size_t)(k0 + kk) * N + n0 + 4 * (lane & 7)) * qs;
        LAS float* d = scr + kk * 33 + 4 * (lane & 7); d[0] = wv[0]; d[1] = wv[1]; d[2] = wv[2]; d[3] = wv[3]; }
    LDS_WAIT(); asm volatile("" ::: "memory");
    const int c = lane & 7;
#pragma unroll
    for (int j = 0; j < 4; ++j) { const int n = (lane >> 3) + 8 * j; const LAS float* s = scr + (8 * c) * 33 + n;
        u32x2 o; o.x = pk4_fp8(s[0 * 33], s[1 * 33], s[2 * 33], s[3 * 33]); o.y = pk4_fp8(s[4 * 33], s[5 * 33], s[6 * 33], s[7 * 33]);
        *(GAS u32x2*)(WT + (size_t)(drow0 + n) * K + k0 + 8 * c) = o; }
    LDS_WAIT(); asm volatile("" ::: "memory");
}
__device__ __forceinline__ int gu_row(int j) { const int isu = j >= DFF, jj = isu ? j - DFF : j; return (jj >> 7) * 256 + isu * 128 + (jj & 127); }
__device__ __forceinline__ int qkv_row(int L) { const int pn = L >> 8, rem = L & 255, hsel = rem >> 7, axis = (rem >> 6) & 1, half = (rem >> 5) & 1, x = rem & 31; return pn * 256 + 128 * half + 32 * (2 * hsel + axis) + x; }

__device__ __forceinline__ void p0_prologue(Frame& F) {
    for (int task = F.vcu; task < 192; task += F.G) p0_mod_task(F, task);
    if (F.vcu == F.G - 1) {
        float* rope = WSP(float, WS_ROPE);
        for (int idx = F.tid; idx < 2048; idx += NWAVES * 64) { const int pos = idx >> 5, i = idx & 31;
            const double freq = exp2(-(double)i * (13.287712379549449 / 32.0));
            const float ang = (float)pos * (float)freq;
            double rev = (double)ang * 0.15915494309189535; rev -= floor(rev);
            rope[idx] = __builtin_amdgcn_cosf((float)rev); rope[2048 + idx] = __builtin_amdgcn_sinf((float)rev); }
    }
    LAS float* scr = (LAS float*)(F.lds + F.wave * 8704);
    const int gw = F.vcu * NWAVES + F.wave, NGW = F.G * NWAVES;
    constexpr int I_QKV = 16 * 48;
    for (int r = gw; r < I_QKV; r += NGW) { const int kb = r / 48, n0 = (r % 48) * 32; p0_transpose_item8<7>(F.w_qkv, 1024, 1536, WSP(unsigned char, WS_WQKV), kb, n0, qkv_row(n0), scr, F.lane); }
}

constexpr int MOE_I_GU = 16 * 224, MOE_I_DN = 56 * 32, MOE_ITEMS = 8 * (MOE_I_GU + MOE_I_DN);
constexpr int DR_O = 16 * 32, DR_GU = 16 * 224, DR_DN = 56 * 32, DR_IN = 16 * 64, DR_OUT = 16 * 32, DR_LG = 32 * 8, DR_ITEMS = DR_O + DR_GU + DR_DN + DR_IN + DR_OUT + DR_LG;
constexpr int CV_ITEMS = DR_ITEMS + MOE_ITEMS;
__device__ __forceinline__ void moe_convert_items(Frame& F, int lo, int hi, int rank, int nranks) {
    LAS float* scr = (LAS float*)(F.lds + F.wave * 8704);
    for (int it0 = lo + rank * NWAVES + F.wave; it0 < hi; it0 += nranks * NWAVES) {
        int r = it0;
        if (r < DR_O) { const int kb = r / 32, n0 = (r % 32) * 32; p0_transpose_item8<7>(F.w_o, 1024, 1024, WSP(unsigned char, WS_WO), kb, n0, n0, scr, F.lane); continue; } r -= DR_O;
        if (r < DR_GU) { const int kb = r / 224, n0 = (r % 224) * 32; p0_transpose_item8<7>(F.w_gu, 1024, 7168, WSP(unsigned char, WS_WGU), kb, n0, gu_row(n0), scr, F.lane); continue; } r -= DR_GU;
        if (r < DR_DN) { const int kb = r / 32, n0 = (r % 32) * 32; p0_transpose_item8<9>(F.w_dn, 3584, 1024, WSP(unsigned char, WS_WDN), kb, n0, n0, scr, F.lane); continue; } r -= DR_DN;
        if (r < DR_IN) { const int kb = r / 64, n0 = (r % 64) * 32; p0_transpose_item(F.w_in, 1024, 2048, WSP(bf16, WS_WIN), kb, n0, n0, scr, F.lane); continue; } r -= DR_IN;
        if (r < DR_OUT) { const int kb = r / 32, n0 = (r % 32) * 32; p0_transpose_item(F.w_out, 1024, 1024, WSP(bf16, WS_WOUT), kb, n0, n0, scr, F.lane); continue; } r -= DR_OUT;
        if (r < DR_LG) { const int mi = r >> 3, sub = r & 7, which = mi >> 4, d = (mi >> 3) & 1, n = mi & 7, kb = sub >> 2, n0 = (sub & 3) * 32;
            p0_transpose_item((which ? F.w_i : F.w_r) + (size_t)(d * 8 + n) * 16384, 128, 128, WSP(bf16, WS_WLG) + (size_t)(n * 4 + 2 * d + which) * 16384, kb, n0, n0, scr, F.lane); continue; } r -= DR_LG;
        if (r < 8 * MOE_I_GU) { const int e = r / MOE_I_GU, q = r % MOE_I_GU, kb = q / 224, n0 = (q % 224) * 32;
            p0_transpose_item8<7>(F.mw_gu + (size_t)e * 1024 * 7168, 1024, 7168, WSP(unsigned char, WS_WMGU) + (size_t)e * 7168 * 1024, kb, n0, gu_row(n0), scr, F.lane); }
        else { r -= 8 * MOE_I_GU; const int e = r / MOE_I_DN, q = r % MOE_I_DN, kb = q / 32, n0 = (q % 32) * 32;
            p0_transpose_item8<9>(F.mw_dn + (size_t)e * 3584 * 1024, 3584, 1024, WSP(unsigned char, WS_WMDN) + (size_t)e * 1024 * 3584, kb, n0, n0, scr, F.lane); }
    }
}
__device__ __forceinline__ void moe_convert_filler(Frame& F, int nwg, int c, int lo, int hi) {
    const int R = (nwg + F.G - 1) / F.G, rem = nwg - (R - 1) * F.G;
    if (rem >= F.G) { moe_convert_items(F, lo, hi, c, F.G); return; }
    if (c >= rem) { REFRESH_F(F); moe_convert_items(F, lo, hi, c - rem, F.G - rem); }
}
__device__ __forceinline__ void row_load(f32x4 (&v)[4], const float* p, int lane) {
#pragma unroll
    for (int j = 0; j < 4; ++j) v[j] = *(const f32x4*)(p + 4 * lane + 256 * j);
}
__device__ __forceinline__ void row_load_bf(f32x4 (&v)[4], const bf16* p, int lane) {
#pragma unroll
    for (int j = 0; j < 4; ++j) { const u32x2 w = *(const u32x2*)(p + 4 * lane + 256 * j); v[j] = (f32x4){bflo(w.x), bfhi(w.x), bflo(w.y), bfhi(w.y)}; }
}
__device__ __forceinline__ void row_store(const f32x4 (&v)[4], float* p, int lane) {
#pragma unroll
    for (int j = 0; j < 4; ++j) *(f32x4*)(p + 4 * lane + 256 * j) = v[j];
}
struct Vec16 { f32x4 q[4]; };
__device__ __forceinline__ Vec16 vec_load(const float* p, int lane) { Vec16 r;
#pragma unroll
    for (int j = 0; j < 4; ++j) r.q[j] = *(const f32x4*)(p + 4 * lane + 256 * j);
    return r; }
__device__ __forceinline__ f32x2 row_ln_v(f32x4 (&v)[4], const Vec16& g, const Vec16& bt) {
    float s = 0.f;
#pragma unroll
    for (int j = 0; j < 4; ++j) s += (v[j].x + v[j].y) + (v[j].z + v[j].w);
    const float mean = wave_sum(s) * (1.f / DM); float s2 = 0.f;
#pragma unroll
    for (int j = 0; j < 4; ++j) { v[j] = v[j] - mean; s2 += (v[j].x * v[j].x + v[j].y * v[j].y) + (v[j].z * v[j].z + v[j].w * v[j].w); }
    const float rstd = 1.f / sqrtf(wave_sum(s2) * (1.f / DM) + LN_EPS);
#pragma unroll
    for (int j = 0; j < 4; ++j) v[j] = v[j] * rstd * g.q[j] + bt.q[j];
    return (f32x2){mean, rstd};
}
template <bool H8> __device__ __forceinline__ void row_mod_store_v(const f32x4 (&v)[4], const Vec16& sh, const Vec16& sc, void* hbase, size_t r, int lane) {
#pragma unroll
    for (int j = 0; j < 4; ++j) { const f32x4 h = v[j] * (sc.q[j] + 1.0f) + sh.q[j];
        if constexpr (H8) *(unsigned*)((unsigned char*)hbase + r * DM + 4 * lane + 256 * j) = pk4_fp8(h[0] * 4.f, h[1] * 4.f, h[2] * 4.f, h[3] * 4.f);
        else { u32x2 w; w.x = cvtpk(h[0], h[1]); w.y = cvtpk(h[2], h[3]); *(u32x2*)((bf16*)hbase + r * DM + 4 * lane + 256 * j) = w; } }
}
#define ROWS_LAT(...) do { const int nwb_ = NGW / 8; if (nwb_ > 0 && gw < 8 * nwb_) { const int b = gw / nwb_, nwin_ = (SEQ + nwb_ - 1) / nwb_; \
    for (int i_ = 0; i_ < nwin_; ++i_) { const int r = b * SEQ + ((i_ + 2 * b) % nwin_) * nwb_ + gw % nwb_;     \
        if (r < (b + 1) * SEQ) { __VA_ARGS__ } } } } while (0)
#define ROWS_CTX(...) do { const int b = 8; for (int r = RL + gw; r < RT; r += NGW) { __VA_ARGS__ } } while (0)
__device__ __forceinline__ void p1_modulate(Frame& F) {
    const int gw = F.vcu * NWAVES + F.wave, NGW = F.G * NWAVES; const float* mod = WSP(float, WS_MOD); bf16* H = WSP(bf16, WS_H);
    { const int bb = gw / (NGW / 8) < 8 ? gw / (NGW / 8) : 7; const Vec16 sh = vec_load(mod + (size_t)bb * 6144, F.lane), sc = vec_load(mod + (size_t)bb * 6144 + 1024, F.lane);
      ROWS_LAT( (void)b; f32x4 v[4]; row_load(v, F.x + (size_t)r * DM, F.lane); row_mod_store_v<true>(v, sh, sc, H, (size_t)r, F.lane); ); }
    { const Vec16 sh = vec_load(mod + (size_t)8 * 6144, F.lane), sc = vec_load(mod + (size_t)8 * 6144 + 1024, F.lane);
      ROWS_CTX( (void)b; f32x4 v[4]; row_load(v, F.ctx + (size_t)(r - RL) * DM, F.lane); row_mod_store_v<true>(v, sh, sc, H, (size_t)r, F.lane); ); }
}
template <bool H8> __device__ __forceinline__ void ln_mod_pass(Frame& F, bool with_ctx, const float* g, const float* bt, int ml, int cs) {
    const int gw = F.vcu * NWAVES + F.wave, NGW = F.G * NWAVES; const float* mod = WSP(float, WS_MOD) + (size_t)ml * 9 * 6144; bf16* H = WSP(bf16, WS_H); const bf16* YB = WSP(bf16, WS_YB);
    const Vec16 gv = vec_load(g, F.lane), bv = vec_load(bt, F.lane);
    { const int bb = gw / (NGW / 8) < 8 ? gw / (NGW / 8) : 7; const Vec16 sh = vec_load(mod + (size_t)bb * 6144 + cs, F.lane), sc = vec_load(mod + (size_t)bb * 6144 + cs + 1024, F.lane);
      ROWS_LAT( (void)b; f32x4 v[4]; row_load_bf(v, YB + (size_t)r * DM, F.lane); const f32x2 sv = row_ln_v(v, gv, bv); if (F.lane == 0) ((f32x2*)(F.ws + WS_STATS))[r] = sv;
                row_mod_store_v<H8>(v, sh, sc, H, (size_t)r, F.lane); ); }
    if (with_ctx) { const Vec16 sh = vec_load(mod + (size_t)8 * 6144 + cs, F.lane), sc = vec_load(mod + (size_t)8 * 6144 + cs + 1024, F.lane);
      ROWS_CTX( (void)b; f32x4 v[4]; row_load_bf(v, YB + (size_t)r * DM, F.lane); const f32x2 sv = row_ln_v(v, gv, bv); if (F.lane == 0) ((f32x2*)(F.ws + WS_STATS))[r] = sv;
                row_mod_store_v<H8>(v, sh, sc, H, (size_t)r, F.lane); ); }
}

namespace att {
constexpr float SCALE = 0.08838834764831845f, THR = 8.f;
constexpr int SHM_V = 64 * 128 * 2, SHM_K = 64 * 128 * 2;
#define KSWZ(row, colB) ((row) * 256 + ((colB) ^ (((row) & 7) << 4)))
#define SBAR() __builtin_amdgcn_sched_barrier(0)
__device__ __forceinline__ int crow(int r, int hi) { return (r & 3) + 8 * (r >> 2) + 4 * hi; }
__device__ __forceinline__ float psm_max(const f32x16& p) {
    float a = fmaxf(fmaxf(p[0], p[1]), p[2]), b = fmaxf(fmaxf(p[3], p[4]), p[5]), c = fmaxf(fmaxf(p[6], p[7]), p[8]), d = fmaxf(fmaxf(p[9], p[10]), p[11]);
    a = fmaxf(fmaxf(a, p[12]), p[13]); b = fmaxf(fmaxf(b, p[14]), p[15]); return fmaxf(fmaxf(fmaxf(a, b), c), d);
}
__device__ __forceinline__ void psm_mask(f32x16& p0, f32x16& p1, int d0) {
#pragma unroll
    for (int r = 0; r < 16; ++r) { const int rel = d0 + (r & 3) + 8 * (r >> 2);
        p0[r] = ((unsigned)(rel + 128) <= 256u) ? p0[r] : -1e30f; p1[r] = ((unsigned)(rel + 160) <= 256u) ? p1[r] : -1e30f; }
}
__device__ __forceinline__ void partialSM(f32x16& p0, f32x16& p1, float& m_reg, float& mn, float& alpha, bool domask, int d0) {
    constexpr float C = SCALE * 1.4426950408889634f;
    if (domask) psm_mask(p0, p1, d0);
    float pmax = fmaxf(psm_max(p0), psm_max(p1));
    { auto rr = __builtin_amdgcn_permlane32_swap(__float_as_uint(pmax), __float_as_uint(pmax), false, false);
      pmax = fmaxf(__uint_as_float(rr[0]), __uint_as_float(rr[1])); }
    mn = (pmax - m_reg > THR / SCALE) ? pmax : m_reg; alpha = ex2((m_reg - mn) * C); m_reg = mn;
    const float mnC = -mn * C;
    p0 = p0 * C + mnC; p1 = p1 * C + mnC;
#pragma unroll
    for (int r = 0; r < 16; ++r) p0[r] = ex2(p0[r]);
}
__device__ __forceinline__ void finishSM(f32x16& p0, f32x16& p1, float alpha, float& l_reg, bf16x8& pa0, bf16x8& pa1, bf16x8& pa2, bf16x8& pa3) {
#pragma unroll
    for (int r = 0; r < 16; ++r) p1[r] = ex2(p1[r]);
    f32x2 s2 = (f32x2){0.f, 0.f};
#pragma unroll
    for (int r = 0; r < 16; r += 2) s2 += (f32x2){p0[r], p0[r + 1]} + (f32x2){p1[r], p1[r + 1]};
    float ps = s2.x + s2.y;
    { auto rr = __builtin_amdgcn_permlane32_swap(__float_as_uint(ps), __float_as_uint(ps), false, false);
      ps = __uint_as_float(rr[0]) + __uint_as_float(rr[1]); }
    l_reg = l_reg * alpha + ps;
#define PK4(P, BASE, OUT) do { unsigned a0 = cvtpk(P[BASE + 0], P[BASE + 1]), a1 = cvtpk(P[BASE + 2], P[BASE + 3]);   \
    unsigned b0 = cvtpk(P[BASE + 4], P[BASE + 5]), b1 = cvtpk(P[BASE + 6], P[BASE + 7]);                              \
    auto r0 = __builtin_amdgcn_permlane32_swap(a0, b0, false, false); auto r1 = __builtin_amdgcn_permlane32_swap(a1, b1, false, false); \
    u32x4 w = {r0[0], r1[0], r0[1], r1[1]}; OUT = __builtin_bit_cast(bf16x8, w); } while (0)
    PK4(p0, 0, pa0); PK4(p0, 8, pa1); PK4(p1, 0, pa2); PK4(p1, 8, pa3);
#undef PK4
}
__device__ __forceinline__ void qkt(f32x16& p0, f32x16& p1, LAS const unsigned char* Ks, const bf16x8* qr, int r32, int hi) {
    p0 = f32x16{}; p1 = f32x16{};
#pragma unroll
    for (int d0 = 0; d0 < 8; ++d0) { const int cb = (d0 * 16 + hi * 8) * 2;
        const bf16x8 b0 = *(LAS const bf16x8*)(Ks + KSWZ(r32, cb));
        const bf16x8 b1 = *(LAS const bf16x8*)(Ks + KSWZ(32 + r32, cb));
        p0 = __builtin_amdgcn_mfma_f32_32x32x16_bf16(b0, qr[d0], p0, 0, 0, 0);
        p1 = __builtin_amdgcn_mfma_f32_32x32x16_bf16(b1, qr[d0], p1, 0, 0, 0); }
}
__device__ __forceinline__ int v_st(int k, int c) { const int kk = (k & ~0xC) | ((k & 4) << 1) | ((k & 8) >> 1); return ((kk >> 3) * 4 + (c >> 5)) * 512 + ((kk & 7) * 32 + (c & 31)) * 2; }
__device__ __forceinline__ int v_rd_base(int lane) { return ((lane & 3) << 3) | (((lane >> 2) & 3) << 6) | (((lane >> 4) & 1) << 5) | (((lane >> 5) & 1) << 8); }
constexpr int v_rd_off(int d0, int ks, int half) { return d0 * 512 + ks * 4096 + half * 2048; }
template <int OFF> __device__ __forceinline__ s16x4 tr_read(int vb) {
    s16x4 r; asm volatile("ds_read_b64_tr_b16 %0, %1 offset:%2" : "=&v"(r) : "v"(vb), "i"(OFF) : "memory"); return r;
}
template <int D0> __device__ __forceinline__ void pv_one(f32x16& od, int vb, bf16x8 pa0, bf16x8 pa1, bf16x8 pa2, bf16x8 pa3) {
    const s16x4 l0 = tr_read<v_rd_off(D0, 0, 0)>(vb), h0 = tr_read<v_rd_off(D0, 0, 1)>(vb), l1 = tr_read<v_rd_off(D0, 1, 0)>(vb), h1 = tr_read<v_rd_off(D0, 1, 1)>(vb);
    const s16x4 l2 = tr_read<v_rd_off(D0, 2, 0)>(vb), h2 = tr_read<v_rd_off(D0, 2, 1)>(vb), l3 = tr_read<v_rd_off(D0, 3, 0)>(vb), h3 = tr_read<v_rd_off(D0, 3, 1)>(vb);
    asm volatile("s_waitcnt lgkmcnt(0)" ::: "memory"); SBAR();
#define PKV(L, H) (bf16x8){L[0], L[1], L[2], L[3], H[0], H[1], H[2], H[3]}
    od = __builtin_amdgcn_mfma_f32_32x32x16_bf16(pa0, PKV(l0, h0), od, 0, 0, 0);
    od = __builtin_amdgcn_mfma_f32_32x32x16_bf16(pa1, PKV(l1, h1), od, 0, 0, 0);
    od = __builtin_amdgcn_mfma_f32_32x32x16_bf16(pa2, PKV(l2, h2), od, 0, 0, 0);
    od = __builtin_amdgcn_mfma_f32_32x32x16_bf16(pa3, PKV(l3, h3), od, 0, 0, 0);
#undef PKV
}
__device__ __forceinline__ void pv_d0(f32x16* o, int vb, bf16x8 pa0, bf16x8 pa1, bf16x8 pa2, bf16x8 pa3) {
    pv_one<0>(o[0], vb, pa0, pa1, pa2, pa3); pv_one<1>(o[1], vb, pa0, pa1, pa2, pa3); pv_one<2>(o[2], vb, pa0, pa1, pa2, pa3); pv_one<3>(o[3], vb, pa0, pa1, pa2, pa3);
}
__device__ __forceinline__ void pv_partial(f32x16* o, int vb, bf16x8 pa0, bf16x8 pa1, bf16x8 pa2, bf16x8 pa3, f32x16& p0, f32x16& p1, float& m_reg, float& mn, float& alpha, bool domask, int d0) {
    constexpr float C = SCALE * 1.4426950408889634f;
#define PKV(L, H) (bf16x8){L[0], L[1], L[2], L[3], H[0], H[1], H[2], H[3]}
#define RD8(A, D0) A##0 = tr_read<v_rd_off(D0, 0, 0)>(vb); A##1 = tr_read<v_rd_off(D0, 0, 1)>(vb); A##2 = tr_read<v_rd_off(D0, 1, 0)>(vb); A##3 = tr_read<v_rd_off(D0, 1, 1)>(vb); \
    A##4 = tr_read<v_rd_off(D0, 2, 0)>(vb); A##5 = tr_read<v_rd_off(D0, 2, 1)>(vb); A##6 = tr_read<v_rd_off(D0, 3, 0)>(vb); A##7 = tr_read<v_rd_off(D0, 3, 1)>(vb)
#define MM4(OD, A) OD = __builtin_amdgcn_mfma_f32_32x32x16_bf16(pa0, PKV(A##0, A##1), OD, 0, 0, 0); OD = __builtin_amdgcn_mfma_f32_32x32x16_bf16(pa1, PKV(A##2, A##3), OD, 0, 0, 0); \
    OD = __builtin_amdgcn_mfma_f32_32x32x16_bf16(pa2, PKV(A##4, A##5), OD, 0, 0, 0); OD = __builtin_amdgcn_mfma_f32_32x32x16_bf16(pa3, PKV(A##6, A##7), OD, 0, 0, 0)
    s16x4 a0, a1, a2, a3, a4, a5, a6, a7, b0, b1, b2, b3, b4, b5, b6, b7;
    RD8(a, 0); RD8(b, 1);
    asm volatile("s_waitcnt lgkmcnt(8)" ::: "memory"); SBAR(); MM4(o[0], a);
    if (domask) psm_mask(p0, p1, d0);
    const float mx0 = psm_max(p0);
    SBAR(); RD8(a, 2);
    asm volatile("s_waitcnt lgkmcnt(8)" ::: "memory"); SBAR(); MM4(o[1], b);
    float pmax = fmaxf(mx0, psm_max(p1));
    { auto rr = __builtin_amdgcn_permlane32_swap(__float_as_uint(pmax), __float_as_uint(pmax), false, false);
      pmax = fmaxf(__uint_as_float(rr[0]), __uint_as_float(rr[1])); }
    mn = (pmax - m_reg > THR / SCALE) ? pmax : m_reg; alpha = ex2((m_reg - mn) * C); m_reg = mn;
    const float mnC = -mn * C;
    SBAR(); RD8(b, 3);
    asm volatile("s_waitcnt lgkmcnt(8)" ::: "memory"); SBAR(); MM4(o[2], a);
    p0 = p0 * C + mnC; p1 = p1 * C + mnC;
    SBAR();
    asm volatile("s_waitcnt lgkmcnt(0)" ::: "memory"); SBAR(); MM4(o[3], b);
#pragma unroll
    for (int r = 0; r < 16; ++r) p0[r] = ex2(p0[r]);
    asm volatile("" : "+v"(p0), "+v"(p1));
    SBAR();
#undef PKV
#undef RD8
#undef MM4
}
__device__ __forceinline__ void attn_unit(const bf16* __restrict__ QKV, bf16* __restrict__ O, const float* __restrict__ sink, int qrow0, int head0, int kvh, int krow_band, int nband, int krow_ctx, int dpos0, LAS unsigned char* lds, const int wid) {
    const int lane = lane_id(), r32 = lane & 31, hi = lane >> 5;
    LAS unsigned char* V_lds = lds; LAS unsigned char* K_lds = lds + 3 * SHM_V;
    LAS float* wsf = (LAS float*)(lds + 3 * SHM_V + 3 * SHM_K) + wid * 64; LAS float* li_l = wsf; LAS float* al_l = wsf + 32;
    const int head = head0 + (wid >> 2), qoff = 32 * (wid & 3);
    float m_reg = sink[head] * (1.0f / SCALE), l_reg = 1.0f; f32x16 o[4] = {}; bf16x8 qr[8];
    const bf16* Qw = QKV + (size_t)(qrow0 + qoff + r32) * QKVD + head * HDIM + hi * 8;
#pragma unroll
    for (int d0 = 0; d0 < 8; ++d0) qr[d0] = *(const bf16x8*)(Qw + d0 * 16);
    unsigned voK[2], voV[2];
#pragma unroll
    for (int i = 0; i < 2; ++i) { const int s = (i * 8 + wid) * 64 + lane;
        { const int row = s >> 4, ch = (s & 15) ^ (row & 7); voK[i] = (unsigned)(row * (QKVD * 2) + ch * 16); }
        { const int qlo = s & 3, kklo = (s >> 2) & 7, blk = s >> 5, qhi = blk & 3, kk = (blk >> 2) * 8 + kklo, k = (kk & ~0xC) | ((kk & 4) << 1) | ((kk & 8) >> 1); voV[i] = (unsigned)(k * (QKVD * 2) + (qhi * 4 + qlo) * 16); } }
    const __amdgpu_buffer_rsrc_t rs = __builtin_amdgcn_make_buffer_rsrc((void*)QKV, 0, -1, 0x00020000);
    const unsigned kcol = (unsigned)(1024 + kvh * HDIM) * 2u;
    const int vb0 = (int)(unsigned)(uintptr_t)V_lds + v_rd_base(lane);
    const int NT = nband + 4;
#define TROW(j) ((j) < nband ? krow_band + 64 * (j) : krow_ctx + 64 * ((j) - nband))
#define DMA(j, bo) do { const unsigned so_ = (unsigned)TROW(j) * (unsigned)(QKVD * 2) + kcol; _Pragma("unroll") for (int i_ = 0; i_ < 2; ++i_) { \
        __builtin_amdgcn_raw_ptr_buffer_load_lds(rs, (LAS void*)(K_lds + (bo) + (i_ * 8 + wid) * 1024), 16, voK[i_], so_, 0, 0); \
        __builtin_amdgcn_raw_ptr_buffer_load_lds(rs, (LAS void*)(V_lds + (bo) + (i_ * 8 + wid) * 1024), 16, voV[i_], so_ + 512u, 0, 0); } } while (0)
#define UBAR(n) do { asm volatile("s_waitcnt vmcnt(" #n ") lgkmcnt(0)" ::: "memory"); __builtin_amdgcn_s_barrier(); asm volatile("" ::: "memory"); } while (0)
#define RESC(a) do { if (__any((a) < 1.f)) { if (hi == 0) al_l[r32] = (a); asm volatile("s_waitcnt lgkmcnt(0)" ::: "memory"); \
    _Pragma("unroll") for (int d = 0; d < 4; ++d) _Pragma("unroll") for (int r = 0; r < 16; ++r) o[d][r] *= al_l[crow(r, hi)]; } } while (0)
    f32x16 pA0, pA1, pB0, pB1; float mnA, mnB, alA, alB; bf16x8 pa0, pa1, pa2, pa3;
    int bc = 0, bn = SHM_K, bnn = 2 * SHM_K;
    DMA(0, 0); DMA(1, SHM_K);
    UBAR(4);
    qkt(pA0, pA1, K_lds, qr, r32, hi); { const int dl = dpos0 - qoff; const bool dm = (0 < nband) && !(dl >= -97 && dl <= 65); partialSM(pA0, pA1, m_reg, mnA, alA, dm, dl - r32 + 4 * hi); }
#define STEP(Pc0, Pc1, alc, Pn0, Pn1, mnn, aln, t) do { UBAR(0); if ((t) + 2 < NT) DMA((t) + 2, bnn); \
        SBAR(); qkt(Pn0, Pn1, K_lds + bn, qr, r32, hi); finishSM(Pc0, Pc1, alc, l_reg, pa0, pa1, pa2, pa3); SBAR(); \
        { const int jj = (t) + 1; const int dl = dpos0 + 64 * jj - qoff; const bool dm = (jj < nband) && !(dl >= -97 && dl <= 65); \
          pv_partial(o, vb0 + bc, pa0, pa1, pa2, pa3, Pn0, Pn1, m_reg, mnn, aln, dm, dl - r32 + 4 * hi); } \
        RESC(aln); { const int t_ = bc; bc = bn; bn = bnn; bnn = t_; } } while (0)
    int t = 0;
    for (; t + 2 < NT - 1; t += 2) { STEP(pA0, pA1, alA, pB0, pB1, mnB, alB, t); STEP(pB0, pB1, alB, pA0, pA1, mnA, alA, t + 1); }
    STEP(pA0, pA1, alA, pB0, pB1, mnB, alB, t);
    finishSM(pB0, pB1, alB, l_reg, pa0, pa1, pa2, pa3); SBAR();
    pv_d0(o, vb0 + bc, pa0, pa1, pa2, pa3);
    if (hi == 0) li_l[r32] = l_reg; asm volatile("s_waitcnt lgkmcnt(0)" ::: "memory");
    float rli[16];
#pragma unroll
    for (int r = 0; r < 16; ++r) rli[r] = rcpf_(li_l[crow(r, hi)]);
    { LAS unsigned char* ot = lds + 3 * SHM_V + 3 * SHM_K + 4096 + wid * 4096;
#pragma unroll
      for (int r = 0; r < 16; ++r) { const int orow = crow(r, hi);
#pragma unroll
          for (int d0 = 0; d0 < 4; ++d0) { const float x = clamp8(o[d0][r] * rli[r] * 16.0f); ot[orow * 128 + d0 * 32 + r32] = (unsigned char)(__builtin_amdgcn_cvt_pk_fp8_f32(x, x, 0, false) & 0xff); } }
      asm volatile("s_waitcnt lgkmcnt(0)" ::: "memory");
      unsigned char* Ob = (unsigned char*)O + (size_t)(qrow0 + qoff) * DM + head * HDIM;
#pragma unroll
      for (int i = 0; i < 4; ++i) { const int row = (lane >> 3) + 8 * i, ch = lane & 7; *(u32x4*)(Ob + (size_t)row * DM + ch * 16) = *(LAS const u32x4*)(ot + row * 128 + ch * 16); } }
    __syncthreads();
#undef TROW
#undef DMA
#undef UBAR
#undef RESC
#undef STEP
}
constexpr int N_LAT_UNITS = NB * 32 * NKVH * 2, N_CTX_UNITS = NB * 2 * NKVH * 2, N_UNITS = N_LAT_UNITS + N_CTX_UNITS;
__device__ __forceinline__ void attn_phase(const bf16* QKV, bf16* O, const float* sink, int G, int c, LAS unsigned char* lds, const int wid) {
    for (int i = 0; ; ++i) { const int L = i * G + c; if (L >= N_UNITS) break;
        if (L < N_LAT_UNITS) { int hp, kh, n, b;
            if (G == 256) { const int u = (i < 3) ? L : ((c >= 64) ? 768 + (c - 64) : -1);
                if (u >= 0) { hp = u & 1; kh = (u >> 1) & 1; const int rest = u >> 2; n = 1 + rest % 30; b = rest / 30; }
                else { hp = c & 1; kh = (c >> 1) & 1; n = ((c >> 2) & 1) ? 31 : 0; b = c >> 3; } }
            else { hp = L & 1; kh = (L >> 1) & 1; n = (L >> 2) & 31; b = L >> 7; }
            const int nlo = n > 0 ? n - 1 : 0, nhi = n < 31 ? n + 1 : 31, nband = 2 * (nhi - nlo + 1);
            attn_unit(QKV, O, sink, b * SEQ + n * 128, kh * 4 + hp * 2, kh, b * SEQ + nlo * 128, nband, RL + b * LCTX, (nlo - n) * 128, lds, wid);
        } else { const int u = L - N_LAT_UNITS, hp = u & 1, kh = (u >> 1) & 1, qh = (u >> 2) & 1, b = u >> 3;
            attn_unit(QKV, O, sink, RL + b * LCTX + qh * 128, kh * 4 + hp * 2, kh, 0, 0, RL + b * LCTX, 0, lds, wid);
        }
    }
}
#undef KSWZ
#undef SBAR
}

__device__ __forceinline__ void p10_conv(Frame& F) {
    const int gw = F.vcu * NWAVES + F.wave, NGW = F.G * NWAVES; const bf16* XB = WSP(bf16, WS_XB); bf16* U = WSP(bf16, WS_U);
    float cw[4][16], cb[16];
#pragma unroll
    for (int j = 0; j < 4; ++j)
#pragma unroll
        for (int q = 0; q < 4; ++q) { const f32x4 w = *(const f32x4*)(F.conv_w + j * 1024 + 16 * F.lane + 4 * q); cw[j][4 * q] = w[0]; cw[j][4 * q + 1] = w[1]; cw[j][4 * q + 2] = w[2]; cw[j][4 * q + 3] = w[3]; }
#pragma unroll
    for (int q = 0; q < 4; ++q) { const f32x4 w = *(const f32x4*)(F.conv_b + 16 * F.lane + 4 * q); cb[4 * q] = w[0]; cb[4 * q + 1] = w[1]; cb[4 * q + 2] = w[2]; cb[4 * q + 3] = w[3]; }
    const int per = (RT + NGW - 1) / NGW, r0 = gw * per, r1 = (r0 + per < RT) ? r0 + per : RT;
    if (r0 >= RT) return;
    u32x4 w0[4], w1[4];
#pragma unroll
    for (int j = 0; j < 4; ++j) { int rr = r0 + j - 2; rr = rr < 0 ? 0 : (rr >= RT ? RT - 1 : rr); const u32x4* p = (const u32x4*)(XB + (size_t)rr * DM + 16 * F.lane); w0[j] = p[0]; w1[j] = p[1]; }
    for (int r = r0; r < r1; ++r) { const bool lat = r < RL; const int t = lat ? (r & (SEQ - 1)) : ((r - RL) & (LCTX - 1)); const int Ls = lat ? SEQ : LCTX;
        u32x4 n0, n1; { int rn = r + 2; rn = rn >= RT ? RT - 1 : rn; const u32x4* p = (const u32x4*)(XB + (size_t)rn * DM + 16 * F.lane); n0 = p[0]; n1 = p[1]; }
        float acc[16];
#pragma unroll
        for (int i = 0; i < 16; ++i) acc[i] = cb[i];
#pragma unroll
        for (int j = 0; j < 4; ++j) { const int tj = t + j - 2;
            if (tj >= 0 && tj < Ls) { const u32x4 x0 = w0[j], x1 = w1[j];
#pragma unroll
                for (int q = 0; q < 4; ++q) { acc[2 * q] += cw[j][2 * q] * bflo(x0[q]); acc[2 * q + 1] += cw[j][2 * q + 1] * bfhi(x0[q]); acc[8 + 2 * q] += cw[j][8 + 2 * q] * bflo(x1[q]); acc[8 + 2 * q + 1] += cw[j][8 + 2 * q + 1] * bfhi(x1[q]); } } }
        u32x4 o0, o1;
#pragma unroll
        for (int q = 0; q < 4; ++q) { o0[q] = cvtpk(acc[2 * q], acc[2 * q + 1]); o1[q] = cvtpk(acc[8 + 2 * q], acc[8 + 2 * q + 1]); }
        u32x4* op = (u32x4*)(U + (size_t)r * DM + 16 * F.lane); op[0] = o0; op[1] = o1;
        w0[0] = w0[1]; w0[1] = w0[2]; w0[2] = w0[3]; w0[3] = n0; w1[0] = w1[1]; w1[1] = w1[2]; w1[2] = w1[3]; w1[3] = n1; }
}
namespace lru {
constexpr int AIMG_BYTES = 65536;
constexpr int EX_OFF = 2 * AIMG_BYTES;
struct Ctx { const bf16* U; const bf16* G; bf16* HH; u32x4* HF; const bf16* WLG; const float *lam, *b_r, *b_i; };

__device__ __forceinline__ void issue_u(const __amdgpu_buffer_rsrc_t rs, LAS unsigned char* buf, int n, size_t row0, int wid, unsigned voff) {
#pragma unroll
    for (int ii = 0; ii < 8; ++ii) { const int i = wid + 8 * ii;
        __builtin_amdgcn_raw_ptr_buffer_load_lds(rs, (LAS void*)(buf + i * 1024), 16, voff, (unsigned)((row0 + 32 * ii) * DM * 2 + n * 256), 0, 0); }
}
__device__ __forceinline__ void chunk_geom(int DIR, int k, int b, size_t& row0, int& lc) {
    if (k == 0) { row0 = (size_t)RL + b * LCTX; lc = -1; } else { lc = DIR ? 16 - k : k - 1; row0 = (size_t)b * SEQ + 256 * lc; }
}
#define LRU_BAR() do { asm volatile("s_waitcnt lgkmcnt(0)" ::: "memory"); __builtin_amdgcn_s_barrier(); asm volatile("" ::: "memory"); } while (0)
template <int DIR>
__device__ __forceinline__ void walk(const Ctx& C, LAS unsigned char* lds, int task, const int wid) {
    const int cq = task & 3, n = (task >> 2) & 7, b = task >> 5;
    const int lane = lane_id(), tid = wid * 64 + lane, c = lane & 15, g = lane >> 4;
    const int chalf = wid & 1, tq = wid >> 1;
    const int chl = 32 * cq + 16 * chalf + c;
    const int ch = n * 128 + chl;
    bf16x8 Br[4], Bi[4];
    { const bf16* wr = C.WLG + ((size_t)(n * 4 + 2 * DIR) * 128 + chl) * 128 + 8 * g; const bf16* wi = wr + 16384;
#pragma unroll
      for (int ks = 0; ks < 4; ++ks) { Br[ks] = *(const bf16x8*)(wr + ks * 32); Bi[ks] = *(const bf16x8*)(wi + ks * 32); } }
    const float br = C.b_r[DIR * 1024 + ch], bi = C.b_i[DIR * 1024 + ch];
    const float sp8 = 8.0f * log1pf(expf(-C.lam[DIR * 1024 + ch]));
    const float kbr = -LOG2E * br, kbi = -LOG2E * bi, ka = -sp8 * LOG2E;
    float H = 0.f;
    unsigned fb[4], ub[4];
#pragma unroll
    for (int ks = 0; ks < 4; ++ks) fb[ks] = (unsigned)((64 * tq + c) * 256 + ((ks * 64 + 16 * g) ^ (c << 4)));
#pragma unroll
    for (int r = 0; r < 4; ++r) ub[r] = (unsigned)((64 * tq + 4 * g + r) * 256 + ((2 * chl) ^ ((4 * g + r) << 4)));
    const __amdgpu_buffer_rsrc_t urs = __builtin_amdgcn_make_buffer_rsrc((void*)C.U, 0, -1, 0x00020000);
    const unsigned uvoff = (unsigned)((4 * wid + (lane >> 4)) * DM * 2 + (((lane & 15) ^ ((4 * wid + (lane >> 4)) & 15)) * 16));
    { size_t r0; int lc; chunk_geom(DIR, 0, b, r0, lc); issue_u(urs, lds, n, r0, wid, uvoff); }
    for (int k = 0; k < 17; ++k) {
        size_t row0; int lc; chunk_geom(DIR, k, b, row0, lc);
        LAS unsigned char* img = lds + (k & 1) * AIMG_BYTES;
        asm volatile("s_waitcnt vmcnt(0)" ::: "memory");
        LRU_BAR();
        if (k + 1 < 17) { size_t r1; int l1; chunk_geom(DIR, k + 1, b, r1, l1); issue_u(urs, lds + ((k + 1) & 1) * AIMG_BYTES, n, r1, wid, uvoff); }
        u32x4 hf0, hf1;
        u32x4 gp0, gp1;
        if (DIR == 1 && lc >= 0) { const u32x4* hp = C.HF + ((((size_t)task * 16 + lc) * 8 + wid) * 2) * 64 + lane; hf0 = hp[0]; hf1 = hp[64];
            const size_t grow = (row0 + (tid >> 1)) * DM + n * 128 + 32 * cq + 16 * (tid & 1); gp0 = *(const u32x4*)(C.G + grow); gp1 = *(const u32x4*)(C.G + grow + 8); }
        f32x4 ar[4], ai[4];
#pragma unroll
        for (int mt = 0; mt < 4; ++mt) { ar[mt] = (f32x4){0.f, 0.f, 0.f, 0.f}; ai[mt] = (f32x4){0.f, 0.f, 0.f, 0.f};
#pragma unroll
            for (int ks = 0; ks < 4; ++ks) { const bf16x8 af = *(LAS const bf16x8*)(img + fb[ks] + mt * 4096);
                ar[mt] = __builtin_amdgcn_mfma_f32_16x16x32_bf16(af, Br[ks], ar[mt], 0, 0, 0);
                ai[mt] = __builtin_amdgcn_mfma_f32_16x16x32_bf16(af, Bi[ks], ai[mt], 0, 0, 0); } }
        float y0[4][4], P[4][4]; float TA = 1.f, TB = 0.f;
#pragma unroll
        for (int mm = 0; mm < 4; ++mm) { const int mt = DIR ? 3 - mm : mm;
            float a[4], bb[4];
#pragma unroll
            for (int r = 0; r < 4; ++r) {
                const float rg = rcpf_(1.0f + ex2(fmaf(ar[mt][r], -LOG2E, kbr))), ig = rcpf_(1.0f + ex2(fmaf(ai[mt][r], -LOG2E, kbi)));
                a[r] = ex2(rg * ka);
                const float em = fmaf(-a[r], a[r], 1.0f);
                const float uu = __uint_as_float((unsigned)*(LAS const bf16*)(img + ub[r] + mt * 4096) << 16);
                bb[r] = __builtin_amdgcn_sqrtf(em) * (ig * uu); }
            float p[4], yl[4];
            if (DIR == 0) { p[0] = a[0]; yl[0] = bb[0];
#pragma unroll
                for (int r = 1; r < 4; ++r) { p[r] = a[r] * p[r - 1]; yl[r] = a[r] * yl[r - 1] + bb[r]; } }
            else { p[3] = a[3]; yl[3] = bb[3];
#pragma unroll
                for (int r = 2; r >= 0; --r) { p[r] = a[r] * p[r + 1]; yl[r] = a[r] * yl[r + 1] + bb[r]; } }
            const float Al = DIR ? p[0] : p[3], Bl = DIR ? yl[0] : yl[3];
            const float A0 = __shfl(Al, c), A1 = __shfl(Al, 16 + c), A2 = __shfl(Al, 32 + c), A3 = __shfl(Al, 48 + c);
            const float B0 = __shfl(Bl, c), B1 = __shfl(Bl, 16 + c), B2 = __shfl(Bl, 32 + c), B3 = __shfl(Bl, 48 + c);
            float EA, EB, At, Bt;
            if (DIR == 0) { const float e1a = A0, e1b = B0, e2a = A1 * e1a, e2b = A1 * e1b + B1, e3a = A2 * e2a, e3b = A2 * e2b + B2;
                EA = g == 0 ? 1.f : (g == 1 ? e1a : (g == 2 ? e2a : e3a)); EB = g == 0 ? 0.f : (g == 1 ? e1b : (g == 2 ? e2b : e3b)); At = A3 * e3a; Bt = A3 * e3b + B3; }
            else { const float e2a = A3, e2b = B3, e1a = A2 * e2a, e1b = A2 * e2b + B2, e0a = A1 * e1a, e0b = A1 * e1b + B1;
                EA = g == 3 ? 1.f : (g == 2 ? e2a : (g == 1 ? e1a : e0a)); EB = g == 3 ? 0.f : (g == 2 ? e2b : (g == 1 ? e1b : e0b)); At = A0 * e0a; Bt = A0 * e0b + B0; }
            const float QA = EA * TA, QB = EA * TB + EB;
#pragma unroll
            for (int r = 0; r < 4; ++r) { P[mt][r] = p[r] * QA; y0[mt][r] = p[r] * QB + yl[r]; }
            TB = At * TB + Bt; TA = At * TA;
        }
        if (g == 0) *(LAS f32x2*)(lds + EX_OFF + ((tq * 2 + chalf) * 16 + c) * 8) = (f32x2){TA, TB};
        LRU_BAR();
        float Hw;
        { const f32x2 e0 = *(LAS const f32x2*)(lds + EX_OFF + ((0 * 2 + chalf) * 16 + c) * 8), e1 = *(LAS const f32x2*)(lds + EX_OFF + ((1 * 2 + chalf) * 16 + c) * 8),
                      e2 = *(LAS const f32x2*)(lds + EX_OFF + ((2 * 2 + chalf) * 16 + c) * 8), e3 = *(LAS const f32x2*)(lds + EX_OFF + ((3 * 2 + chalf) * 16 + c) * 8);
          if (DIR == 0) { const float h1 = e0.x * H + e0.y, h2 = e1.x * h1 + e1.y, h3 = e2.x * h2 + e2.y; Hw = tq == 0 ? H : (tq == 1 ? h1 : (tq == 2 ? h2 : h3)); H = e3.x * h3 + e3.y; }
          else { const float h2 = e3.x * H + e3.y, h1 = e2.x * h2 + e2.y, h0 = e1.x * h1 + e1.y; Hw = tq == 3 ? H : (tq == 2 ? h2 : (tq == 1 ? h1 : h0)); H = e0.x * h0 + e0.y; } }
        if (lc >= 0) {
#pragma unroll
            for (int mt = 0; mt < 4; ++mt)
#pragma unroll
                for (int r = 0; r < 4; ++r) y0[mt][r] += P[mt][r] * Hw;
            if (DIR == 0) {
                u32x4* hp = C.HF + ((((size_t)task * 16 + lc) * 8 + wid) * 2) * 64 + lane;
                u32x4 w0, w1; w0.x = cvtpk(y0[0][0], y0[0][1]); w0.y = cvtpk(y0[0][2], y0[0][3]); w0.z = cvtpk(y0[1][0], y0[1][1]); w0.w = cvtpk(y0[1][2], y0[1][3]);
                w1.x = cvtpk(y0[2][0], y0[2][1]); w1.y = cvtpk(y0[2][2], y0[2][3]); w1.z = cvtpk(y0[3][0], y0[3][1]); w1.w = cvtpk(y0[3][2], y0[3][3]);
                hp[0] = w0; hp[64] = w1;
            } else {
                const unsigned hw[8] = {hf0.x, hf0.y, hf0.z, hf0.w, hf1.x, hf1.y, hf1.z, hf1.w};
#pragma unroll
                for (int mt = 0; mt < 4; ++mt)
#pragma unroll
                    for (int r = 0; r < 4; ++r) { const unsigned w = hw[mt * 2 + (r >> 1)]; const float hfv = (r & 1) ? bfhi(w) : bflo(w); const float s = y0[mt][r] + hfv;
                        *(LAS bf16*)(img + (64 * tq + mt * 16 + 4 * g + r) * 64 + (16 * chalf + c) * 2) = (bf16)(cvtpk(s, 0.f) & 0xffffu); }
                LRU_BAR();
                { const int tt = tid >> 1, hh = tid & 1; const size_t grow = (row0 + tt) * DM + n * 128 + 32 * cq + 16 * hh;
                  const u32x4 s0 = *(LAS const u32x4*)(img + tt * 64 + hh * 32), s1 = *(LAS const u32x4*)(img + tt * 64 + hh * 32 + 16);
                  const u32x4 g0 = gp0, g1 = gp1;
                  u32x4 o0, o1;
#pragma unroll
                  for (int j = 0; j < 4; ++j) { o0[j] = cvtpk(bflo(s0[j]) * bflo(g0[j]), bfhi(s0[j]) * bfhi(g0[j])); o1[j] = cvtpk(bflo(s1[j]) * bflo(g1[j]), bfhi(s1[j]) * bfhi(g1[j])); }
                  *(u32x4*)(C.HH + grow) = o0; *(u32x4*)(C.HH + grow + 8) = o1; }
            }
        }
    }
    asm volatile("s_waitcnt vmcnt(0)" ::: "memory");
    LRU_BAR();
}
#undef LRU_BAR
}
__device__ __forceinline__ void p11_lru(Frame& F, const lru::Ctx& C) {
    for (int task = F.vcu; task < 256; task += F.G) { lru::walk<0>(C, F.lds, task, F.wave); lru::walk<1>(C, F.lds, task, F.wave); }
}

__device__ __forceinline__ void p13_ln_router(Frame& F) {
    LAS float* RTR = (LAS float*)F.lds;
    LAS int* lcnt = (LAS int*)(F.lds + 32768);
    for (int idx = F.tid; idx < 8192; idx += NWAVES * 64) RTR[(idx & 7) * 1024 + (idx >> 3)] = F.router[idx];
    const float* mod = WSP(float, WS_MOD) + (size_t)1 * 9 * 6144; unsigned char* H8 = WSP(unsigned char, WS_H);
    int* eidx = (int*)(F.ws + WS_ROUTE + RT_EIDX); float* wgt = (float*)(F.ws + WS_ROUTE + RT_WGT); int* cnt = (int*)(F.ws + WS_ROUTE + RT_CNT);
    const Vec16 gv = vec_load(F.ln_g + 2 * 1024, F.lane), bv = vec_load(F.ln_b + 2 * 1024, F.lane);
    for (int batch = F.vcu; batch < RL / 128; batch += F.G) {
        const float* mb0 = mod + (size_t)((batch * 128) >> 12) * 6144 + 3072; const Vec16 sh = vec_load(mb0, F.lane), sc = vec_load(mb0 + 1024, F.lane);
        if (F.tid < 8) lcnt[F.tid] = 0;
        __syncthreads();
        u32x2 nx[4]; { const bf16* yp = WSP(bf16, WS_YB) + (size_t)(batch * 128 + F.wave * 16) * DM;
#pragma unroll
            for (int j = 0; j < 4; ++j) nx[j] = *(const u32x2*)(yp + 4 * F.lane + 256 * j); }
        for (int i = 0; i < 16; ++i) { const int r = batch * 128 + F.wave * 16 + i;
            f32x4 v[4];
#pragma unroll
            for (int j = 0; j < 4; ++j) v[j] = (f32x4){bflo(nx[j].x), bfhi(nx[j].x), bflo(nx[j].y), bfhi(nx[j].y)};
            if (i + 1 < 16) { const bf16* yp = WSP(bf16, WS_YB) + (size_t)(r + 1) * DM;
#pragma unroll
                for (int j = 0; j < 4; ++j) nx[j] = *(const u32x2*)(yp + 4 * F.lane + 256 * j); }
            row_ln_v(v, gv, bv);
            float lg[8];
#pragma unroll
            for (int e = 0; e < 8; ++e) lg[e] = 0.f;
#pragma unroll
            for (int j = 0; j < 4; ++j) { const f32x4 hm = v[j] * (sc.q[j] + 1.0f) + sh.q[j];
                *(unsigned*)(H8 + (size_t)r * DM + 4 * F.lane + 256 * j) = pk4_fp8(hm[0] * 4.f, hm[1] * 4.f, hm[2] * 4.f, hm[3] * 4.f);
#pragma unroll
                for (int e = 0; e < 8; ++e) { const f32x4 rt = *(LAS const f32x4*)(RTR + e * 1024 + 4 * F.lane + 256 * j); lg[e] += (hm[0] * rt[0] + hm[1] * rt[1]) + (hm[2] * rt[2] + hm[3] * rt[3]); } }
#pragma unroll
            for (int e = 0; e < 8; ++e) lg[e] = wave_sum(lg[e]);
            int ea = 0; float la = lg[0];
#pragma unroll
            for (int e = 1; e < 8; ++e) if (lg[e] > la) { la = lg[e]; ea = e; }
            int eb = -1; float lb = -3.0e38f;
#pragma unroll
            for (int e = 0; e < 8; ++e) if (e != ea && lg[e] > lb) { lb = lg[e]; eb = e; }
            const float wa = 1.0f / (1.0f + __expf(lb - la)), wb = 1.0f - wa;
            if (F.lane == 0) { *(int2*)(eidx + 2 * r) = make_int2(ea, eb); *(float2*)(wgt + 2 * r) = make_float2(wa, wb); atomicAdd((int*)(lcnt + ea), 1); atomicAdd((int*)(lcnt + eb), 1); }
        }
        __syncthreads();
        if (F.tid < 8) cnt[batch * 8 + F.tid] = lcnt[F.tid];
        __syncthreads();
    }
}
__device__ __forceinline__ void moe_totals(Frame& F, int upto_batch, int (&tot)[8], int (&before)[8]) {
    const int* cnt = (const int*)(F.ws + WS_ROUTE + RT_CNT);
#pragma unroll
    for (int e = 0; e < 8; ++e) { tot[e] = 0; before[e] = 0; }
#pragma unroll
    for (int k = 0; k < 4; ++k) { const int bb = 4 * F.lane + k; const int4 c0 = *(const int4*)(cnt + bb * 8), c1 = *(const int4*)(cnt + bb * 8 + 4); const int m = bb < upto_batch ? 1 : 0;
        tot[0] += c0.x; tot[1] += c0.y; tot[2] += c0.z; tot[3] += c0.w; tot[4] += c1.x; tot[5] += c1.y; tot[6] += c1.z; tot[7] += c1.w;
        before[0] += m * c0.x; before[1] += m * c0.y; before[2] += m * c0.z; before[3] += m * c0.w; before[4] += m * c1.x; before[5] += m * c1.y; before[6] += m * c1.z; before[7] += m * c1.w; }
#pragma unroll
    for (int e = 0; e < 8; ++e) {
#pragma unroll
        for (int o = 1; o < 64; o <<= 1) { tot[e] += __shfl_xor(tot[e], o); before[e] += __shfl_xor(before[e], o); } }
}
__device__ __forceinline__ void p14_gather(Frame& F) {
    const int* eidx = (const int*)(F.ws + WS_ROUTE + RT_EIDX); const float* wgt = (const float*)(F.ws + WS_ROUTE + RT_WGT);
    int* slot = (int*)(F.ws + WS_ROUTE + RT_SLOT); float* wsort = (float*)(F.ws + WS_ROUTE + RT_WS);
    const unsigned char* H8 = WSP(unsigned char, WS_H); unsigned char* HS8 = WSP(unsigned char, WS_HS);
    LAS int* wcnt = (LAS int*)F.lds;
    LAS int* dsts = (LAS int*)(F.lds + 256);
    for (int batch = F.vcu; batch < RL / 128; batch += F.G) {
        int tot[8], before[8]; moe_totals(F, batch, tot, before);
        int base[8]; { int tp = 0;
#pragma unroll
            for (int e = 0; e < 8; ++e) { base[e] = tp * 256 + before[e]; tp += (tot[e] + 255) >> 8; } }
        int my_e = 0, rank_in_wave = 0;
        if (F.tid < 256) { my_e = eidx[batch * 256 + F.tid];
#pragma unroll
            for (int e = 0; e < 8; ++e) { const unsigned long long m = __ballot(my_e == e); if (my_e == e) rank_in_wave = __popcll(m & ((1ull << F.lane) - 1ull)); if (F.lane == 0) wcnt[F.wave * 8 + e] = __popcll(m); } }
        __syncthreads();
        if (F.tid < 256) { int off = 0;
#pragma unroll
            for (int w = 0; w < 4; ++w) if (w < F.wave) off += wcnt[w * 8 + my_e];
            int bs = 0;
#pragma unroll
            for (int e = 0; e < 8; ++e) bs = (my_e == e) ? base[e] : bs;
            const int d = bs + off + rank_in_wave; dsts[F.tid] = d; slot[batch * 256 + F.tid] = d; wsort[d] = wgt[batch * 256 + F.tid]; }
        __syncthreads();
        for (int i = 0; i < 32; ++i) { const int a = F.wave * 32 + i; const int d = dsts[a]; const int r = batch * 128 + (a >> 1);
            const u32x4* src = (const u32x4*)(H8 + (size_t)r * DM); u32x4* dp = (u32x4*)(HS8 + (size_t)d * DM);
            dp[F.lane] = src[F.lane]; }
        __syncthreads();
    }
}
__device__ __forceinline__ void p17_final(Frame& F) {
    const int gw = F.vcu * NWAVES + F.wave, NGW = F.G * NWAVES; const float* mod = WSP(float, WS_MOD) + (size_t)1 * 9 * 6144; const bf16* FO = WSP(bf16, WS_FO);
    const int* slot = (const int*)(F.ws + WS_ROUTE + RT_SLOT);
    const Vec16 g0 = vec_load(F.ln_g + 2 * 1024, F.lane), b0 = vec_load(F.ln_b + 2 * 1024, F.lane), g1 = vec_load(F.ln_g + 3 * 1024, F.lane), b1 = vec_load(F.ln_b + 3 * 1024, F.lane);
    const int bb = gw / (NGW / 8) < 8 ? gw / (NGW / 8) : 7; const Vec16 g2 = vec_load(mod + (size_t)bb * 6144 + 5120, F.lane);
    ROWS_LAT( (void)b; float* yp = F.out + (size_t)r * DM; const int2 s = *(const int2*)(slot + 2 * r);
        const bf16* fa = FO + (size_t)s.x * DM, * fb = FO + (size_t)s.y * DM;
        f32x4 v[4]; row_load_bf(v, WSP(bf16, WS_YB) + (size_t)r * DM, F.lane); row_ln_v(v, g0, b0);
        _Pragma("unroll") for (int j = 0; j < 4; ++j) { const u32x2 a = *(const u32x2*)(fa + 4 * F.lane + 256 * j), c = *(const u32x2*)(fb + 4 * F.lane + 256 * j);
            const f32x4 f = {bflo(a.x) + bflo(c.x), bfhi(a.x) + bfhi(c.x), bflo(a.y) + bflo(c.y), bfhi(a.y) + bfhi(c.y)};
            v[j] = v[j] * ALPHA + g2.q[j] * f; }
        row_ln_v(v, g1, b1); row_store(v, yp, F.lane); );
}

constexpr int N_PHASES = 18;
#ifndef REP_PHASE
#define REP_PHASE -1
#endif
struct Args { const float* in[25]; float* out; unsigned char* ws; int ph_lo, ph_hi; };
__global__ void __launch_bounds__(NWAVES * 64, 2) fwd_kernel(Args args) {
    extern __shared__ __attribute__((aligned(16))) unsigned char lds[];
    Frame F;
    F.lds = (LAS unsigned char*)lds;
    F.MISC = (volatile LAS unsigned*)(F.lds + MISC_OFF);
    F.wave = __builtin_amdgcn_readfirstlane((int)(threadIdx.x >> 6)); F.lane = lane_id(); F.tid = F.wave * 64 + F.lane;
    F.G = gridDim.x; { const int bx = blockIdx.x; F.vcu = (F.G % 8 == 0) ? (bx % 8) * (F.G / 8) + bx / 8 : bx; }
    F.x = args.in[0]; F.c = args.in[1]; F.ctx = args.in[2]; F.cctx = args.in[3]; F.w_mod = args.in[4]; F.b_mod = args.in[5]; F.ln_g = args.in[6]; F.ln_b = args.in[7];
    F.w_qkv = args.in[8]; F.w_o = args.in[9]; F.sink = args.in[10]; F.w_gu = args.in[11]; F.w_dn = args.in[12]; F.w_in = args.in[13]; F.conv_w = args.in[14]; F.conv_b = args.in[15];
    F.lam = args.in[16]; F.w_r = args.in[17]; F.b_r = args.in[18]; F.w_i = args.in[19]; F.b_i = args.in[20]; F.w_out = args.in[21]; F.router = args.in[22]; F.mw_gu = args.in[23]; F.mw_dn = args.in[24];
    F.out = args.out; F.ws = args.ws;
    for (int u = F.tid; u < (LDS_BYTES - LDSCTL_OFF) / 4; u += NWAVES * 64) ((LAS unsigned*)(F.lds + LDSCTL_OFF))[u] = 0u;
    __syncthreads();
    const int lo = args.ph_lo, hi = args.ph_hi;
    const bool multi = (hi - lo) > 1;
    XcdBarrier bar; bar.bar = (unsigned*)(F.ws + WS_CTL) + 1024; bar.x = 0; bar.st = nullptr;
    if (multi) bar = xcd_barrier_post((unsigned*)(F.ws + WS_CTL) + 1024, F.MISC + 8, F.wave == 0 && lane_id() == 0);
#define IN(k) (lo <= (k) && (k) < hi)
#define REFRESH() do { F.lane = lane_id(); F.tid = F.wave * 64 + F.lane; } while (0)
#define SEAM(k) do { if (IN(k) && IN((k) + 1)) xcd_barrier(bar, F.wave == 0 && lane_id() == 0); } while (0)
    const float* MOD = WSP(float, WS_MOD);
    bf16* H = WSP(bf16, WS_H); bf16* YB = WSP(bf16, WS_YB); const f32x2* ST = (const f32x2*)(F.ws + WS_STATS);

    if (IN(0)) { REFRESH(); p0_prologue(F); if (REP_PHASE == 0) { xcd_barrier(bar, F.wave == 0 && lane_id() == 0); p0_prologue(F); } } SEAM(0);
    if (IN(1)) { REFRESH(); p1_modulate(F); if (REP_PHASE == 1) { xcd_barrier(bar, F.wave == 0 && lane_id() == 0); p1_modulate(F); } } SEAM(1);
    if (IN(2)) {
        pg8::Gemm g{H, WSP(bf16, WS_WQKV), RT, QKVD, DM / 2}; pg8::StaticOrder S; S.init(RT, QKVD, F.G, (int)blockIdx.x);
        pg8::EpiQKV E{WSP(bf16, WS_QKV), WSP(float, WS_ROPE), 1.0f / 512.0f};
        pg8::gemm_phase<pg8::EpiQKV, pg8::StaticOrder, true, true, true>(F.lds + RING_OFF, g, S, E, F.wave);
        moe_convert_filler(F, (RT / 256) * (QKVD / 256), (int)blockIdx.x, 0, 6400);
    } SEAM(2);
    if (IN(3)) { att::attn_phase(WSP(bf16, WS_QKV), WSP(bf16, WS_O), F.sink, F.G, F.vcu, F.lds + RING_OFF, F.wave); if (REP_PHASE == 3) { xcd_barrier(bar, F.wave == 0 && lane_id() == 0); att::attn_phase(WSP(bf16, WS_QKV), WSP(bf16, WS_O), F.sink, F.G, F.vcu, F.lds + RING_OFF, F.wave); } } SEAM(3);
    if (IN(4)) {
        pg8::Gemm g{WSP(bf16, WS_O), WSP(bf16, WS_WO), RT, DM, DM / 2}; pg8::StaticOrder S; S.init(RT, DM, F.G, (int)blockIdx.x);
        pg8::EpiResid<false> E{F.x, F.ctx, YB, MOD + 2048, 1.0f / 2048.0f, nullptr, nullptr, nullptr};
        pg8::gemm_phase<pg8::EpiResid<false>, pg8::StaticOrder, true, true, true>(F.lds + RING_OFF, g, S, E, F.wave);
        moe_convert_filler(F, (RT / 256) * (DM / 256), (int)blockIdx.x, 6400, 17408);
    } SEAM(4);
    if (IN(5)) { REFRESH(); ln_mod_pass<true>(F, true, F.ln_g, F.ln_b, 0, 3072); } SEAM(5);
    if (IN(6)) {
        pg8::Gemm g{H, WSP(bf16, WS_WGU), RT, 2 * DFF, DM / 2}; pg8::StaticOrder S; S.init(RT, 2 * DFF, F.G, (int)blockIdx.x);
        pg8::EpiSwiGLU8 E{WSP(unsigned char, WS_ACT), 28};
        pg8::gemm_phase<pg8::EpiSwiGLU8, pg8::StaticOrder, true, true, true>(F.lds + RING_OFF, g, S, E, F.wave);
    } SEAM(6);
    if (IN(7)) {
        pg8::Gemm g{WSP(bf16, WS_ACT), WSP(bf16, WS_WDN), RT, DM, DFF / 2}; pg8::StaticOrder S; S.init(RT, DM, F.G, (int)blockIdx.x);
        pg8::EpiResid<true> E{nullptr, nullptr, YB, MOD + 5120, 1.0f / 4096.0f, ST, F.ln_g, F.ln_b};
        pg8::gemm_phase<pg8::EpiResid<true>, pg8::StaticOrder, true, true, true>(F.lds + RING_OFF, g, S, E, F.wave);
        moe_convert_filler(F, (RT / 256) * (DM / 256), (int)blockIdx.x, 17408, 37888);
    } SEAM(7);
    if (IN(8)) { REFRESH(); ln_mod_pass<false>(F, true, F.ln_g + 1024, F.ln_b + 1024, 1, 0); } SEAM(8);
    if (IN(9)) {
        pg8::Gemm g{H, WSP(bf16, WS_WIN), RT, 2048, DM}; pg8::StaticOrder S; S.init(RT, 2048, F.G, (int)blockIdx.x);
        pg8::EpiLruIn E{WSP(bf16, WS_G), WSP(bf16, WS_XB)};
        pg8::gemm_phase<pg8::EpiLruIn, pg8::StaticOrder, true, true>(F.lds + RING_OFF, g, S, E, F.wave);
        moe_convert_filler(F, (RT / 256) * (2048 / 256), (int)blockIdx.x, 37888, CV_ITEMS);
    } SEAM(9);
    {
        const lru::Ctx LC{WSP(bf16, WS_U), WSP(bf16, WS_G), WSP(bf16, WS_HH), WSP(u32x4, WS_HF), WSP(bf16, WS_WLG), F.lam, F.b_r, F.b_i};
        if (IN(10)) { REFRESH(); p10_conv(F); } SEAM(10);
        if (IN(11)) { REFRESH(); p11_lru(F, LC); if (REP_PHASE == 11) { xcd_barrier(bar, F.wave == 0 && lane_id() == 0); p11_lru(F, LC); } } SEAM(11);
    }
    if (IN(12)) {
        pg8::Gemm g{WSP(bf16, WS_HH), WSP(bf16, WS_WOUT), RL, DM, DM}; pg8::StaticOrder S; S.init(RL, DM, F.G, (int)blockIdx.x);
        pg8::EpiResid<true> E{nullptr, nullptr, YB, MOD + 9 * 6144 + 2048, 1.0f, ST, F.ln_g + 1024, F.ln_b + 1024};
        pg8::gemm_phase<pg8::EpiResid<true>, pg8::StaticOrder, true, true>(F.lds + RING_OFF, g, S, E, F.wave);
    } SEAM(12);
    if (IN(13)) { REFRESH(); p13_ln_router(F); } SEAM(13);
    if (IN(14)) { REFRESH(); p14_gather(F); if (REP_PHASE == 14) { xcd_barrier(bar, F.wave == 0 && lane_id() == 0); p14_gather(F); } } SEAM(14);
    if (IN(15) || IN(16)) {
        REFRESH();
        int tot[8], before[8]; moe_totals(F, 0, tot, before);
        int tp[9]; tp[0] = 0;
#pragma unroll
        for (int e = 0; e < 8; ++e) tp[e + 1] = __builtin_amdgcn_readfirstlane(tp[e] + ((tot[e] + 255) >> 8));
        const int ntiles = tp[8];
        if (IN(15)) {
            pg8::Gemm g{WSP(bf16, WS_HS), WSP(bf16, WS_WMGU), ntiles * 256, 2 * DFF, DM / 2};
            pg8::MoeOrder S{ntiles, 28, ntiles * 28, F.G, (int)blockIdx.x, 28, tp[1], tp[2], tp[3], tp[4], tp[5], tp[6], tp[7]};
            pg8::EpiSwiGLU8 E{WSP(unsigned char, WS_MACT), 28};
            pg8::gemm_phase<pg8::EpiSwiGLU8, pg8::MoeOrder, true, true, true>(F.lds + RING_OFF, g, S, E, F.wave);
        } SEAM(15);
        if (IN(16)) {
            pg8::Gemm g{WSP(bf16, WS_MACT), WSP(bf16, WS_WMDN), ntiles * 256, DM, DFF / 2};
            pg8::MoeOrder S{ntiles, 4, ntiles * 4, F.G, (int)blockIdx.x, 4, tp[1], tp[2], tp[3], tp[4], tp[5], tp[6], tp[7]};
            pg8::EpiMoeOut8 E{WSP(bf16, WS_FO), (const float*)(F.ws + WS_ROUTE + RT_WS)};
            pg8::gemm_phase<pg8::EpiMoeOut8, pg8::MoeOrder, true, true, true>(F.lds + RING_OFF, g, S, E, F.wave);
        } SEAM(16);
    }
    if (IN(17)) { REFRESH(); p17_final(F); }
#undef IN
#undef SEAM
}

#ifndef N_LAUNCH_MODE
#define N_LAUNCH_MODE 1
#endif
extern "C" void kernel_launch(void* const* d_in, const int* in_sizes, int n_in, void* d_out, int out_size, void* d_ws, size_t ws_size, hipStream_t stream) {
    static int grid = 0;
    if (grid == 0) {
        if (n_in != 25 || out_size != RL * DM || ws_size < WS_END) { fprintf(stderr, "kernel_launch: unexpected shapes (n_in %d out %d ws %zu)\n", n_in, out_size, ws_size); grid = -1; return; }
        int dev = 0, cus = 0, per_cu = 0;
        if (hipGetDevice(&dev) != hipSuccess || hipDeviceGetAttribute(&cus, hipDeviceAttributeMultiprocessorCount, dev) != hipSuccess) { grid = -1; return; }
        if (hipFuncSetAttribute((const void*)fwd_kernel, hipFuncAttributeMaxDynamicSharedMemorySize, LDS_BYTES) != hipSuccess) { fprintf(stderr, "kernel_launch: hipFuncSetAttribute failed\n"); grid = -1; return; }
        if (hipOccupancyMaxActiveBlocksPerMultiprocessor(&per_cu, (const void*)fwd_kernel, NWAVES * 64, LDS_BYTES) != hipSuccess || per_cu < 1) { fprintf(stderr, "kernel_launch: occupancy query says %d\n", per_cu); per_cu = 1; }
        (void)hipGetLastError();
        grid = cus;
    }
    if (grid < 0) return;
    (void)hipMemsetAsync((char*)d_ws + WS_CTL, 0, CTL_ZERO_BYTES, stream);
    Args a{};
    for (int i = 0; i < 25; ++i) a.in[i] = (const float*)d_in[i];
    a.out = (float*)d_out; a.ws = (unsigned char*)d_ws;
#if N_LAUNCH_MODE == 1
    a.ph_lo = 0; a.ph_hi = N_PHASES;
    hipLaunchKernelGGL(fwd_kernel, dim3(grid), dim3(NWAVES * 64), LDS_BYTES, stream, a);
#else
    for (int p = 0; p < N_PHASES; ++p) { a.ph_lo = p; a.ph_hi = p + 1; hipLaunchKernelGGL(fwd_kernel, dim3(grid), dim3(NWAVES * 64), LDS_BYTES, stream, a); }
#endif
    const hipError_t le = hipPeekAtLastError();
    if (le != hipSuccess) fprintf(stderr, "kernel_launch: launch failed: %s\n", hipGetErrorName(le));
}
```

```cpp
#include <hip/hip_runtime.h>
#include <cstdio>
#include <cstdint>

#define GAS __attribute__((address_space(1)))
#define LAS __attribute__((address_space(3)))
typedef unsigned short bf16;
typedef short bf16x8 __attribute__((ext_vector_type(8)));
typedef short s16x4 __attribute__((ext_vector_type(4)));
typedef float f32x4 __attribute__((ext_vector_type(4)));
typedef float f32x2 __attribute__((ext_vector_type(2)));
typedef float f32x16 __attribute__((ext_vector_type(16)));
typedef unsigned u32x4 __attribute__((ext_vector_type(4)));
typedef unsigned u32x2 __attribute__((ext_vector_type(2)));
typedef GAS unsigned gu32;

constexpr int NB = 8, SEQ = 4096, DM = 1024, LCTX = 256;
constexpr int RL = NB * SEQ;
constexpr int RC = NB * LCTX;
constexpr int RT = RL + RC;
constexpr int NHEAD = 8, NKVH = 2, HDIM = 128, QKVD = 1536;
constexpr int DFF = 3584, NEXP = 8;
constexpr float ALPHA = 1.4142135623730951f;
constexpr float LN_EPS = 1e-5f;
constexpr float LOG2E = 1.4426950408889634f;
constexpr int NWAVES = 8;

__device__ __forceinline__ unsigned cvtpk(float lo, float hi) { unsigned r; asm volatile("v_cvt_pk_bf16_f32 %0, %1, %2" : "=v"(r) : "v"(lo), "v"(hi)); return r; }
__device__ __forceinline__ float bflo(unsigned w) { return __uint_as_float(w << 16); }
__device__ __forceinline__ float bfhi(unsigned w) { return __uint_as_float(w & 0xffff0000u); }
__device__ __forceinline__ float ex2(float x) { return __builtin_amdgcn_exp2f(x); }
__device__ __forceinline__ float rcpf_(float x) { return __builtin_amdgcn_rcpf(x); }
__device__ __forceinline__ float sigm(float x) { return rcpf_(1.0f + ex2(-LOG2E * x)); }
typedef int v8i __attribute__((ext_vector_type(8)));
typedef int v4i __attribute__((ext_vector_type(4)));
__device__ __forceinline__ float clamp8(float x) { return __builtin_amdgcn_fmed3f(x, -448.f, 448.f); }
__device__ __forceinline__ unsigned pk4_fp8(float a, float b, float c, float d) {
    int p = __builtin_amdgcn_cvt_pk_fp8_f32(clamp8(a), clamp8(b), 0, false); p = __builtin_amdgcn_cvt_pk_fp8_f32(clamp8(c), clamp8(d), p, true); return (unsigned)p; }
__device__ __forceinline__ int lane_id() { int l; asm volatile("v_mbcnt_lo_u32_b32 %0, -1, 0\n\tv_mbcnt_hi_u32_b32 %0, -1, %0" : "=v"(l)); return l; }
#define REFRESH_F(F) do { (F).lane = lane_id(); (F).tid = (F).wave * 64 + (F).lane; } while (0)
__device__ __forceinline__ float dpp_add(float v, const int ctrl_sel) {
    int r;
    switch (ctrl_sel) { case 0: r = __builtin_amdgcn_update_dpp(0, __float_as_int(v), 0xB1, 0xf, 0xf, true); break;
                        case 1: r = __builtin_amdgcn_update_dpp(0, __float_as_int(v), 0x4E, 0xf, 0xf, true); break;
                        case 2: r = __builtin_amdgcn_update_dpp(0, __float_as_int(v), 0x141, 0xf, 0xf, true); break;
                        default: r = __builtin_amdgcn_update_dpp(0, __float_as_int(v), 0x140, 0xf, 0xf, true); break; }
    return v + __int_as_float(r);
}
__device__ __forceinline__ float wave_sum(float v) {
    v = dpp_add(v, 0); v = dpp_add(v, 1); v = dpp_add(v, 2); v = dpp_add(v, 3);
    const float r0 = __int_as_float(__builtin_amdgcn_readlane(__float_as_int(v), 0)), r1 = __int_as_float(__builtin_amdgcn_readlane(__float_as_int(v), 16)),
                r2 = __int_as_float(__builtin_amdgcn_readlane(__float_as_int(v), 32)), r3 = __int_as_float(__builtin_amdgcn_readlane(__float_as_int(v), 48));
    return (r0 + r1) + (r2 + r3);
}

namespace pg8 {
#define PG8_LAS __attribute__((address_space(3)))
typedef unsigned short bf16_t;
constexpr int BM = 256, BK = 64, HALF = 128, HTB = HALF * BK * 2, STAGE_BYTES = 8 * HTB, NXCD = 8, WGM = 8;
__host__ __device__ __forceinline__ int lds_byte(int r, int c) { const int st = (r >> 4) * 2 + (c >> 5), rr = r & 15, cc = c & 31, ob = rr * 64 + cc * 2; return st * 1024 + (ob ^ (((ob >> 9) & 1) << 5)); }
__host__ __device__ __forceinline__ void stage_rc(int b, int& R, int& C) { const int st = b / 1024, sb = b % 1024, swz = sb ^ (((sb >> 9) & 1) << 5); R = (st >> 1) * 16 + swz / 64; C = (st & 1) * 32 + (swz % 64) / 2; }
__host__ __device__ __forceinline__ int perm32(int rho) { const int n = rho >> 4, i = rho & 15; return 8 * (i >> 2) + 4 * n + (i & 3); }
struct Unit { int pm, pn; };
struct Gemm { const bf16_t* A; const bf16_t* Bt; int M, N, K; };
struct StaticOrder {
    int nM, nN, nwg, G, c;
    __host__ __device__ void init(int M, int N, int G_, int c_) { nM = M / BM; nN = N / BM; nwg = nM * nN; G = G_; c = c_; }
    __host__ __device__ bool next(int i, Unit& u) const {
        const long L = (long)i * G + c; if (L >= nwg) return false;
        int wgid = (int)L; { const int q = nwg / NXCD, r = nwg % NXCD, xcd = wgid % NXCD, off = wgid / NXCD; wgid = (xcd < r ? xcd * (q + 1) : r * (q + 1) + (xcd - r) * q) + off; }
        const int nig = WGM * nN, gid = wgid / nig, fm = gid * WGM, gsz = (nM - fm) < WGM ? (nM - fm) : WGM;
        u.pm = fm + ((wgid % nig) % gsz); u.pn = (wgid % nig) / gsz; return true;
    }
    __device__ __forceinline__ void a_ready(const Unit&) const {}
    __device__ __forceinline__ void done(const Unit&) const {}
};
struct MoeOrder {
    int nM, nN, nwg, G, c, npe; int t1, t2, t3, t4, t5, t6, t7;
    __device__ bool next(int i, Unit& u) const {
        const long L = (long)i * G + c; if (L >= nwg) return false;
        int wgid = (int)L; { const int q = nwg / NXCD, r = nwg % NXCD, xcd = wgid % NXCD, off = wgid / NXCD; wgid = (xcd < r ? xcd * (q + 1) : r * (q + 1) + (xcd - r) * q) + off; }
        const int nig = WGM * nN, gid = wgid / nig, fm = gid * WGM, gsz = (nM - fm) < WGM ? (nM - fm) : WGM;
        const int pm = fm + ((wgid % nig) % gsz), pnl = (wgid % nig) / gsz;
        const int e = (pm >= t1) + (pm >= t2) + (pm >= t3) + (pm >= t4) + (pm >= t5) + (pm >= t6) + (pm >= t7);
        u.pm = pm; u.pn = e * npe + pnl; return true;
    }
    __device__ __forceinline__ void a_ready(const Unit&) const {}
    __device__ __forceinline__ void done(const Unit&) const {}
};


struct EpiQKV {
    static constexpr bool PERM = true, AFTER_DRAIN = false;
    bf16_t* O; const float* rope; float ascale;
    __device__ __forceinline__ void operator()(const f32x4 (&acc)[2][2][4][2], const Unit& u, int wr, int wc, int fr, int fq) const {
        const int row0 = u.pm * BM + wr * 64 + fr;
        const bool rope_on = (u.pm < (RL / BM)) && (u.pn < 5);
        const int axis = wc & 1;
        const int colb = u.pn * 256 + (wc >> 1) * 128 + axis * 64 + 8 * fq;
#pragma unroll
        for (int ai = 0; ai < 2; ++ai)
#pragma unroll
            for (int m = 0; m < 4; ++m) {
                const int r = row0 + ai * HALF + m * 16;
                f32x4 a0 = acc[ai][0][m][0] * ascale, a1 = acc[ai][0][m][1] * ascale, b0 = acc[ai][1][m][0] * ascale, b1 = acc[ai][1][m][1] * ascale;
                if (rope_on) {
                    const int t = r & (SEQ - 1); const int pos = axis ? (t & 63) : (t >> 6);
                    const float* cp = rope + pos * 32 + 8 * fq;
                    const f32x4 c0 = *(const f32x4*)cp, c1 = *(const f32x4*)(cp + 4), s0 = *(const f32x4*)(cp + 2048), s1 = *(const f32x4*)(cp + 2052);
                    const f32x4 o0 = a0 * c0 - b0 * s0, o1 = a1 * c1 - b1 * s1, q0 = b0 * c0 + a0 * s0, q1 = b1 * c1 + a1 * s1;
                    a0 = o0; a1 = o1; b0 = q0; b1 = q1;
                }
                bf16_t* rowp = O + (size_t)r * QKVD + colb;
                u32x4 w; w.x = cvtpk(a0[0], a0[1]); w.y = cvtpk(a0[2], a0[3]); w.z = cvtpk(a1[0], a1[1]); w.w = cvtpk(a1[2], a1[3]);
                *(u32x4*)rowp = w;
                u32x4 v; v.x = cvtpk(b0[0], b0[1]); v.y = cvtpk(b0[2], b0[3]); v.z = cvtpk(b1[0], b1[1]); v.w = cvtpk(b1[2], b1[3]);
                *(u32x4*)(rowp + 32) = v;
            }
    }
};
template <bool LN> struct EpiResid {
    static constexpr bool PERM = true, AFTER_DRAIN = false;
    const float* xin_lat; const float* xin_ctx; bf16_t* y; const float* gate; float ascale; const f32x2* st; const float* lng; const float* lnb;
    __device__ __forceinline__ void operator()(const f32x4 (&acc)[2][2][4][2], const Unit& u, int wr, int wc, int fr, int fq) const {
        const bool lat = u.pm < (RL / BM);
        const int b = lat ? (u.pm >> 4) : 8;
        const int row0 = u.pm * BM + wr * 64 + fr, col0 = u.pn * BM + wc * 32 + 8 * fq;
        const float* xin = lat ? xin_lat + (size_t)row0 * DM : xin_ctx + (size_t)(row0 - RL) * DM;
        f32x2 sv[2][4];
        if constexpr (LN) {
#pragma unroll
            for (int ai = 0; ai < 2; ++ai)
#pragma unroll
                for (int m = 0; m < 4; ++m) sv[ai][m] = st[row0 + ai * HALF + m * 16];
        }
#pragma unroll
        for (int bj = 0; bj < 2; ++bj) { const int cc = col0 + bj * HALF;
            const f32x4 g0 = *(const f32x4*)(gate + (size_t)b * 6144 + cc) * ascale, g1 = *(const f32x4*)(gate + (size_t)b * 6144 + cc + 4) * ascale;
            f32x4 lg0, lg1, lb0, lb1; if constexpr (LN) { lg0 = *(const f32x4*)(lng + cc) * ALPHA; lg1 = *(const f32x4*)(lng + cc + 4) * ALPHA; lb0 = *(const f32x4*)(lnb + cc) * ALPHA; lb1 = *(const f32x4*)(lnb + cc + 4) * ALPHA; }
#pragma unroll
            for (int ai = 0; ai < 2; ++ai)
#pragma unroll
                for (int m = 0; m < 4; ++m) { const int rr = ai * HALF + m * 16; f32x4 x0, x1;
                    if constexpr (LN) { const u32x4 w = *(const u32x4*)(y + (size_t)(row0 + rr) * DM + cc);
                        x0 = (f32x4){bflo(w.x), bfhi(w.x), bflo(w.y), bfhi(w.y)}; x1 = (f32x4){bflo(w.z), bfhi(w.z), bflo(w.w), bfhi(w.w)};
                        x0 = (x0 - sv[ai][m].x) * sv[ai][m].y * lg0 + lb0; x1 = (x1 - sv[ai][m].x) * sv[ai][m].y * lg1 + lb1; }
                    else { x0 = *(const f32x4*)(xin + (size_t)rr * DM + cc) * ALPHA; x1 = *(const f32x4*)(xin + (size_t)rr * DM + cc + 4) * ALPHA; }
                    const f32x4 o0 = x0 + g0 * acc[ai][bj][m][0], o1 = x1 + g1 * acc[ai][bj][m][1];
                    u32x4 w; w.x = cvtpk(o0[0], o0[1]); w.y = cvtpk(o0[2], o0[3]); w.z = cvtpk(o1[0], o1[1]); w.w = cvtpk(o1[2], o1[3]);
                    *(u32x4*)(y + (size_t)(row0 + rr) * DM + cc) = w; }
            asm volatile("" ::: "memory"); }
    }
};
struct EpiSwiGLU {
    static constexpr bool PERM = true, AFTER_DRAIN = false;
    bf16_t* O; int npe;
    __device__ __forceinline__ void operator()(const f32x4 (&acc)[2][2][4][2], const Unit& u, int wr, int wc, int fr, int fq) const {
        const int row0 = u.pm * BM + wr * 64 + fr, pnl = u.pn % npe, col0 = pnl * 128 + wc * 32 + 8 * fq;
#pragma unroll
        for (int ai = 0; ai < 2; ++ai)
#pragma unroll
            for (int m = 0; m < 4; ++m) {
                unsigned w[4];
#pragma unroll
                for (int n = 0; n < 2; ++n) { const f32x4 g = acc[ai][0][m][n], uu = acc[ai][1][m][n]; float o[4];
#pragma unroll
                    for (int j = 0; j < 4; ++j) o[j] = g[j] * sigm(g[j]) * uu[j];
                    w[2 * n] = cvtpk(o[0], o[1]); w[2 * n + 1] = cvtpk(o[2], o[3]); }
                u32x4 ww; ww.x = w[0]; ww.y = w[1]; ww.z = w[2]; ww.w = w[3];
                *(u32x4*)(O + (size_t)(row0 + ai * HALF + m * 16) * DFF + col0) = ww;
            }
    }
};
struct EpiLruIn {
    static constexpr bool PERM = true, AFTER_DRAIN = false;
    bf16_t* G; bf16_t* XB;
    __device__ __forceinline__ void operator()(const f32x4 (&acc)[2][2][4][2], const Unit& u, int wr, int wc, int fr, int fq) const {
        const int row0 = u.pm * BM + wr * 64 + fr; const bool isg = u.pn < 4;
        bf16_t* base = isg ? G : XB; const int col0 = (u.pn & 3) * BM + wc * 32 + 8 * fq;
#pragma unroll
        for (int ai = 0; ai < 2; ++ai)
#pragma unroll
            for (int m = 0; m < 4; ++m)
#pragma unroll
                for (int bj = 0; bj < 2; ++bj) {
                    f32x4 v0 = acc[ai][bj][m][0], v1 = acc[ai][bj][m][1];
                    if (isg) {
                        constexpr float C0 = -2.0f * LOG2E * 0.7978845608028654f, C1 = C0 * 0.044715f;
#define GELU2(X) do { const f32x2 t_ = ((X) * (X) * C1 + C0) * (X); const f32x2 d_ = (f32x2){ex2(t_.x), ex2(t_.y)} + 1.0f; (X) = (X) * (f32x2){rcpf_(d_.x), rcpf_(d_.y)}; } while (0)
                        f32x2 a0 = __builtin_shufflevector(v0, v0, 0, 1), a1 = __builtin_shufflevector(v0, v0, 2, 3), b0 = __builtin_shufflevector(v1, v1, 0, 1), b1 = __builtin_shufflevector(v1, v1, 2, 3);
                        GELU2(a0); GELU2(a1); GELU2(b0); GELU2(b1);
#undef GELU2
                        v0 = __builtin_shufflevector(a0, a1, 0, 1, 2, 3); v1 = __builtin_shufflevector(b0, b1, 0, 1, 2, 3);
                    }
                    u32x4 w; w.x = cvtpk(v0[0], v0[1]); w.y = cvtpk(v0[2], v0[3]); w.z = cvtpk(v1[0], v1[1]); w.w = cvtpk(v1[2], v1[3]);
                    *(u32x4*)(base + (size_t)(row0 + ai * HALF + m * 16) * DM + col0 + bj * HALF) = w;
                }
    }
};
struct EpiMoeOut {
    static constexpr bool PERM = true, AFTER_DRAIN = false;
    bf16_t* O; const float* wrow;
    __device__ __forceinline__ void operator()(const f32x4 (&acc)[2][2][4][2], const Unit& u, int wr, int wc, int fr, int fq) const {
        const int row0 = u.pm * BM + wr * 64 + fr, col0 = (u.pn & 3) * BM + wc * 32 + 8 * fq;
#pragma unroll
        for (int ai = 0; ai < 2; ++ai)
#pragma unroll
            for (int m = 0; m < 4; ++m) { const int r = row0 + ai * HALF + m * 16; const float g = wrow[r];
#pragma unroll
                for (int bj = 0; bj < 2; ++bj) { const f32x4 v0 = acc[ai][bj][m][0] * g, v1 = acc[ai][bj][m][1] * g;
                    u32x4 w; w.x = cvtpk(v0[0], v0[1]); w.y = cvtpk(v0[2], v0[3]); w.z = cvtpk(v1[0], v1[1]); w.w = cvtpk(v1[2], v1[3]);
                    *(u32x4*)(O + (size_t)r * DM + col0 + bj * HALF) = w; } }
    }
};

struct EpiSwiGLU8 {
    static constexpr bool PERM = true, AFTER_DRAIN = false;
    unsigned char* O; int npe;
    __device__ __forceinline__ void operator()(const f32x4 (&acc)[2][2][4][2], const Unit& u, int wr, int wc, int fr, int fq) const {
        const int row0 = u.pm * BM + wr * 64 + fr, pnl = u.pn % npe, col0 = pnl * 128 + wc * 32 + 8 * fq;
        constexpr float C1 = -LOG2E / 512.0f, KK = 32768.0f;
#pragma unroll
        for (int ai = 0; ai < 2; ++ai)
#pragma unroll
            for (int m = 0; m < 4; ++m) {
                u32x2 w;
#pragma unroll
                for (int n = 0; n < 2; ++n) { const f32x4 g = acc[ai][0][m][n], uu = acc[ai][1][m][n];
                    const f32x2 g0 = __builtin_shufflevector(g, g, 0, 1), g1 = __builtin_shufflevector(g, g, 2, 3), u0 = __builtin_shufflevector(uu, uu, 0, 1), u1 = __builtin_shufflevector(uu, uu, 2, 3);
                    const f32x2 t0 = g0 * C1, t1 = g1 * C1;
                    const f32x2 e0 = (f32x2){ex2(t0.x), ex2(t0.y)}, e1 = (f32x2){ex2(t1.x), ex2(t1.y)};
                    const f32x2 d0 = e0 * KK + KK, d1 = e1 * KK + KK;
                    const f32x2 o0 = (g0 * u0) * (f32x2){rcpf_(d0.x), rcpf_(d0.y)}, o1 = (g1 * u1) * (f32x2){rcpf_(d1.x), rcpf_(d1.y)};
                    w[n] = pk4_fp8(o0.x, o0.y, o1.x, o1.y); }
                *(u32x2*)(O + (size_t)(row0 + ai * HALF + m * 16) * DFF + col0) = w;
            }
    }
};
struct EpiMoeOut8 {
    static constexpr bool PERM = true, AFTER_DRAIN = false;
    bf16_t* O; const float* wrow;
    __device__ __forceinline__ void operator()(const f32x4 (&acc)[2][2][4][2], const Unit& u, int wr, int wc, int fr, int fq) const {
        const int row0 = u.pm * BM + wr * 64 + fr, col0 = (u.pn & 3) * BM + wc * 32 + 8 * fq;
#pragma unroll
        for (int ai = 0; ai < 2; ++ai)
#pragma unroll
            for (int m = 0; m < 4; ++m) { const int r = row0 + ai * HALF + m * 16; const float g = wrow[r] * (1.0f / 4096.0f);
#pragma unroll
                for (int bj = 0; bj < 2; ++bj) { const f32x4 v0 = acc[ai][bj][m][0] * g, v1 = acc[ai][bj][m][1] * g;
                    u32x4 w; w.x = cvtpk(v0[0], v0[1]); w.y = cvtpk(v0[2], v0[3]); w.z = cvtpk(v1[0], v1[1]); w.w = cvtpk(v1[2], v1[3]);
                    *(u32x4*)(O + (size_t)r * DM + col0 + bj * HALF) = w; } }
    }
};

template <class Epi, class Sched, bool ALIGN_EPI = false, bool SP2 = false, bool FP8 = false>
__device__ __forceinline__ void gemm_phase(PG8_LAS unsigned char* lds, const Gemm g, const Sched& S, const Epi& E, const int wid) {
    const int lane = lane_id(), tid = wid * 64 + lane, wr = wid >> 2, wc = wid & 3, fr = lane & 15, fq = lane >> 4;
    const int K = g.K, nt = K / BK;
    unsigned voffA[2], voffB[2];
#pragma unroll
    for (int i = 0; i < 2; ++i) { int R, C; stage_rc(tid * 16 + i * 8192, R, C); const int Rb = Epi::PERM ? ((R & ~31) + perm32(R & 31)) : R;
        voffA[i] = (unsigned)(R * K + C) * 2u; voffB[i] = (unsigned)(Rb * K + C) * 2u; }
    const unsigned kstep = (unsigned)(BK * 2);
    const unsigned hstep = (unsigned)HALF * K * 2;
    const unsigned tstep = 2 * hstep;
    const __amdgpu_buffer_rsrc_t rs_voffA = __builtin_amdgcn_make_buffer_rsrc((void*)g.A, 0, -1, 0x00020000), rs_voffB = __builtin_amdgcn_make_buffer_rsrc((void*)g.Bt, 0, -1, 0x00020000);
    const unsigned ldsw = (unsigned)wid * 1024u;
    const int aoff = lds_byte(wr * 64 + fr, fq * 8), boff = lds_byte(wc * 32 + fr, fq * 8);
#define PG8_SA(b, h) (((b) * 2 + (h)) * HTB)
#define PG8_SB(b, h) ((4 + (b) * 2 + (h)) * HTB)
#define PG8_STAGE(bufoff, gbase, voff) do { _Pragma("unroll") for (int _i = 0; _i < 2; ++_i) \
        __builtin_amdgcn_raw_ptr_buffer_load_lds(rs_##voff, (PG8_LAS void*)(lds + (bufoff) + ldsw + _i * 8192), 16, (voff)[_i], (gbase), 0, 0); } while (0)
#define PG8_LDA(dst, b, h) do { if constexpr (FP8) { _Pragma("unroll") for (int m = 0; m < 4; ++m) { const v4i _l = *(const PG8_LAS v4i*)(lds + PG8_SA(b, h) + aoff + m * 2048), _h = *(const PG8_LAS v4i*)(lds + PG8_SA(b, h) + aoff + m * 2048 + 1024); \
            dst##8[m] = __builtin_shufflevector(_l, _h, 0, 1, 2, 3, 4, 5, 6, 7); } } \
        else { _Pragma("unroll") for (int m = 0; m < 4; ++m) _Pragma("unroll") for (int k = 0; k < 2; ++k) dst[m][k] = *(const PG8_LAS bf16x8*)(lds + PG8_SA(b, h) + aoff + m * 2048 + k * 1024); } } while (0)
#define PG8_LDB(dst, b, h) do { if constexpr (FP8) { _Pragma("unroll") for (int n = 0; n < 2; ++n) { const v4i _l = *(const PG8_LAS v4i*)(lds + PG8_SB(b, h) + boff + n * 2048), _h = *(const PG8_LAS v4i*)(lds + PG8_SB(b, h) + boff + n * 2048 + 1024); \
            dst##8[n] = __builtin_shufflevector(_l, _h, 0, 1, 2, 3, 4, 5, 6, 7); } } \
        else { _Pragma("unroll") for (int n = 0; n < 2; ++n) _Pragma("unroll") for (int k = 0; k < 2; ++k) dst[n][k] = *(const PG8_LAS bf16x8*)(lds + PG8_SB(b, h) + boff + n * 2048 + k * 1024); } } while (0)
#define PG8_MMA(ai, bj, At, Bt) do { if constexpr (FP8) __builtin_amdgcn_sched_barrier(0); __builtin_amdgcn_s_setprio(1); \
        if constexpr (FP8) { _Pragma("unroll") for (int m = 0; m < 4; ++m) _Pragma("unroll") for (int n = 0; n < 2; ++n) \
            acc[ai][bj][m][n] = __builtin_amdgcn_mfma_scale_f32_16x16x128_f8f6f4(Bt##8[n], At##8[m], acc[ai][bj][m][n], 0, 0, 0, 0, 0, 0); } \
        else { _Pragma("unroll") for (int m = 0; m < 4; ++m) _Pragma("unroll") for (int n = 0; n < 2; ++n) _Pragma("unroll") for (int k = 0; k < 2; ++k) \
            acc[ai][bj][m][n] = __builtin_amdgcn_mfma_f32_16x16x32_bf16(Bt[n][k], At[m][k], acc[ai][bj][m][n], 0, 0, 0); } \
        __builtin_amdgcn_s_setprio(0); if constexpr (FP8) __builtin_amdgcn_sched_barrier(0); } while (0)
#define PG8_WAIT_V(n) asm volatile("s_waitcnt vmcnt(" #n ")" ::: "memory")
#define PG8_WAIT_L(n) asm volatile("s_waitcnt lgkmcnt(" #n ")" ::: "memory")
#define PG8_BAR __builtin_amdgcn_s_barrier()
#define PG8_SCHED __builtin_amdgcn_sched_barrier(0)
    Unit cur, nxt; int ui = 0;
    if (!S.next(0, cur)) return;
    f32x4 acc[2][2][4][2];
#pragma unroll
    for (int a = 0; a < 2; ++a)
#pragma unroll
        for (int b = 0; b < 2; ++b)
#pragma unroll
            for (int m = 0; m < 4; ++m)
#pragma unroll
                for (int n = 0; n < 2; ++n) acc[a][b][m][n] = (f32x4){0.f, 0.f, 0.f, 0.f};
    bf16x8 At[4][2], B0[2][2], B1[2][2]; v8i At8[4], B08[2], B18[2];
    unsigned cA = (unsigned)cur.pm * tstep, cB = (unsigned)cur.pn * tstep;
    S.a_ready(cur);
    if constexpr (SP2) {
        PG8_STAGE(PG8_SB(0, 0), cB, voffB); PG8_STAGE(PG8_SB(0, 1), cB + hstep, voffB); PG8_STAGE(PG8_SA(0, 0), cA, voffA); PG8_STAGE(PG8_SA(0, 1), cA + hstep, voffA);
        if (wr == 1) PG8_BAR;
        PG8_WAIT_V(2); PG8_BAR;
        PG8_STAGE(PG8_SB(1, 0), cB + kstep, voffB); PG8_STAGE(PG8_SA(1, 0), cA + kstep, voffA); PG8_STAGE(PG8_SB(1, 1), cB + hstep + kstep, voffB);
        PG8_WAIT_V(6); PG8_BAR;
    } else {
        PG8_STAGE(PG8_SB(0, 0), cB, voffB); PG8_STAGE(PG8_SA(0, 0), cA, voffA); PG8_STAGE(PG8_SB(0, 1), cB + hstep, voffB); PG8_STAGE(PG8_SA(0, 1), cA + hstep, voffA);
        if (wr == 1) PG8_BAR;
        PG8_WAIT_V(4); PG8_BAR;
        PG8_STAGE(PG8_SB(1, 0), cB + kstep, voffB); PG8_STAGE(PG8_SA(1, 0), cA + kstep, voffA); PG8_STAGE(PG8_SB(1, 1), cB + hstep + kstep, voffB);
        PG8_WAIT_V(6); PG8_BAR;
    }
    for (;;) {
        const bool has_next = S.next(ui + 1, nxt);
        const unsigned nA = has_next ? (unsigned)nxt.pm * tstep : cA, nB = has_next ? (unsigned)nxt.pn * tstep : cB;
        _Pragma("clang loop unroll(disable)") for (int t = 0; t < nt; t += 2) {
            const bool last = (t == nt - 2);
            const unsigned a1 = cA + (unsigned)(t + 1) * kstep;
            const unsigned a2 = last ? nA : cA + (unsigned)(t + 2) * kstep, b2 = last ? nB : cB + (unsigned)(t + 2) * kstep;
            const unsigned a3 = a2 + kstep, b3 = b2 + kstep;
            if (last && has_next) S.a_ready(nxt);
            if constexpr (SP2) {
            PG8_LDB(B0, 0, 0); PG8_LDB(B1, 0, 1); PG8_SCHED; PG8_LDA(At, 0, 0); PG8_STAGE(PG8_SA(1, 1), a1 + hstep, voffA);
            PG8_WAIT_V(8); PG8_WAIT_L(0); PG8_BAR; PG8_MMA(0, 0, At, B0); PG8_MMA(0, 1, At, B1); PG8_BAR; PG8_SCHED;
            PG8_LDA(At, 0, 1); PG8_STAGE(PG8_SB(0, 0), b2, voffB); PG8_STAGE(PG8_SB(0, 1), b2 + hstep, voffB); PG8_STAGE(PG8_SA(0, 0), a2, voffA);
            PG8_WAIT_V(8); PG8_WAIT_L(0); PG8_BAR; PG8_MMA(1, 0, At, B0); PG8_MMA(1, 1, At, B1); PG8_BAR; PG8_SCHED;
            PG8_LDB(B0, 1, 0); PG8_LDB(B1, 1, 1); PG8_SCHED; PG8_LDA(At, 1, 0); PG8_STAGE(PG8_SA(0, 1), a2 + hstep, voffA);
            PG8_WAIT_V(8); PG8_WAIT_L(0); PG8_BAR; PG8_MMA(0, 0, At, B0); PG8_MMA(0, 1, At, B1); PG8_BAR; PG8_SCHED;
            PG8_LDA(At, 1, 1); PG8_STAGE(PG8_SB(1, 0), b3, voffB); PG8_STAGE(PG8_SB(1, 1), b3 + hstep, voffB); PG8_STAGE(PG8_SA(1, 0), a3, voffA);
            PG8_WAIT_V(8); PG8_WAIT_L(0); PG8_BAR; PG8_MMA(1, 0, At, B0); PG8_MMA(1, 1, At, B1); PG8_BAR; PG8_SCHED;
            } else {
            PG8_LDB(B0, 0, 0); PG8_SCHED; PG8_LDA(At, 0, 0); PG8_STAGE(PG8_SA(1, 1), a1 + hstep, voffA);
            PG8_WAIT_L(8); PG8_BAR; PG8_WAIT_L(0); PG8_MMA(0, 0, At, B0); PG8_BAR; PG8_SCHED;
            PG8_LDB(B1, 0, 1); PG8_STAGE(PG8_SB(0, 0), b2, voffB);
            PG8_BAR; PG8_WAIT_L(0); PG8_MMA(0, 1, At, B1); PG8_BAR;
            PG8_LDA(At, 0, 1); PG8_STAGE(PG8_SA(0, 0), a2, voffA);
            PG8_BAR; PG8_WAIT_L(0); PG8_MMA(1, 0, At, B0); PG8_BAR; PG8_SCHED;
            PG8_STAGE(PG8_SB(0, 1), b2 + hstep, voffB);
            PG8_WAIT_V(6); PG8_BAR; PG8_MMA(1, 1, At, B1); PG8_BAR;
            PG8_LDB(B0, 1, 0); PG8_SCHED; PG8_LDA(At, 1, 0); PG8_STAGE(PG8_SA(0, 1), a2 + hstep, voffA);
            PG8_WAIT_L(8); PG8_BAR; PG8_WAIT_L(0); PG8_MMA(0, 0, At, B0); PG8_BAR; PG8_SCHED;
            PG8_LDB(B1, 1, 1); PG8_STAGE(PG8_SB(1, 0), b3, voffB);
            PG8_BAR; PG8_WAIT_L(0); PG8_MMA(0, 1, At, B1); PG8_BAR;
            PG8_LDA(At, 1, 1); PG8_STAGE(PG8_SA(1, 0), a3, voffA);
            PG8_BAR; PG8_WAIT_L(0); PG8_MMA(1, 0, At, B0); PG8_BAR; PG8_SCHED;
            PG8_STAGE(PG8_SB(1, 1), b3 + hstep, voffB);
            PG8_WAIT_V(6); PG8_BAR; PG8_MMA(1, 1, At, B1); PG8_BAR;
            }
        }
        if constexpr (ALIGN_EPI) { if (wr == 0) PG8_BAR; }
        if constexpr (!Epi::AFTER_DRAIN) { int le = lane_id();
            E(acc, cur, wr, wc, le & 15, le >> 4); S.done(cur); }
        if (!has_next) break;
#pragma unroll
        for (int a = 0; a < 2; ++a)
#pragma unroll
            for (int b = 0; b < 2; ++b)
#pragma unroll
                for (int m = 0; m < 4; ++m)
#pragma unroll
                    for (int n = 0; n < 2; ++n) acc[a][b][m][n] = (f32x4){0.f, 0.f, 0.f, 0.f};
        cur = nxt; cA = nA; cB = nB; ++ui;
        if constexpr (ALIGN_EPI) { if (wr == 1) PG8_BAR; }
    }
    PG8_WAIT_V(0);
    if constexpr (!ALIGN_EPI) { if (wr == 0) PG8_BAR; }
    PG8_BAR;
    if constexpr (Epi::AFTER_DRAIN) { E.fused(acc, cur, wr, wc, fr, fq, lds, wid, lane); S.done(cur); }
#undef PG8_SA
#undef PG8_SB
#undef PG8_STAGE
#undef PG8_LDA
#undef PG8_LDB
#undef PG8_MMA
#undef PG8_WAIT_V
#undef PG8_WAIT_L
#undef PG8_BAR
#undef PG8_SCHED
}
}

constexpr size_t MiB = 1u << 20;
constexpr size_t WS_CTL = 0, CTL_ZERO_BYTES = 65536;
constexpr size_t WS_MOD = 65536;
constexpr size_t WS_ROPE = 65536 + 458752;
constexpr size_t WS_WQKV = 1 * MiB, WS_WO = 4 * MiB, WS_WGU = 6 * MiB, WS_WDN = 20 * MiB, WS_WIN = 27 * MiB, WS_WOUT = 31 * MiB, WS_WLG = 33 * MiB;
constexpr size_t WS_WMGU = 34 * MiB, WS_WMDN = 146 * MiB;
constexpr size_t WS_YB = 760 * MiB;
constexpr size_t WS_H = 210 * MiB;
constexpr size_t WS_ACTV = 278 * MiB;
constexpr size_t WS_QKV = WS_ACTV, WS_O = WS_ACTV + 102 * MiB, WS_ACT = WS_ACTV + 170 * MiB;
constexpr size_t WS_G = WS_ACTV, WS_XB = WS_ACTV + 68 * MiB, WS_HF = WS_ACTV + 136 * MiB, WS_HH = WS_ACTV + 200 * MiB;
constexpr size_t WS_U = WS_ACTV + 264 * MiB;
constexpr size_t WS_HS = WS_ACTV, WS_FO = WS_ACTV + 68 * MiB, WS_MACT = WS_ACTV + 200 * MiB;
constexpr size_t WS_ROUTE = 872 * MiB;
constexpr size_t WS_LRUS = 874 * MiB;
constexpr size_t WS_END = 875 * MiB;
constexpr int MOE_MAXT = 264;
constexpr size_t RT_EIDX = 0, RT_WGT = 262144, RT_SLOT = 524288, RT_WS = 786432, RT_CNT = 786432 + 270336 + 0;
constexpr size_t LS_SUM = 0, LS_CTX = 524288;
constexpr size_t WS_STATS = WS_LRUS + 655360;

constexpr int RING_OFF = 0, RING_BYTES = 135168;
constexpr int LDSCTL_OFF = RING_BYTES, MISC_OFF = LDSCTL_OFF + 320;
constexpr int LDS_BYTES = 136192;

#define RLX_AGENT __ATOMIC_RELAXED, __HIP_MEMORY_SCOPE_AGENT
#define LDS_WAIT() asm volatile("s_waitcnt lgkmcnt(0)" ::: "memory")
#define VM_WAIT() asm volatile("s_waitcnt vmcnt(0)" ::: "memory")
#define XB_TMO      128
#define XB_XCNT(j)  (256  + 64 * (j))
#define XB_XSUB(j)  (1280 + 64 * (j))
#define XB_XGEN(j)  (2304 + 64 * (j))
#define XB_TOP      3328
#define XB_TOPGEN   3392
#define XCD_BAR_WORDS 3456
#define XB_SPIN_CAP (1u << 18)

__device__ __forceinline__ unsigned xb_ld(unsigned* p)              { return __hip_atomic_load(p, __ATOMIC_RELAXED, __HIP_MEMORY_SCOPE_AGENT); }
__device__ __forceinline__ unsigned xb_add(unsigned* p, unsigned v) { return __hip_atomic_fetch_add(p, v, __ATOMIC_RELAXED, __HIP_MEMORY_SCOPE_AGENT); }
__device__ __forceinline__ unsigned xb_xcc_id() { return (unsigned)__builtin_amdgcn_s_getreg((3 << 11) | 20) & 0xFu; }
#define XB_SPIN(cond, bar) do { unsigned _sp = 0; while (cond) { __builtin_amdgcn_s_sleep(1); \
    if ((++_sp & 255u) == 0u) { if (xb_ld(&(bar)[XB_TMO])) break; if (_sp > XB_SPIN_CAP) { atomicAdd(&(bar)[XB_TMO], 1u); break; } } } } while (0)

struct XcdBarrier {
    unsigned* bar; unsigned x;
    volatile LAS unsigned* st;
};

__device__ __forceinline__ XcdBarrier xcd_barrier_post(unsigned* bar, volatile LAS unsigned* st, const bool t0  ) {
    XcdBarrier b; b.bar = bar; b.x = xb_xcc_id(); b.st = st;
    if (t0) (void)xb_add(&bar[XB_XCNT(b.x)], 1u);
    return b;
}
__device__ __forceinline__ void xcd_barrier_complete(unsigned* bar, unsigned x, unsigned& nloc, unsigned& nx) {
    const unsigned G = gridDim.x * gridDim.y * gridDim.z;
    unsigned sum, cnt, mine, sp = 0u;
    for (;;) {
        sum = 0u; cnt = 0u; mine = 0u;
#pragma unroll
        for (unsigned j = 0; j < 16; ++j) { const unsigned c = xb_ld(&bar[XB_XCNT(j)]); sum += c; cnt += (c > 0u) ? 1u : 0u; mine = (j == x) ? c : mine; }
        if (sum == G) break;
        __builtin_amdgcn_s_sleep(1);
        if ((++sp & 255u) == 0u) { if (xb_ld(&bar[XB_TMO])) break; if (sp > XB_SPIN_CAP) { atomicAdd(&bar[XB_TMO], 1u); break; } }
    }
    nloc = mine > 0u ? mine : 1u; nx = cnt > 0u ? cnt : 1u;
}

__device__ __forceinline__ void xcd_barrier(const XcdBarrier& b, const bool t0  ) {
    asm volatile("s_waitcnt vmcnt(0)" ::: "memory");
    __syncthreads();
    if (t0) {
        unsigned* bar = b.bar;
        __builtin_amdgcn_s_waitcnt(0);
        unsigned nloc = b.st[0], nx = b.st[1];
        if (nloc == 0u) { xcd_barrier_complete(bar, b.x, nloc, nx); b.st[0] = nloc; b.st[1] = nx; }
        const unsigned old = xb_add(&bar[XB_XSUB(b.x)], 1u);
        const unsigned gen = old / nloc;
        if (old + 1u == (gen + 1u) * nloc) {
            __builtin_amdgcn_fence(__ATOMIC_RELEASE, "agent");
            asm volatile("s_waitcnt vmcnt(0)" ::: "memory");
            const unsigned og = xb_add(&bar[XB_TOP], 1u);
            const unsigned tg = og / nx;
            if (og + 1u == (tg + 1u) * nx) xb_add(&bar[XB_TOPGEN], 1u);
            else XB_SPIN(xb_ld(&bar[XB_TOPGEN]) == tg, bar);
            __builtin_amdgcn_fence(__ATOMIC_ACQUIRE, "agent");
            xb_add(&bar[XB_XGEN(b.x)], 1u);
            asm volatile("s_waitcnt vmcnt(0)" ::: "memory");
        } else {
            XB_SPIN(xb_ld(&bar[XB_XGEN(b.x)]) == gen, bar);
            __builtin_amdgcn_fence(__ATOMIC_ACQUIRE, "agent");
            asm volatile("s_waitcnt vmcnt(0)" ::: "memory");
        }
    }
    __syncthreads();
}


struct Frame {
    LAS unsigned char* lds;
    volatile LAS unsigned* MISC;
    int tid, lane, wave, vcu, G;
    const float *x, *c, *ctx, *cctx, *w_mod, *b_mod, *ln_g, *ln_b, *w_qkv, *w_o, *sink, *w_gu, *w_dn, *w_in, *conv_w, *conv_b, *lam, *w_r, *b_r, *w_i, *b_i, *w_out, *router, *mw_gu, *mw_dn;
    float* out; unsigned char* ws;
};
#define WSP(T, off) ((T*)(F.ws + (off)))

__device__ __forceinline__ void p0_mod_task(Frame& F, int task) {
    const int li = task / 96, cb = task % 96;
    LAS float* S = (LAS float*)F.lds;
    LAS float* red = (LAS float*)(F.lds + 36864);
    for (int idx = F.tid; idx < 9 * 1024; idx += NWAVES * 64) { const int b = idx >> 10, k = idx & 1023; const float v = (b < 8) ? F.c[b * 1024 + k] : F.cctx[k]; S[idx] = v * sigm(v); }
    __syncthreads();
    const float* W = F.w_mod + (size_t)li * 1024 * 6144 + cb * 64;
    const int cl = F.lane & 15, kr = F.lane >> 4;
    f32x4 acc[9];
#pragma unroll
    for (int b = 0; b < 9; ++b) acc[b] = (f32x4){0.f, 0.f, 0.f, 0.f};
#pragma unroll 4
    for (int kk = 0; kk < 32; ++kk) { const int k = 128 * F.wave + 4 * kk + kr; const f32x4 wv = *(const f32x4*)(W + (size_t)k * 6144 + 4 * cl);
#pragma unroll
        for (int b = 0; b < 9; ++b) acc[b] += wv * S[b * 1024 + k]; }
#pragma unroll
    for (int b = 0; b < 9; ++b)
#pragma unroll
        for (int j = 0; j < 4; ++j) { float v = acc[b][j]; v += __shfl_xor(v, 16); v += __shfl_xor(v, 32); acc[b][j] = v; }
    if (kr == 0) {
#pragma unroll
        for (int b = 0; b < 9; ++b) *(LAS f32x4*)(red + (F.wave * 9 + b) * 64 + 4 * cl) = acc[b]; }
    __syncthreads();
    float* mod = WSP(float, WS_MOD);
    for (int idx = F.tid; idx < 9 * 64; idx += NWAVES * 64) { const int b = idx >> 6, col = idx & 63; float s = 0.f;
#pragma unroll
        for (int w = 0; w < 8; ++w) s += red[(w * 9 + b) * 64 + col];
        mod[(size_t)(li * 9 + b) * 6144 + cb * 64 + col] = s + F.b_mod[li * 6144 + cb * 64 + col]; }
    __syncthreads();
}
__device__ __forceinline__ void p0_transpose_item(const float* W, int K, int N, bf16* WT, int kb, int n0, int drow0, LAS float* scr, int lane) {
    const int k0 = 64 * kb;
#pragma unroll
    for (int i = 0; i < 8; ++i) { const int kk = 8 * i + (lane >> 3); const f32x4 wv = *(const f32x4*)(W + (size_t)(k0 + kk) * N + n0 + 4 * (lane & 7));
        LAS float* d = scr + kk * 33 + 4 * (lane & 7); d[0] = wv[0]; d[1] = wv[1]; d[2] = wv[2]; d[3] = wv[3]; }
    LDS_WAIT(); asm volatile("" ::: "memory");
    const int c = lane & 7;
#pragma unroll
    for (int j = 0; j < 4; ++j) { const int n = (lane >> 3) + 8 * j; const LAS float* s = scr + (8 * c) * 33 + n;
        u32x4 o; o.x = cvtpk(s[0 * 33], s[1 * 33]); o.y = cvtpk(s[2 * 33], s[3 * 33]); o.z = cvtpk(s[4 * 33], s[5 * 33]); o.w = cvtpk(s[6 * 33], s[7 * 33]);
        *(GAS u32x4*)(WT + (size_t)(drow0 + n) * K + k0 + 8 * c) = o; }
    LDS_WAIT(); asm volatile("" ::: "memory");
}
template <int QS> __device__ __forceinline__ void p0_transpose_item8(const float* W, int K, int N, unsigned char* WT, int kb, int n0, int drow0, LAS float* scr, int lane) {
    const int k0 = 64 * kb; constexpr float qs = (float)(1 << QS);
#pragma unroll
    for (int i = 0; i < 8; ++i) { const int kk = 8 * i + (lane >> 3); const f32x4 wv = *(const f32x4*)(W + (size_t)(k0 + kk) * N + n0 + 4 * (lane & 7)) * qs;
        LAS float* d = scr + kk * 33 + 4 * (lane & 7); d[0] = wv[0]; d[1] = wv[1]; d[2] = wv[2]; d[3] = wv[3]; }
    LDS_WAIT(); asm volatile("" ::: "memory");
    const int c = lane & 7;
#pragma unroll
    for (int j = 0; j < 4; ++j) { const int n = (lane >> 3) + 8 * j; const LAS float* s = scr + (8 * c) * 33 + n;
        u32x2 o; o.x = pk4_fp8(s[0 * 33], s[1 * 33], s[2 * 33], s[3 * 33]); o.y = pk4_fp8(s[4 * 33], s[5 * 33], s[6 * 33], s[7 * 33]);
        *(GAS u32x2*)(WT + (size_t)(drow0 + n) * K + k0 + 8 * c) = o; }
    LDS_WAIT(); asm volatile("" ::: "memory");
}
__device__ __forceinline__ int gu_row(int j) { const int isu = j >= DFF, jj = isu ? j - DFF : j; return (jj >> 7) * 256 + isu * 128 + (jj & 127); }
__device__ __forceinline__ int qkv_row(int L) { const int pn = L >> 8, rem = L & 255, hsel = rem >> 7, axis = (rem >> 6) & 1, half = (rem >> 5) & 1, x = rem & 31; return pn * 256 + 128 * half + 32 * (2 * hsel + axis) + x; }

__device__ __forceinline__ void p0_prologue(Frame& F) {
    for (int task = F.vcu; task < 192; task += F.G) p0_mod_task(F, task);
    if (F.vcu == F.G - 1) {
        float* rope = WSP(float, WS_ROPE);
        for (int idx = F.tid; idx < 2048; idx += NWAVES * 64) { const int pos = idx >> 5, i = idx & 31;
            const double freq = exp2(-(double)i * (13.287712379549449 / 32.0));
            const float ang = (float)pos * (float)freq;
            double rev = (double)ang * 0.15915494309189535; rev -= floor(rev);
            rope[idx] = __builtin_amdgcn_cosf((float)rev); rope[2048 + idx] = __builtin_amdgcn_sinf((float)rev); }
    }
    LAS float* scr = (LAS float*)(F.lds + F.wave * 8704);
    const int gw = F.vcu * NWAVES + F.wave, NGW = F.G * NWAVES;
    constexpr int I_QKV = 16 * 48;
    for (int r = gw; r < I_QKV; r += NGW) { const int kb = r / 48, n0 = (r % 48) * 32; p0_transpose_item8<7>(F.w_qkv, 1024, 1536, WSP(unsigned char, WS_WQKV), kb, n0, qkv_row(n0), scr, F.lane); }
}

constexpr int MOE_I_GU = 16 * 224, MOE_I_DN = 56 * 32, MOE_ITEMS = 8 * (MOE_I_GU + MOE_I_DN);
constexpr int DR_O = 16 * 32, DR_GU = 16 * 224, DR_DN = 56 * 32, DR_IN = 16 * 64, DR_OUT = 16 * 32, DR_LG = 32 * 8, DR_ITEMS = DR_O + DR_GU + DR_DN + DR_IN + DR_OUT + DR_LG;
constexpr int CV_ITEMS = DR_ITEMS + MOE_ITEMS;
__device__ __forceinline__ void moe_convert_items(Frame& F, int lo, int hi, int rank, int nranks) {
    LAS float* scr = (LAS float*)(F.lds + F.wave * 8704);
    for (int it0 = lo + rank * NWAVES + F.wave; it0 < hi; it0 += nranks * NWAVES) {
        int r = it0;
        if (r < DR_O) { const int kb = r / 32, n0 = (r % 32) * 32; p0_transpose_item8<7>(F.w_o, 1024, 1024, WSP(unsigned char, WS_WO), kb, n0, n0, scr, F.lane); continue; } r -= DR_O;
        if (r < DR_GU) { const int kb = r / 224, n0 = (r % 224) * 32; p0_transpose_item8<7>(F.w_gu, 1024, 7168, WSP(unsigned char, WS_WGU), kb, n0, gu_row(n0), scr, F.lane); continue; } r -= DR_GU;
        if (r < DR_DN) { const int kb = r / 32, n0 = (r % 32) * 32; p0_transpose_item8<9>(F.w_dn, 3584, 1024, WSP(unsigned char, WS_WDN), kb, n0, n0, scr, F.lane); continue; } r -= DR_DN;
        if (r < DR_IN) { const int kb = r / 64, n0 = (r % 64) * 32; p0_transpose_item(F.w_in, 1024, 2048, WSP(bf16, WS_WIN), kb, n0, n0, scr, F.lane); continue; } r -= DR_IN;
        if (r < DR_OUT) { const int kb = r / 32, n0 = (r % 32) * 32; p0_transpose_item(F.w_out, 1024, 1024, WSP(bf16, WS_WOUT), kb, n0, n0, scr, F.lane); continue; } r -= DR_OUT;
        if (r < DR_LG) { const int mi = r >> 3, sub = r & 7, which = mi >> 4, d = (mi >> 3) & 1, n = mi & 7, kb = sub >> 2, n0 = (sub & 3) * 32;
            p0_transpose_item((which ? F.w_i : F.w_r) + (size_t)(d * 8 + n) * 16384, 128, 128, WSP(bf16, WS_WLG) + (size_t)(n * 4 + 2 * d + which) * 16384, kb, n0, n0, scr, F.lane); continue; } r -= DR_LG;
        if (r < 8 * MOE_I_GU) { const int e = r / MOE_I_GU, q = r % MOE_I_GU, kb = q / 224, n0 = (q % 224) * 32;
            p0_transpose_item8<7>(F.mw_gu + (size_t)e * 1024 * 7168, 1024, 7168, WSP(unsigned char, WS_WMGU) + (size_t)e * 7168 * 1024, kb, n0, gu_row(n0), scr, F.lane); }
        else { r -= 8 * MOE_I_GU; const int e = r / MOE_I_DN, q = r % MOE_I_DN, kb = q / 32, n0 = (q % 32) * 32;
            p0_transpose_item8<9>(F.mw_dn + (size_t)e * 3584 * 1024, 3584, 1024, WSP(unsigned char, WS_WMDN) + (size_t)e * 1024 * 3584, kb, n0, n0, scr, F.lane); }
    }
}
__device__ __forceinline__ void moe_convert_filler(Frame& F, int nwg, int c, int lo, int hi) {
    const int R = (nwg + F.G - 1) / F.G, rem = nwg - (R - 1) * F.G;
    if (rem >= F.G) { moe_convert_items(F, lo, hi, c, F.G); return; }
    if (c >= rem) { REFRESH_F(F); moe_convert_items(F, lo, hi, c - rem, F.G - rem); }
}
__device__ __forceinline__ void row_load(f32x4 (&v)[4], const float* p, int lane) {
#pragma unroll
    for (int j = 0; j < 4; ++j) v[j] = *(const f32x4*)(p + 4 * lane + 256 * j);
}
__device__ __forceinline__ void row_load_bf(f32x4 (&v)[4], const bf16* p, int lane) {
#pragma unroll
    for (int j = 0; j < 4; ++j) { const u32x2 w = *(const u32x2*)(p + 4 * lane + 256 * j); v[j] = (f32x4){bflo(w.x), bfhi(w.x), bflo(w.y), bfhi(w.y)}; }
}
__device__ __forceinline__ void row_store(const f32x4 (&v)[4], float* p, int lane) {
#pragma unroll
    for (int j = 0; j < 4; ++j) *(f32x4*)(p + 4 * lane + 256 * j) = v[j];
}
struct Vec16 { f32x4 q[4]; };
__device__ __forceinline__ Vec16 vec_load(const float* p, int lane) { Vec16 r;
#pragma unroll
    for (int j = 0; j < 4; ++j) r.q[j] = *(const f32x4*)(p + 4 * lane + 256 * j);
    return r; }
__device__ __forceinline__ f32x2 row_ln_v(f32x4 (&v)[4], const Vec16& g, const Vec16& bt) {
    float s = 0.f;
#pragma unroll
    for (int j = 0; j < 4; ++j) s += (v[j].x + v[j].y) + (v[j].z + v[j].w);
    const float mean = wave_sum(s) * (1.f / DM); float s2 = 0.f;
#pragma unroll
    for (int j = 0; j < 4; ++j) { v[j] = v[j] - mean; s2 += (v[j].x * v[j].x + v[j].y * v[j].y) + (v[j].z * v[j].z + v[j].w * v[j].w); }
    const float rstd = 1.f / sqrtf(wave_sum(s2) * (1.f / DM) + LN_EPS);
#pragma unroll
    for (int j = 0; j < 4; ++j) v[j] = v[j] * rstd * g.q[j] + bt.q[j];
    return (f32x2){mean, rstd};
}
template <bool H8> __device__ __forceinline__ void row_mod_store_v(const f32x4 (&v)[4], const Vec16& sh, const Vec16& sc, void* hbase, size_t r, int lane) {
#pragma unroll
    for (int j = 0; j < 4; ++j) { const f32x4 h = v[j] * (sc.q[j] + 1.0f) + sh.q[j];
        if constexpr (H8) *(unsigned*)((unsigned char*)hbase + r * DM + 4 * lane + 256 * j) = pk4_fp8(h[0] * 4.f, h[1] * 4.f, h[2] * 4.f, h[3] * 4.f);
        else { u32x2 w; w.x = cvtpk(h[0], h[1]); w.y = cvtpk(h[2], h[3]); *(u32x2*)((bf16*)hbase + r * DM + 4 * lane + 256 * j) = w; } }
}
#define ROWS_LAT(...) do { const int nwb_ = NGW / 8; if (nwb_ > 0 && gw < 8 * nwb_) { const int b = gw / nwb_, nwin_ = (SEQ + nwb_ - 1) / nwb_; \
    for (int i_ = 0; i_ < nwin_; ++i_) { const int r = b * SEQ + ((i_ + 2 * b) % nwin_) * nwb_ + gw % nwb_;     \
        if (r < (b + 1) * SEQ) { __VA_ARGS__ } } } } while (0)
#define ROWS_CTX(...) do { const int b = 8; for (int r = RL + gw; r < RT; r += NGW) { __VA_ARGS__ } } while (0)
__device__ __forceinline__ void p1_modulate(Frame& F) {
    const int gw = F.vcu * NWAVES + F.wave, NGW = F.G * NWAVES; const float* mod = WSP(float, WS_MOD); bf16* H = WSP(bf16, WS_H);
    { const int bb = gw / (NGW / 8) < 8 ? gw / (NGW / 8) : 7; const Vec16 sh = vec_load(mod + (size_t)bb * 6144, F.lane), sc = vec_load(mod + (size_t)bb * 6144 + 1024, F.lane);
      ROWS_LAT( (void)b; f32x4 v[4]; row_load(v, F.x + (size_t)r * DM, F.lane); row_mod_store_v<true>(v, sh, sc, H, (size_t)r, F.lane); ); }
    { const Vec16 sh = vec_load(mod + (size_t)8 * 6144, F.lane), sc = vec_load(mod + (size_t)8 * 6144 + 1024, F.lane);
      ROWS_CTX( (void)b; f32x4 v[4]; row_load(v, F.ctx + (size_t)(r - RL) * DM, F.lane); row_mod_store_v<true>(v, sh, sc, H, (size_t)r, F.lane); ); }
}
template <bool H8> __device__ __forceinline__ void ln_mod_pass(Frame& F, bool with_ctx, const float* g, const float* bt, int ml, int cs) {
    const int gw = F.vcu * NWAVES + F.wave, NGW = F.G * NWAVES; const float* mod = WSP(float, WS_MOD) + (size_t)ml * 9 * 6144; bf16* H = WSP(bf16, WS_H); const bf16* YB = WSP(bf16, WS_YB);
    const Vec16 gv = vec_load(g, F.lane), bv = vec_load(bt, F.lane);
    { const int bb = gw / (NGW / 8) < 8 ? gw / (NGW / 8) : 7; const Vec16 sh = vec_load(mod + (size_t)bb * 6144 + cs, F.lane), sc = vec_load(mod + (size_t)bb * 6144 + cs + 1024, F.lane);
      ROWS_LAT( (void)b; f32x4 v[4]; row_load_bf(v, YB + (size_t)r * DM, F.lane); const f32x2 sv = row_ln_v(v, gv, bv); if (F.lane == 0) ((f32x2*)(F.ws + WS_STATS))[r] = sv;
                row_mod_store_v<H8>(v, sh, sc, H, (size_t)r, F.lane); ); }
    if (with_ctx) { const Vec16 sh = vec_load(mod + (size_t)8 * 6144 + cs, F.lane), sc = vec_load(mod + (size_t)8 * 6144 + cs + 1024, F.lane);
      ROWS_CTX( (void)b; f32x4 v[4]; row_load_bf(v, YB + (size_t)r * DM, F.lane); const f32x2 sv = row_ln_v(v, gv, bv); if (F.lane == 0) ((f32x2*)(F.ws + WS_STATS))[r] = sv;
                row_mod_store_v<H8>(v, sh, sc, H, (size_t)r, F.lane); ); }
}

namespace att {
constexpr float SCALE = 0.08838834764831845f, THR = 8.f;
constexpr int SHM_V = 64 * 128 * 2, SHM_K = 64 * 128 * 2;
#define KSWZ(row, colB) ((row) * 256 + ((colB) ^ (((row) & 7) << 4)))
#define SBAR() __builtin_amdgcn_sched_barrier(0)
__device__ __forceinline__ int crow(int r, int hi) { return (r & 3) + 8 * (r >> 2) + 4 * hi; }
__device__ __forceinline__ float psm_max(const f32x16& p) {
    float a = fmaxf(fmaxf(p[0], p[1]), p[2]), b = fmaxf(fmaxf(p[3], p[4]), p[5]), c = fmaxf(fmaxf(p[6], p[7]), p[8]), d = fmaxf(fmaxf(p[9], p[10]), p[11]);
    a = fmaxf(fmaxf(a, p[12]), p[13]); b = fmaxf(fmaxf(b, p[14]), p[15]); return fmaxf(fmaxf(fmaxf(a, b), c), d);
}
__device__ __forceinline__ void psm_mask(f32x16& p0, f32x16& p1, int d0) {
#pragma unroll
    for (int r = 0; r < 16; ++r) { const int rel = d0 + (r & 3) + 8 * (r >> 2);
        p0[r] = ((unsigned)(rel + 128) <= 256u) ? p0[r] : -1e30f; p1[r] = ((unsigned)(rel + 160) <= 256u) ? p1[r] : -1e30f; }
}
__device__ __forceinline__ void partialSM(f32x16& p0, f32x16& p1, float& m_reg, float& mn, float& alpha, bool domask, int d0) {
    constexpr float C = SCALE * 1.4426950408889634f;
    if (domask) psm_mask(p0, p1, d0);
    float pmax = fmaxf(psm_max(p0), psm_max(p1));
    { auto rr = __builtin_amdgcn_permlane32_swap(__float_as_uint(pmax), __float_as_uint(pmax), false, false);
      pmax = fmaxf(__uint_as_float(rr[0]), __uint_as_float(rr[1])); }
    mn = (pmax - m_reg > THR / SCALE) ? pmax : m_reg; alpha = ex2((m_reg - mn) * C); m_reg = mn;
    const float mnC = -mn * C;
    p0 = p0 * C + mnC; p1 = p1 * C + mnC;
#pragma unroll
    for (int r = 0; r < 16; ++r) p0[r] = ex2(p0[r]);
}
__device__ __forceinline__ void finishSM(f32x16& p0, f32x16& p1, float alpha, float& l_reg, bf16x8& pa0, bf16x8& pa1, bf16x8& pa2, bf16x8& pa3) {
#pragma unroll
    for (int r = 0; r < 16; ++r) p1[r] = ex2(p1[r]);
    f32x2 s2 = (f32x2){0.f, 0.f};
#pragma unroll
    for (int r = 0; r < 16; r += 2) s2 += (f32x2){p0[r], p0[r + 1]} + (f32x2){p1[r], p1[r + 1]};
    float ps = s2.x + s2.y;
    { auto rr = __builtin_amdgcn_permlane32_swap(__float_as_uint(ps), __float_as_uint(ps), false, false);
      ps = __uint_as_float(rr[0]) + __uint_as_float(rr[1]); }
    l_reg = l_reg * alpha + ps;
#define PK4(P, BASE, OUT) do { unsigned a0 = cvtpk(P[BASE + 0], P[BASE + 1]), a1 = cvtpk(P[BASE + 2], P[BASE + 3]);   \
    unsigned b0 = cvtpk(P[BASE + 4], P[BASE + 5]), b1 = cvtpk(P[BASE + 6], P[BASE + 7]);                              \
    auto r0 = __builtin_amdgcn_permlane32_swap(a0, b0, false, false); auto r1 = __builtin_amdgcn_permlane32_swap(a1, b1, false, false); \
    u32x4 w = {r0[0], r1[0], r0[1], r1[1]}; OUT = __builtin_bit_cast(bf16x8, w); } while (0)
    PK4(p0, 0, pa0); PK4(p0, 8, pa1); PK4(p1, 0, pa2); PK4(p1, 8, pa3);
#undef PK4
}
__device__ __forceinline__ void qkt(f32x16& p0, f32x16& p1, LAS const unsigned char* Ks, const bf16x8* qr, int r32, int hi) {
    p0 = f32x16{}; p1 = f32x16{};
#pragma unroll
    for (int d0 = 0; d0 < 8; ++d0) { const int cb = (d0 * 16 + hi * 8) * 2;
        const bf16x8 b0 = *(LAS const bf16x8*)(Ks + KSWZ(r32, cb));
        const bf16x8 b1 = *(LAS const bf16x8*)(Ks + KSWZ(32 + r32, cb));
        p0 = __builtin_amdgcn_mfma_f32_32x32x16_bf16(b0, qr[d0], p0, 0, 0, 0);
        p1 = __builtin_amdgcn_mfma_f32_32x32x16_bf16(b1, qr[d0], p1, 0, 0, 0); }
}
__device__ __forceinline__ int v_st(int k, int c) { const int kk = (k & ~0xC) | ((k & 4) << 1) | ((k & 8) >> 1); return ((kk >> 3) * 4 + (c >> 5)) * 512 + ((kk & 7) * 32 + (c & 31)) * 2; }
__device__ __forceinline__ int v_rd_base(int lane) { return ((lane & 3) << 3) | (((lane >> 2) & 3) << 6) | (((lane >> 4) & 1) << 5) | (((lane >> 5) & 1) << 8); }
constexpr int v_rd_off(int d0, int ks, int half) { return d0 * 512 + ks * 4096 + half * 2048; }
template <int OFF> __device__ __forceinline__ s16x4 tr_read(int vb) {
    s16x4 r; asm volatile("ds_read_b64_tr_b16 %0, %1 offset:%2" : "=&v"(r) : "v"(vb), "i"(OFF) : "memory"); return r;
}
template <int D0> __device__ __forceinline__ void pv_one(f32x16& od, int vb, bf16x8 pa0, bf16x8 pa1, bf16x8 pa2, bf16x8 pa3) {
    const s16x4 l0 = tr_read<v_rd_off(D0, 0, 0)>(vb), h0 = tr_read<v_rd_off(D0, 0, 1)>(vb), l1 = tr_read<v_rd_off(D0, 1, 0)>(vb), h1 = tr_read<v_rd_off(D0, 1, 1)>(vb);
    const s16x4 l2 = tr_read<v_rd_off(D0, 2, 0)>(vb), h2 = tr_read<v_rd_off(D0, 2, 1)>(vb), l3 = tr_read<v_rd_off(D0, 3, 0)>(vb), h3 = tr_read<v_rd_off(D0, 3, 1)>(vb);
    asm volatile("s_waitcnt lgkmcnt(0)" ::: "memory"); SBAR();
#define PKV(L, H) (bf16x8){L[0], L[1], L[2], L[3], H[0], H[1], H[2], H[3]}
    od = __builtin_amdgcn_mfma_f32_32x32x16_bf16(pa0, PKV(l0, h0), od, 0, 0, 0);
    od = __builtin_amdgcn_mfma_f32_32x32x16_bf16(pa1, PKV(l1, h1), od, 0, 0, 0);
    od = __builtin_amdgcn_mfma_f32_32x32x16_bf16(pa2, PKV(l2, h2), od, 0, 0, 0);
    od = __builtin_amdgcn_mfma_f32_32x32x16_bf16(pa3, PKV(l3, h3), od, 0, 0, 0);
#undef PKV
}
__device__ __forceinline__ void pv_d0(f32x16* o, int vb, bf16x8 pa0, bf16x8 pa1, bf16x8 pa2, bf16x8 pa3) {
    pv_one<0>(o[0], vb, pa0, pa1, pa2, pa3); pv_one<1>(o[1], vb, pa0, pa1, pa2, pa3); pv_one<2>(o[2], vb, pa0, pa1, pa2, pa3); pv_one<3>(o[3], vb, pa0, pa1, pa2, pa3);
}
__device__ __forceinline__ void pv_partial(f32x16* o, int vb, bf16x8 pa0, bf16x8 pa1, bf16x8 pa2, bf16x8 pa3, f32x16& p0, f32x16& p1, float& m_reg, float& mn, float& alpha, bool domask, int d0) {
    constexpr float C = SCALE * 1.4426950408889634f;
#define PKV(L, H) (bf16x8){L[0], L[1], L[2], L[3], H[0], H[1], H[2], H[3]}
#define RD8(A, D0) A##0 = tr_read<v_rd_off(D0, 0, 0)>(vb); A##1 = tr_read<v_rd_off(D0, 0, 1)>(vb); A##2 = tr_read<v_rd_off(D0, 1, 0)>(vb); A##3 = tr_read<v_rd_off(D0, 1, 1)>(vb); \
    A##4 = tr_read<v_rd_off(D0, 2, 0)>(vb); A##5 = tr_read<v_rd_off(D0, 2, 1)>(vb); A##6 = tr_read<v_rd_off(D0, 3, 0)>(vb); A##7 = tr_read<v_rd_off(D0, 3, 1)>(vb)
#define MM4(OD, A) OD = __builtin_amdgcn_mfma_f32_32x32x16_bf16(pa0, PKV(A##0, A##1), OD, 0, 0, 0); OD = __builtin_amdgcn_mfma_f32_32x32x16_bf16(pa1, PKV(A##2, A##3), OD, 0, 0, 0); \
    OD = __builtin_amdgcn_mfma_f32_32x32x16_bf16(pa2, PKV(A##4, A##5), OD, 0, 0, 0); OD = __builtin_amdgcn_mfma_f32_32x32x16_bf16(pa3, PKV(A##6, A##7), OD, 0, 0, 0)
    s16x4 a0, a1, a2, a3, a4, a5, a6, a7, b0, b1, b2, b3, b4, b5, b6, b7;
    RD8(a, 0); RD8(b, 1);
    asm volatile("s_waitcnt lgkmcnt(8)" ::: "memory"); SBAR(); MM4(o[0], a);
    if (domask) psm_mask(p0, p1, d0);
    const float mx0 = psm_max(p0);
    SBAR(); RD8(a, 2);
    asm volatile("s_waitcnt lgkmcnt(8)" ::: "memory"); SBAR(); MM4(o[1], b);
    float pmax = fmaxf(mx0, psm_max(p1));
    { auto rr = __builtin_amdgcn_permlane32_swap(__float_as_uint(pmax), __float_as_uint(pmax), false, false);
      pmax = fmaxf(__uint_as_float(rr[0]), __uint_as_float(rr[1])); }
    mn = (pmax - m_reg > THR / SCALE) ? pmax : m_reg; alpha = ex2((m_reg - mn) * C); m_reg = mn;
    const float mnC = -mn * C;
    SBAR(); RD8(b, 3);
    asm volatile("s_waitcnt lgkmcnt(8)" ::: "memory"); SBAR(); MM4(o[2], a);
    p0 = p0 * C + mnC; p1 = p1 * C + mnC;
    SBAR();
    asm volatile("s_waitcnt lgkmcnt(0)" ::: "memory"); SBAR(); MM4(o[3], b);
#pragma unroll
    for (int r = 0; r < 16; ++r) p0[r] = ex2(p0[r]);
    asm volatile("" : "+v"(p0), "+v"(p1));
    SBAR();
#undef PKV
#undef RD8
#undef MM4
}
__device__ __forceinline__ void attn_unit(const bf16* __restrict__ QKV, bf16* __restrict__ O, const float* __restrict__ sink, int qrow0, int head0, int kvh, int krow_band, int nband, int krow_ctx, int dpos0, LAS unsigned char* lds, const int wid) {
    const int lane = lane_id(), r32 = lane & 31, hi = lane >> 5;
    LAS unsigned char* V_lds = lds; LAS unsigned char* K_lds = lds + 3 * SHM_V;
    LAS float* wsf = (LAS float*)(lds + 3 * SHM_V + 3 * SHM_K) + wid * 64; LAS float* li_l = wsf; LAS float* al_l = wsf + 32;
    const int head = head0 + (wid >> 2), qoff = 32 * (wid & 3);
    float m_reg = sink[head] * (1.0f / SCALE), l_reg = 1.0f; f32x16 o[4] = {}; bf16x8 qr[8];
    const bf16* Qw = QKV + (size_t)(qrow0 + qoff + r32) * QKVD + head * HDIM + hi * 8;
#pragma unroll
    for (int d0 = 0; d0 < 8; ++d0) qr[d0] = *(const bf16x8*)(Qw + d0 * 16);
    unsigned voK[2], voV[2];
#pragma unroll
    for (int i = 0; i < 2; ++i) { const int s = (i * 8 + wid) * 64 + lane;
        { const int row = s >> 4, ch = (s & 15) ^ (row & 7); voK[i] = (unsigned)(row * (QKVD * 2) + ch * 16); }
        { const int qlo = s & 3, kklo = (s >> 2) & 7, blk = s >> 5, qhi = blk & 3, kk = (blk >> 2) * 8 + kklo, k = (kk & ~0xC) | ((kk & 4) << 1) | ((kk & 8) >> 1); voV[i] = (unsigned)(k * (QKVD * 2) + (qhi * 4 + qlo) * 16); } }
    const __amdgpu_buffer_rsrc_t rs = __builtin_amdgcn_make_buffer_rsrc((void*)QKV, 0, -1, 0x00020000);
    const unsigned kcol = (unsigned)(1024 + kvh * HDIM) * 2u;
    const int vb0 = (int)(unsigned)(uintptr_t)V_lds + v_rd_base(lane);
    const int NT = nband + 4;
#define TROW(j) ((j) < nband ? krow_band + 64 * (j) : krow_ctx + 64 * ((j) - nband))
#define DMA(j, bo) do { const unsigned so_ = (unsigned)TROW(j) * (unsigned)(QKVD * 2) + kcol; _Pragma("unroll") for (int i_ = 0; i_ < 2; ++i_) { \
        __builtin_amdgcn_raw_ptr_buffer_load_lds(rs, (LAS void*)(K_lds + (bo) + (i_ * 8 + wid) * 1024), 16, voK[i_], so_, 0, 0); \
        __builtin_amdgcn_raw_ptr_buffer_load_lds(rs, (LAS void*)(V_lds + (bo) + (i_ * 8 + wid) * 1024), 16, voV[i_], so_ + 512u, 0, 0); } } while (0)
#define UBAR(n) do { asm volatile("s_waitcnt vmcnt(" #n ") lgkmcnt(0)" ::: "memory"); __builtin_amdgcn_s_barrier(); asm volatile("" ::: "memory"); } while (0)
#define RESC(a) do { if (__any((a) < 1.f)) { if (hi == 0) al_l[r32] = (a); asm volatile("s_waitcnt lgkmcnt(0)" ::: "memory"); \
    _Pragma("unroll") for (int d = 0; d < 4; ++d) _Pragma("unroll") for (int r = 0; r < 16; ++r) o[d][r] *= al_l[crow(r, hi)]; } } while (0)
    f32x16 pA0, pA1, pB0, pB1; float mnA, mnB, alA, alB; bf16x8 pa0, pa1, pa2, pa3;
    int bc = 0, bn = SHM_K, bnn = 2 * SHM_K;
    DMA(0, 0); DMA(1, SHM_K);
    UBAR(4);
    qkt(pA0, pA1, K_lds, qr, r32, hi); { const int dl = dpos0 - qoff; const bool dm = (0 < nband) && !(dl >= -97 && dl <= 65); partialSM(pA0, pA1, m_reg, mnA, alA, dm, dl - r32 + 4 * hi); }
#define STEP(Pc0, Pc1, alc, Pn0, Pn1, mnn, aln, t) do { UBAR(0); if ((t) + 2 < NT) DMA((t) + 2, bnn); \
        SBAR(); qkt(Pn0, Pn1, K_lds + bn, qr, r32, hi); finishSM(Pc0, Pc1, alc, l_reg, pa0, pa1, pa2, pa3); SBAR(); \
        { const int jj = (t) + 1; const int dl = dpos0 + 64 * jj - qoff; const bool dm = (jj < nband) && !(dl >= -97 && dl <= 65); \
          pv_partial(o, vb0 + bc, pa0, pa1, pa2, pa3, Pn0, Pn1, m_reg, mnn, aln, dm, dl - r32 + 4 * hi); } \
        RESC(aln); { const int t_ = bc; bc = bn; bn = bnn; bnn = t_; } } while (0)
    int t = 0;
    for (; t + 2 < NT - 1; t += 2) { STEP(pA0, pA1, alA, pB0, pB1, mnB, alB, t); STEP(pB0, pB1, alB, pA0, pA1, mnA, alA, t + 1); }
    STEP(pA0, pA1, alA, pB0, pB1, mnB, alB, t);
    finishSM(pB0, pB1, alB, l_reg, pa0, pa1, pa2, pa3); SBAR();
    pv_d0(o, vb0 + bc, pa0, pa1, pa2, pa3);
    if (hi == 0) li_l[r32] = l_reg; asm volatile("s_waitcnt lgkmcnt(0)" ::: "memory");
    float rli[16];
#pragma unroll
    for (int r = 0; r < 16; ++r) rli[r] = rcpf_(li_l[crow(r, hi)]);
    { LAS unsigned char* ot = lds + 3 * SHM_V + 3 * SHM_K + 4096 + wid * 4096;
#pragma unroll
      for (int r = 0; r < 16; ++r) { const int orow = crow(r, hi);
#pragma unroll
          for (int d0 = 0; d0 < 4; ++d0) { const float x = clamp8(o[d0][r] * rli[r] * 16.0f); ot[orow * 128 + d0 * 32 + r32] = (unsigned char)(__builtin_amdgcn_cvt_pk_fp8_f32(x, x, 0, false) & 0xff); } }
      asm volatile("s_waitcnt lgkmcnt(0)" ::: "memory");
      unsigned char* Ob = (unsigned char*)O + (size_t)(qrow0 + qoff) * DM + head * HDIM;
#pragma unroll
      for (int i = 0; i < 4; ++i) { const int row = (lane >> 3) + 8 * i, ch = lane & 7; *(u32x4*)(Ob + (size_t)row * DM + ch * 16) = *(LAS const u32x4*)(ot + row * 128 + ch * 16); } }
    __syncthreads();
#undef TROW
#undef DMA
#undef UBAR
#undef RESC
#undef STEP
}
constexpr int N_LAT_UNITS = NB * 32 * NKVH * 2, N_CTX_UNITS = NB * 2 * NKVH * 2, N_UNITS = N_LAT_UNITS + N_CTX_UNITS;
__device__ __forceinline__ void attn_phase(const bf16* QKV, bf16* O, const float* sink, int G, int c, LAS unsigned char* lds, const int wid) {
    for (int i = 0; ; ++i) { const int L = i * G + c; if (L >= N_UNITS) break;
        if (L < N_LAT_UNITS) { int hp, kh, n, b;
            if (G == 256) { const int u = (i < 3) ? L : ((c >= 64) ? 768 + (c - 64) : -1);
                if (u >= 0) { hp = u & 1; kh = (u >> 1) & 1; const int rest = u >> 2; n = 1 + rest % 30; b = rest / 30; }
                else { hp = c & 1; kh = (c >> 1) & 1; n = ((c >> 2) & 1) ? 31 : 0; b = c >> 3; } }
            else { hp = L & 1; kh = (L >> 1) & 1; n = (L >> 2) & 31; b = L >> 7; }
            const int nlo = n > 0 ? n - 1 : 0, nhi = n < 31 ? n + 1 : 31, nband = 2 * (nhi - nlo + 1);
            attn_unit(QKV, O, sink, b * SEQ + n * 128, kh * 4 + hp * 2, kh, b * SEQ + nlo * 128, nband, RL + b * LCTX, (nlo - n) * 128, lds, wid);
        } else { const int u = L - N_LAT_UNITS, hp = u & 1, kh = (u >> 1) & 1, qh = (u >> 2) & 1, b = u >> 3;
            attn_unit(QKV, O, sink, RL + b * LCTX + qh * 128, kh * 4 + hp * 2, kh, 0, 0, RL + b * LCTX, 0, lds, wid);
        }
    }
}
#undef KSWZ
#undef SBAR
}

__device__ __forceinline__ void p10_conv(Frame& F) {
    const int gw = F.vcu * NWAVES + F.wave, NGW = F.G * NWAVES; const bf16* XB = WSP(bf16, WS_XB); bf16* U = WSP(bf16, WS_U);
    float cw[4][16], cb[16];
#pragma unroll
    for (int j = 0; j < 4; ++j)
#pragma unroll
        for (int q = 0; q < 4; ++q) { const f32x4 w = *(const f32x4*)(F.conv_w + j * 1024 + 16 * F.lane + 4 * q); cw[j][4 * q] = w[0]; cw[j][4 * q + 1] = w[1]; cw[j][4 * q + 2] = w[2]; cw[j][4 * q + 3] = w[3]; }
#pragma unroll
    for (int q = 0; q < 4; ++q) { const f32x4 w = *(const f32x4*)(F.conv_b + 16 * F.lane + 4 * q); cb[4 * q] = w[0]; cb[4 * q + 1] = w[1]; cb[4 * q + 2] = w[2]; cb[4 * q + 3] = w[3]; }
    const int per = (RT + NGW - 1) / NGW, r0 = gw * per, r1 = (r0 + per < RT) ? r0 + per : RT;
    if (r0 >= RT) return;
    u32x4 w0[4], w1[4];
#pragma unroll
    for (int j = 0; j < 4; ++j) { int rr = r0 + j - 2; rr = rr < 0 ? 0 : (rr >= RT ? RT - 1 : rr); const u32x4* p = (const u32x4*)(XB + (size_t)rr * DM + 16 * F.lane); w0[j] = p[0]; w1[j] = p[1]; }
    for (int r = r0; r < r1; ++r) { const bool lat = r < RL; const int t = lat ? (r & (SEQ - 1)) : ((r - RL) & (LCTX - 1)); const int Ls = lat ? SEQ : LCTX;
        u32x4 n0, n1; { int rn = r + 2; rn = rn >= RT ? RT - 1 : rn; const u32x4* p = (const u32x4*)(XB + (size_t)rn * DM + 16 * F.lane); n0 = p[0]; n1 = p[1]; }
        float acc[16];
#pragma unroll
        for (int i = 0; i < 16; ++i) acc[i] = cb[i];
#pragma unroll
        for (int j = 0; j < 4; ++j) { const int tj = t + j - 2;
            if (tj >= 0 && tj < Ls) { const u32x4 x0 = w0[j], x1 = w1[j];
#pragma unroll
                for (int q = 0; q < 4; ++q) { acc[2 * q] += cw[j][2 * q] * bflo(x0[q]); acc[2 * q + 1] += cw[j][2 * q + 1] * bfhi(x0[q]); acc[8 + 2 * q] += cw[j][8 + 2 * q] * bflo(x1[q]); acc[8 + 2 * q + 1] += cw[j][8 + 2 * q + 1] * bfhi(x1[q]); } } }
        u32x4 o0, o1;
#pragma unroll
        for (int q = 0; q < 4; ++q) { o0[q] = cvtpk(acc[2 * q], acc[2 * q + 1]); o1[q] = cvtpk(acc[8 + 2 * q], acc[8 + 2 * q + 1]); }
        u32x4* op = (u32x4*)(U + (size_t)r * DM + 16 * F.lane); op[0] = o0; op[1] = o1;
        w0[0] = w0[1]; w0[1] = w0[2]; w0[2] = w0[3]; w0[3] = n0; w1[0] = w1[1]; w1[1] = w1[2]; w1[2] = w1[3]; w1[3] = n1; }
}
namespace lru {
constexpr int AIMG_BYTES = 65536;
constexpr int EX_OFF = 2 * AIMG_BYTES;
struct Ctx { const bf16* U; const bf16* G; bf16* HH; u32x4* HF; const bf16* WLG; const float *lam, *b_r, *b_i; };

__device__ __forceinline__ void issue_u(const __amdgpu_buffer_rsrc_t rs, LAS unsigned char* buf, int n, size_t row0, int wid, unsigned voff) {
#pragma unroll
    for (int ii = 0; ii < 8; ++ii) { const int i = wid + 8 * ii;
        __builtin_amdgcn_raw_ptr_buffer_load_lds(rs, (LAS void*)(buf + i * 1024), 16, voff, (unsigned)((row0 + 32 * ii) * DM * 2 + n * 256), 0, 0); }
}
__device__ __forceinline__ void chunk_geom(int DIR, int k, int b, size_t& row0, int& lc) {
    if (k == 0) { row0 = (size_t)RL + b * LCTX; lc = -1; } else { lc = DIR ? 16 - k : k - 1; row0 = (size_t)b * SEQ + 256 * lc; }
}
#define LRU_BAR() do { asm volatile("s_waitcnt lgkmcnt(0)" ::: "memory"); __builtin_amdgcn_s_barrier(); asm volatile("" ::: "memory"); } while (0)
template <int DIR>
__device__ __forceinline__ void walk(const Ctx& C, LAS unsigned char* lds, int task, const int wid) {
    const int cq = task & 3, n = (task >> 2) & 7, b = task >> 5;
    const int lane = lane_id(), tid = wid * 64 + lane, c = lane & 15, g = lane >> 4;
    const int chalf = wid & 1, tq = wid >> 1;
    const int chl = 32 * cq + 16 * chalf + c;
    const int ch = n * 128 + chl;
    bf16x8 Br[4], Bi[4];
    { const bf16* wr = C.WLG + ((size_t)(n * 4 + 2 * DIR) * 128 + chl) * 128 + 8 * g; const bf16* wi = wr + 16384;
#pragma unroll
      for (int ks = 0; ks < 4; ++ks) { Br[ks] = *(const bf16x8*)(wr + ks * 32); Bi[ks] = *(const bf16x8*)(wi + ks * 32); } }
    const float br = C.b_r[DIR * 1024 + ch], bi = C.b_i[DIR * 1024 + ch];
    const float sp8 = 8.0f * log1pf(expf(-C.lam[DIR * 1024 + ch]));
    const float kbr = -LOG2E * br, kbi = -LOG2E * bi, ka = -sp8 * LOG2E;
    float H = 0.f;
    unsigned fb[4], ub[4];
#pragma unroll
    for (int ks = 0; ks < 4; ++ks) fb[ks] = (unsigned)((64 * tq + c) * 256 + ((ks * 64 + 16 * g) ^ (c << 4)));
#pragma unroll
    for (int r = 0; r < 4; ++r) ub[r] = (unsigned)((64 * tq + 4 * g + r) * 256 + ((2 * chl) ^ ((4 * g + r) << 4)));
    const __amdgpu_buffer_rsrc_t urs = __builtin_amdgcn_make_buffer_rsrc((void*)C.U, 0, -1, 0x00020000);
    const unsigned uvoff = (unsigned)((4 * wid + (lane >> 4)) * DM * 2 + (((lane & 15) ^ ((4 * wid + (lane >> 4)) & 15)) * 16));
    { size_t r0; int lc; chunk_geom(DIR, 0, b, r0, lc); issue_u(urs, lds, n, r0, wid, uvoff); }
    for (int k = 0; k < 17; ++k) {
        size_t row0; int lc; chunk_geom(DIR, k, b, row0, lc);
        LAS unsigned char* img = lds + (k & 1) * AIMG_BYTES;
        asm volatile("s_waitcnt vmcnt(0)" ::: "memory");
        LRU_BAR();
        if (k + 1 < 17) { size_t r1; int l1; chunk_geom(DIR, k + 1, b, r1, l1); issue_u(urs, lds + ((k + 1) & 1) * AIMG_BYTES, n, r1, wid, uvoff); }
        u32x4 hf0, hf1;
        u32x4 gp0, gp1;
        if (DIR == 1 && lc >= 0) { const u32x4* hp = C.HF + ((((size_t)task * 16 + lc) * 8 + wid) * 2) * 64 + lane; hf0 = hp[0]; hf1 = hp[64];
            const size_t grow = (row0 + (tid >> 1)) * DM + n * 128 + 32 * cq + 16 * (tid & 1); gp0 = *(const u32x4*)(C.G + grow); gp1 = *(const u32x4*)(C.G + grow + 8); }
        f32x4 ar[4], ai[4];
#pragma unroll
        for (int mt = 0; mt < 4; ++mt) { ar[mt] = (f32x4){0.f, 0.f, 0.f, 0.f}; ai[mt] = (f32x4){0.f, 0.f, 0.f, 0.f};
#pragma unroll
            for (int ks = 0; ks < 4; ++ks) { const bf16x8 af = *(LAS const bf16x8*)(img + fb[ks] + mt * 4096);
                ar[mt] = __builtin_amdgcn_mfma_f32_16x16x32_bf16(af, Br[ks], ar[mt], 0, 0, 0);
                ai[mt] = __builtin_amdgcn_mfma_f32_16x16x32_bf16(af, Bi[ks], ai[mt], 0, 0, 0); } }
        float y0[4][4], P[4][4]; float TA = 1.f, TB = 0.f;
#pragma unroll
        for (int mm = 0; mm < 4; ++mm) { const int mt = DIR ? 3 - mm : mm;
            float a[4], bb[4];
#pragma unroll
            for (int r = 0; r < 4; ++r) {
                const float rg = rcpf_(1.0f + ex2(fmaf(ar[mt][r], -LOG2E, kbr))), ig = rcpf_(1.0f + ex2(fmaf(ai[mt][r], -LOG2E, kbi)));
                a[r] = ex2(rg * ka);
                const float em = fmaf(-a[r], a[r], 1.0f);
                const float uu = __uint_as_float((unsigned)*(LAS const bf16*)(img + ub[r] + mt * 4096) << 16);
                bb[r] = __builtin_amdgcn_sqrtf(em) * (ig * uu); }
            float p[4], yl[4];
            if (DIR == 0) { p[0] = a[0]; yl[0] = bb[0];
#pragma unroll
                for (int r = 1; r < 4; ++r) { p[r] = a[r] * p[r - 1]; yl[r] = a[r] * yl[r - 1] + bb[r]; } }
            else { p[3] = a[3]; yl[3] = bb[3];
#pragma unroll
                for (int r = 2; r >= 0; --r) { p[r] = a[r] * p[r + 1]; yl[r] = a[r] * yl[r + 1] + bb[r]; } }
            const float Al = DIR ? p[0] : p[3], Bl = DIR ? yl[0] : yl[3];
            const float A0 = __shfl(Al, c), A1 = __shfl(Al, 16 + c), A2 = __shfl(Al, 32 + c), A3 = __shfl(Al, 48 + c);
            const float B0 = __shfl(Bl, c), B1 = __shfl(Bl, 16 + c), B2 = __shfl(Bl, 32 + c), B3 = __shfl(Bl, 48 + c);
            float EA, EB, At, Bt;
            if (DIR == 0) { const float e1a = A0, e1b = B0, e2a = A1 * e1a, e2b = A1 * e1b + B1, e3a = A2 * e2a, e3b = A2 * e2b + B2;
                EA = g == 0 ? 1.f : (g == 1 ? e1a : (g == 2 ? e2a : e3a)); EB = g == 0 ? 0.f : (g == 1 ? e1b : (g == 2 ? e2b : e3b)); At = A3 * e3a; Bt = A3 * e3b + B3; }
            else { const float e2a = A3, e2b = B3, e1a = A2 * e2a, e1b = A2 * e2b + B2, e0a = A1 * e1a, e0b = A1 * e1b + B1;
                EA = g == 3 ? 1.f : (g == 2 ? e2a : (g == 1 ? e1a : e0a)); EB = g == 3 ? 0.f : (g == 2 ? e2b : (g == 1 ? e1b : e0b)); At = A0 * e0a; Bt = A0 * e0b + B0; }
            const float QA = EA * TA, QB = EA * TB + EB;
#pragma unroll
            for (int r = 0; r < 4; ++r) { P[mt][r] = p[r] * QA; y0[mt][r] = p[r] * QB + yl[r]; }
            TB = At * TB + Bt; TA = At * TA;
        }
        if (g == 0) *(LAS f32x2*)(lds + EX_OFF + ((tq * 2 + chalf) * 16 + c) * 8) = (f32x2){TA, TB};
        LRU_BAR();
        float Hw;
        { const f32x2 e0 = *(LAS const f32x2*)(lds + EX_OFF + ((0 * 2 + chalf) * 16 + c) * 8), e1 = *(LAS const f32x2*)(lds + EX_OFF + ((1 * 2 + chalf) * 16 + c) * 8),
                      e2 = *(LAS const f32x2*)(lds + EX_OFF + ((2 * 2 + chalf) * 16 + c) * 8), e3 = *(LAS const f32x2*)(lds + EX_OFF + ((3 * 2 + chalf) * 16 + c) * 8);
          if (DIR == 0) { const float h1 = e0.x * H + e0.y, h2 = e1.x * h1 + e1.y, h3 = e2.x * h2 + e2.y; Hw = tq == 0 ? H : (tq == 1 ? h1 : (tq == 2 ? h2 : h3)); H = e3.x * h3 + e3.y; }
          else { const float h2 = e3.x * H + e3.y, h1 = e2.x * h2 + e2.y, h0 = e1.x * h1 + e1.y; Hw = tq == 3 ? H : (tq == 2 ? h2 : (tq == 1 ? h1 : h0)); H = e0.x * h0 + e0.y; } }
        if (lc >= 0) {
#pragma unroll
            for (int mt = 0; mt < 4; ++mt)
#pragma unroll
                for (int r = 0; r < 4; ++r) y0[mt][r] += P[mt][r] * Hw;
            if (DIR == 0) {
                u32x4* hp = C.HF + ((((size_t)task * 16 + lc) * 8 + wid) * 2) * 64 + lane;
                u32x4 w0, w1; w0.x = cvtpk(y0[0][0], y0[0][1]); w0.y = cvtpk(y0[0][2], y0[0][3]); w0.z = cvtpk(y0[1][0], y0[1][1]); w0.w = cvtpk(y0[1][2], y0[1][3]);
                w1.x = cvtpk(y0[2][0], y0[2][1]); w1.y = cvtpk(y0[2][2], y0[2][3]); w1.z = cvtpk(y0[3][0], y0[3][1]); w1.w = cvtpk(y0[3][2], y0[3][3]);
                hp[0] = w0; hp[64] = w1;
            } else {
                const unsigned hw[8] = {hf0.x, hf0.y, hf0.z, hf0.w, hf1.x, hf1.y, hf1.z, hf1.w};
#pragma unroll
                for (int mt = 0; mt < 4; ++mt)
#pragma unroll
                    for (int r = 0; r < 4; ++r) { const unsigned w = hw[mt * 2 + (r >> 1)]; const float hfv = (r & 1) ? bfhi(w) : bflo(w); const float s = y0[mt][r] + hfv;
                        *(LAS bf16*)(img + (64 * tq + mt * 16 + 4 * g + r) * 64 + (16 * chalf + c) * 2) = (bf16)(cvtpk(s, 0.f) & 0xffffu); }
                LRU_BAR();
                { const int tt = tid >> 1, hh = tid & 1; const size_t grow = (row0 + tt) * DM + n * 128 + 32 * cq + 16 * hh;
                  const u32x4 s0 = *(LAS const u32x4*)(img + tt * 64 + hh * 32), s1 = *(LAS const u32x4*)(img + tt * 64 + hh * 32 + 16);
                  const u32x4 g0 = gp0, g1 = gp1;
                  u32x4 o0, o1;
#pragma unroll
                  for (int j = 0; j < 4; ++j) { o0[j] = cvtpk(bflo(s0[j]) * bflo(g0[j]), bfhi(s0[j]) * bfhi(g0[j])); o1[j] = cvtpk(bflo(s1[j]) * bflo(g1[j]), bfhi(s1[j]) * bfhi(g1[j])); }
                  *(u32x4*)(C.HH + grow) = o0; *(u32x4*)(C.HH + grow + 8) = o1; }
            }
        }
    }
    asm volatile("s_waitcnt vmcnt(0)" ::: "memory");
    LRU_BAR();
}
#undef LRU_BAR
}
__device__ __forceinline__ void p11_lru(Frame& F, const lru::Ctx& C) {
    for (int task = F.vcu; task < 256; task += F.G) { lru::walk<0>(C, F.lds, task, F.wave); lru::walk<1>(C, F.lds, task, F.wave); }
}

__device__ __forceinline__ void p13_ln_router(Frame& F) {
    LAS float* RTR = (LAS float*)F.lds;
    LAS int* lcnt = (LAS int*)(F.lds + 32768);
    for (int idx = F.tid; idx < 8192; idx += NWAVES * 64) RTR[(idx & 7) * 1024 + (idx >> 3)] = F.router[idx];
    const float* mod = WSP(float, WS_MOD) + (size_t)1 * 9 * 6144; unsigned char* H8 = WSP(unsigned char, WS_H);
    int* eidx = (int*)(F.ws + WS_ROUTE + RT_EIDX); float* wgt = (float*)(F.ws + WS_ROUTE + RT_WGT); int* cnt = (int*)(F.ws + WS_ROUTE + RT_CNT);
    const Vec16 gv = vec_load(F.ln_g + 2 * 1024, F.lane), bv = vec_load(F.ln_b + 2 * 1024, F.lane);
    for (int batch = F.vcu; batch < RL / 128; batch += F.G) {
        const float* mb0 = mod + (size_t)((batch * 128) >> 12) * 6144 + 3072; const Vec16 sh = vec_load(mb0, F.lane), sc = vec_load(mb0 + 1024, F.lane);
        if (F.tid < 8) lcnt[F.tid] = 0;
        __syncthreads();
        u32x2 nx[4]; { const bf16* yp = WSP(bf16, WS_YB) + (size_t)(batch * 128 + F.wave * 16) * DM;
#pragma unroll
            for (int j = 0; j < 4; ++j) nx[j] = *(const u32x2*)(yp + 4 * F.lane + 256 * j); }
        for (int i = 0; i < 16; ++i) { const int r = batch * 128 + F.wave * 16 + i;
            f32x4 v[4];
#pragma unroll
            for (int j = 0; j < 4; ++j) v[j] = (f32x4){bflo(nx[j].x), bfhi(nx[j].x), bflo(nx[j].y), bfhi(nx[j].y)};
            if (i + 1 < 16) { const bf16* yp = WSP(bf16, WS_YB) + (size_t)(r + 1) * DM;
#pragma unroll
                for (int j = 0; j < 4; ++j) nx[j] = *(const u32x2*)(yp + 4 * F.lane + 256 * j); }
            row_ln_v(v, gv, bv);
            float lg[8];
#pragma unroll
            for (int e = 0; e < 8; ++e) lg[e] = 0.f;
#pragma unroll
            for (int j = 0; j < 4; ++j) { const f32x4 hm = v[j] * (sc.q[j] + 1.0f) + sh.q[j];
                *(unsigned*)(H8 + (size_t)r * DM + 4 * F.lane + 256 * j) = pk4_fp8(hm[0] * 4.f, hm[1] * 4.f, hm[2] * 4.f, hm[3] * 4.f);
#pragma unroll
                for (int e = 0; e < 8; ++e) { const f32x4 rt = *(LAS const f32x4*)(RTR + e * 1024 + 4 * F.lane + 256 * j); lg[e] += (hm[0] * rt[0] + hm[1] * rt[1]) + (hm[2] * rt[2] + hm[3] * rt[3]); } }
#pragma unroll
            for (int e = 0; e < 8; ++e) lg[e] = wave_sum(lg[e]);
            int ea = 0; float la = lg[0];
#pragma unroll
            for (int e = 1; e < 8; ++e) if (lg[e] > la) { la = lg[e]; ea = e; }
            int eb = -1; float lb = -3.0e38f;
#pragma unroll
            for (int e = 0; e < 8; ++e) if (e != ea && lg[e] > lb) { lb = lg[e]; eb = e; }
            const float wa = 1.0f / (1.0f + __expf(lb - la)), wb = 1.0f - wa;
            if (F.lane == 0) { *(int2*)(eidx + 2 * r) = make_int2(ea, eb); *(float2*)(wgt + 2 * r) = make_float2(wa, wb); atomicAdd((int*)(lcnt + ea), 1); atomicAdd((int*)(lcnt + eb), 1); }
        }
        __syncthreads();
        if (F.tid < 8) cnt[batch * 8 + F.tid] = lcnt[F.tid];
        __syncthreads();
    }
}
__device__ __forceinline__ void moe_totals(Frame& F, int upto_batch, int (&tot)[8], int (&before)[8]) {
    const int* cnt = (const int*)(F.ws + WS_ROUTE + RT_CNT);
#pragma unroll
    for (int e = 0; e < 8; ++e) { tot[e] = 0; before[e] = 0; }
#pragma unroll
    for (int k = 0; k < 4; ++k) { const int bb = 4 * F.lane + k; const int4 c0 = *(const int4*)(cnt + bb * 8), c1 = *(const int4*)(cnt + bb * 8 + 4); const int m = bb < upto_batch ? 1 : 0;
        tot[0] += c0.x; tot[1] += c0.y; tot[2] += c0.z; tot[3] += c0.w; tot[4] += c1.x; tot[5] += c1.y; tot[6] += c1.z; tot[7] += c1.w;
        before[0] += m * c0.x; before[1] += m * c0.y; before[2] += m * c0.z; before[3] += m * c0.w; before[4] += m * c1.x; before[5] += m * c1.y; before[6] += m * c1.z; before[7] += m * c1.w; }
#pragma unroll
    for (int e = 0; e < 8; ++e) {
#pragma unroll
        for (int o = 1; o < 64; o <<= 1) { tot[e] += __shfl_xor(tot[e], o); before[e] += __shfl_xor(before[e], o); } }
}
__device__ __forceinline__ void p14_gather(Frame& F) {
    const int* eidx = (const int*)(F.ws + WS_ROUTE + RT_EIDX); const float* wgt = (const float*)(F.ws + WS_ROUTE + RT_WGT);
    int* slot = (int*)(F.ws + WS_ROUTE + RT_SLOT); float* wsort = (float*)(F.ws + WS_ROUTE + RT_WS);
    const unsigned char* H8 = WSP(unsigned char, WS_H); unsigned char* HS8 = WSP(unsigned char, WS_HS);
    LAS int* wcnt = (LAS int*)F.lds;
    LAS int* dsts = (LAS int*)(F.lds + 256);
    for (int batch = F.vcu; batch < RL / 128; batch += F.G) {
        int tot[8], before[8]; moe_totals(F, batch, tot, before);
        int base[8]; { int tp = 0;
#pragma unroll
            for (int e = 0; e < 8; ++e) { base[e] = tp * 256 + before[e]; tp += (tot[e] + 255) >> 8; } }
        int my_e = 0, rank_in_wave = 0;
        if (F.tid < 256) { my_e = eidx[batch * 256 + F.tid];
#pragma unroll
            for (int e = 0; e < 8; ++e) { const unsigned long long m = __ballot(my_e == e); if (my_e == e) rank_in_wave = __popcll(m & ((1ull << F.lane) - 1ull)); if (F.lane == 0) wcnt[F.wave * 8 + e] = __popcll(m); } }
        __syncthreads();
        if (F.tid < 256) { int off = 0;
#pragma unroll
            for (int w = 0; w < 4; ++w) if (w < F.wave) off += wcnt[w * 8 + my_e];
            int bs = 0;
#pragma unroll
            for (int e = 0; e < 8; ++e) bs = (my_e == e) ? base[e] : bs;
            const int d = bs + off + rank_in_wave; dsts[F.tid] = d; slot[batch * 256 + F.tid] = d; wsort[d] = wgt[batch * 256 + F.tid]; }
        __syncthreads();
        for (int i = 0; i < 32; ++i) { const int a = F.wave * 32 + i; const int d = dsts[a]; const int r = batch * 128 + (a >> 1);
            const u32x4* src = (const u32x4*)(H8 + (size_t)r * DM); u32x4* dp = (u32x4*)(HS8 + (size_t)d * DM);
            dp[F.lane] = src[F.lane]; }
        __syncthreads();
    }
}
__device__ __forceinline__ void p17_final(Frame& F) {
    const int gw = F.vcu * NWAVES + F.wave, NGW = F.G * NWAVES; const float* mod = WSP(float, WS_MOD) + (size_t)1 * 9 * 6144; const bf16* FO = WSP(bf16, WS_FO);
    const int* slot = (const int*)(F.ws + WS_ROUTE + RT_SLOT);
    const Vec16 g0 = vec_load(F.ln_g + 2 * 1024, F.lane), b0 = vec_load(F.ln_b + 2 * 1024, F.lane), g1 = vec_load(F.ln_g + 3 * 1024, F.lane), b1 = vec_load(F.ln_b + 3 * 1024, F.lane);
    const int bb = gw / (NGW / 8) < 8 ? gw / (NGW / 8) : 7; const Vec16 g2 = vec_load(mod + (size_t)bb * 6144 + 5120, F.lane);
    ROWS_LAT( (void)b; float* yp = F.out + (size_t)r * DM; const int2 s = *(const int2*)(slot + 2 * r);
        const bf16* fa = FO + (size_t)s.x * DM, * fb = FO + (size_t)s.y * DM;
        f32x4 v[4]; row_load_bf(v, WSP(bf16, WS_YB) + (size_t)r * DM, F.lane); row_ln_v(v, g0, b0);
        _Pragma("unroll") for (int j = 0; j < 4; ++j) { const u32x2 a = *(const u32x2*)(fa + 4 * F.lane + 256 * j), c = *(const u32x2*)(fb + 4 * F.lane + 256 * j);
            const f32x4 f = {bflo(a.x) + bflo(c.x), bfhi(a.x) + bfhi(c.x), bflo(a.y) + bflo(c.y), bfhi(a.y) + bfhi(c.y)};
            v[j] = v[j] * ALPHA + g2.q[j] * f; }
        row_ln_v(v, g1, b1); row_store(v, yp, F.lane); );
}

constexpr int N_PHASES = 18;
#ifndef REP_PHASE
#define REP_PHASE -1
#endif
struct Args { const float* in[25]; float* out; unsigned char* ws; int ph_lo, ph_hi; };
__global__ void __launch_bounds__(NWAVES * 64, 2) fwd_kernel(Args args) {
    extern __shared__ __attribute__((aligned(16))) unsigned char lds[];
    Frame F;
    F.lds = (LAS unsigned char*)lds;
    F.MISC = (volatile LAS unsigned*)(F.lds + MISC_OFF);
    F.wave = __builtin_amdgcn_readfirstlane((int)(threadIdx.x >> 6)); F.lane = lane_id(); F.tid = F.wave * 64 + F.lane;
    F.G = gridDim.x; { const int bx = blockIdx.x; F.vcu = (F.G % 8 == 0) ? (bx % 8) * (F.G / 8) + bx / 8 : bx; }
    F.x = args.in[0]; F.c = args.in[1]; F.ctx = args.in[2]; F.cctx = args.in[3]; F.w_mod = args.in[4]; F.b_mod = args.in[5]; F.ln_g = args.in[6]; F.ln_b = args.in[7];
    F.w_qkv = args.in[8]; F.w_o = args.in[9]; F.sink = args.in[10]; F.w_gu = args.in[11]; F.w_dn = args.in[12]; F.w_in = args.in[13]; F.conv_w = args.in[14]; F.conv_b = args.in[15];
    F.lam = args.in[16]; F.w_r = args.in[17]; F.b_r = args.in[18]; F.w_i = args.in[19]; F.b_i = args.in[20]; F.w_out = args.in[21]; F.router = args.in[22]; F.mw_gu = args.in[23]; F.mw_dn = args.in[24];
    F.out = args.out; F.ws = args.ws;
    for (int u = F.tid; u < (LDS_BYTES - LDSCTL_OFF) / 4; u += NWAVES * 64) ((LAS unsigned*)(F.lds + LDSCTL_OFF))[u] = 0u;
    __syncthreads();
    const int lo = args.ph_lo, hi = args.ph_hi;
    const bool multi = (hi - lo) > 1;
    XcdBarrier bar; bar.bar = (unsigned*)(F.ws + WS_CTL) + 1024; bar.x = 0; bar.st = nullptr;
    if (multi) bar = xcd_barrier_post((unsigned*)(F.ws + WS_CTL) + 1024, F.MISC + 8, F.wave == 0 && lane_id() == 0);
#define IN(k) (lo <= (k) && (k) < hi)
#define REFRESH() do { F.lane = lane_id(); F.tid = F.wave * 64 + F.lane; } while (0)
#define SEAM(k) do { if (IN(k) && IN((k) + 1)) xcd_barrier(bar, F.wave == 0 && lane_id() == 0); } while (0)
    const float* MOD = WSP(float, WS_MOD);
    bf16* H = WSP(bf16, WS_H); bf16* YB = WSP(bf16, WS_YB); const f32x2* ST = (const f32x2*)(F.ws + WS_STATS);

    if (IN(0)) { REFRESH(); p0_prologue(F); if (REP_PHASE == 0) { xcd_barrier(bar, F.wave == 0 && lane_id() == 0); p0_prologue(F); } } SEAM(0);
    if (IN(1)) { REFRESH(); p1_modulate(F); if (REP_PHASE == 1) { xcd_barrier(bar, F.wave == 0 && lane_id() == 0); p1_modulate(F); } } SEAM(1);
    if (IN(2)) {
        pg8::Gemm g{H, WSP(bf16, WS_WQKV), RT, QKVD, DM / 2}; pg8::StaticOrder S; S.init(RT, QKVD, F.G, (int)blockIdx.x);
        pg8::EpiQKV E{WSP(bf16, WS_QKV), WSP(float, WS_ROPE), 1.0f / 512.0f};
        pg8::gemm_phase<pg8::EpiQKV, pg8::StaticOrder, true, true, true>(F.lds + RING_OFF, g, S, E, F.wave);
        moe_convert_filler(F, (RT / 256) * (QKVD / 256), (int)blockIdx.x, 0, 6400);
    } SEAM(2);
    if (IN(3)) { att::attn_phase(WSP(bf16, WS_QKV), WSP(bf16, WS_O), F.sink, F.G, F.vcu, F.lds + RING_OFF, F.wave); if (REP_PHASE == 3) { xcd_barrier(bar, F.wave == 0 && lane_id() == 0); att::attn_phase(WSP(bf16, WS_QKV), WSP(bf16, WS_O), F.sink, F.G, F.vcu, F.lds + RING_OFF, F.wave); } } SEAM(3);
    if (IN(4)) {
        pg8::Gemm g{WSP(bf16, WS_O), WSP(bf16, WS_WO), RT, DM, DM / 2}; pg8::StaticOrder S; S.init(RT, DM, F.G, (int)blockIdx.x);
        pg8::EpiResid<false> E{F.x, F.ctx, YB, MOD + 2048, 1.0f / 2048.0f, nullptr, nullptr, nullptr};
        pg8::gemm_phase<pg8::EpiResid<false>, pg8::StaticOrder, true, true, true>(F.lds + RING_OFF, g, S, E, F.wave);
        moe_convert_filler(F, (RT / 256) * (DM / 256), (int)blockIdx.x, 6400, 17408);
    } SEAM(4);
    if (IN(5)) { REFRESH(); ln_mod_pass<true>(F, true, F.ln_g, F.ln_b, 0, 3072); } SEAM(5);
    if (IN(6)) {
        pg8::Gemm g{H, WSP(bf16, WS_WGU), RT, 2 * DFF, DM / 2}; pg8::StaticOrder S; S.init(RT, 2 * DFF, F.G, (int)blockIdx.x);
        pg8::EpiSwiGLU8 E{WSP(unsigned char, WS_ACT), 28};
        pg8::gemm_phase<pg8::EpiSwiGLU8, pg8::StaticOrder, true, true, true>(F.lds + RING_OFF, g, S, E, F.wave);
    } SEAM(6);
    if (IN(7)) {
        pg8::Gemm g{WSP(bf16, WS_ACT), WSP(bf16, WS_WDN), RT, DM, DFF / 2}; pg8::StaticOrder S; S.init(RT, DM, F.G, (int)blockIdx.x);
        pg8::EpiResid<true> E{nullptr, nullptr, YB, MOD + 5120, 1.0f / 4096.0f, ST, F.ln_g, F.ln_b};
        pg8::gemm_phase<pg8::EpiResid<true>, pg8::StaticOrder, true, true, true>(F.lds + RING_OFF, g, S, E, F.wave);
        moe_convert_filler(F, (RT / 256) * (DM / 256), (int)blockIdx.x, 17408, 37888);
    } SEAM(7);
    if (IN(8)) { REFRESH(); ln_mod_pass<false>(F, true, F.ln_g + 1024, F.ln_b + 1024, 1, 0); } SEAM(8);
    if (IN(9)) {
        pg8::Gemm g{H, WSP(bf16, WS_WIN), RT, 2048, DM}; pg8::StaticOrder S; S.init(RT, 2048, F.G, (int)blockIdx.x);
        pg8::EpiLruIn E{WSP(bf16, WS_G), WSP(bf16, WS_XB)};
        pg8::gemm_phase<pg8::EpiLruIn, pg8::StaticOrder, true, true>(F.lds + RING_OFF, g, S, E, F.wave);
        moe_convert_filler(F, (RT / 256) * (2048 / 256), (int)blockIdx.x, 37888, CV_ITEMS);
    } SEAM(9);
    {
        const lru::Ctx LC{WSP(bf16, WS_U), WSP(bf16, WS_G), WSP(bf16, WS_HH), WSP(u32x4, WS_HF), WSP(bf16, WS_WLG), F.lam, F.b_r, F.b_i};
        if (IN(10)) { REFRESH(); p10_conv(F); } SEAM(10);
        if (IN(11)) { REFRESH(); p11_lru(F, LC); if (REP_PHASE == 11) { xcd_barrier(bar, F.wave == 0 && lane_id() == 0); p11_lru(F, LC); } } SEAM(11);
    }
    if (IN(12)) {
        pg8::Gemm g{WSP(bf16, WS_HH), WSP(bf16, WS_WOUT), RL, DM, DM}; pg8::StaticOrder S; S.init(RL, DM, F.G, (int)blockIdx.x);
        pg8::EpiResid<true> E{nullptr, nullptr, YB, MOD + 9 * 6144 + 2048, 1.0f, ST, F.ln_g + 1024, F.ln_b + 1024};
        pg8::gemm_phase<pg8::EpiResid<true>, pg8::StaticOrder, true, true>(F.lds + RING_OFF, g, S, E, F.wave);
    } SEAM(12);
    if (IN(13)) { REFRESH(); p13_ln_router(F); } SEAM(13);
    if (IN(14)) { REFRESH(); p14_gather(F); if (REP_PHASE == 14) { xcd_barrier(bar, F.wave == 0 && lane_id() == 0); p14_gather(F); } } SEAM(14);
    if (IN(15) || IN(16)) {
        REFRESH();
        int tot[8], before[8]; moe_totals(F, 0, tot, before);
        int tp[9]; tp[0] = 0;
#pragma unroll
        for (int e = 0; e < 8; ++e) tp[e + 1] = __builtin_amdgcn_readfirstlane(tp[e] + ((tot[e] + 255) >> 8));
        const int ntiles = tp[8];
        if (IN(15)) {
            pg8::Gemm g{WSP(bf16, WS_HS), WSP(bf16, WS_WMGU), ntiles * 256, 2 * DFF, DM / 2};
            pg8::MoeOrder S{ntiles, 28, ntiles * 28, F.G, (int)blockIdx.x, 28, tp[1], tp[2], tp[3], tp[4], tp[5], tp[6], tp[7]};
            pg8::EpiSwiGLU8 E{WSP(unsigned char, WS_MACT), 28};
            pg8::gemm_phase<pg8::EpiSwiGLU8, pg8::MoeOrder, true, true, true>(F.lds + RING_OFF, g, S, E, F.wave);
        } SEAM(15);
        if (IN(16)) {
            pg8::Gemm g{WSP(bf16, WS_MACT), WSP(bf16, WS_WMDN), ntiles * 256, DM, DFF / 2};
            pg8::MoeOrder S{ntiles, 4, ntiles * 4, F.G, (int)blockIdx.x, 4, tp[1], tp[2], tp[3], tp[4], tp[5], tp[6], tp[7]};
            pg8::EpiMoeOut8 E{WSP(bf16, WS_FO), (const float*)(F.ws + WS_ROUTE + RT_WS)};
            pg8::gemm_phase<pg8::EpiMoeOut8, pg8::MoeOrder, true, true, true>(F.lds + RING_OFF, g, S, E, F.wave);
        } SEAM(16);
    }
    if (IN(17)) { REFRESH(); p17_final(F); }
#undef IN
#undef SEAM
}

#ifndef N_LAUNCH_MODE
#define N_LAUNCH_MODE 1
#endif
extern "C" void kernel_launch(void* const* d_in, const int* in_sizes, int n_in, void* d_out, int out_size, void* d_ws, size_t ws_size, hipStream_t stream) {
    static int grid = 0;
    if (grid == 0) {
        if (n_in != 25 || out_size != RL * DM || ws_size < WS_END) { fprintf(stderr, "kernel_launch: unexpected shapes (n_in %d out %d ws %zu)\n", n_in, out_size, ws_size); grid = -1; return; }
        int dev = 0, cus = 0, per_cu = 0;
        if (hipGetDevice(&dev) != hipSuccess || hipDeviceGetAttribute(&cus, hipDeviceAttributeMultiprocessorCount, dev) != hipSuccess) { grid = -1; return; }
        if (hipFuncSetAttribute((const void*)fwd_kernel, hipFuncAttributeMaxDynamicSharedMemorySize, LDS_BYTES) != hipSuccess) { fprintf(stderr, "kernel_launch: hipFuncSetAttribute failed\n"); grid = -1; return; }
        if (hipOccupancyMaxActiveBlocksPerMultiprocessor(&per_cu, (const void*)fwd_kernel, NWAVES * 64, LDS_BYTES) != hipSuccess || per_cu < 1) { fprintf(stderr, "kernel_launch: occupancy query says %d\n", per_cu); per_cu = 1; }
        (void)hipGetLastError();
        grid = cus;
    }
    if (grid < 0) return;
    (void)hipMemsetAsync((char*)d_ws + WS_CTL, 0, CTL_ZERO_BYTES, stream);
    Args a{};
    for (int i = 0; i < 25; ++i) a.in[i] = (const float*)d_in[i];
    a.out = (float*)d_out; a.ws = (unsigned char*)d_ws;
#if N_LAUNCH_MODE == 1
    a.ph_lo = 0; a.ph_hi = N_PHASES;
    hipLaunchKernelGGL(fwd_kernel, dim3(grid), dim3(NWAVES * 64), LDS_BYTES, stream, a);
#else
    for (int p = 0; p < N_PHASES; ++p) { a.ph_lo = p; a.ph_hi = p + 1; hipLaunchKernelGGL(fwd_kernel, dim3(grid), dim3(NWAVES * 64), LDS_BYTES, stream, a); }
#endif
    const hipError_t le = hipPeekAtLastError();
    if (le != hipSuccess) fprintf(stderr, "kernel_launch: launch failed: %s\n", hipGetErrorName(le));
}
```

```cpp
#include <hip/hip_runtime.h>
#include <cstdio>
#include <cstdint>

#define GAS __attribute__((address_space(1)))
#define LAS __attribute__((address_space(3)))
typedef unsigned short bf16;
typedef short bf16x8 __attribute__((ext_vector_type(8)));
typedef short s16x4 __attribute__((ext_vector_type(4)));
typedef float f32x4 __attribute__((ext_vector_type(4)));
typedef float f32x2 __attribute__((ext_vector_type(2)));
typedef float f32x16 __attribute__((ext_vector_type(16)));
typedef unsigned u32x4 __attribute__((ext_vector_type(4)));
typedef unsigned u32x2 __attribute__((ext_vector_type(2)));
typedef GAS unsigned gu32;

constexpr int NB = 8, SEQ = 4096, DM = 1024, LCTX = 256;
constexpr int RL = NB * SEQ;
constexpr int RC = NB * LCTX;
constexpr int RT = RL + RC;
constexpr int NHEAD = 8, NKVH = 2, HDIM = 128, QKVD = 1536;
constexpr int DFF = 3584, NEXP = 8;
constexpr float ALPHA = 1.4142135623730951f;
constexpr float LN_EPS = 1e-5f;
constexpr float LOG2E = 1.4426950408889634f;
constexpr int NWAVES = 8;

__device__ __forceinline__ unsigned cvtpk(float lo, float hi) { unsigned r; asm volatile("v_cvt_pk_bf16_f32 %0, %1, %2" : "=v"(r) : "v"(lo), "v"(hi)); return r; }
__device__ __forceinline__ float bflo(unsigned w) { return __uint_as_float(w << 16); }
__device__ __forceinline__ float bfhi(unsigned w) { return __uint_as_float(w & 0xffff0000u); }
__device__ __forceinline__ float ex2(float x) { return __builtin_amdgcn_exp2f(x); }
__device__ __forceinline__ float rcpf_(float x) { return __builtin_amdgcn_rcpf(x); }
__device__ __forceinline__ float sigm(float x) { return rcpf_(1.0f + ex2(-LOG2E * x)); }
typedef int v8i __attribute__((ext_vector_type(8)));
typedef int v4i __attribute__((ext_vector_type(4)));
__device__ __forceinline__ float clamp8(float x) { return __builtin_amdgcn_fmed3f(x, -448.f, 448.f); }
__device__ __forceinline__ unsigned pk4_fp8(float a, float b, float c, float d) {
    int p = __builtin_amdgcn_cvt_pk_fp8_f32(clamp8(a), clamp8(b), 0, false); p = __builtin_amdgcn_cvt_pk_fp8_f32(clamp8(c), clamp8(d), p, true); return (unsigned)p; }
__device__ __forceinline__ int lane_id() { int l; asm volatile("v_mbcnt_lo_u32_b32 %0, -1, 0\n\tv_mbcnt_hi_u32_b32 %0, -1, %0" : "=v"(l)); return l; }
#define REFRESH_F(F) do { (F).lane = lane_id(); (F).tid = (F).wave * 64 + (F).lane; } while (0)
__device__ __forceinline__ float dpp_add(float v, const int ctrl_sel) {
    int r;
    switch (ctrl_sel) { case 0: r = __builtin_amdgcn_update_dpp(0, __float_as_int(v), 0xB1, 0xf, 0xf, true); break;
                        case 1: r = __builtin_amdgcn_update_dpp(0, __float_as_int(v), 0x4E, 0xf, 0xf, true); break;
                        case 2: r = __builtin_amdgcn_update_dpp(0, __float_as_int(v), 0x141, 0xf, 0xf, true); break;
                        default: r = __builtin_amdgcn_update_dpp(0, __float_as_int(v), 0x140, 0xf, 0xf, true); break; }
    return v + __int_as_float(r);
}
__device__ __forceinline__ float wave_sum(float v) {
    v = dpp_add(v, 0); v = dpp_add(v, 1); v = dpp_add(v, 2); v = dpp_add(v, 3);
    const float r0 = __int_as_float(__builtin_amdgcn_readlane(__float_as_int(v), 0)), r1 = __int_as_float(__builtin_amdgcn_readlane(__float_as_int(v), 16)),
                r2 = __int_as_float(__builtin_amdgcn_readlane(__float_as_int(v), 32)), r3 = __int_as_float(__builtin_amdgcn_readlane(__float_as_int(v), 48));
    return (r0 + r1) + (r2 + r3);
}

__device__ __forceinline__ float dpp_xor1(float v) { return __int_as_float(__builtin_amdgcn_update_dpp(0, __float_as_int(v), 0xB1, 0xf, 0xf, true)); }
__device__ __forceinline__ float dpp_xor2(float v) { return __int_as_float(__builtin_amdgcn_update_dpp(0, __float_as_int(v), 0x4E, 0xf, 0xf, true)); }
__device__ __forceinline__ float dpp_xor4(float v) {
    int r = __builtin_amdgcn_update_dpp(0, __float_as_int(v), 0x114, 0xf, 0xa, false); r = __builtin_amdgcn_update_dpp(r, __float_as_int(v), 0x104, 0xf, 0x5, false); return __int_as_float(r); }
__device__ __forceinline__ float dpp_xor8(float v) { return __int_as_float(__builtin_amdgcn_update_dpp(0, __float_as_int(v), 0x128, 0xf, 0xf, true)); }
__device__ __forceinline__ void wave_sum8(float (&a)[8], int lane) {
    const bool b0 = lane & 1, b1 = lane & 2, b2 = lane & 4;
    float c[4], d[2];
#pragma unroll
    for (int k = 0; k < 4; ++k) { const float keep = b0 ? a[k + 4] : a[k], send = b0 ? a[k] : a[k + 4]; c[k] = keep + dpp_xor1(send); }
#pragma unroll
    for (int k = 0; k < 2; ++k) { const float keep = b1 ? c[k + 2] : c[k], send = b1 ? c[k] : c[k + 2]; d[k] = keep + dpp_xor2(send); }
    float x; { const float keep = b2 ? d[1] : d[0], send = b2 ? d[0] : d[1]; x = keep + dpp_xor4(send); }
    x += dpp_xor8(x);
    { auto rr = __builtin_amdgcn_permlane16_swap(__float_as_uint(x), __float_as_uint(x), false, false); x = __uint_as_float(rr[0]) + __uint_as_float(rr[1]); }
    { auto rr = __builtin_amdgcn_permlane32_swap(__float_as_uint(x), __float_as_uint(x), false, false); x = __uint_as_float(rr[0]) + __uint_as_float(rr[1]); }
#pragma unroll
    for (int e = 0; e < 8; ++e) a[e] = __int_as_float(__builtin_amdgcn_readlane(__float_as_int(x), (e >> 2) | (((e >> 1) & 1) << 1) | ((e & 1) << 2)));
}

namespace pg8 {
#define PG8_LAS __attribute__((address_space(3)))
typedef unsigned short bf16_t;
constexpr int BM = 256, BK = 64, HALF = 128, HTB = HALF * BK * 2, STAGE_BYTES = 8 * HTB, NXCD = 8, WGM = 8;
__host__ __device__ __forceinline__ int lds_byte(int r, int c) { const int st = (r >> 4) * 2 + (c >> 5), rr = r & 15, cc = c & 31, ob = rr * 64 + cc * 2; return st * 1024 + (ob ^ (((ob >> 9) & 1) << 5)); }
__host__ __device__ __forceinline__ void stage_rc(int b, int& R, int& C) { const int st = b / 1024, sb = b % 1024, swz = sb ^ (((sb >> 9) & 1) << 5); R = (st >> 1) * 16 + swz / 64; C = (st & 1) * 32 + (swz % 64) / 2; }
__host__ __device__ __forceinline__ int perm32(int rho) { const int n = rho >> 4, i = rho & 15; return 8 * (i >> 2) + 4 * n + (i & 3); }
struct Unit { int pm, pn, pk; };
struct Gemm { const bf16_t* A; const bf16_t* Bt; int M, N, K, nt; };
struct StaticOrder {
    int nM, nN, nwg, G, c;
    __host__ __device__ void init(int M, int N, int G_, int c_) { nM = M / BM; nN = N / BM; nwg = nM * nN; G = G_; c = c_; }
    __host__ __device__ bool next(int i, Unit& u) const {
        const long L = (long)i * G + c; if (L >= nwg) return false;
        int wgid = (int)L; { const int q = nwg / NXCD, r = nwg % NXCD, xcd = wgid % NXCD, off = wgid / NXCD; wgid = (xcd < r ? xcd * (q + 1) : r * (q + 1) + (xcd - r) * q) + off; }
        const int nig = WGM * nN, gid = wgid / nig, fm = gid * WGM, gsz = (nM - fm) < WGM ? (nM - fm) : WGM;
        u.pm = fm + ((wgid % nig) % gsz); u.pn = (wgid % nig) / gsz; u.pk = 0; return true;
    }
    __device__ __forceinline__ void a_ready(const Unit&) const {}
    __device__ __forceinline__ void done(const Unit&) const {}
    __device__ __forceinline__ int kn(const Unit&, int nt) const { return nt; }
    __device__ __forceinline__ int koff(const Unit& u, int nt) const { return u.pk * nt; }
};
struct MoeOrder {
    int nM, nN, nwg, G, c, npe; int t1, t2, t3, t4, t5, t6, t7;
    __device__ bool next(int i, Unit& u) const {
        const long L = (long)i * G + c; if (L >= nwg) return false;
        int wgid = (int)L; { const int q = nwg / NXCD, r = nwg % NXCD, xcd = wgid % NXCD, off = wgid / NXCD; wgid = (xcd < r ? xcd * (q + 1) : r * (q + 1) + (xcd - r) * q) + off; }
        const int nig = WGM * nN, gid = wgid / nig, fm = gid * WGM, gsz = (nM - fm) < WGM ? (nM - fm) : WGM;
        const int pm = fm + ((wgid % nig) % gsz), pnl = (wgid % nig) / gsz;
        const int e = (pm >= t1) + (pm >= t2) + (pm >= t3) + (pm >= t4) + (pm >= t5) + (pm >= t6) + (pm >= t7);
        u.pm = pm; u.pn = e * npe + pnl; u.pk = 0; return true;
    }
    __device__ __forceinline__ void a_ready(const Unit&) const {}
    __device__ __forceinline__ void done(const Unit&) const {}
    __device__ __forceinline__ int kn(const Unit&, int nt) const { return nt; }
    __device__ __forceinline__ int koff(const Unit& u, int nt) const { return u.pk * nt; }
};
struct MoeTailOrder {
    int nT, G, c; int t1, t2, t3, t4, t5, t6, t7;
    __device__ bool next(int i, Unit& u) const {
        const long L = (long)i * G + c; if (L >= (long)nT * 16) return false;
        const int pm = 256 + (int)(L >> 4), rem = (int)(L & 15);
        const int e = (pm >= t1) + (pm >= t2) + (pm >= t3) + (pm >= t4) + (pm >= t5) + (pm >= t6) + (pm >= t7);
        u.pm = pm; u.pn = e * 4 + (rem >> 2); u.pk = rem & 3; return true;
    }
    __device__ __forceinline__ void a_ready(const Unit&) const {}
    __device__ __forceinline__ void done(const Unit&) const {}
    __device__ __forceinline__ int kn(const Unit& u, int) const { return (u.pk & 1) ? 6 : 8; }
    __device__ __forceinline__ int koff(const Unit& u, int) const { return 14 * (u.pk >> 1) + 8 * (u.pk & 1); }
};

struct TailOrder {
    int pm0, nrow, nN, G, c;
    __device__ bool next(int i, Unit& u) const {
        const long L = (long)i * G + c; if (L >= (long)nrow * nN * 2) return false;
        const int rem = (int)(L % (2 * nN)); u.pm = pm0 + (int)(L / (2 * nN)); u.pn = rem >> 1; u.pk = rem & 1; return true;
    }
    __device__ __forceinline__ void a_ready(const Unit&) const {}
    __device__ __forceinline__ void done(const Unit&) const {}
    __device__ __forceinline__ int kn(const Unit&, int nt) const { return nt; }
    __device__ __forceinline__ int koff(const Unit& u, int nt) const { return u.pk * nt; }
};
struct CtxOrder {
    int pm0, nrow, nN, G, c, pn0;
    __device__ bool next(int i, Unit& u) const {
        const long L = (long)i * G + c; if (L >= (long)nrow * nN) return false;
        u.pm = pm0 + (int)(L / nN); u.pn = pn0 + (int)(L % nN); u.pk = 0; return true;
    }
    __device__ __forceinline__ void a_ready(const Unit&) const {}
    __device__ __forceinline__ void done(const Unit&) const {}
    __device__ __forceinline__ int kn(const Unit&, int nt) const { return nt; }
    __device__ __forceinline__ int koff(const Unit&, int) const { return 0; }
};


struct EpiQKV {
    static constexpr bool PERM = true, AFTER_DRAIN = false;
    bf16_t* O; const float* rope; float ascale;
    __device__ __forceinline__ void operator()(const f32x4 (&acc)[2][2][4][2], const Unit& u, int wr, int wc, int fr, int fq) const {
        const int row0 = u.pm * BM + wr * 64 + fr;
        const bool rope_on = (u.pm < (RL / BM)) && (u.pn < 5);
        const int axis = wc & 1;
        const int colb = u.pn * 256 + (wc >> 1) * 128 + axis * 64 + 8 * fq;
#pragma unroll
        for (int ai = 0; ai < 2; ++ai)
#pragma unroll
            for (int m = 0; m < 4; ++m) {
                const int r = row0 + ai * HALF + m * 16;
                f32x4 a0 = acc[ai][0][m][0] * ascale, a1 = acc[ai][0][m][1] * ascale, b0 = acc[ai][1][m][0] * ascale, b1 = acc[ai][1][m][1] * ascale;
                if (rope_on) {
                    const int t = r & (SEQ - 1); const int pos = axis ? (t & 63) : (t >> 6);
                    const float* cp = rope + pos * 32 + 8 * fq;
                    const f32x4 c0 = *(const f32x4*)cp, c1 = *(const f32x4*)(cp + 4), s0 = *(const f32x4*)(cp + 2048), s1 = *(const f32x4*)(cp + 2052);
                    const f32x4 o0 = a0 * c0 - b0 * s0, o1 = a1 * c1 - b1 * s1, q0 = b0 * c0 + a0 * s0, q1 = b1 * c1 + a1 * s1;
                    a0 = o0; a1 = o1; b0 = q0; b1 = q1;
                }
                bf16_t* rowp = O + (size_t)r * QKVD + colb;
                u32x4 w; w.x = cvtpk(a0[0], a0[1]); w.y = cvtpk(a0[2], a0[3]); w.z = cvtpk(a1[0], a1[1]); w.w = cvtpk(a1[2], a1[3]);
                *(u32x4*)rowp = w;
                u32x4 v; v.x = cvtpk(b0[0], b0[1]); v.y = cvtpk(b0[2], b0[3]); v.z = cvtpk(b1[0], b1[1]); v.w = cvtpk(b1[2], b1[3]);
                *(u32x4*)(rowp + 32) = v;
            }
    }
};
template <bool LN> struct EpiResid {
    static constexpr bool PERM = true, AFTER_DRAIN = false;
    const float* xin_lat; const float* xin_ctx; bf16_t* y; const float* gate; float ascale; const f32x2* st; const float* lng; const float* lnb; float* side;
    __device__ __forceinline__ void operator()(const f32x4 (&acc)[2][2][4][2], const Unit& u, int wr, int wc, int fr, int fq) const {
        const bool lat = u.pm < (RL / BM);
        const int b = lat ? (u.pm >> 4) : 8;
        const int row0 = u.pm * BM + wr * 64 + fr, col0 = u.pn * BM + wc * 32 + 8 * fq;
        if (u.pk) {
#pragma unroll
            for (int bj = 0; bj < 2; ++bj) { const int cc = col0 + bj * HALF;
                const f32x4 g0 = *(const f32x4*)(gate + (size_t)b * 6144 + cc) * ascale, g1 = *(const f32x4*)(gate + (size_t)b * 6144 + cc + 4) * ascale;
#pragma unroll
                for (int ai = 0; ai < 2; ++ai)
#pragma unroll
                    for (int m = 0; m < 4; ++m) { float* sp = side + (size_t)(row0 - RL + ai * HALF + m * 16) * DM + cc; *(f32x4*)sp = g0 * acc[ai][bj][m][0]; *(f32x4*)(sp + 4) = g1 * acc[ai][bj][m][1]; } }
            return; }
        const float* xin = lat ? xin_lat + (size_t)row0 * DM : xin_ctx + (size_t)(row0 - RL) * DM;
        f32x2 sv[2][4];
        if constexpr (LN) {
#pragma unroll
            for (int ai = 0; ai < 2; ++ai)
#pragma unroll
                for (int m = 0; m < 4; ++m) sv[ai][m] = st[row0 + ai * HALF + m * 16];
        }
#pragma unroll
        for (int bj = 0; bj < 2; ++bj) { const int cc = col0 + bj * HALF;
            const f32x4 g0 = *(const f32x4*)(gate + (size_t)b * 6144 + cc) * ascale, g1 = *(const f32x4*)(gate + (size_t)b * 6144 + cc + 4) * ascale;
            f32x4 lg0, lg1, lb0, lb1; if constexpr (LN) { lg0 = *(const f32x4*)(lng + cc) * ALPHA; lg1 = *(const f32x4*)(lng + cc + 4) * ALPHA; lb0 = *(const f32x4*)(lnb + cc) * ALPHA; lb1 = *(const f32x4*)(lnb + cc + 4) * ALPHA; }
#pragma unroll
            for (int ai = 0; ai < 2; ++ai)
#pragma unroll
                for (int m = 0; m < 4; ++m) { const int rr = ai * HALF + m * 16; f32x4 x0, x1;
                    if constexpr (LN) { const u32x4 w = *(const u32x4*)(y + (size_t)(row0 + rr) * DM + cc);
                        x0 = (f32x4){bflo(w.x), bfhi(w.x), bflo(w.y), bfhi(w.y)}; x1 = (f32x4){bflo(w.z), bfhi(w.z), bflo(w.w), bfhi(w.w)};
                        x0 = (x0 - sv[ai][m].x) * sv[ai][m].y * lg0 + lb0; x1 = (x1 - sv[ai][m].x) * sv[ai][m].y * lg1 + lb1; }
                    else { x0 = *(const f32x4*)(xin + (size_t)rr * DM + cc) * ALPHA; x1 = *(const f32x4*)(xin + (size_t)rr * DM + cc + 4) * ALPHA; }
                    const f32x4 o0 = x0 + g0 * acc[ai][bj][m][0], o1 = x1 + g1 * acc[ai][bj][m][1];
                    u32x4 w; w.x = cvtpk(o0[0], o0[1]); w.y = cvtpk(o0[2], o0[3]); w.z = cvtpk(o1[0], o1[1]); w.w = cvtpk(o1[2], o1[3]);
                    *(u32x4*)(y + (size_t)(row0 + rr) * DM + cc) = w; }
            asm volatile("" ::: "memory"); }
    }
};
struct EpiSwiGLU {
    static constexpr bool PERM = true, AFTER_DRAIN = false;
    bf16_t* O; int npe;
    __device__ __forceinline__ void operator()(const f32x4 (&acc)[2][2][4][2], const Unit& u, int wr, int wc, int fr, int fq) const {
        const int row0 = u.pm * BM + wr * 64 + fr, pnl = u.pn % npe, col0 = pnl * 128 + wc * 32 + 8 * fq;
#pragma unroll
        for (int ai = 0; ai < 2; ++ai)
#pragma unroll
            for (int m = 0; m < 4; ++m) {
                unsigned w[4];
#pragma unroll
                for (int n = 0; n < 2; ++n) { const f32x4 g = acc[ai][0][m][n], uu = acc[ai][1][m][n]; float o[4];
#pragma unroll
                    for (int j = 0; j < 4; ++j) o[j] = g[j] * sigm(g[j]) * uu[j];
                    w[2 * n] = cvtpk(o[0], o[1]); w[2 * n + 1] = cvtpk(o[2], o[3]); }
                u32x4 ww; ww.x = w[0]; ww.y = w[1]; ww.z = w[2]; ww.w = w[3];
                *(u32x4*)(O + (size_t)(row0 + ai * HALF + m * 16) * DFF + col0) = ww;
            }
    }
};
struct EpiLruIn {
    static constexpr bool PERM = true, AFTER_DRAIN = false;
    bf16_t* G; bf16_t* XB;
    __device__ __forceinline__ void operator()(const f32x4 (&acc)[2][2][4][2], const Unit& u, int wr, int wc, int fr, int fq) const {
        const int row0 = u.pm * BM + wr * 64 + fr; const bool isg = u.pn < 4;
        bf16_t* base = isg ? G : XB; const int col0 = (u.pn & 3) * BM + wc * 32 + 8 * fq;
#pragma unroll
        for (int ai = 0; ai < 2; ++ai)
#pragma unroll
            for (int m = 0; m < 4; ++m)
#pragma unroll
                for (int bj = 0; bj < 2; ++bj) {
                    f32x4 v0 = acc[ai][bj][m][0], v1 = acc[ai][bj][m][1];
                    if (isg) {
                        constexpr float C0 = -2.0f * LOG2E * 0.7978845608028654f, C1 = C0 * 0.044715f;
#define GELU2(X) do { const f32x2 t_ = ((X) * (X) * C1 + C0) * (X); const f32x2 d_ = (f32x2){ex2(t_.x), ex2(t_.y)} + 1.0f; (X) = (X) * (f32x2){rcpf_(d_.x), rcpf_(d_.y)}; } while (0)
                        f32x2 a0 = __builtin_shufflevector(v0, v0, 0, 1), a1 = __builtin_shufflevector(v0, v0, 2, 3), b0 = __builtin_shufflevector(v1, v1, 0, 1), b1 = __builtin_shufflevector(v1, v1, 2, 3);
                        GELU2(a0); GELU2(a1); GELU2(b0); GELU2(b1);
#undef GELU2
                        v0 = __builtin_shufflevector(a0, a1, 0, 1, 2, 3); v1 = __builtin_shufflevector(b0, b1, 0, 1, 2, 3);
                    }
                    u32x4 w; w.x = cvtpk(v0[0], v0[1]); w.y = cvtpk(v0[2], v0[3]); w.z = cvtpk(v1[0], v1[1]); w.w = cvtpk(v1[2], v1[3]);
                    *(u32x4*)(base + (size_t)(row0 + ai * HALF + m * 16) * DM + col0 + bj * HALF) = w;
                }
    }
};
struct EpiMoeOut {
    static constexpr bool PERM = true, AFTER_DRAIN = false;
    bf16_t* O; const float* wrow;
    __device__ __forceinline__ void operator()(const f32x4 (&acc)[2][2][4][2], const Unit& u, int wr, int wc, int fr, int fq) const {
        const int row0 = u.pm * BM + wr * 64 + fr, col0 = (u.pn & 3) * BM + wc * 32 + 8 * fq;
#pragma unroll
        for (int ai = 0; ai < 2; ++ai)
#pragma unroll
            for (int m = 0; m < 4; ++m) { const int r = row0 + ai * HALF + m * 16; const float g = wrow[r];
#pragma unroll
                for (int bj = 0; bj < 2; ++bj) { const f32x4 v0 = acc[ai][bj][m][0] * g, v1 = acc[ai][bj][m][1] * g;
                    u32x4 w; w.x = cvtpk(v0[0], v0[1]); w.y = cvtpk(v0[2], v0[3]); w.z = cvtpk(v1[0], v1[1]); w.w = cvtpk(v1[2], v1[3]);
                    *(u32x4*)(O + (size_t)r * DM + col0 + bj * HALF) = w; } }
    }
};

struct EpiSwiGLU8 {
    static constexpr bool PERM = true, AFTER_DRAIN = false;
    unsigned char* O; int npe;
    __device__ __forceinline__ void operator()(const f32x4 (&acc)[2][2][4][2], const Unit& u, int wr, int wc, int fr, int fq) const {
        const int row0 = u.pm * BM + wr * 64 + fr, pnl = u.pn % npe, col0 = pnl * 128 + wc * 32 + 8 * fq;
        constexpr float C1 = -LOG2E / 512.0f, KK = 32768.0f;
#pragma unroll
        for (int ai = 0; ai < 2; ++ai)
#pragma unroll
            for (int m = 0; m < 4; ++m) {
                u32x2 w;
#pragma unroll
                for (int n = 0; n < 2; ++n) { const f32x4 g = acc[ai][0][m][n], uu = acc[ai][1][m][n];
                    const f32x2 g0 = __builtin_shufflevector(g, g, 0, 1), g1 = __builtin_shufflevector(g, g, 2, 3), u0 = __builtin_shufflevector(uu, uu, 0, 1), u1 = __builtin_shufflevector(uu, uu, 2, 3);
                    const f32x2 t0 = g0 * C1, t1 = g1 * C1;
                    const f32x2 e0 = (f32x2){ex2(t0.x), ex2(t0.y)}, e1 = (f32x2){ex2(t1.x), ex2(t1.y)};
                    const f32x2 d0 = e0 * KK + KK, d1 = e1 * KK + KK;
                    const f32x2 o0 = (g0 * u0) * (f32x2){rcpf_(d0.x), rcpf_(d0.y)}, o1 = (g1 * u1) * (f32x2){rcpf_(d1.x), rcpf_(d1.y)};
                    w[n] = pk4_fp8(o0.x, o0.y, o1.x, o1.y); }
                *(u32x2*)(O + (size_t)(row0 + ai * HALF + m * 16) * DFF + col0) = w;
            }
    }
};
struct EpiMoeOut8 {
    static constexpr bool PERM = true, AFTER_DRAIN = false;
    bf16_t* O; const float* wrow; bf16_t* O2;
    __device__ __forceinline__ void operator()(const f32x4 (&acc)[2][2][4][2], const Unit& u, int wr, int wc, int fr, int fq) const {
        const int row0 = u.pm * BM + wr * 64 + fr, col0 = (u.pn & 3) * BM + wc * 32 + 8 * fq;
        bf16_t* Ob = u.pk ? O2 + ((size_t)(u.pk - 1) * 2048 + (size_t)(row0 - 65536)) * DM : O + (size_t)row0 * DM;
#pragma unroll
        for (int ai = 0; ai < 2; ++ai)
#pragma unroll
            for (int m = 0; m < 4; ++m) { const int rr = ai * HALF + m * 16; const float g = wrow[row0 + rr] * (1.0f / 4096.0f);
#pragma unroll
                for (int bj = 0; bj < 2; ++bj) { const f32x4 v0 = acc[ai][bj][m][0] * g, v1 = acc[ai][bj][m][1] * g;
                    u32x4 w; w.x = cvtpk(v0[0], v0[1]); w.y = cvtpk(v0[2], v0[3]); w.z = cvtpk(v1[0], v1[1]); w.w = cvtpk(v1[2], v1[3]);
                    *(u32x4*)(Ob + (size_t)rr * DM + col0 + bj * HALF) = w; } }
    }
};

template <class Epi, class Sched, bool ALIGN_EPI = false, bool SP2 = false, bool FP8 = false>
__device__ __forceinline__ void gemm_phase(PG8_LAS unsigned char* lds, const Gemm g, const Sched& S, const Epi& E, const int wid) {
    const int lane = lane_id(), tid = wid * 64 + lane, wr = wid >> 2, wc = wid & 3, fr = lane & 15, fq = lane >> 4;
    const int K = g.K, nt = g.nt ? g.nt : K / BK;
    unsigned voffA[2], voffB[2];
#pragma unroll
    for (int i = 0; i < 2; ++i) { int R, C; stage_rc(tid * 16 + i * 8192, R, C); const int Rb = Epi::PERM ? ((R & ~31) + perm32(R & 31)) : R;
        voffA[i] = (unsigned)(R * K + C) * 2u; voffB[i] = (unsigned)(Rb * K + C) * 2u; }
    const unsigned kstep = (unsigned)(BK * 2);
    const unsigned hstep = (unsigned)HALF * K * 2;
    const unsigned tstep = 2 * hstep;
    const __amdgpu_buffer_rsrc_t rs_voffA = __builtin_amdgcn_make_buffer_rsrc((void*)g.A, 0, -1, 0x00020000), rs_voffB = __builtin_amdgcn_make_buffer_rsrc((void*)g.Bt, 0, -1, 0x00020000);
    const unsigned ldsw = (unsigned)wid * 1024u;
    const int aoff = lds_byte(wr * 64 + fr, fq * 8), boff = lds_byte(wc * 32 + fr, fq * 8);
#define PG8_SA(b, h) (((b) * 2 + (h)) * HTB)
#define PG8_SB(b, h) ((4 + (b) * 2 + (h)) * HTB)
#define PG8_STAGE(bufoff, gbase, voff) do { _Pragma("unroll") for (int _i = 0; _i < 2; ++_i) \
        __builtin_amdgcn_raw_ptr_buffer_load_lds(rs_##voff, (PG8_LAS void*)(lds + (bufoff) + ldsw + _i * 8192), 16, (voff)[_i], (gbase), 0, 0); } while (0)
#define PG8_LDA(dst, b, h) do { if constexpr (FP8) { _Pragma("unroll") for (int m = 0; m < 4; ++m) { const v4i _l = *(const PG8_LAS v4i*)(lds + PG8_SA(b, h) + aoff + m * 2048), _h = *(const PG8_LAS v4i*)(lds + PG8_SA(b, h) + aoff + m * 2048 + 1024); \
            dst##8[m] = __builtin_shufflevector(_l, _h, 0, 1, 2, 3, 4, 5, 6, 7); } } \
        else { _Pragma("unroll") for (int m = 0; m < 4; ++m) _Pragma("unroll") for (int k = 0; k < 2; ++k) dst[m][k] = *(const PG8_LAS bf16x8*)(lds + PG8_SA(b, h) + aoff + m * 2048 + k * 1024); } } while (0)
#define PG8_LDB(dst, b, h) do { if constexpr (FP8) { _Pragma("unroll") for (int n = 0; n < 2; ++n) { const v4i _l = *(const PG8_LAS v4i*)(lds + PG8_SB(b, h) + boff + n * 2048), _h = *(const PG8_LAS v4i*)(lds + PG8_SB(b, h) + boff + n * 2048 + 1024); \
            dst##8[n] = __builtin_shufflevector(_l, _h, 0, 1, 2, 3, 4, 5, 6, 7); } } \
        else { _Pragma("unroll") for (int n = 0; n < 2; ++n) _Pragma("unroll") for (int k = 0; k < 2; ++k) dst[n][k] = *(const PG8_LAS bf16x8*)(lds + PG8_SB(b, h) + boff + n * 2048 + k * 1024); } } while (0)
#define PG8_MMA(ai, bj, At, Bt) do { if constexpr (FP8) __builtin_amdgcn_sched_barrier(0); __builtin_amdgcn_s_setprio(1); \
        if constexpr (FP8) { _Pragma("unroll") for (int m = 0; m < 4; ++m) _Pragma("unroll") for (int n = 0; n < 2; ++n) \
            acc[ai][bj][m][n] = __builtin_amdgcn_mfma_scale_f32_16x16x128_f8f6f4(Bt##8[n], At##8[m], acc[ai][bj][m][n], 0, 0, 0, 0, 0, 0); } \
        else { _Pragma("unroll") for (int m = 0; m < 4; ++m) _Pragma("unroll") for (int n = 0; n < 2; ++n) _Pragma("unroll") for (int k = 0; k < 2; ++k) \
            acc[ai][bj][m][n] = __builtin_amdgcn_mfma_f32_16x16x32_bf16(Bt[n][k], At[m][k], acc[ai][bj][m][n], 0, 0, 0); } \
        __builtin_amdgcn_s_setprio(0); if constexpr (FP8) __builtin_amdgcn_sched_barrier(0); } while (0)
#define PG8_WAIT_V(n) asm volatile("s_waitcnt vmcnt(" #n ")" ::: "memory")
#define PG8_WAIT_L(n) asm volatile("s_waitcnt lgkmcnt(" #n ")" ::: "memory")
#define PG8_BAR __builtin_amdgcn_s_barrier()
#define PG8_SCHED __builtin_amdgcn_sched_barrier(0)
    Unit cur, nxt; int ui = 0;
    if (!S.next(0, cur)) return;
    f32x4 acc[2][2][4][2];
#pragma unroll
    for (int a = 0; a < 2; ++a)
#pragma unroll
        for (int b = 0; b < 2; ++b)
#pragma unroll
            for (int m = 0; m < 4; ++m)
#pragma unroll
                for (int n = 0; n < 2; ++n) acc[a][b][m][n] = (f32x4){0.f, 0.f, 0.f, 0.f};
    bf16x8 At[4][2], B0[2][2], B1[2][2]; v8i At8[4], B08[2], B18[2];
    unsigned cA = (unsigned)cur.pm * tstep + (unsigned)S.koff(cur, nt) * kstep, cB = (unsigned)cur.pn * tstep + (unsigned)S.koff(cur, nt) * kstep;
    S.a_ready(cur);
    if constexpr (SP2) {
        PG8_STAGE(PG8_SB(0, 0), cB, voffB); PG8_STAGE(PG8_SB(0, 1), cB + hstep, voffB); PG8_STAGE(PG8_SA(0, 0), cA, voffA); PG8_STAGE(PG8_SA(0, 1), cA + hstep, voffA);
        if (wr == 1) PG8_BAR;
        PG8_WAIT_V(2); PG8_BAR;
        PG8_STAGE(PG8_SB(1, 0), cB + kstep, voffB); PG8_STAGE(PG8_SA(1, 0), cA + kstep, voffA); PG8_STAGE(PG8_SB(1, 1), cB + hstep + kstep, voffB);
        PG8_WAIT_V(6); PG8_BAR;
    } else {
        PG8_STAGE(PG8_SB(0, 0), cB, voffB); PG8_STAGE(PG8_SA(0, 0), cA, voffA); PG8_STAGE(PG8_SB(0, 1), cB + hstep, voffB); PG8_STAGE(PG8_SA(0, 1), cA + hstep, voffA);
        if (wr == 1) PG8_BAR;
        PG8_WAIT_V(4); PG8_BAR;
        PG8_STAGE(PG8_SB(1, 0), cB + kstep, voffB); PG8_STAGE(PG8_SA(1, 0), cA + kstep, voffA); PG8_STAGE(PG8_SB(1, 1), cB + hstep + kstep, voffB);
        PG8_WAIT_V(6); PG8_BAR;
    }
    for (;;) {
        const bool has_next = S.next(ui + 1, nxt);
        const unsigned nA = has_next ? (unsigned)nxt.pm * tstep + (unsigned)S.koff(nxt, nt) * kstep : cA, nB = has_next ? (unsigned)nxt.pn * tstep + (unsigned)S.koff(nxt, nt) * kstep : cB;
        const int ntu = S.kn(cur, nt);
        _Pragma("clang loop unroll(disable)") for (int t = 0; t < ntu; t += 2) {
            const bool last = (t == ntu - 2);
            const unsigned a1 = cA + (unsigned)(t + 1) * kstep;
            const unsigned a2 = last ? nA : cA + (unsigned)(t + 2) * kstep, b2 = last ? nB : cB + (unsigned)(t + 2) * kstep;
            const unsigned a3 = a2 + kstep, b3 = b2 + kstep;
            if (last && has_next) S.a_ready(nxt);
            if constexpr (SP2) {
            PG8_LDB(B0, 0, 0); PG8_LDB(B1, 0, 1); PG8_SCHED; PG8_LDA(At, 0, 0); PG8_STAGE(PG8_SA(1, 1), a1 + hstep, voffA);
            PG8_WAIT_V(8); PG8_WAIT_L(0); PG8_BAR; PG8_MMA(0, 0, At, B0); PG8_MMA(0, 1, At, B1); PG8_BAR; PG8_SCHED;
            PG8_LDA(At, 0, 1); PG8_STAGE(PG8_SB(0, 0), b2, voffB); PG8_STAGE(PG8_SB(0, 1), b2 + hstep, voffB); PG8_STAGE(PG8_SA(0, 0), a2, voffA);
            PG8_WAIT_V(8); PG8_WAIT_L(0); PG8_BAR; PG8_MMA(1, 0, At, B0); PG8_MMA(1, 1, At, B1); PG8_BAR; PG8_SCHED;
            PG8_LDB(B0, 1, 0); PG8_LDB(B1, 1, 1); PG8_SCHED; PG8_LDA(At, 1, 0); PG8_STAGE(PG8_SA(0, 1), a2 + hstep, voffA);
            PG8_WAIT_V(8); PG8_WAIT_L(0); PG8_BAR; PG8_MMA(0, 0, At, B0); PG8_MMA(0, 1, At, B1); PG8_BAR; PG8_SCHED;
            PG8_LDA(At, 1, 1); PG8_STAGE(PG8_SB(1, 0), b3, voffB); PG8_STAGE(PG8_SB(1, 1), b3 + hstep, voffB); PG8_STAGE(PG8_SA(1, 0), a3, voffA);
            PG8_WAIT_V(8); PG8_WAIT_L(0); PG8_BAR; PG8_MMA(1, 0, At, B0); PG8_MMA(1, 1, At, B1); PG8_BAR; PG8_SCHED;
            } else {
            PG8_LDB(B0, 0, 0); PG8_SCHED; PG8_LDA(At, 0, 0); PG8_STAGE(PG8_SA(1, 1), a1 + hstep, voffA);
            PG8_WAIT_L(8); PG8_BAR; PG8_WAIT_L(0); PG8_MMA(0, 0, At, B0); PG8_BAR; PG8_SCHED;
            PG8_LDB(B1, 0, 1); PG8_STAGE(PG8_SB(0, 0), b2, voffB);
            PG8_BAR; PG8_WAIT_L(0); PG8_MMA(0, 1, At, B1); PG8_BAR;
            PG8_LDA(At, 0, 1); PG8_STAGE(PG8_SA(0, 0), a2, voffA);
            PG8_BAR; PG8_WAIT_L(0); PG8_MMA(1, 0, At, B0); PG8_BAR; PG8_SCHED;
            PG8_STAGE(PG8_SB(0, 1), b2 + hstep, voffB);
            PG8_WAIT_V(6); PG8_BAR; PG8_MMA(1, 1, At, B1); PG8_BAR;
            PG8_LDB(B0, 1, 0); PG8_SCHED; PG8_LDA(At, 1, 0); PG8_STAGE(PG8_SA(0, 1), a2 + hstep, voffA);
            PG8_WAIT_L(8); PG8_BAR; PG8_WAIT_L(0); PG8_MMA(0, 0, At, B0); PG8_BAR; PG8_SCHED;
            PG8_LDB(B1, 1, 1); PG8_STAGE(PG8_SB(1, 0), b3, voffB);
            PG8_BAR; PG8_WAIT_L(0); PG8_MMA(0, 1, At, B1); PG8_BAR;
            PG8_LDA(At, 1, 1); PG8_STAGE(PG8_SA(1, 0), a3, voffA);
            PG8_BAR; PG8_WAIT_L(0); PG8_MMA(1, 0, At, B0); PG8_BAR; PG8_SCHED;
            PG8_STAGE(PG8_SB(1, 1), b3 + hstep, voffB);
            PG8_WAIT_V(6); PG8_BAR; PG8_MMA(1, 1, At, B1); PG8_BAR;
            }
        }
        if constexpr (ALIGN_EPI) { if (wr == 0) PG8_BAR; }
        if constexpr (!Epi::AFTER_DRAIN) { int le = lane_id();
            E(acc, cur, wr, wc, le & 15, le >> 4); S.done(cur); }
        if (!has_next) break;
#pragma unroll
        for (int a = 0; a < 2; ++a)
#pragma unroll
            for (int b = 0; b < 2; ++b)
#pragma unroll
                for (int m = 0; m < 4; ++m)
#pragma unroll
                    for (int n = 0; n < 2; ++n) acc[a][b][m][n] = (f32x4){0.f, 0.f, 0.f, 0.f};
        cur = nxt; cA = nA; cB = nB; ++ui;
        if constexpr (ALIGN_EPI) { if (wr == 1) PG8_BAR; }
    }
    PG8_WAIT_V(0);
    if constexpr (!ALIGN_EPI) { if (wr == 0) PG8_BAR; }
    PG8_BAR;
    if constexpr (Epi::AFTER_DRAIN) { E.fused(acc, cur, wr, wc, fr, fq, lds, wid, lane); S.done(cur); }
#undef PG8_SA
#undef PG8_SB
#undef PG8_STAGE
#undef PG8_LDA
#undef PG8_LDB
#undef PG8_MMA
#undef PG8_WAIT_V
#undef PG8_WAIT_L
#undef PG8_BAR
#undef PG8_SCHED
}
}

constexpr size_t MiB = 1u << 20;
constexpr size_t WS_CTL = 0, CTL_ZERO_BYTES = 65536;
constexpr size_t WS_MOD = 65536;
constexpr size_t WS_ROPE = 65536 + 458752;
constexpr size_t WS_WQKV = 1 * MiB, WS_WO = 4 * MiB, WS_WGU = 6 * MiB, WS_WDN = 20 * MiB, WS_WIN = 27 * MiB, WS_WOUT = 31 * MiB, WS_WLG = 33 * MiB;
constexpr size_t WS_WMGU = 34 * MiB, WS_WMDN = 146 * MiB;
constexpr size_t WS_YB = 760 * MiB;
constexpr size_t WS_H = 210 * MiB;
constexpr size_t WS_ACTV = 278 * MiB;
constexpr size_t WS_QKV = WS_ACTV, WS_O = WS_ACTV + 102 * MiB, WS_ACT = WS_ACTV + 170 * MiB;
constexpr size_t WS_G = WS_ACTV, WS_XB = WS_ACTV + 68 * MiB, WS_HF = WS_ACTV + 136 * MiB, WS_HH = WS_ACTV + 200 * MiB;
constexpr size_t WS_U = WS_ACTV + 264 * MiB;
constexpr size_t WS_HS = WS_ACTV, WS_FO = WS_ACTV + 68 * MiB, WS_MACT = WS_ACTV + 200 * MiB, WS_FO2 = WS_ACTV + 432 * MiB, WS_SIDE = WS_ACTV + 446 * MiB;
constexpr size_t WS_ROUTE = 872 * MiB;
constexpr size_t WS_LRUS = 874 * MiB;
constexpr size_t WS_END = 875 * MiB;
constexpr int MOE_MAXT = 264;
constexpr size_t RT_EIDX = 0, RT_WGT = 262144, RT_SLOT = 524288, RT_WS = 786432, RT_CNT = 786432 + 270336 + 0;
constexpr size_t LS_SUM = 0, LS_CTX = 524288;
constexpr size_t WS_STATS = WS_LRUS + 655360;

constexpr int RING_OFF = 0, RING_BYTES = 135168;
constexpr int LDSCTL_OFF = RING_BYTES, MISC_OFF = LDSCTL_OFF + 320;
constexpr int LRU_OT_OFF = 136192;
constexpr int LDS_BYTES = 136192 + 16384;

#define RLX_AGENT __ATOMIC_RELAXED, __HIP_MEMORY_SCOPE_AGENT
#define LDS_WAIT() asm volatile("s_waitcnt lgkmcnt(0)" ::: "memory")
#define VM_WAIT() asm volatile("s_waitcnt vmcnt(0)" ::: "memory")
#define XB_TMO      128
#define XB_XCNT(j)  (256  + 64 * (j))
#define XB_XSUB(j)  (1280 + 64 * (j))
#define XB_XGEN(j)  (2304 + 64 * (j))
#define XB_TOP      3328
#define XB_TOPGEN   3392
#define XCD_BAR_WORDS 3456
#define XB_SPIN_CAP (1u << 18)

__device__ __forceinline__ unsigned xb_ld(unsigned* p)              { return __hip_atomic_load(p, __ATOMIC_RELAXED, __HIP_MEMORY_SCOPE_AGENT); }
__device__ __forceinline__ unsigned xb_add(unsigned* p, unsigned v) { return __hip_atomic_fetch_add(p, v, __ATOMIC_RELAXED, __HIP_MEMORY_SCOPE_AGENT); }
__device__ __forceinline__ unsigned xb_xcc_id() { return (unsigned)__builtin_amdgcn_s_getreg((3 << 11) | 20) & 0xFu; }
#define XB_SPIN(cond, bar) do { unsigned _sp = 0; while (cond) { __builtin_amdgcn_s_sleep(1); \
    if ((++_sp & 255u) == 0u) { if (xb_ld(&(bar)[XB_TMO])) break; if (_sp > XB_SPIN_CAP) { atomicAdd(&(bar)[XB_TMO], 1u); break; } } } } while (0)

struct XcdBarrier {
    unsigned* bar; unsigned x;
    volatile LAS unsigned* st;
};

__device__ __forceinline__ XcdBarrier xcd_barrier_post(unsigned* bar, volatile LAS unsigned* st, const bool t0  ) {
    XcdBarrier b; b.bar = bar; b.x = xb_xcc_id(); b.st = st;
    if (t0) (void)xb_add(&bar[XB_XCNT(b.x)], 1u);
    return b;
}
__device__ __forceinline__ void xcd_barrier_complete(unsigned* bar, unsigned x, unsigned& nloc, unsigned& nx) {
    const unsigned G = gridDim.x * gridDim.y * gridDim.z;
    unsigned sum, cnt, mine, sp = 0u;
    for (;;) {
        sum = 0u; cnt = 0u; mine = 0u;
#pragma unroll
        for (unsigned j = 0; j < 16; ++j) { const unsigned c = xb_ld(&bar[XB_XCNT(j)]); sum += c; cnt += (c > 0u) ? 1u : 0u; mine = (j == x) ? c : mine; }
        if (sum == G) break;
        __builtin_amdgcn_s_sleep(1);
        if ((++sp & 255u) == 0u) { if (xb_ld(&bar[XB_TMO])) break; if (sp > XB_SPIN_CAP) { atomicAdd(&bar[XB_TMO], 1u); break; } }
    }
    nloc = mine > 0u ? mine : 1u; nx = cnt > 0u ? cnt : 1u;
}

__device__ __forceinline__ void xcd_barrier(const XcdBarrier& b, const bool t0  ) {
    asm volatile("s_waitcnt vmcnt(0)" ::: "memory");
    __syncthreads();
    if (t0) {
        unsigned* bar = b.bar;
        __builtin_amdgcn_s_waitcnt(0);
        unsigned nloc = b.st[0], nx = b.st[1];
        if (nloc == 0u) { xcd_barrier_complete(bar, b.x, nloc, nx); b.st[0] = nloc; b.st[1] = nx; }
        const unsigned old = xb_add(&bar[XB_XSUB(b.x)], 1u);
        const unsigned gen = old / nloc;
        if (old + 1u == (gen + 1u) * nloc) {
            __builtin_amdgcn_fence(__ATOMIC_RELEASE, "agent");
            asm volatile("s_waitcnt vmcnt(0)" ::: "memory");
            const unsigned og = xb_add(&bar[XB_TOP], 1u);
            const unsigned tg = og / nx;
            if (og + 1u == (tg + 1u) * nx) xb_add(&bar[XB_TOPGEN], 1u);
            else XB_SPIN(xb_ld(&bar[XB_TOPGEN]) == tg, bar);
            __builtin_amdgcn_fence(__ATOMIC_ACQUIRE, "agent");
            xb_add(&bar[XB_XGEN(b.x)], 1u);
            asm volatile("s_waitcnt vmcnt(0)" ::: "memory");
        } else {
            XB_SPIN(xb_ld(&bar[XB_XGEN(b.x)]) == gen, bar);
            __builtin_amdgcn_fence(__ATOMIC_ACQUIRE, "agent");
            asm volatile("s_waitcnt vmcnt(0)" ::: "memory");
        }
    }
    __syncthreads();
}


struct Frame {
    LAS unsigned char* lds;
    volatile LAS unsigned* MISC;
    int tid, lane, wave, vcu, G;
    const float *x, *c, *ctx, *cctx, *w_mod, *b_mod, *ln_g, *ln_b, *w_qkv, *w_o, *sink, *w_gu, *w_dn, *w_in, *conv_w, *conv_b, *lam, *w_r, *b_r, *w_i, *b_i, *w_out, *router, *mw_gu, *mw_dn;
    float* out; unsigned char* ws;
};
#define WSP(T, off) ((T*)(F.ws + (off)))

__device__ __forceinline__ void p0_mod_task(Frame& F, int task) {
    const int li = task / 96, cb = task % 96;
    LAS float* S = (LAS float*)F.lds;
    LAS float* red = (LAS float*)(F.lds + 36864);
    for (int idx = F.tid; idx < 9 * 1024; idx += NWAVES * 64) { const int b = idx >> 10, k = idx & 1023; const float v = (b < 8) ? F.c[b * 1024 + k] : F.cctx[k]; S[idx] = v * sigm(v); }
    __syncthreads();
    const float* W = F.w_mod + (size_t)li * 1024 * 6144 + cb * 64;
    const int cl = F.lane & 15, kr = F.lane >> 4;
    f32x4 acc[9];
#pragma unroll
    for (int b = 0; b < 9; ++b) acc[b] = (f32x4){0.f, 0.f, 0.f, 0.f};
    const int k0 = 128 * F.wave + 32 * kr;
    const float* Wl = W + (size_t)k0 * 6144 + 4 * cl;
#pragma unroll
    for (int h = 0; h < 2; ++h) { f32x4 wv[16];
#pragma unroll
        for (int i = 0; i < 16; ++i) wv[i] = *(const f32x4*)(Wl + (size_t)(16 * h + i) * 6144);
#pragma unroll
        for (int q = 0; q < 4; ++q)
#pragma unroll
            for (int b = 0; b < 9; ++b) { const f32x4 s4 = *(LAS const f32x4*)(S + b * 1024 + k0 + 16 * h + 4 * q);
                acc[b] += wv[4 * q] * s4[0]; acc[b] += wv[4 * q + 1] * s4[1]; acc[b] += wv[4 * q + 2] * s4[2]; acc[b] += wv[4 * q + 3] * s4[3]; } }
#pragma unroll
    for (int b = 0; b < 9; ++b)
#pragma unroll
        for (int j = 0; j < 4; ++j) { float v = acc[b][j]; v += __shfl_xor(v, 16); v += __shfl_xor(v, 32); acc[b][j] = v; }
    if (kr == 0) {
#pragma unroll
        for (int b = 0; b < 9; ++b) *(LAS f32x4*)(red + (F.wave * 9 + b) * 64 + 4 * cl) = acc[b]; }
    __syncthreads();
    float* mod = WSP(float, WS_MOD);
    for (int idx = F.tid; idx < 9 * 64; idx += NWAVES * 64) { const int b = idx >> 6, col = idx & 63; float s = 0.f;
#pragma unroll
        for (int w = 0; w < 8; ++w) s += red[(w * 9 + b) * 64 + col];
        mod[(size_t)(li * 9 + b) * 6144 + cb * 64 + col] = s + F.b_mod[li * 6144 + cb * 64 + col]; }
    __syncthreads();
}
__device__ __forceinline__ void p0_transpose_item(const float* W, int K, int N, bf16* WT, int kb, int n0, int drow0, LAS float* scr, int lane) {
    const int k0 = 64 * kb;
#pragma unroll
    for (int i = 0; i < 8; ++i) { const int kk = 8 * i + (lane >> 3); const f32x4 wv = *(const f32x4*)(W + (size_t)(k0 + kk) * N + n0 + 4 * (lane & 7));
        LAS float* d = scr + kk * 33 + 4 * (lane & 7); d[0] = wv[0]; d[1] = wv[1]; d[2] = wv[2]; d[3] = wv[3]; }
    LDS_WAIT(); asm volatile("" ::: "memory");
    const int c = lane & 7;
#pragma unroll
    for (int j = 0; j < 4; ++j) { const int n = (lane >> 3) + 8 * j; const LAS float* s = scr + (8 * c) * 33 + n;
        u32x4 o; o.x = cvtpk(s[0 * 33], s[1 * 33]); o.y = cvtpk(s[2 * 33], s[3 * 33]); o.z = cvtpk(s[4 * 33], s[5 * 33]); o.w = cvtpk(s[6 * 33], s[7 * 33]);
        *(GAS u32x4*)(WT + (size_t)(drow0 + n) * K + k0 + 8 * c) = o; }
    LDS_WAIT(); asm volatile("" ::: "memory");
}
template <int QS> __device__ __forceinline__ void p0_transpose_item8(const float* W, int K, int N, unsigned char* WT, int kb, int n0, int drow0, LAS float* scr, int lane) {
    const int k0 = 64 * kb; constexpr float qs = (float)(1 << QS);
#pragma unroll
    for (int i = 0; i < 8; ++i) { const int kk = 8 * i + (lane >> 3); const f32x4 wv = *(const f32x4*)(W + (size_t)(k0 + kk) * N + n0 + 4 * (lane & 7)) * qs;
        LAS float* d = scr + kk * 33 + 4 * (lane & 7); d[0] = wv[0]; d[1] = wv[1]; d[2] = wv[2]; d[3] = wv[3]; }
    LDS_WAIT(); asm volatile("" ::: "memory");
    const int c = lane & 7;
#pragma unroll
    for (int j = 0; j < 4; ++j) { const int n = (lane >> 3) + 8 * j; const LAS float* s = scr + (8 * c) * 33 + n;
        u32x2 o; o.x = pk4_fp8(s[0 * 33], s[1 * 33], s[2 * 33], s[3 * 33]); o.y = pk4_fp8(s[4 * 33], s[5 * 33], s[6 * 33], s[7 * 33]);
        *(GAS u32x2*)(WT + (size_t)(drow0 + n) * K + k0 + 8 * c) = o; }
    LDS_WAIT(); asm volatile("" ::: "memory");
}
__device__ __forceinline__ int gu_row(int j) { const int isu = j >= DFF, jj = isu ? j - DFF : j; return (jj >> 7) * 256 + isu * 128 + (jj & 127); }
__device__ __forceinline__ int qkv_row(int L) { const int pn = L >> 8, rem = L & 255, hsel = rem >> 7, axis = (rem >> 6) & 1, half = (rem >> 5) & 1, x = rem & 31; return pn * 256 + 128 * half + 32 * (2 * hsel + axis) + x; }

__device__ __forceinline__ void p0_prologue(Frame& F) {
    for (int task = F.vcu; task < 192; task += F.G) p0_mod_task(F, task);
    if (F.vcu == F.G - 1) {
        float* rope = WSP(float, WS_ROPE);
        for (int idx = F.tid; idx < 2048; idx += NWAVES * 64) { const int pos = idx >> 5, i = idx & 31;
            const double freq = exp2(-(double)i * (13.287712379549449 / 32.0));
            const float ang = (float)pos * (float)freq;
            double rev = (double)ang * 0.15915494309189535; rev -= floor(rev);
            rope[idx] = __builtin_amdgcn_cosf((float)rev); rope[2048 + idx] = __builtin_amdgcn_sinf((float)rev); }
    }
    LAS float* scr = (LAS float*)(F.lds + F.wave * 8704);
    const int gw = F.vcu * NWAVES + F.wave, NGW = F.G * NWAVES;
    constexpr int I_QKV = 16 * 48;
    const int idle0 = (F.G > 192) ? 192 * NWAVES : 0, nidle = NGW - idle0;
    if (gw >= idle0) for (int r = gw - idle0; r < I_QKV; r += nidle) { const int kb = r / 48, n0 = (r % 48) * 32; p0_transpose_item8<7>(F.w_qkv, 1024, 1536, WSP(unsigned char, WS_WQKV), kb, n0, qkv_row(n0), scr, F.lane); }
}

constexpr int MOE_I_GU = 16 * 224, MOE_I_DN = 56 * 32, MOE_ITEMS = 8 * (MOE_I_GU + MOE_I_DN);
constexpr int DR_O = 16 * 32, DR_GU = 16 * 224, DR_DN = 56 * 32, DR_IN = 16 * 64, DR_OUT = 16 * 32, DR_LG = 32 * 8, DR_ITEMS = DR_O + DR_GU + DR_DN + DR_IN + DR_OUT + DR_LG;
constexpr int CV_ITEMS = DR_ITEMS + MOE_ITEMS;
__device__ __forceinline__ void moe_convert_items(Frame& F, int lo, int hi, int rank, int nranks) {
    LAS float* scr = (LAS float*)(F.lds + F.wave * 8704);
    for (int it0 = lo + rank * NWAVES + F.wave; it0 < hi; it0 += nranks * NWAVES) {
        int r = it0;
        if (r < DR_O) { const int kb = r / 32, n0 = (r % 32) * 32; p0_transpose_item8<7>(F.w_o, 1024, 1024, WSP(unsigned char, WS_WO), kb, n0, n0, scr, F.lane); continue; } r -= DR_O;
        if (r < DR_GU) { const int kb = r / 224, n0 = (r % 224) * 32; p0_transpose_item8<7>(F.w_gu, 1024, 7168, WSP(unsigned char, WS_WGU), kb, n0, gu_row(n0), scr, F.lane); continue; } r -= DR_GU;
        if (r < DR_DN) { const int kb = r / 32, n0 = (r % 32) * 32; p0_transpose_item8<9>(F.w_dn, 3584, 1024, WSP(unsigned char, WS_WDN), kb, n0, n0, scr, F.lane); continue; } r -= DR_DN;
        if (r < DR_IN) { const int kb = r / 64, n0 = (r % 64) * 32; p0_transpose_item(F.w_in, 1024, 2048, WSP(bf16, WS_WIN), kb, n0, n0, scr, F.lane); continue; } r -= DR_IN;
        if (r < DR_OUT) { const int kb = r / 32, n0 = (r % 32) * 32; p0_transpose_item(F.w_out, 1024, 1024, WSP(bf16, WS_WOUT), kb, n0, n0, scr, F.lane); continue; } r -= DR_OUT;
        if (r < DR_LG) { const int mi = r >> 3, sub = r & 7, which = mi >> 4, d = (mi >> 3) & 1, n = mi & 7, kb = sub >> 2, n0 = (sub & 3) * 32;
            p0_transpose_item((which ? F.w_i : F.w_r) + (size_t)(d * 8 + n) * 16384, 128, 128, WSP(bf16, WS_WLG) + (size_t)(n * 4 + 2 * d + which) * 16384, kb, n0, n0, scr, F.lane); continue; } r -= DR_LG;
        if (r < 8 * MOE_I_GU) { const int e = r / MOE_I_GU, q = r % MOE_I_GU, kb = q / 224, n0 = (q % 224) * 32;
            p0_transpose_item8<7>(F.mw_gu + (size_t)e * 1024 * 7168, 1024, 7168, WSP(unsigned char, WS_WMGU) + (size_t)e * 7168 * 1024, kb, n0, gu_row(n0), scr, F.lane); }
        else { r -= 8 * MOE_I_GU; const int e = r / MOE_I_DN, q = r % MOE_I_DN, kb = q / 32, n0 = (q % 32) * 32;
            p0_transpose_item8<9>(F.mw_dn + (size_t)e * 3584 * 1024, 3584, 1024, WSP(unsigned char, WS_WMDN) + (size_t)e * 1024 * 3584, kb, n0, n0, scr, F.lane); }
    }
}
__device__ __forceinline__ void moe_convert_filler(Frame& F, int nwg, int c, int lo, int hi) {
    const int R = (nwg + F.G - 1) / F.G, rem = nwg - (R - 1) * F.G;
    REFRESH_F(F);
    if (rem >= F.G) { moe_convert_items(F, lo, hi, c, F.G); return; }
    if (c >= rem) moe_convert_items(F, lo, hi, c - rem, F.G - rem);
}
__device__ __forceinline__ void tail_filler(Frame& F, int ntail, int c, int lo, int hi) {
    REFRESH_F(F);
    if (F.G <= ntail) { moe_convert_items(F, lo, hi, c, F.G); return; }
    if (c >= ntail) moe_convert_items(F, lo, hi, c - ntail, F.G - ntail);
}
__device__ __forceinline__ void row_load(f32x4 (&v)[4], const float* p, int lane) {
#pragma unroll
    for (int j = 0; j < 4; ++j) v[j] = *(const f32x4*)(p + 4 * lane + 256 * j);
}
__device__ __forceinline__ void row_load_bf(f32x4 (&v)[4], const bf16* p, int lane) {
#pragma unroll
    for (int j = 0; j < 4; ++j) { const u32x2 w = *(const u32x2*)(p + 4 * lane + 256 * j); v[j] = (f32x4){bflo(w.x), bfhi(w.x), bflo(w.y), bfhi(w.y)}; }
}
__device__ __forceinline__ void row_store(const f32x4 (&v)[4], float* p, int lane) {
#pragma unroll
    for (int j = 0; j < 4; ++j) *(f32x4*)(p + 4 * lane + 256 * j) = v[j];
}
struct Vec16 { f32x4 q[4]; };
__device__ __forceinline__ Vec16 vec_load(const float* p, int lane) { Vec16 r;
#pragma unroll
    for (int j = 0; j < 4; ++j) r.q[j] = *(const f32x4*)(p + 4 * lane + 256 * j);
    return r; }
__device__ __forceinline__ f32x2 row_ln_v(f32x4 (&v)[4], const Vec16& g, const Vec16& bt) {
    const float K = __int_as_float(__builtin_amdgcn_readfirstlane(__float_as_int(v[0].x)));
    float s = 0.f, s2 = 0.f;
#pragma unroll
    for (int j = 0; j < 4; ++j) { v[j] = v[j] - K; s += (v[j].x + v[j].y) + (v[j].z + v[j].w); s2 += (v[j].x * v[j].x + v[j].y * v[j].y) + (v[j].z * v[j].z + v[j].w * v[j].w); }
    const float m1 = wave_sum(s) * (1.f / DM), q = wave_sum(s2) * (1.f / DM);
    const float rstd = 1.f / sqrtf(fmaxf(q - m1 * m1, 0.f) + LN_EPS);
#pragma unroll
    for (int j = 0; j < 4; ++j) v[j] = (v[j] - m1) * rstd * g.q[j] + bt.q[j];
    return (f32x2){K + m1, rstd};
}
template <bool H8> __device__ __forceinline__ void row_mod_store_v(const f32x4 (&v)[4], const Vec16& sh, const Vec16& sc, void* hbase, size_t r, int lane) {
#pragma unroll
    for (int j = 0; j < 4; ++j) { const f32x4 h = v[j] * (sc.q[j] + 1.0f) + sh.q[j];
        if constexpr (H8) *(unsigned*)((unsigned char*)hbase + r * DM + 4 * lane + 256 * j) = pk4_fp8(h[0] * 4.f, h[1] * 4.f, h[2] * 4.f, h[3] * 4.f);
        else { u32x2 w; w.x = cvtpk(h[0], h[1]); w.y = cvtpk(h[2], h[3]); *(u32x2*)((bf16*)hbase + r * DM + 4 * lane + 256 * j) = w; } }
}
#define ROWS_LAT(...) do { const int nwb_ = NGW / 8; if (nwb_ > 0 && gw < 8 * nwb_) { const int b = gw / nwb_, nwin_ = (SEQ + nwb_ - 1) / nwb_; \
    for (int i_ = 0; i_ < nwin_; ++i_) { const int r = b * SEQ + ((i_ + 2 * b) % nwin_) * nwb_ + gw % nwb_;     \
        if (r < (b + 1) * SEQ) { __VA_ARGS__ } } } } while (0)
#define ROWS_CTX(...) do { const int b = 8; for (int r = RL + gw; r < RT; r += NGW) { __VA_ARGS__ } } while (0)
struct Raw8 { u32x2 q[4]; };
template <class Raw, class LoadF, class ProcF> __device__ __forceinline__ void rows_lat4(int gw, int NGW, LoadF load, ProcF proc) {
    const int nwb = NGW / 8; if (nwb <= 0 || gw >= 8 * nwb) return;
    const int b = gw / nwb, nwin = (SEQ + nwb - 1) / nwb;
    for (int i0 = 0; i0 < nwin; i0 += 4) { int rr[4]; Raw raw[4];
#pragma unroll
        for (int q = 0; q < 4; ++q) { const int i = i0 + q; int r = b * SEQ + ((i + 2 * b) % nwin) * nwb + gw % nwb; if (i >= nwin || r >= (b + 1) * SEQ) r = -1; rr[q] = r; load(raw[q], r < 0 ? b * SEQ : r); }
#pragma unroll
        for (int q = 0; q < 4; ++q) if (rr[q] >= 0) proc(raw[q], rr[q]); }
}
__device__ __forceinline__ void raw8_load(Raw8& w, const bf16* p, int lane) {
#pragma unroll
    for (int j = 0; j < 4; ++j) w.q[j] = *(const u32x2*)(p + 4 * lane + 256 * j);
}
__device__ __forceinline__ void raw8_cvt(f32x4 (&v)[4], const Raw8& w) {
#pragma unroll
    for (int j = 0; j < 4; ++j) v[j] = (f32x4){bflo(w.q[j].x), bfhi(w.q[j].x), bflo(w.q[j].y), bfhi(w.q[j].y)};
}
__device__ __forceinline__ void p1_modulate(Frame& F) {
    const int gw = F.vcu * NWAVES + F.wave, NGW = F.G * NWAVES; const float* mod = WSP(float, WS_MOD); bf16* H = WSP(bf16, WS_H);
    { const int bb = gw / (NGW / 8) < 8 ? gw / (NGW / 8) : 7; const Vec16 sh = vec_load(mod + (size_t)bb * 6144, F.lane), sc = vec_load(mod + (size_t)bb * 6144 + 1024, F.lane);
      rows_lat4<Vec16>(gw, NGW, [&](Vec16& w, int r) { const f32x4* p = (const f32x4*)(F.x + (size_t)r * DM) + F.lane; _Pragma("unroll") for (int j = 0; j < 4; ++j) w.q[j] = __builtin_nontemporal_load(p + 64 * j); }, [&](const Vec16& w, int r) { row_mod_store_v<true>(w.q, sh, sc, H, (size_t)r, F.lane); }); }
    { const Vec16 sh = vec_load(mod + (size_t)8 * 6144, F.lane), sc = vec_load(mod + (size_t)8 * 6144 + 1024, F.lane);
      ROWS_CTX( (void)b; f32x4 v[4]; row_load(v, F.ctx + (size_t)(r - RL) * DM, F.lane); row_mod_store_v<true>(v, sh, sc, H, (size_t)r, F.lane); ); }
}
template <bool H8> __device__ __forceinline__ void ln_mod_pass(Frame& F, bool with_ctx, const float* g, const float* bt, int ml, int cs, const float* side) {
    const int gw = F.vcu * NWAVES + F.wave, NGW = F.G * NWAVES; const float* mod = WSP(float, WS_MOD) + (size_t)ml * 9 * 6144; bf16* H = WSP(bf16, WS_H); const bf16* YB = WSP(bf16, WS_YB);
    const Vec16 gv = vec_load(g, F.lane), bv = vec_load(bt, F.lane);
    { const int bb = gw / (NGW / 8) < 8 ? gw / (NGW / 8) : 7; const Vec16 sh = vec_load(mod + (size_t)bb * 6144 + cs, F.lane), sc = vec_load(mod + (size_t)bb * 6144 + cs + 1024, F.lane);
      rows_lat4<Raw8>(gw, NGW, [&](Raw8& w, int r) { raw8_load(w, YB + (size_t)r * DM, F.lane); },
                      [&](const Raw8& w, int r) { f32x4 v[4]; raw8_cvt(v, w); const f32x2 sv = row_ln_v(v, gv, bv); if (F.lane == 0) ((f32x2*)(F.ws + WS_STATS))[r] = sv;
                          row_mod_store_v<H8>(v, sh, sc, H, (size_t)r, F.lane); }); }
    if (with_ctx) { const Vec16 sh = vec_load(mod + (size_t)8 * 6144 + cs, F.lane), sc = vec_load(mod + (size_t)8 * 6144 + cs + 1024, F.lane);
      ROWS_CTX( (void)b; f32x4 v[4]; row_load_bf(v, YB + (size_t)r * DM, F.lane);
                { const float* sp = side + (size_t)(r - RL) * DM; bf16* yw = (bf16*)YB + (size_t)r * DM;
                  _Pragma("unroll") for (int j = 0; j < 4; ++j) { const f32x4 t = v[j] + *(const f32x4*)(sp + 4 * F.lane + 256 * j); u32x2 w; w.x = cvtpk(t[0], t[1]); w.y = cvtpk(t[2], t[3]);
                      *(u32x2*)(yw + 4 * F.lane + 256 * j) = w; v[j] = (f32x4){bflo(w.x), bfhi(w.x), bflo(w.y), bfhi(w.y)}; } }
                const f32x2 sv = row_ln_v(v, gv, bv); if (F.lane == 0) ((f32x2*)(F.ws + WS_STATS))[r] = sv;
                row_mod_store_v<H8>(v, sh, sc, H, (size_t)r, F.lane); ); }
}

namespace att {
constexpr float SCALE = 0.08838834764831845f, THR = 8.f;
constexpr int SHM_V = 64 * 128 * 2, SHM_K = 64 * 128 * 2;
#define KSWZ(row, colB) ((row) * 256 + ((colB) ^ (((row) & 7) << 4)))
#define SBAR() __builtin_amdgcn_sched_barrier(0)
__device__ __forceinline__ int crow(int r, int hi) { return (r & 3) + 8 * (r >> 2) + 4 * hi; }
__device__ __forceinline__ float psm_max(const f32x16& p) {
    float a = fmaxf(fmaxf(p[0], p[1]), p[2]), b = fmaxf(fmaxf(p[3], p[4]), p[5]), c = fmaxf(fmaxf(p[6], p[7]), p[8]), d = fmaxf(fmaxf(p[9], p[10]), p[11]);
    a = fmaxf(fmaxf(a, p[12]), p[13]); b = fmaxf(fmaxf(b, p[14]), p[15]); return fmaxf(fmaxf(fmaxf(a, b), c), d);
}
__device__ __forceinline__ void psm_mask(f32x16& p0, f32x16& p1, int d0) {
#pragma unroll
    for (int r = 0; r < 16; ++r) { const int rel = d0 + (r & 3) + 8 * (r >> 2);
        p0[r] = ((unsigned)(rel + 128) <= 256u) ? p0[r] : -1e30f; p1[r] = ((unsigned)(rel + 160) <= 256u) ? p1[r] : -1e30f; }
}
__device__ __forceinline__ void partialSM(f32x16& p0, f32x16& p1, float& m_reg, float& mn, float& alpha, bool domask, int d0) {
    constexpr float C = SCALE * 1.4426950408889634f;
    if (domask) psm_mask(p0, p1, d0);
    float pmax = fmaxf(psm_max(p0), psm_max(p1));
    { auto rr = __builtin_amdgcn_permlane32_swap(__float_as_uint(pmax), __float_as_uint(pmax), false, false);
      pmax = fmaxf(__uint_as_float(rr[0]), __uint_as_float(rr[1])); }
    mn = (pmax - m_reg > THR / SCALE) ? pmax : m_reg; alpha = ex2((m_reg - mn) * C); m_reg = mn;
    const float mnC = -mn * C;
    p0 = p0 * C + mnC; p1 = p1 * C + mnC;
#pragma unroll
    for (int r = 0; r < 16; ++r) p0[r] = ex2(p0[r]);
}
__device__ __forceinline__ void finishSM(f32x16& p0, f32x16& p1, float alpha, float& l_reg, bf16x8& pa0, bf16x8& pa1, bf16x8& pa2, bf16x8& pa3) {
#pragma unroll
    for (int r = 0; r < 16; ++r) p1[r] = ex2(p1[r]);
    f32x2 s2 = (f32x2){0.f, 0.f};
#pragma unroll
    for (int r = 0; r < 16; r += 2) s2 += (f32x2){p0[r], p0[r + 1]} + (f32x2){p1[r], p1[r + 1]};
    float ps = s2.x + s2.y;
    { auto rr = __builtin_amdgcn_permlane32_swap(__float_as_uint(ps), __float_as_uint(ps), false, false);
      ps = __uint_as_float(rr[0]) + __uint_as_float(rr[1]); }
    l_reg = l_reg * alpha + ps;
#define PK4(P, BASE, OUT) do { unsigned a0 = cvtpk(P[BASE + 0], P[BASE + 1]), a1 = cvtpk(P[BASE + 2], P[BASE + 3]);   \
    unsigned b0 = cvtpk(P[BASE + 4], P[BASE + 5]), b1 = cvtpk(P[BASE + 6], P[BASE + 7]);                              \
    auto r0 = __builtin_amdgcn_permlane32_swap(a0, b0, false, false); auto r1 = __builtin_amdgcn_permlane32_swap(a1, b1, false, false); \
    u32x4 w = {r0[0], r1[0], r0[1], r1[1]}; OUT = __builtin_bit_cast(bf16x8, w); } while (0)
    PK4(p0, 0, pa0); PK4(p0, 8, pa1); PK4(p1, 0, pa2); PK4(p1, 8, pa3);
#undef PK4
}
__device__ __forceinline__ void qkt(f32x16& p0, f32x16& p1, LAS const unsigned char* Ks, const bf16x8* qr, int r32, int hi) {
    p0 = f32x16{}; p1 = f32x16{};
#pragma unroll
    for (int d0 = 0; d0 < 8; ++d0) { const int cb = (d0 * 16 + hi * 8) * 2;
        const bf16x8 b0 = *(LAS const bf16x8*)(Ks + KSWZ(r32, cb));
        const bf16x8 b1 = *(LAS const bf16x8*)(Ks + KSWZ(32 + r32, cb));
        p0 = __builtin_amdgcn_mfma_f32_32x32x16_bf16(b0, qr[d0], p0, 0, 0, 0);
        p1 = __builtin_amdgcn_mfma_f32_32x32x16_bf16(b1, qr[d0], p1, 0, 0, 0); }
}
__device__ __forceinline__ int v_st(int k, int c) { const int kk = (k & ~0xC) | ((k & 4) << 1) | ((k & 8) >> 1); return ((kk >> 3) * 4 + (c >> 5)) * 512 + ((kk & 7) * 32 + (c & 31)) * 2; }
__device__ __forceinline__ int v_rd_base(int lane) { return ((lane & 3) << 3) | (((lane >> 2) & 3) << 6) | (((lane >> 4) & 1) << 5) | (((lane >> 5) & 1) << 8); }
constexpr int v_rd_off(int d0, int ks, int half) { return d0 * 512 + ks * 4096 + half * 2048; }
template <int OFF> __device__ __forceinline__ s16x4 tr_read(int vb) {
    s16x4 r; asm volatile("ds_read_b64_tr_b16 %0, %1 offset:%2" : "=&v"(r) : "v"(vb), "i"(OFF) : "memory"); return r;
}
template <int D0> __device__ __forceinline__ void pv_one(f32x16& od, int vb, bf16x8 pa0, bf16x8 pa1, bf16x8 pa2, bf16x8 pa3) {
    const s16x4 l0 = tr_read<v_rd_off(D0, 0, 0)>(vb), h0 = tr_read<v_rd_off(D0, 0, 1)>(vb), l1 = tr_read<v_rd_off(D0, 1, 0)>(vb), h1 = tr_read<v_rd_off(D0, 1, 1)>(vb);
    const s16x4 l2 = tr_read<v_rd_off(D0, 2, 0)>(vb), h2 = tr_read<v_rd_off(D0, 2, 1)>(vb), l3 = tr_read<v_rd_off(D0, 3, 0)>(vb), h3 = tr_read<v_rd_off(D0, 3, 1)>(vb);
    asm volatile("s_waitcnt lgkmcnt(0)" ::: "memory"); SBAR();
#define PKV(L, H) (bf16x8){L[0], L[1], L[2], L[3], H[0], H[1], H[2], H[3]}
    od = __builtin_amdgcn_mfma_f32_32x32x16_bf16(pa0, PKV(l0, h0), od, 0, 0, 0);
    od = __builtin_amdgcn_mfma_f32_32x32x16_bf16(pa1, PKV(l1, h1), od, 0, 0, 0);
    od = __builtin_amdgcn_mfma_f32_32x32x16_bf16(pa2, PKV(l2, h2), od, 0, 0, 0);
    od = __builtin_amdgcn_mfma_f32_32x32x16_bf16(pa3, PKV(l3, h3), od, 0, 0, 0);
#undef PKV
}
__device__ __forceinline__ void pv_d0(f32x16* o, int vb, bf16x8 pa0, bf16x8 pa1, bf16x8 pa2, bf16x8 pa3) {
    pv_one<0>(o[0], vb, pa0, pa1, pa2, pa3); pv_one<1>(o[1], vb, pa0, pa1, pa2, pa3); pv_one<2>(o[2], vb, pa0, pa1, pa2, pa3); pv_one<3>(o[3], vb, pa0, pa1, pa2, pa3);
}
__device__ __forceinline__ void pv_partial(f32x16* o, int vb, bf16x8 pa0, bf16x8 pa1, bf16x8 pa2, bf16x8 pa3, f32x16& p0, f32x16& p1, float& m_reg, float& mn, float& alpha, bool domask, int d0) {
    constexpr float C = SCALE * 1.4426950408889634f;
#define PKV(L, H) (bf16x8){L[0], L[1], L[2], L[3], H[0], H[1], H[2], H[3]}
#define RD8(A, D0) A##0 = tr_read<v_rd_off(D0, 0, 0)>(vb); A##1 = tr_read<v_rd_off(D0, 0, 1)>(vb); A##2 = tr_read<v_rd_off(D0, 1, 0)>(vb); A##3 = tr_read<v_rd_off(D0, 1, 1)>(vb); \
    A##4 = tr_read<v_rd_off(D0, 2, 0)>(vb); A##5 = tr_read<v_rd_off(D0, 2, 1)>(vb); A##6 = tr_read<v_rd_off(D0, 3, 0)>(vb); A##7 = tr_read<v_rd_off(D0, 3, 1)>(vb)
#define MM4(OD, A) OD = __builtin_amdgcn_mfma_f32_32x32x16_bf16(pa0, PKV(A##0, A##1), OD, 0, 0, 0); OD = __builtin_amdgcn_mfma_f32_32x32x16_bf16(pa1, PKV(A##2, A##3), OD, 0, 0, 0); \
    OD = __builtin_amdgcn_mfma_f32_32x32x16_bf16(pa2, PKV(A##4, A##5), OD, 0, 0, 0); OD = __builtin_amdgcn_mfma_f32_32x32x16_bf16(pa3, PKV(A##6, A##7), OD, 0, 0, 0)
    s16x4 a0, a1, a2, a3, a4, a5, a6, a7, b0, b1, b2, b3, b4, b5, b6, b7;
    RD8(a, 0); RD8(b, 1);
    asm volatile("s_waitcnt lgkmcnt(8)" ::: "memory"); SBAR(); MM4(o[0], a);
    if (domask) psm_mask(p0, p1, d0);
    const float mx0 = psm_max(p0);
    SBAR(); RD8(a, 2);
    asm volatile("s_waitcnt lgkmcnt(8)" ::: "memory"); SBAR(); MM4(o[1], b);
    float pmax = fmaxf(mx0, psm_max(p1));
    { auto rr = __builtin_amdgcn_permlane32_swap(__float_as_uint(pmax), __float_as_uint(pmax), false, false);
      pmax = fmaxf(__uint_as_float(rr[0]), __uint_as_float(rr[1])); }
    mn = (pmax - m_reg > THR / SCALE) ? pmax : m_reg; alpha = ex2((m_reg - mn) * C); m_reg = mn;
    const float mnC = -mn * C;
    SBAR(); RD8(b, 3);
    asm volatile("s_waitcnt lgkmcnt(8)" ::: "memory"); SBAR(); MM4(o[2], a);
    p0 = p0 * C + mnC; p1 = p1 * C + mnC;
    SBAR();
    asm volatile("s_waitcnt lgkmcnt(0)" ::: "memory"); SBAR(); MM4(o[3], b);
#pragma unroll
    for (int r = 0; r < 16; ++r) p0[r] = ex2(p0[r]);
    asm volatile("" : "+v"(p0), "+v"(p1));
    SBAR();
#undef PKV
#undef RD8
#undef MM4
}
struct UnitP { int qrow0, head0, kvh, krow_band, nband, krow_ctx, dpos0; };
__device__ __forceinline__ void attn_unit(const bf16* __restrict__ QKV, bf16* __restrict__ O, const float* __restrict__ sink, const UnitP U, const bool pre, const bool has_next, const UnitP N,
                                          bf16x8 (&qr)[8], int (&ring)[3], LAS unsigned char* lds, const int wid) {
    const int lane = lane_id(), r32 = lane & 31, hi = lane >> 5;
    LAS unsigned char* V_lds = lds; LAS unsigned char* K_lds = lds + 3 * SHM_V;
    LAS float* wsf = (LAS float*)(lds + 3 * SHM_V + 3 * SHM_K) + wid * 64; LAS float* li_l = wsf; LAS float* al_l = wsf + 32;
    const int qoff = 32 * (wid & 3), head = U.head0 + (wid >> 2);
    const int nband = U.nband, dpos0 = U.dpos0;
    float m_reg = sink[head] * (1.0f / SCALE), l_reg = 1.0f; f32x16 o[4] = {};
    unsigned voK[2], voV[2];
#pragma unroll
    for (int i = 0; i < 2; ++i) { const int s = (i * 8 + wid) * 64 + lane;
        { const int row = s >> 4, ch = (s & 15) ^ (row & 7); voK[i] = (unsigned)(row * (QKVD * 2) + ch * 16); }
        { const int qlo = s & 3, kklo = (s >> 2) & 7, blk = s >> 5, qhi = blk & 3, kk = (blk >> 2) * 8 + kklo, k = (kk & ~0xC) | ((kk & 4) << 1) | ((kk & 8) >> 1); voV[i] = (unsigned)(k * (QKVD * 2) + (qhi * 4 + qlo) * 16); } }
    const __amdgpu_buffer_rsrc_t rs = __builtin_amdgcn_make_buffer_rsrc((void*)QKV, 0, -1, 0x00020000);
    const int vb0 = (int)(unsigned)(uintptr_t)V_lds + v_rd_base(lane);
    const int NT = nband + 4;
#define TROWP(P, j) ((j) < (P).nband ? (P).krow_band + 64 * (j) : (P).krow_ctx + 64 * ((j) - (P).nband))
#define DMAP(P, j, bo) do { const unsigned so_ = (unsigned)TROWP(P, j) * (unsigned)(QKVD * 2) + (unsigned)(1024 + (P).kvh * HDIM) * 2u; _Pragma("unroll") for (int i_ = 0; i_ < 2; ++i_) { \
        __builtin_amdgcn_raw_ptr_buffer_load_lds(rs, (LAS void*)(K_lds + (bo) + (i_ * 8 + wid) * 1024), 16, voK[i_], so_, 0, 0); \
        __builtin_amdgcn_raw_ptr_buffer_load_lds(rs, (LAS void*)(V_lds + (bo) + (i_ * 8 + wid) * 1024), 16, voV[i_], so_ + 512u, 0, 0); } } while (0)
#define QLOAD(P) do { const bf16* Qw_ = QKV + (size_t)((P).qrow0 + qoff + r32) * QKVD + ((P).head0 + (wid >> 2)) * HDIM + hi * 8; _Pragma("unroll") for (int d0 = 0; d0 < 8; ++d0) qr[d0] = *(const bf16x8*)(Qw_ + d0 * 16); } while (0)
#define UBAR(n) do { asm volatile("s_waitcnt vmcnt(" #n ") lgkmcnt(0)" ::: "memory"); __builtin_amdgcn_s_barrier(); asm volatile("" ::: "memory"); } while (0)
#define RESC(a) do { if (__any((a) < 1.f)) { if (hi == 0) al_l[r32] = (a); asm volatile("s_waitcnt lgkmcnt(0)" ::: "memory"); \
    _Pragma("unroll") for (int d = 0; d < 4; ++d) _Pragma("unroll") for (int r = 0; r < 16; ++r) o[d][r] *= al_l[crow(r, hi)]; } } while (0)
    f32x16 pA0, pA1, pB0, pB1; float mnA, mnB, alA, alB; bf16x8 pa0, pa1, pa2, pa3;
    int bc = ring[0], bn = ring[1], bnn = ring[2];
    if (!pre) { QLOAD(U); DMAP(U, 0, bc); DMAP(U, 1, bn); }
    UBAR(0);
    qkt(pA0, pA1, K_lds + bc, qr, r32, hi); { const int dl = dpos0 - qoff; const bool dm = (0 < nband) && !(dl >= -97 && dl <= 65); partialSM(pA0, pA1, m_reg, mnA, alA, dm, dl - r32 + 4 * hi); }
#define STEP(Pc0, Pc1, alc, Pn0, Pn1, mnn, aln, t) do { UBAR(0); if ((t) + 2 < NT) DMAP(U, (t) + 2, bnn); \
        SBAR(); qkt(Pn0, Pn1, K_lds + bn, qr, r32, hi); finishSM(Pc0, Pc1, alc, l_reg, pa0, pa1, pa2, pa3); SBAR(); \
        { const int jj = (t) + 1; const int dl = dpos0 + 64 * jj - qoff; const bool dm = (jj < nband) && !(dl >= -97 && dl <= 65); \
          pv_partial(o, vb0 + bc, pa0, pa1, pa2, pa3, Pn0, Pn1, m_reg, mnn, aln, dm, dl - r32 + 4 * hi); } \
        RESC(aln); { const int t_ = bc; bc = bn; bn = bnn; bnn = t_; } } while (0)
    int t = 0;
    for (; t + 2 < NT - 1; t += 2) { STEP(pA0, pA1, alA, pB0, pB1, mnB, alB, t); STEP(pB0, pB1, alB, pA0, pA1, mnA, alA, t + 1); }
    STEP(pA0, pA1, alA, pB0, pB1, mnB, alB, t);
    if (has_next) { UBAR(0); DMAP(N, 0, bn); DMAP(N, 1, bnn); QLOAD(N); }
    ring[0] = bn; ring[1] = bnn; ring[2] = bc;
    finishSM(pB0, pB1, alB, l_reg, pa0, pa1, pa2, pa3); SBAR();
    pv_d0(o, vb0 + bc, pa0, pa1, pa2, pa3);
    if (hi == 0) li_l[r32] = l_reg; asm volatile("s_waitcnt lgkmcnt(0)" ::: "memory");
    float rli[16];
#pragma unroll
    for (int r = 0; r < 16; ++r) rli[r] = rcpf_(li_l[crow(r, hi)]);
    { LAS unsigned char* ot = lds + 3 * SHM_V + 3 * SHM_K + 4096 + wid * 4096;
#pragma unroll
      for (int r = 0; r < 16; ++r) { const int orow = crow(r, hi);
#pragma unroll
          for (int d0 = 0; d0 < 4; ++d0) { const float x = clamp8(o[d0][r] * rli[r] * 16.0f); ot[orow * 128 + d0 * 32 + r32] = (unsigned char)(__builtin_amdgcn_cvt_pk_fp8_f32(x, x, 0, false) & 0xff); } }
      asm volatile("s_waitcnt lgkmcnt(0)" ::: "memory");
      unsigned char* Ob = (unsigned char*)O + (size_t)(U.qrow0 + qoff) * DM + head * HDIM;
#pragma unroll
      for (int i = 0; i < 4; ++i) { const int row = (lane >> 3) + 8 * i, ch = lane & 7; *(u32x4*)(Ob + (size_t)row * DM + ch * 16) = *(LAS const u32x4*)(ot + row * 128 + ch * 16); } }
    asm volatile("s_waitcnt lgkmcnt(0)" ::: "memory");
#undef TROWP
#undef DMAP
#undef QLOAD
#undef UBAR
#undef RESC
#undef STEP
}
constexpr int N_LAT_UNITS = NB * 32 * NKVH * 2, N_CTX_UNITS = NB * 2 * NKVH * 2, N_UNITS = N_LAT_UNITS + N_CTX_UNITS;
__device__ __forceinline__ bool unit_params(int i, int c, int G, UnitP& P) {
    const int L = i * G + c; if (L >= N_UNITS) return false;
    if (L < N_LAT_UNITS) { int hp, kh, n, b;
        if (G == 256) { const int u = (i < 3) ? L : ((c >= 64) ? 768 + (c - 64) : -1);
            if (u >= 0) { hp = u & 1; kh = (u >> 1) & 1; const int rest = u >> 2; n = 1 + rest % 30; b = rest / 30; }
            else { hp = c & 1; kh = (c >> 1) & 1; n = ((c >> 2) & 1) ? 31 : 0; b = c >> 3; } }
        else { hp = L & 1; kh = (L >> 1) & 1; n = (L >> 2) & 31; b = L >> 7; }
        const int nlo = n > 0 ? n - 1 : 0, nhi = n < 31 ? n + 1 : 31;
        P.qrow0 = b * SEQ + n * 128; P.head0 = kh * 4 + hp * 2; P.kvh = kh; P.krow_band = b * SEQ + nlo * 128; P.nband = 2 * (nhi - nlo + 1); P.krow_ctx = RL + b * LCTX; P.dpos0 = (nlo - n) * 128;
    } else { const int u = L - N_LAT_UNITS, hp = u & 1, kh = (u >> 1) & 1, qh = (u >> 2) & 1, b = u >> 3;
        P.qrow0 = RL + b * LCTX + qh * 128; P.head0 = kh * 4 + hp * 2; P.kvh = kh; P.krow_band = 0; P.nband = 0; P.krow_ctx = RL + b * LCTX; P.dpos0 = 0; }
    return true;
}
__device__ __forceinline__ void attn_phase(const bf16* QKV, bf16* O, const float* sink, int G, int c, LAS unsigned char* lds, const int wid) {
    UnitP U, N; bf16x8 qr[8]; int ring[3] = {0, SHM_K, 2 * SHM_K};
    bool have = unit_params(0, c, G, U), pre = false;
    for (int i = 0; have; ++i) { const bool has_next = unit_params(i + 1, c, G, N);
        attn_unit(QKV, O, sink, U, pre, has_next, has_next ? N : U, qr, ring, lds, wid);
        U = N; have = has_next; pre = true; }
}
#undef KSWZ
#undef SBAR
}

__device__ __forceinline__ void p10_conv(Frame& F) {
    const int gw = F.vcu * NWAVES + F.wave, NGW = F.G * NWAVES; const bf16* XB = WSP(bf16, WS_XB); bf16* U = WSP(bf16, WS_U);
    float cw[4][16], cb[16];
#pragma unroll
    for (int j = 0; j < 4; ++j)
#pragma unroll
        for (int q = 0; q < 4; ++q) { const f32x4 w = *(const f32x4*)(F.conv_w + j * 1024 + 16 * F.lane + 4 * q); cw[j][4 * q] = w[0]; cw[j][4 * q + 1] = w[1]; cw[j][4 * q + 2] = w[2]; cw[j][4 * q + 3] = w[3]; }
#pragma unroll
    for (int q = 0; q < 4; ++q) { const f32x4 w = *(const f32x4*)(F.conv_b + 16 * F.lane + 4 * q); cb[4 * q] = w[0]; cb[4 * q + 1] = w[1]; cb[4 * q + 2] = w[2]; cb[4 * q + 3] = w[3]; }
    const int per = (RT + NGW - 1) / NGW, r0 = gw * per, r1 = (r0 + per < RT) ? r0 + per : RT;
    if (r0 >= RT) return;
    u32x4 w0[4], w1[4];
#pragma unroll
    for (int j = 0; j < 4; ++j) { int rr = r0 + j - 2; rr = rr < 0 ? 0 : (rr >= RT ? RT - 1 : rr); const u32x4* p = (const u32x4*)(XB + (size_t)rr * DM + 16 * F.lane); w0[j] = p[0]; w1[j] = p[1]; }
    for (int r = r0; r < r1; ++r) { const bool lat = r < RL; const int t = lat ? (r & (SEQ - 1)) : ((r - RL) & (LCTX - 1)); const int Ls = lat ? SEQ : LCTX;
        u32x4 n0, n1; { int rn = r + 2; rn = rn >= RT ? RT - 1 : rn; const u32x4* p = (const u32x4*)(XB + (size_t)rn * DM + 16 * F.lane); n0 = p[0]; n1 = p[1]; }
        float acc[16];
#pragma unroll
        for (int i = 0; i < 16; ++i) acc[i] = cb[i];
#pragma unroll
        for (int j = 0; j < 4; ++j) { const int tj = t + j - 2;
            if (tj >= 0 && tj < Ls) { const u32x4 x0 = w0[j], x1 = w1[j];
#pragma unroll
                for (int q = 0; q < 4; ++q) { acc[2 * q] += cw[j][2 * q] * bflo(x0[q]); acc[2 * q + 1] += cw[j][2 * q + 1] * bfhi(x0[q]); acc[8 + 2 * q] += cw[j][8 + 2 * q] * bflo(x1[q]); acc[8 + 2 * q + 1] += cw[j][8 + 2 * q + 1] * bfhi(x1[q]); } } }
        u32x4 o0, o1;
#pragma unroll
        for (int q = 0; q < 4; ++q) { o0[q] = cvtpk(acc[2 * q], acc[2 * q + 1]); o1[q] = cvtpk(acc[8 + 2 * q], acc[8 + 2 * q + 1]); }
        u32x4* op = (u32x4*)(U + (size_t)r * DM + 16 * F.lane); op[0] = o0; op[1] = o1;
        w0[0] = w0[1]; w0[1] = w0[2]; w0[2] = w0[3]; w0[3] = n0; w1[0] = w1[1]; w1[1] = w1[2]; w1[2] = w1[3]; w1[3] = n1; }
}
namespace lru {
constexpr int AIMG_BYTES = 65536;
constexpr int EX_OFF = 2 * AIMG_BYTES;
struct Ctx { const bf16* U; const bf16* G; bf16* HH; u32x4* HF; const bf16* WLG; const float *lam, *b_r, *b_i; };

__device__ __forceinline__ void issue_u(const __amdgpu_buffer_rsrc_t rs, LAS unsigned char* buf, int n, size_t row0, int wid, unsigned voff) {
#pragma unroll
    for (int ii = 0; ii < 8; ++ii) { const int i = wid + 8 * ii;
        __builtin_amdgcn_raw_ptr_buffer_load_lds(rs, (LAS void*)(buf + i * 1024), 16, voff, (unsigned)((row0 + 32 * ii) * DM * 2 + n * 256), 0, 0); }
}
__device__ __forceinline__ void chunk_geom(int DIR, int k, int b, size_t& row0, int& lc) {
    if (k == 0) { row0 = (size_t)RL + b * LCTX; lc = -1; } else { lc = DIR ? 16 - k : k - 1; row0 = (size_t)b * SEQ + 256 * lc; }
}
__device__ __forceinline__ void rows4(float x, float& r0, float& r1, float& r2, float& r3) {
    const unsigned u = __float_as_uint(x);
    auto pq = __builtin_amdgcn_permlane16_swap(u, u, false, false);
    auto a = __builtin_amdgcn_permlane32_swap(pq[0], pq[0], false, false);
    auto b = __builtin_amdgcn_permlane32_swap(pq[1], pq[1], false, false);
    r0 = __uint_as_float(a[0]); r2 = __uint_as_float(a[1]); r1 = __uint_as_float(b[0]); r3 = __uint_as_float(b[1]);
}
#define LRU_BAR() do { asm volatile("s_waitcnt lgkmcnt(0)" ::: "memory"); __builtin_amdgcn_s_barrier(); asm volatile("" ::: "memory"); } while (0)
template <int DIR>
__device__ __forceinline__ void walk(const Ctx& C, LAS unsigned char* lds, int task, const int wid) {
    const int cq = task & 3, n = (task >> 2) & 7, b = task >> 5;
    const int lane = lane_id(), tid = wid * 64 + lane, c = lane & 15, g = lane >> 4;
    const int chalf = wid & 1, tq = wid >> 1;
    const int chl = 32 * cq + 16 * chalf + c;
    const int ch = n * 128 + chl;
    bf16x8 Br[4], Bi[4];
    { const bf16* wr = C.WLG + ((size_t)(n * 4 + 2 * DIR) * 128 + chl) * 128 + 8 * g; const bf16* wi = wr + 16384;
#pragma unroll
      for (int ks = 0; ks < 4; ++ks) { Br[ks] = *(const bf16x8*)(wr + ks * 32); Bi[ks] = *(const bf16x8*)(wi + ks * 32); } }
    const float br = C.b_r[DIR * 1024 + ch], bi = C.b_i[DIR * 1024 + ch];
    const float sp8 = 8.0f * log1pf(expf(-C.lam[DIR * 1024 + ch]));
    const float kbr = -LOG2E * br, kbi = -LOG2E * bi, ka = -sp8 * LOG2E;
    float H = 0.f;
    unsigned fb[4];
#pragma unroll
    for (int ks = 0; ks < 4; ++ks) fb[ks] = (unsigned)((64 * tq + c) * 256 + ((ks * 64 + 16 * g) ^ (c << 4)));
    bf16x8 Bsel;
#pragma unroll
    for (int j = 0; j < 8; ++j) Bsel[j] = (8 * g + j == 16 * chalf + c) ? (short)0x3F80 : (short)0;
    const unsigned fbq = (unsigned)((64 * tq + c) * 256 + ((cq * 64 + 16 * g) ^ (c << 4)));
    const __amdgpu_buffer_rsrc_t urs = __builtin_amdgcn_make_buffer_rsrc((void*)C.U, 0, -1, 0x00020000);
    const unsigned uvoff = (unsigned)((4 * wid + (lane >> 4)) * DM * 2 + (((lane & 15) ^ ((4 * wid + (lane >> 4)) & 15)) * 16));
    { size_t r0; int lc; chunk_geom(DIR, 0, b, r0, lc); issue_u(urs, lds, n, r0, wid, uvoff); }
    u32x4 gq0, gq1; size_t qgrow = 0; bool pend = false;
    float yq[4][4], Pq[4][4], Hwq = 0.f; int lcq = -1;
    LAS unsigned char* otile = lds + LRU_OT_OFF;
#define LRU_FLUSH() do { const int tt = tid >> 1, hh = tid & 1; \
        const u32x4 s0 = *(LAS const u32x4*)(otile + tt * 64 + hh * 32), s1 = *(LAS const u32x4*)(otile + tt * 64 + hh * 32 + 16); u32x4 o0, o1; \
        _Pragma("unroll") for (int j = 0; j < 4; ++j) { o0[j] = cvtpk(bflo(s0[j]) * bflo(gq0[j]), bfhi(s0[j]) * bfhi(gq0[j])); o1[j] = cvtpk(bflo(s1[j]) * bflo(gq1[j]), bfhi(s1[j]) * bfhi(gq1[j])); } \
        *(u32x4*)(C.HH + qgrow) = o0; *(u32x4*)(C.HH + qgrow + 8) = o1; } while (0)
#define LRU_FWD_FLUSH() do { u32x4* hp = C.HF + ((((size_t)task * 16 + lcq) * 8 + wid) * 2) * 64 + lane; \
        _Pragma("unroll") for (int mt = 0; mt < 4; ++mt) _Pragma("unroll") for (int r = 0; r < 4; ++r) yq[mt][r] += Pq[mt][r] * Hwq; \
        u32x4 w0, w1; w0.x = cvtpk(yq[0][0], yq[0][1]); w0.y = cvtpk(yq[0][2], yq[0][3]); w0.z = cvtpk(yq[1][0], yq[1][1]); w0.w = cvtpk(yq[1][2], yq[1][3]); \
        w1.x = cvtpk(yq[2][0], yq[2][1]); w1.y = cvtpk(yq[2][2], yq[2][3]); w1.z = cvtpk(yq[3][0], yq[3][1]); w1.w = cvtpk(yq[3][2], yq[3][3]); \
        hp[0] = w0; hp[64] = w1; } while (0)
    for (int k = 0; k < 17; ++k) {
        size_t row0; int lc; chunk_geom(DIR, k, b, row0, lc);
        LAS unsigned char* img = lds + (k & 1) * AIMG_BYTES;
        asm volatile("s_waitcnt vmcnt(0)" ::: "memory");
        LRU_BAR();
        if (k + 1 < 17) { size_t r1; int l1; chunk_geom(DIR, k + 1, b, r1, l1); issue_u(urs, lds + ((k + 1) & 1) * AIMG_BYTES, n, r1, wid, uvoff); }
        if (DIR == 1 && pend) LRU_FLUSH();
        if (DIR == 0 && lcq >= 0) LRU_FWD_FLUSH();
        u32x4 hf0, hf1;
        u32x4 gp0, gp1;
        if (DIR == 1 && lc >= 0) { const u32x4* hp = C.HF + ((((size_t)task * 16 + lc) * 8 + wid) * 2) * 64 + lane; hf0 = hp[0]; hf1 = hp[64];
            const size_t grow = (row0 + (tid >> 1)) * DM + n * 128 + 32 * cq + 16 * (tid & 1); gp0 = *(const u32x4*)(C.G + grow); gp1 = *(const u32x4*)(C.G + grow + 8); }
        f32x4 ar[4], ai[4], au[4];
#pragma unroll
        for (int mt = 0; mt < 4; ++mt) { ar[mt] = (f32x4){0.f, 0.f, 0.f, 0.f}; ai[mt] = (f32x4){0.f, 0.f, 0.f, 0.f};
#pragma unroll
            for (int ks = 0; ks < 4; ++ks) { const bf16x8 af = *(LAS const bf16x8*)(img + fb[ks] + mt * 4096);
                ar[mt] = __builtin_amdgcn_mfma_f32_16x16x32_bf16(af, Br[ks], ar[mt], 0, 0, 0);
                ai[mt] = __builtin_amdgcn_mfma_f32_16x16x32_bf16(af, Bi[ks], ai[mt], 0, 0, 0); }
            { const bf16x8 af = *(LAS const bf16x8*)(img + fbq + mt * 4096); au[mt] = __builtin_amdgcn_mfma_f32_16x16x32_bf16(af, Bsel, (f32x4){0.f, 0.f, 0.f, 0.f}, 0, 0, 0); } }
        float y0[4][4], P[4][4]; float TA = 1.f, TB = 0.f;
#pragma unroll
        for (int mm = 0; mm < 4; ++mm) { const int mt = DIR ? 3 - mm : mm;
            float a[4], bb[4];
#pragma unroll
            for (int h = 0; h < 2; ++h) {
                const f32x2 xr = (f32x2){ar[mt][2 * h], ar[mt][2 * h + 1]}, xi = (f32x2){ai[mt][2 * h], ai[mt][2 * h + 1]}, uu = (f32x2){au[mt][2 * h], au[mt][2 * h + 1]};
                const f32x2 tr = xr * (-LOG2E) + kbr, ti = xi * (-LOG2E) + kbi;
                const f32x2 dr = (f32x2){ex2(tr.x), ex2(tr.y)} + 1.0f, di = (f32x2){ex2(ti.x), ex2(ti.y)} + 1.0f;
                const f32x2 ta = (f32x2){rcpf_(dr.x), rcpf_(dr.y)} * ka, ig = (f32x2){rcpf_(di.x), rcpf_(di.y)};
                const f32x2 av = (f32x2){ex2(ta.x), ex2(ta.y)};
                const f32x2 em = 1.0f - av * av;
                const f32x2 bv = (f32x2){__builtin_amdgcn_sqrtf(em.x), __builtin_amdgcn_sqrtf(em.y)} * (ig * uu);
                a[2 * h] = av.x; a[2 * h + 1] = av.y; bb[2 * h] = bv.x; bb[2 * h + 1] = bv.y; }
            float p[4], yl[4];
            if (DIR == 0) { p[0] = a[0]; yl[0] = bb[0];
#pragma unroll
                for (int r = 1; r < 4; ++r) { p[r] = a[r] * p[r - 1]; yl[r] = a[r] * yl[r - 1] + bb[r]; } }
            else { p[3] = a[3]; yl[3] = bb[3];
#pragma unroll
                for (int r = 2; r >= 0; --r) { p[r] = a[r] * p[r + 1]; yl[r] = a[r] * yl[r + 1] + bb[r]; } }
            const float Al = DIR ? p[0] : p[3], Bl = DIR ? yl[0] : yl[3];
            float A0, A1, A2, A3, B0, B1, B2, B3; rows4(Al, A0, A1, A2, A3); rows4(Bl, B0, B1, B2, B3);
            float EA, EB, At, Bt;
            if (DIR == 0) { const float e1a = A0, e1b = B0, e2a = A1 * e1a, e2b = A1 * e1b + B1, e3a = A2 * e2a, e3b = A2 * e2b + B2;
                EA = g == 0 ? 1.f : (g == 1 ? e1a : (g == 2 ? e2a : e3a)); EB = g == 0 ? 0.f : (g == 1 ? e1b : (g == 2 ? e2b : e3b)); At = A3 * e3a; Bt = A3 * e3b + B3; }
            else { const float e2a = A3, e2b = B3, e1a = A2 * e2a, e1b = A2 * e2b + B2, e0a = A1 * e1a, e0b = A1 * e1b + B1;
                EA = g == 3 ? 1.f : (g == 2 ? e2a : (g == 1 ? e1a : e0a)); EB = g == 3 ? 0.f : (g == 2 ? e2b : (g == 1 ? e1b : e0b)); At = A0 * e0a; Bt = A0 * e0b + B0; }
            const float QA = EA * TA, QB = EA * TB + EB;
#pragma unroll
            for (int r = 0; r < 4; ++r) { P[mt][r] = p[r] * QA; y0[mt][r] = p[r] * QB + yl[r]; }
            TB = At * TB + Bt; TA = At * TA;
        }
        if (g == 0) *(LAS f32x2*)(lds + EX_OFF + ((tq * 2 + chalf) * 16 + c) * 8) = (f32x2){TA, TB};
        LRU_BAR();
        float Hw;
        { const f32x2 e0 = *(LAS const f32x2*)(lds + EX_OFF + ((0 * 2 + chalf) * 16 + c) * 8), e1 = *(LAS const f32x2*)(lds + EX_OFF + ((1 * 2 + chalf) * 16 + c) * 8),
                      e2 = *(LAS const f32x2*)(lds + EX_OFF + ((2 * 2 + chalf) * 16 + c) * 8), e3 = *(LAS const f32x2*)(lds + EX_OFF + ((3 * 2 + chalf) * 16 + c) * 8);
          if (DIR == 0) { const float h1 = e0.x * H + e0.y, h2 = e1.x * h1 + e1.y, h3 = e2.x * h2 + e2.y; Hw = tq == 0 ? H : (tq == 1 ? h1 : (tq == 2 ? h2 : h3)); H = e3.x * h3 + e3.y; }
          else { const float h2 = e3.x * H + e3.y, h1 = e2.x * h2 + e2.y, h0 = e1.x * h1 + e1.y; Hw = tq == 3 ? H : (tq == 2 ? h2 : (tq == 1 ? h1 : h0)); H = e0.x * h0 + e0.y; } }
        if (DIR == 0) { lcq = lc; Hwq = Hw;
#pragma unroll
            for (int mt = 0; mt < 4; ++mt)
#pragma unroll
                for (int r = 0; r < 4; ++r) { yq[mt][r] = y0[mt][r]; Pq[mt][r] = P[mt][r]; } }
        if (DIR == 1 && lc >= 0) {
#pragma unroll
            for (int mt = 0; mt < 4; ++mt)
#pragma unroll
                for (int r = 0; r < 4; ++r) y0[mt][r] += P[mt][r] * Hw;
            {
                const unsigned hw[8] = {hf0.x, hf0.y, hf0.z, hf0.w, hf1.x, hf1.y, hf1.z, hf1.w};
#pragma unroll
                for (int mt = 0; mt < 4; ++mt)
#pragma unroll
                    for (int r = 0; r < 4; ++r) { const unsigned w = hw[mt * 2 + (r >> 1)]; const float hfv = (r & 1) ? bfhi(w) : bflo(w); const float s = y0[mt][r] + hfv;
                        *(LAS bf16*)(otile + (64 * tq + mt * 16 + 4 * g + r) * 64 + (16 * chalf + c) * 2) = (bf16)(cvtpk(s, 0.f) & 0xffffu); }
                gq0 = gp0; gq1 = gp1; qgrow = (row0 + (tid >> 1)) * DM + n * 128 + 32 * cq + 16 * (tid & 1); pend = true;
            }
        }
    }
    asm volatile("s_waitcnt vmcnt(0)" ::: "memory");
    LRU_BAR();
    if (DIR == 1 && pend) { LRU_FLUSH(); asm volatile("s_waitcnt lgkmcnt(0)" ::: "memory"); }
    if (DIR == 0 && lcq >= 0) LRU_FWD_FLUSH();
#undef LRU_FWD_FLUSH
#undef LRU_FLUSH
}
#undef LRU_BAR
}
__device__ __forceinline__ void p11_lru(Frame& F, const lru::Ctx& C) {
    for (int task = F.vcu; task < 256; task += F.G) { lru::walk<0>(C, F.lds, task, F.wave); lru::walk<1>(C, F.lds, task, F.wave); }
}

__device__ __forceinline__ void p13_ln_router(Frame& F) {
    LAS float* RTR = (LAS float*)F.lds;
    LAS int* lcnt = (LAS int*)(F.lds + 32768);
    for (int idx = F.tid; idx < 8192; idx += NWAVES * 64) RTR[(idx & 7) * 1024 + (idx >> 3)] = F.router[idx];
    const float* mod = WSP(float, WS_MOD) + (size_t)1 * 9 * 6144; unsigned char* H8 = WSP(unsigned char, WS_H);
    int* eidx = (int*)(F.ws + WS_ROUTE + RT_EIDX); float* wgt = (float*)(F.ws + WS_ROUTE + RT_WGT); int* cnt = (int*)(F.ws + WS_ROUTE + RT_CNT);
    const Vec16 gv = vec_load(F.ln_g + 2 * 1024, F.lane), bv = vec_load(F.ln_b + 2 * 1024, F.lane);
    for (int batch = F.vcu; batch < RL / 128; batch += F.G) {
        const float* mb0 = mod + (size_t)((batch * 128) >> 12) * 6144 + 3072; const Vec16 sh = vec_load(mb0, F.lane), sc = vec_load(mb0 + 1024, F.lane);
        if (F.tid < 8) lcnt[F.tid] = 0;
        __syncthreads();
        u32x2 nx[4]; { const bf16* yp = WSP(bf16, WS_YB) + (size_t)(batch * 128 + F.wave * 16) * DM;
#pragma unroll
            for (int j = 0; j < 4; ++j) nx[j] = *(const u32x2*)(yp + 4 * F.lane + 256 * j); }
        for (int i = 0; i < 16; ++i) { const int r = batch * 128 + F.wave * 16 + i;
            f32x4 v[4];
#pragma unroll
            for (int j = 0; j < 4; ++j) v[j] = (f32x4){bflo(nx[j].x), bfhi(nx[j].x), bflo(nx[j].y), bfhi(nx[j].y)};
            if (i + 1 < 16) { const bf16* yp = WSP(bf16, WS_YB) + (size_t)(r + 1) * DM;
#pragma unroll
                for (int j = 0; j < 4; ++j) nx[j] = *(const u32x2*)(yp + 4 * F.lane + 256 * j); }
            row_ln_v(v, gv, bv);
            float lg[8]; f32x2 l2[8];
#pragma unroll
            for (int e = 0; e < 8; ++e) l2[e] = (f32x2){0.f, 0.f};
#pragma unroll
            for (int j = 0; j < 4; ++j) { const f32x4 hm = v[j] * (sc.q[j] + 1.0f) + sh.q[j];
                *(unsigned*)(H8 + (size_t)r * DM + 4 * F.lane + 256 * j) = pk4_fp8(hm[0] * 4.f, hm[1] * 4.f, hm[2] * 4.f, hm[3] * 4.f);
                f32x4 rt[8];
#pragma unroll
                for (int e = 0; e < 8; ++e) rt[e] = *(LAS const f32x4*)(RTR + e * 1024 + 4 * F.lane + 256 * j);
                const f32x2 h01 = __builtin_shufflevector(hm, hm, 0, 1), h23 = __builtin_shufflevector(hm, hm, 2, 3);
#pragma unroll
                for (int e = 0; e < 8; ++e) { l2[e] += h01 * __builtin_shufflevector(rt[e], rt[e], 0, 1); l2[e] += h23 * __builtin_shufflevector(rt[e], rt[e], 2, 3); } }
#pragma unroll
            for (int e = 0; e < 8; ++e) lg[e] = l2[e].x + l2[e].y;
            wave_sum8(lg, F.lane);
            int ea = 0; float la = lg[0];
#pragma unroll
            for (int e = 1; e < 8; ++e) if (lg[e] > la) { la = lg[e]; ea = e; }
            int eb = -1; float lb = -3.0e38f;
#pragma unroll
            for (int e = 0; e < 8; ++e) if (e != ea && lg[e] > lb) { lb = lg[e]; eb = e; }
            const float wa = 1.0f / (1.0f + __expf(lb - la)), wb = 1.0f - wa;
            if (F.lane == 0) { *(int2*)(eidx + 2 * r) = make_int2(ea, eb); *(float2*)(wgt + 2 * r) = make_float2(wa, wb); atomicAdd((int*)(lcnt + ea), 1); atomicAdd((int*)(lcnt + eb), 1); }
        }
        __syncthreads();
        if (F.tid < 8) cnt[batch * 8 + F.tid] = lcnt[F.tid];
        __syncthreads();
    }
}
__device__ __forceinline__ void moe_totals(Frame& F, int upto_batch, int (&tot)[8], int (&before)[8]) {
    const int* cnt = (const int*)(F.ws + WS_ROUTE + RT_CNT);
#pragma unroll
    for (int e = 0; e < 8; ++e) { tot[e] = 0; before[e] = 0; }
#pragma unroll
    for (int k = 0; k < 4; ++k) { const int bb = 4 * F.lane + k; const int4 c0 = *(const int4*)(cnt + bb * 8), c1 = *(const int4*)(cnt + bb * 8 + 4); const int m = bb < upto_batch ? 1 : 0;
        tot[0] += c0.x; tot[1] += c0.y; tot[2] += c0.z; tot[3] += c0.w; tot[4] += c1.x; tot[5] += c1.y; tot[6] += c1.z; tot[7] += c1.w;
        before[0] += m * c0.x; before[1] += m * c0.y; before[2] += m * c0.z; before[3] += m * c0.w; before[4] += m * c1.x; before[5] += m * c1.y; before[6] += m * c1.z; before[7] += m * c1.w; }
#pragma unroll
    for (int e = 0; e < 8; ++e) {
#pragma unroll
        for (int o = 1; o < 64; o <<= 1) { tot[e] += __shfl_xor(tot[e], o); before[e] += __shfl_xor(before[e], o); } }
}
__device__ __forceinline__ void p14_gather(Frame& F) {
    const int* eidx = (const int*)(F.ws + WS_ROUTE + RT_EIDX); const float* wgt = (const float*)(F.ws + WS_ROUTE + RT_WGT);
    int* slot = (int*)(F.ws + WS_ROUTE + RT_SLOT); float* wsort = (float*)(F.ws + WS_ROUTE + RT_WS);
    const unsigned char* H8 = WSP(unsigned char, WS_H); unsigned char* HS8 = WSP(unsigned char, WS_HS);
    LAS int* wcnt = (LAS int*)F.lds;
    LAS int* dsts = (LAS int*)(F.lds + 256);
    for (int batch = F.vcu; batch < RL / 128; batch += F.G) {
        int tot[8], before[8]; moe_totals(F, batch, tot, before);
        int base[8]; { int tp = 0;
#pragma unroll
            for (int e = 0; e < 8; ++e) { base[e] = tp * 256 + before[e]; tp += (tot[e] + 255) >> 8; } }
        int my_e = 0, rank_in_wave = 0;
        if (F.tid < 256) { my_e = eidx[batch * 256 + F.tid];
#pragma unroll
            for (int e = 0; e < 8; ++e) { const unsigned long long m = __ballot(my_e == e); if (my_e == e) rank_in_wave = __popcll(m & ((1ull << F.lane) - 1ull)); if (F.lane == 0) wcnt[F.wave * 8 + e] = __popcll(m); } }
        __syncthreads();
        if (F.tid < 256) { int off = 0;
#pragma unroll
            for (int w = 0; w < 4; ++w) if (w < F.wave) off += wcnt[w * 8 + my_e];
            int bs = 0;
#pragma unroll
            for (int e = 0; e < 8; ++e) bs = (my_e == e) ? base[e] : bs;
            const int d = bs + off + rank_in_wave; dsts[F.tid] = d; slot[batch * 256 + F.tid] = d; wsort[d] = wgt[batch * 256 + F.tid]; }
        __syncthreads();
        for (int i = 0; i < 32; ++i) { const int a = F.wave * 32 + i; const int d = dsts[a]; const int r = batch * 128 + (a >> 1);
            const u32x4* src = (const u32x4*)(H8 + (size_t)r * DM); u32x4* dp = (u32x4*)(HS8 + (size_t)d * DM);
            dp[F.lane] = src[F.lane]; }
        __syncthreads();
    }
}
__device__ __forceinline__ void p17_final(Frame& F) {
    const int gw = F.vcu * NWAVES + F.wave, NGW = F.G * NWAVES; const float* mod = WSP(float, WS_MOD) + (size_t)1 * 9 * 6144; const bf16* FO = WSP(bf16, WS_FO);
    const int* slot = (const int*)(F.ws + WS_ROUTE + RT_SLOT);
    const Vec16 g0 = vec_load(F.ln_g + 2 * 1024, F.lane), b0 = vec_load(F.ln_b + 2 * 1024, F.lane), g1 = vec_load(F.ln_g + 3 * 1024, F.lane), b1 = vec_load(F.ln_b + 3 * 1024, F.lane);
    const int bb = gw / (NGW / 8) < 8 ? gw / (NGW / 8) : 7; const Vec16 g2 = vec_load(mod + (size_t)bb * 6144 + 5120, F.lane);
    ROWS_LAT( (void)b; float* yp = F.out + (size_t)r * DM; const int2 s = *(const int2*)(slot + 2 * r);
        const bf16* fa = FO + (size_t)s.x * DM, * fb = FO + (size_t)s.y * DM; const bf16* FO2 = WSP(bf16, WS_FO2);
        const bool xa = s.x >= 65536, xb = s.y >= 65536;
        f32x4 v[4]; row_load_bf(v, WSP(bf16, WS_YB) + (size_t)r * DM, F.lane); row_ln_v(v, g0, b0);
        _Pragma("unroll") for (int j = 0; j < 4; ++j) { const u32x2 a = *(const u32x2*)(fa + 4 * F.lane + 256 * j), c = *(const u32x2*)(fb + 4 * F.lane + 256 * j);
            const f32x4 f = {bflo(a.x) + bflo(c.x), bfhi(a.x) + bfhi(c.x), bflo(a.y) + bflo(c.y), bfhi(a.y) + bfhi(c.y)};
            v[j] = v[j] * ALPHA + g2.q[j] * f; }
        if (__builtin_expect(xa || xb, 0)) {
            const bf16* ea = FO2 + (size_t)(xa ? s.x - 65536 : 0) * DM, * eb = FO2 + (size_t)(xb ? s.y - 65536 : 0) * DM;
            _Pragma("unroll") for (int part = 0; part < 3; ++part, ea += (size_t)2048 * DM, eb += (size_t)2048 * DM)
            _Pragma("unroll") for (int j = 0; j < 4; ++j) { u32x2 p = *(const u32x2*)(ea + 4 * F.lane + 256 * j), q = *(const u32x2*)(eb + 4 * F.lane + 256 * j);
                if (!xa) p = (u32x2){0u, 0u}; if (!xb) q = (u32x2){0u, 0u};
                const f32x4 f2 = (f32x4){bflo(p.x), bfhi(p.x), bflo(p.y), bfhi(p.y)} + (f32x4){bflo(q.x), bfhi(q.x), bflo(q.y), bfhi(q.y)};
                v[j] += g2.q[j] * f2; } }
        row_ln_v(v, g1, b1); row_store(v, yp, F.lane); );
}

constexpr int N_PHASES = 18;
#ifndef REP_PHASE
#define REP_PHASE -1
#endif
struct Args { const float* in[25]; float* out; unsigned char* ws; int ph_lo, ph_hi; };
__global__ void __launch_bounds__(NWAVES * 64, 2) fwd_kernel(Args args) {
    extern __shared__ __attribute__((aligned(16))) unsigned char lds[];
    Frame F;
    F.lds = (LAS unsigned char*)lds;
    F.MISC = (volatile LAS unsigned*)(F.lds + MISC_OFF);
    F.wave = __builtin_amdgcn_readfirstlane((int)(threadIdx.x >> 6)); F.lane = lane_id(); F.tid = F.wave * 64 + F.lane;
    F.G = gridDim.x; { const int bx = blockIdx.x; F.vcu = (F.G % 8 == 0) ? (bx % 8) * (F.G / 8) + bx / 8 : bx; }
    F.x = args.in[0]; F.c = args.in[1]; F.ctx = args.in[2]; F.cctx = args.in[3]; F.w_mod = args.in[4]; F.b_mod = args.in[5]; F.ln_g = args.in[6]; F.ln_b = args.in[7];
    F.w_qkv = args.in[8]; F.w_o = args.in[9]; F.sink = args.in[10]; F.w_gu = args.in[11]; F.w_dn = args.in[12]; F.w_in = args.in[13]; F.conv_w = args.in[14]; F.conv_b = args.in[15];
    F.lam = args.in[16]; F.w_r = args.in[17]; F.b_r = args.in[18]; F.w_i = args.in[19]; F.b_i = args.in[20]; F.w_out = args.in[21]; F.router = args.in[22]; F.mw_gu = args.in[23]; F.mw_dn = args.in[24];
    F.out = args.out; F.ws = args.ws;
    for (int u = F.tid; u < (LDS_BYTES - LDSCTL_OFF) / 4; u += NWAVES * 64) ((LAS unsigned*)(F.lds + LDSCTL_OFF))[u] = 0u;
    __syncthreads();
    const int lo = args.ph_lo, hi = args.ph_hi;
    const bool multi = (hi - lo) > 1;
    XcdBarrier bar; bar.bar = (unsigned*)(F.ws + WS_CTL) + 1024; bar.x = 0; bar.st = nullptr;
    if (multi) bar = xcd_barrier_post((unsigned*)(F.ws + WS_CTL) + 1024, F.MISC + 8, F.wave == 0 && lane_id() == 0);
#define IN(k) (lo <= (k) && (k) < hi)
#define REFRESH() do { F.lane = lane_id(); F.tid = F.wave * 64 + F.lane; } while (0)
#define SEAM(k) do { if (IN(k) && IN((k) + 1)) xcd_barrier(bar, F.wave == 0 && lane_id() == 0); } while (0)
    const float* MOD = WSP(float, WS_MOD);
    bf16* H = WSP(bf16, WS_H); bf16* YB = WSP(bf16, WS_YB); const f32x2* ST = (const f32x2*)(F.ws + WS_STATS);

    if (IN(0)) { REFRESH(); p0_prologue(F); if (REP_PHASE == 0) { xcd_barrier(bar, F.wave == 0 && lane_id() == 0); p0_prologue(F); } } SEAM(0);
    if (IN(1)) { REFRESH(); p1_modulate(F); if (REP_PHASE == 1) { xcd_barrier(bar, F.wave == 0 && lane_id() == 0); p1_modulate(F); } } SEAM(1);
    if (IN(2)) {
        pg8::Gemm g{H, WSP(bf16, WS_WQKV), RT, QKVD, DM / 2}; pg8::StaticOrder S; S.init(RT, QKVD, F.G, (int)blockIdx.x);
        pg8::EpiQKV E{WSP(bf16, WS_QKV), WSP(float, WS_ROPE), 1.0f / 512.0f};
        pg8::gemm_phase<pg8::EpiQKV, pg8::StaticOrder, true, true, true>(F.lds + RING_OFF, g, S, E, F.wave);
        moe_convert_filler(F, (RT / 256) * (QKVD / 256), (int)blockIdx.x, 0, 9000);
    } SEAM(2);
    if (IN(3)) { att::attn_phase(WSP(bf16, WS_QKV), WSP(bf16, WS_O), F.sink, F.G, F.vcu, F.lds + RING_OFF, F.wave); if (REP_PHASE == 3) { xcd_barrier(bar, F.wave == 0 && lane_id() == 0); att::attn_phase(WSP(bf16, WS_QKV), WSP(bf16, WS_O), F.sink, F.G, F.vcu, F.lds + RING_OFF, F.wave); } } SEAM(3);
    if (IN(4)) {
        pg8::EpiResid<false> E{F.x, F.ctx, YB, MOD + 2048, 1.0f / 2048.0f, nullptr, nullptr, nullptr, WSP(float, WS_SIDE)};
        { pg8::Gemm g{WSP(bf16, WS_O), WSP(bf16, WS_WO), RT, DM, DM / 2, DM / 256}; pg8::TailOrder T{RL / 256, RC / 256, DM / 256, F.G, (int)blockIdx.x};
          pg8::gemm_phase<pg8::EpiResid<false>, pg8::TailOrder, true, true, true>(F.lds + RING_OFF, g, T, E, F.wave); }
        { pg8::Gemm g{WSP(bf16, WS_O), WSP(bf16, WS_WO), RT, DM, DM / 2, 0}; pg8::StaticOrder S; S.init(RL, DM, F.G, (int)blockIdx.x);
          pg8::gemm_phase<pg8::EpiResid<false>, pg8::StaticOrder, true, true, true>(F.lds + RING_OFF, g, S, E, F.wave); }
        tail_filler(F, (RC / 256) * (DM / 256) * 2, (int)blockIdx.x, 9000, 17500);
    } SEAM(4);
    if (IN(5)) { REFRESH(); ln_mod_pass<true>(F, true, F.ln_g, F.ln_b, 0, 3072, WSP(float, WS_SIDE)); } SEAM(5);
    if (IN(6)) {
        pg8::Gemm g{H, WSP(bf16, WS_WGU), RT, 2 * DFF, DM / 2}; pg8::StaticOrder S; S.init(RT, 2 * DFF, F.G, (int)blockIdx.x);
        pg8::EpiSwiGLU8 E{WSP(unsigned char, WS_ACT), 28};
        pg8::gemm_phase<pg8::EpiSwiGLU8, pg8::StaticOrder, true, true, true>(F.lds + RING_OFF, g, S, E, F.wave);
    } SEAM(6);
    if (IN(7)) {
        pg8::EpiResid<true> E{nullptr, nullptr, YB, MOD + 5120, 1.0f / 4096.0f, ST, F.ln_g, F.ln_b, WSP(float, WS_SIDE)};
        { pg8::Gemm g{WSP(bf16, WS_ACT), WSP(bf16, WS_WDN), RT, DM, DFF / 2, DFF / 256}; pg8::TailOrder T{RL / 256, RC / 256, DM / 256, F.G, (int)blockIdx.x};
          pg8::gemm_phase<pg8::EpiResid<true>, pg8::TailOrder, true, true, true>(F.lds + RING_OFF, g, T, E, F.wave); }
        { pg8::Gemm g{WSP(bf16, WS_ACT), WSP(bf16, WS_WDN), RT, DM, DFF / 2, 0}; pg8::StaticOrder S; S.init(RL, DM, F.G, (int)blockIdx.x);
          pg8::gemm_phase<pg8::EpiResid<true>, pg8::StaticOrder, true, true, true>(F.lds + RING_OFF, g, S, E, F.wave); }
        tail_filler(F, (RC / 256) * (DM / 256) * 2, (int)blockIdx.x, 17500, 36388);
    } SEAM(7);
    if (IN(8)) { REFRESH(); ln_mod_pass<false>(F, true, F.ln_g + 1024, F.ln_b + 1024, 1, 0, WSP(float, WS_SIDE)); } SEAM(8);
    if (IN(9)) {
        pg8::EpiLruIn E{WSP(bf16, WS_G), WSP(bf16, WS_XB)};
        { pg8::Gemm g{H, WSP(bf16, WS_WIN), RT, 2048, DM, 0}; pg8::CtxOrder T{RL / 256, RC / 256, 4, F.G, (int)blockIdx.x, 4};
          pg8::gemm_phase<pg8::EpiLruIn, pg8::CtxOrder, true, true>(F.lds + RING_OFF, g, T, E, F.wave); }
        { pg8::Gemm g{H, WSP(bf16, WS_WIN), RT, 2048, DM, 0}; pg8::StaticOrder S; S.init(RL, 2048, F.G, (int)blockIdx.x);
          pg8::gemm_phase<pg8::EpiLruIn, pg8::StaticOrder, true, true>(F.lds + RING_OFF, g, S, E, F.wave); }
        tail_filler(F, (RC / 256) * 4, (int)blockIdx.x, 36388, CV_ITEMS);
    } SEAM(9);
    {
        const lru::Ctx LC{WSP(bf16, WS_U), WSP(bf16, WS_G), WSP(bf16, WS_HH), WSP(u32x4, WS_HF), WSP(bf16, WS_WLG), F.lam, F.b_r, F.b_i};
        if (IN(10)) { REFRESH(); p10_conv(F); } SEAM(10);
        if (IN(11)) { REFRESH(); p11_lru(F, LC); if (REP_PHASE == 11) { xcd_barrier(bar, F.wave == 0 && lane_id() == 0); p11_lru(F, LC); } } SEAM(11);
    }
    if (IN(12)) {
        pg8::Gemm g{WSP(bf16, WS_HH), WSP(bf16, WS_WOUT), RL, DM, DM}; pg8::StaticOrder S; S.init(RL, DM, F.G, (int)blockIdx.x);
        pg8::EpiResid<true> E{nullptr, nullptr, YB, MOD + 9 * 6144 + 2048, 1.0f, ST, F.ln_g + 1024, F.ln_b + 1024, nullptr};
        pg8::gemm_phase<pg8::EpiResid<true>, pg8::StaticOrder, true, true>(F.lds + RING_OFF, g, S, E, F.wave);
    } SEAM(12);
    if (IN(13)) { REFRESH(); p13_ln_router(F); } SEAM(13);
    if (IN(14)) { REFRESH(); p14_gather(F); if (REP_PHASE == 14) { xcd_barrier(bar, F.wave == 0 && lane_id() == 0); p14_gather(F); } } SEAM(14);
    if (IN(15) || IN(16)) {
        REFRESH();
        int tot[8], before[8]; moe_totals(F, 0, tot, before);
        int tp[9]; tp[0] = 0;
#pragma unroll
        for (int e = 0; e < 8; ++e) tp[e + 1] = __builtin_amdgcn_readfirstlane(tp[e] + ((tot[e] + 255) >> 8));
        const int ntiles = tp[8];
        if (IN(15)) {
            pg8::Gemm g{WSP(bf16, WS_HS), WSP(bf16, WS_WMGU), ntiles * 256, 2 * DFF, DM / 2};
            pg8::MoeOrder S{ntiles, 28, ntiles * 28, F.G, (int)blockIdx.x, 28, tp[1], tp[2], tp[3], tp[4], tp[5], tp[6], tp[7]};
            pg8::EpiSwiGLU8 E{WSP(unsigned char, WS_MACT), 28};
            pg8::gemm_phase<pg8::EpiSwiGLU8, pg8::MoeOrder, true, true, true>(F.lds + RING_OFF, g, S, E, F.wave);
        } SEAM(15);
        if (IN(16)) {
            const int nfull = ntiles < 256 ? ntiles : 256;
            pg8::EpiMoeOut8 E{WSP(bf16, WS_FO), (const float*)(F.ws + WS_ROUTE + RT_WS), WSP(bf16, WS_FO2)};
            { pg8::Gemm g{WSP(bf16, WS_MACT), WSP(bf16, WS_WMDN), ntiles * 256, DM, DFF / 2, DFF / 256};
              pg8::MoeTailOrder T{ntiles - nfull, F.G, (int)blockIdx.x, tp[1], tp[2], tp[3], tp[4], tp[5], tp[6], tp[7]};
              pg8::gemm_phase<pg8::EpiMoeOut8, pg8::MoeTailOrder, true, true, true>(F.lds + RING_OFF, g, T, E, F.wave); }
            { pg8::Gemm g{WSP(bf16, WS_MACT), WSP(bf16, WS_WMDN), ntiles * 256, DM, DFF / 2, 0};
              pg8::MoeOrder S{nfull, 4, nfull * 4, F.G, (int)blockIdx.x, 4, tp[1], tp[2], tp[3], tp[4], tp[5], tp[6], tp[7]};
              pg8::gemm_phase<pg8::EpiMoeOut8, pg8::MoeOrder, true, true, true>(F.lds + RING_OFF, g, S, E, F.wave); }
        } SEAM(16);
    }
    if (IN(17)) { REFRESH(); p17_final(F); }
#undef IN
#undef SEAM
}

#ifndef N_LAUNCH_MODE
#define N_LAUNCH_MODE 1
#endif
extern "C" void kernel_launch(void* const* d_in, const int* in_sizes, int n_in, void* d_out, int out_size, void* d_ws, size_t ws_size, hipStream_t stream) {
    static int grid = 0;
    if (grid == 0) {
        if (n_in != 25 || out_size != RL * DM || ws_size < WS_END) { fprintf(stderr, "kernel_launch: unexpected shapes (n_in %d out %d ws %zu)\n", n_in, out_size, ws_size); grid = -1; return; }
        int dev = 0, cus = 0, per_cu = 0;
        if (hipGetDevice(&dev) != hipSuccess || hipDeviceGetAttribute(&cus, hipDeviceAttributeMultiprocessorCount, dev) != hipSuccess) { grid = -1; return; }
        if (hipFuncSetAttribute((const void*)fwd_kernel, hipFuncAttributeMaxDynamicSharedMemorySize, LDS_BYTES) != hipSuccess) { fprintf(stderr, "kernel_launch: hipFuncSetAttribute failed\n"); grid = -1; return; }
        if (hipOccupancyMaxActiveBlocksPerMultiprocessor(&per_cu, (const void*)fwd_kernel, NWAVES * 64, LDS_BYTES) != hipSuccess || per_cu < 1) { fprintf(stderr, "kernel_launch: occupancy query says %d\n", per_cu); per_cu = 1; }
        (void)hipGetLastError();
        grid = cus;
    }
    if (grid < 0) return;
    (void)hipMemsetAsync((char*)d_ws + WS_CTL, 0, CTL_ZERO_BYTES, stream);
    Args a{};
    for (int i = 0; i < 25; ++i) a.in[i] = (const float*)d_in[i];
    a.out = (float*)d_out; a.ws = (unsigned char*)d_ws;
#if N_LAUNCH_MODE == 1
    a.ph_lo = 0; a.ph_hi = N_PHASES;
    hipLaunchKernelGGL(fwd_kernel, dim3(grid), dim3(NWAVES * 64), LDS_BYTES, stream, a);
#else
    for (int p = 0; p < N_PHASES; ++p) { a.ph_lo = p; a.ph_hi = p + 1; hipLaunchKernelGGL(fwd_kernel, dim3(grid), dim3(NWAVES * 64), LDS_BYTES, stream, a); }
#endif
    const hipError_t le = hipPeekAtLastError();
    if (le != hipSuccess) fprintf(stderr, "kernel_launch: launch failed: %s\n", hipGetErrorName(le));
}
```
